# Optimizing an MI355X kernel written in HIP

```python
import math
import jax, jax.numpy as jnp
from jax import lax
import numpy as np

D_MODEL = 1024
BATCH = 8
SEQ = 4096
DEPTH = 2

A_HEADS = 8
A_HEAD_DIM = 64
A_WIDTH = A_HEADS * A_HEAD_DIM
MOBA_BLOCK = 256
MOBA_TOPK = 3
MOBA_QCHUNK = 16
B_HEADS = 8
B_HEAD_DIM = 64
B_WIDTH = B_HEADS * B_HEAD_DIM
IDX_HEADS = 4
IDX_DIM = 64
DSA_TOPK_MAX = 256
DSA_QCHUNK = 128
REL_BUCKETS = 32
REL_MAX_DIST = 128
N_HEADS_TOTAL = A_HEADS + B_HEADS
EPS = 1e-6

SPLIT_SIZES = (A_WIDTH, A_WIDTH, A_WIDTH, A_WIDTH,
               B_WIDTH, B_HEAD_DIM, B_HEAD_DIM, B_WIDTH,
               IDX_HEADS * IDX_DIM, IDX_DIM, IDX_HEADS,
               D_MODEL, D_MODEL)
D_IN = 4 * A_WIDTH + 2 * B_WIDTH + 2 * B_HEAD_DIM + IDX_HEADS * IDX_DIM + IDX_DIM + IDX_HEADS + 2 * D_MODEL

kernel_name = "hybrid_moba_dsa_gated_block"


def _split_points():
    pts, acc = [], 0
    for s in SPLIT_SIZES[:-1]:
        acc += s
        pts.append(acc)
    return pts


def rmsnorm(x, g):
    x32 = x.astype(jnp.float32)
    r = lax.rsqrt(jnp.mean(x32 * x32, axis=-1, keepdims=True) + EPS)
    return (x32 * r).astype(x.dtype) * g


def rel_bucket(n):
    n = jnp.maximum(n, 0)
    max_exact = REL_BUCKETS // 2
    nf = jnp.maximum(n, 1).astype(jnp.float32)
    large = max_exact + (jnp.log(nf / max_exact) / math.log(REL_MAX_DIST / max_exact)
                         * (REL_BUCKETS - max_exact)).astype(jnp.int32)
    large = jnp.minimum(large, REL_BUCKETS - 1)
    return jnp.where(n < max_exact, n, large)


def moba_attention(q, k, v, bias_table):
    B, S, H, Dh = q.shape
    nb = -(-S // MOBA_BLOCK)
    sp = nb * MOBA_BLOCK
    ntop = min(MOBA_TOPK, nb)
    pad = ((0, 0), (0, sp - S), (0, 0), (0, 0))
    kb = jnp.pad(k, pad).reshape(B, nb, MOBA_BLOCK, H, Dh)
    vb = jnp.pad(v, pad).reshape(B, nb, MOBA_BLOCK, H, Dh)
    kmean = jnp.mean(kb.astype(jnp.float32), axis=2).astype(k.dtype)
    kbh = kb.transpose(0, 3, 1, 2, 4)
    vbh = vb.transpose(0, 3, 1, 2, 4)
    scale = Dh ** -0.5
    nc = S // MOBA_QCHUNK
    qc_all = q.reshape(B, nc, MOBA_QCHUNK, H, Dh).transpose(1, 0, 2, 3, 4)
    bi = jnp.arange(B)[:, None, None, None]
    hi = jnp.arange(H)[None, :, None, None]
    offs = jnp.arange(MOBA_BLOCK)

    def chunk(args):
        ci, qi = args
        pos = ci * MOBA_QCHUNK + jnp.arange(MOBA_QCHUNK)
        qblk = (ci * MOBA_QCHUNK) // MOBA_BLOCK
        qh = qi.transpose(0, 2, 1, 3)
        gate = jnp.einsum('bhqd,bnhd->bhqn', qh, kmean).astype(jnp.float32)
        gate = jnp.where(jnp.arange(nb) < qblk, gate, -jnp.inf)
        _, sel = lax.top_k(gate, ntop)
        valid = sel < qblk
        kg = kbh[bi, hi, sel]
        vg = vbh[bi, hi, sel]
        keypos = sel[..., None] * MOBA_BLOCK + offs
        dist = pos[None, None, :, None, None] - keypos
        b_past = bias_table[rel_bucket(dist), jnp.arange(H)[None, :, None, None, None]]
        lp = (jnp.einsum('bhqd,bhqjkd->bhqjk', qh, kg) * scale).astype(jnp.float32) + b_past.astype(jnp.float32)
        lp = jnp.where(valid[..., None], lp, -jnp.inf)
        kown = lax.dynamic_index_in_dim(kbh, qblk, axis=2, keepdims=False)
        vown = lax.dynamic_index_in_dim(vbh, qblk, axis=2, keepdims=False)
        dist_o = pos[:, None] - (qblk * MOBA_BLOCK + offs)[None, :]
        b_own = bias_table[rel_bucket(dist_o)].transpose(2, 0, 1)
        lo = (jnp.einsum('bhqd,bhkd->bhqk', qh, kown) * scale).astype(jnp.float32) + b_own.astype(jnp.float32)
        lo = jnp.where(dist_o >= 0, lo, -jnp.inf)
        logits = jnp.concatenate([lp.reshape(B, H, MOBA_QCHUNK, ntop * MOBA_BLOCK), lo], axis=-1)
        p = jax.nn.softmax(logits, axis=-1).astype(v.dtype)
        pp = p[..., :ntop * MOBA_BLOCK].reshape(B, H, MOBA_QCHUNK, ntop, MOBA_BLOCK)
        po = p[..., ntop * MOBA_BLOCK:]
        return (jnp.einsum('bhqjk,bhqjkd->bqhd', pp, vg)
                + jnp.einsum('bhqk,bhkd->bqhd', po, vown))

    out = lax.map(chunk, (jnp.arange(nc), qc_all))
    return out.transpose(1, 0, 2, 3, 4).reshape(B, S, H, Dh)


def dsa_attention(q, k, v, q_idx, k_idx, w_idx, bias_table):
    B, S, H, Dh = q.shape
    topk = min(DSA_TOPK_MAX, S // 4)
    nc = S // DSA_QCHUNK
    scale = Dh ** -0.5
    idx_scale = IDX_DIM ** -0.5
    w_scale = IDX_HEADS ** -0.5
    qc_all = q.reshape(B, nc, DSA_QCHUNK, H, Dh).transpose(1, 0, 2, 3, 4)
    qic_all = q_idx.reshape(B, nc, DSA_QCHUNK, IDX_HEADS, IDX_DIM).transpose(1, 0, 2, 3, 4)
    wic_all = w_idx.reshape(B, nc, DSA_QCHUNK, IDX_HEADS).transpose(1, 0, 2, 3)
    bi = jnp.arange(B)[:, None, None]
    key_pos = jnp.arange(S)

    def chunk(args):
        ci, qc, qic, wic = args
        pos = ci * DSA_QCHUNK + jnp.arange(DSA_QCHUNK)
        rel = jax.nn.relu(jnp.einsum('bqhd,bsd->bqhs', qic, k_idx) * idx_scale)
        score = jnp.einsum('bqhs,bqh->bqs', rel, wic * w_scale).astype(jnp.float32)
        score = jnp.where(key_pos[None, None, :] <= pos[None, :, None], score, -jnp.inf)
        _, sel = lax.top_k(score, topk)
        valid = sel <= pos[None, :, None]
        kg = k[bi, sel]
        vg = v[bi, sel]
        dist = pos[None, :, None] - sel
        bias = bias_table[rel_bucket(dist)].transpose(0, 3, 1, 2)
        logits = (jnp.einsum('bqhd,bqkd->bhqk', qc, kg) * scale).astype(jnp.float32) + bias.astype(jnp.float32)
        logits = jnp.where(valid[:, None], logits, -jnp.inf)
        p = jax.nn.softmax(logits, axis=-1).astype(v.dtype)
        return jnp.einsum('bhqk,bqkd->bqhd', p, vg)

    out = lax.map(chunk, (jnp.arange(nc), qc_all, qic_all, wic_all))
    return out.transpose(1, 0, 2, 3, 4).reshape(B, S, H, Dh)


def hybrid_layer(x, g_norm, w_in, qn_a, kn_a, qn_b, kn_b, w_br_a, w_br_b, w_out, rel_bias):
    B, S, _ = x.shape
    h = rmsnorm(x, g_norm)
    proj = jnp.einsum('bsd,de->bse', h, w_in)
    (qa, ka, va, ga, qb, kb, vb, gb, qi, ki, wi, ma, mb) = jnp.split(proj, _split_points(), axis=-1)
    qa = rmsnorm(qa.reshape(B, S, A_HEADS, A_HEAD_DIM), qn_a)
    ka = rmsnorm(ka.reshape(B, S, A_HEADS, A_HEAD_DIM), kn_a)
    va = va.reshape(B, S, A_HEADS, A_HEAD_DIM)
    ya = moba_attention(qa, ka, va, rel_bias[:, :A_HEADS]).reshape(B, S, A_WIDTH) * jax.nn.silu(ga)
    qb = rmsnorm(qb.reshape(B, S, B_HEADS, B_HEAD_DIM), qn_b)
    kb = rmsnorm(kb, kn_b)
    qi = qi.reshape(B, S, IDX_HEADS, IDX_DIM)
    yb = dsa_attention(qb, kb, vb, qi, ki, wi, rel_bias[:, A_HEADS:]).reshape(B, S, B_WIDTH) * jax.nn.silu(gb)
    merged = (jax.nn.sigmoid(ma) * jnp.einsum('bsw,wd->bsd', ya, w_br_a)
              + jax.nn.sigmoid(mb) * jnp.einsum('bsw,wd->bsd', yb, w_br_b))
    return x + jnp.einsum('bsd,de->bse', merged, w_out)


def setup_inputs(seed: int = 0) -> dict:
    key = jax.random.key(seed)
    ks = jax.random.split(key, 12)
    f32 = jnp.float32
    x = jax.random.normal(ks[0], (BATCH, SEQ, D_MODEL), f32)
    norm_g = 1.0 + 0.02 * jax.random.normal(ks[1], (DEPTH, D_MODEL), f32)
    w_in = jax.random.normal(ks[2], (DEPTH, D_MODEL, D_IN), f32) * D_MODEL ** -0.5
    q_norm_a = 1.0 + 0.02 * jax.random.normal(ks[3], (DEPTH, A_HEAD_DIM), f32)
    k_norm_a = 1.0 + 0.02 * jax.random.normal(ks[4], (DEPTH, A_HEAD_DIM), f32)
    q_norm_b = 1.0 + 0.02 * jax.random.normal(ks[5], (DEPTH, B_HEAD_DIM), f32)
    k_norm_b = 1.0 + 0.02 * jax.random.normal(ks[6], (DEPTH, B_HEAD_DIM), f32)
    w_branch_a = jax.random.normal(ks[7], (DEPTH, A_WIDTH, D_MODEL), f32) * A_WIDTH ** -0.5
    w_branch_b = jax.random.normal(ks[8], (DEPTH, B_WIDTH, D_MODEL), f32) * B_WIDTH ** -0.5
    w_out = jax.random.normal(ks[9], (DEPTH, D_MODEL, D_MODEL), f32) * D_MODEL ** -0.5
    rel_bias = 0.5 * jax.random.normal(ks[10], (REL_BUCKETS, N_HEADS_TOTAL), f32)
    return {"x": x, "norm_g": norm_g, "w_in": w_in,
            "q_norm_a": q_norm_a, "k_norm_a": k_norm_a,
            "q_norm_b": q_norm_b, "k_norm_b": k_norm_b,
            "w_branch_a": w_branch_a, "w_branch_b": w_branch_b,
            "w_out": w_out, "rel_bias": rel_bias}


def reference(x, norm_g, w_in, q_norm_a, k_norm_a, q_norm_b, k_norm_b,
              w_branch_a, w_branch_b, w_out, rel_bias):
    h = x
    for l in range(DEPTH):
        h = hybrid_layer(h, norm_g[l], w_in[l], q_norm_a[l], k_norm_a[l], q_norm_b[l], k_norm_b[l],
                         w_branch_a[l], w_branch_b[l], w_out[l], rel_bias)
    return h
```

```cpp
#include <hip/hip_runtime.h>
#include <cstdio>
#include <cstdint>
#include <cmath>
namespace pg8 {
#define PG8_LAS __attribute__((address_space(3)))
typedef unsigned short bf16_t;
typedef short bf16x8 __attribute__((ext_vector_type(8)));
typedef float f32x4 __attribute__((ext_vector_type(4)));
typedef unsigned u32x4 __attribute__((ext_vector_type(4)));
constexpr int BM = 256, BK = 64, HALF = 128, HTB = HALF * BK * 2  , STAGE_BYTES = 8 * HTB, NXCD = 8, WGM = 8;

__host__ __device__ __forceinline__ int lds_byte(int r, int c) { const int st = (r >> 4) * 2 + (c >> 5), rr = r & 15, cc = c & 31, ob = rr * 64 + cc * 2; return st * 1024 + (ob ^ (((ob >> 9) & 1) << 5)); }
__host__ __device__ __forceinline__ void stage_rc(int b, int& R, int& C) { const int st = b / 1024, sb = b % 1024, swz = sb ^ (((sb >> 9) & 1) << 5); R = (st >> 1) * 16 + swz / 64; C = (st & 1) * 32 + (swz % 64) / 2; }
__host__ __device__ __forceinline__ int perm32(int rho) { const int n = rho >> 4, i = rho & 15; return 8 * (i >> 2) + 4 * n + (i & 3); }

struct Unit { int pm, pn; };
struct Gemm { const bf16_t* A; const bf16_t* Bt; int M, N, K; };

struct StaticOrder {
    int nM, nN, nwg, G, c;
    __host__ __device__ void init(int M, int N, int G_, int c_) { nM = M / BM; nN = N / BM; nwg = nM * nN; G = G_; c = c_; }
    __host__ __device__ bool next(int i, Unit& u) const {
        const long L = (long)i * G + c; if (L >= nwg) return false;
        int wgid = (int)L; { const int q = nwg / NXCD, r = nwg % NXCD, xcd = wgid % NXCD, off = wgid / NXCD; wgid = (xcd < r ? xcd * (q + 1) : r * (q + 1) + (xcd - r) * q) + off; }
        const int nig = WGM * nN, gid = wgid / nig, fm = gid * WGM, gsz = (nM - fm) < WGM ? (nM - fm) : WGM;
        u.pm = fm + ((wgid % nig) % gsz); u.pn = (wgid % nig) / gsz; return true;
    }
    __device__ __forceinline__ void a_ready(const Unit&) const {}
    __device__ __forceinline__ void done(const Unit&) const {}
};

__device__ __forceinline__ unsigned cvt_pk_bf16(float lo, float hi) { unsigned r; asm volatile("v_cvt_pk_bf16_f32 %0, %1, %2" : "=v"(r) : "v"(lo), "v"(hi)); return r; }
template <class Epi, class Sched, bool ALIGN_EPI = false, bool SP2 = false>
__device__ __forceinline__ void gemm_phase(PG8_LAS unsigned char* lds, const Gemm g, const Sched& S, const Epi& E) {
    int tid_ = threadIdx.x; asm volatile("" : "+v"(tid_));
    const int tid = tid_, wid = __builtin_amdgcn_readfirstlane(tid >> 6), lane = tid & 63, wr = wid >> 2, wc = wid & 3, fr = lane & 15, fq = lane >> 4;
    const int K = g.K, nt = K / BK;
    unsigned voffA[2], voffB[2];
#pragma unroll
    for (int i = 0; i < 2; ++i) { int R, C; stage_rc(tid * 16 + i * 8192, R, C); const int Rb = Epi::PERM ? ((R & ~31) + perm32(R & 31)) : R;
        voffA[i] = (unsigned)(R * K + C) * 2u; voffB[i] = (unsigned)(Rb * K + C) * 2u; }
    const size_t kstep = (size_t)(BK * 2);
    const size_t hstep = (size_t)HALF * K * 2;
    const size_t tstep = 2 * hstep;
    const unsigned ldsw = (unsigned)wid * 1024u;
    const int aoff = lds_byte(wr * 64 + fr, fq * 8), boff = lds_byte(wc * 32 + fr, fq * 8);
#define PG8_SA(b, h) (((b) * 2 + (h)) * HTB)
#define PG8_SB(b, h) ((4 + (b) * 2 + (h)) * HTB)
#define PG8_STAGE(bufoff, gbase, voff) do { _Pragma("unroll") for (int _i = 0; _i < 2; ++_i) \
        __builtin_amdgcn_global_load_lds((const unsigned*)((const char*)(gbase) + (voff)[_i]), (PG8_LAS unsigned*)(lds + (bufoff) + ldsw + _i * 8192), 16, 0, 0); } while (0)
#define PG8_LDA(dst, b, h) do { _Pragma("unroll") for (int m = 0; m < 4; ++m) _Pragma("unroll") for (int k = 0; k < 2; ++k) dst[m][k] = *(const PG8_LAS bf16x8*)(lds + PG8_SA(b, h) + aoff + m * 2048 + k * 1024); } while (0)
#define PG8_LDB(dst, b, h) do { _Pragma("unroll") for (int n = 0; n < 2; ++n) _Pragma("unroll") for (int k = 0; k < 2; ++k) dst[n][k] = *(const PG8_LAS bf16x8*)(lds + PG8_SB(b, h) + boff + n * 2048 + k * 1024); } while (0)
#define PG8_MMA(ai, bj, At, Bt) do { __builtin_amdgcn_s_setprio(1); _Pragma("unroll") for (int m = 0; m < 4; ++m) _Pragma("unroll") for (int n = 0; n < 2; ++n) _Pragma("unroll") for (int k = 0; k < 2; ++k) \
        acc[ai][bj][m][n] = __builtin_amdgcn_mfma_f32_16x16x32_bf16(Bt[n][k], At[m][k], acc[ai][bj][m][n], 0, 0, 0); __builtin_amdgcn_s_setprio(0); } while (0)
#define PG8_WAIT_V(n) asm volatile("s_waitcnt vmcnt(" #n ")" ::: "memory")
#define PG8_WAIT_L(n) asm volatile("s_waitcnt lgkmcnt(" #n ")" ::: "memory")
#define PG8_BAR __builtin_amdgcn_s_barrier()
#define PG8_SCHED __builtin_amdgcn_sched_barrier(0)
    Unit cur, nxt; int ui = 0;
    if (!S.next(0, cur)) return;
    f32x4 acc[2][2][4][2];
#pragma unroll
    for (int a = 0; a < 2; ++a)
#pragma unroll
        for (int b = 0; b < 2; ++b)
#pragma unroll
            for (int m = 0; m < 4; ++m)
#pragma unroll
                for (int n = 0; n < 2; ++n) acc[a][b][m][n] = (f32x4){0.f, 0.f, 0.f, 0.f};
    bf16x8 At[4][2], B0[2][2], B1[2][2];
    const char* cA = (const char*)g.A + (size_t)cur.pm * tstep; const char* cB = (const char*)g.Bt + (size_t)cur.pn * tstep;
    S.a_ready(cur);
    if constexpr (SP2) {
        PG8_STAGE(PG8_SB(0, 0), cB, voffB); PG8_STAGE(PG8_SB(0, 1), cB + hstep, voffB); PG8_STAGE(PG8_SA(0, 0), cA, voffA); PG8_STAGE(PG8_SA(0, 1), cA + hstep, voffA);
        if (wr == 1) PG8_BAR;
        PG8_WAIT_V(2); PG8_BAR;
        PG8_STAGE(PG8_SB(1, 0), cB + kstep, voffB); PG8_STAGE(PG8_SA(1, 0), cA + kstep, voffA); PG8_STAGE(PG8_SB(1, 1), cB + hstep + kstep, voffB);
        PG8_WAIT_V(6); PG8_BAR;
    } else {
        PG8_STAGE(PG8_SB(0, 0), cB, voffB); PG8_STAGE(PG8_SA(0, 0), cA, voffA); PG8_STAGE(PG8_SB(0, 1), cB + hstep, voffB); PG8_STAGE(PG8_SA(0, 1), cA + hstep, voffA);
        if (wr == 1) PG8_BAR;
        PG8_WAIT_V(4); PG8_BAR;
        PG8_STAGE(PG8_SB(1, 0), cB + kstep, voffB); PG8_STAGE(PG8_SA(1, 0), cA + kstep, voffA); PG8_STAGE(PG8_SB(1, 1), cB + hstep + kstep, voffB);
        PG8_WAIT_V(6); PG8_BAR;
    }
    for (;;) {
        const bool has_next = S.next(ui + 1, nxt);
        const char* nA = has_next ? (const char*)g.A + (size_t)nxt.pm * tstep : cA; const char* nB = has_next ? (const char*)g.Bt + (size_t)nxt.pn * tstep : cB;
        for (int t = 0; t < nt; t += 2) {
            const bool last = (t == nt - 2);
            const char* a1 = cA + (size_t)(t + 1) * kstep;
            const char* a2 = last ? nA : cA + (size_t)(t + 2) * kstep; const char* b2 = last ? nB : cB + (size_t)(t + 2) * kstep;
            const char* a3 = a2 + kstep; const char* b3 = b2 + kstep;
            if (last && has_next) S.a_ready(nxt);
            if constexpr (SP2) {
            PG8_LDB(B0, 0, 0); PG8_LDB(B1, 0, 1); PG8_SCHED; PG8_LDA(At, 0, 0); PG8_STAGE(PG8_SA(1, 1), a1 + hstep, voffA);
            PG8_WAIT_V(8); PG8_WAIT_L(0); PG8_BAR; PG8_MMA(0, 0, At, B0); PG8_MMA(0, 1, At, B1); PG8_BAR; PG8_SCHED;
            PG8_LDA(At, 0, 1); PG8_STAGE(PG8_SB(0, 0), b2, voffB); PG8_STAGE(PG8_SB(0, 1), b2 + hstep, voffB); PG8_STAGE(PG8_SA(0, 0), a2, voffA);
            PG8_WAIT_V(8); PG8_WAIT_L(0); PG8_BAR; PG8_MMA(1, 0, At, B0); PG8_MMA(1, 1, At, B1); PG8_BAR; PG8_SCHED;
            PG8_LDB(B0, 1, 0); PG8_LDB(B1, 1, 1); PG8_SCHED; PG8_LDA(At, 1, 0); PG8_STAGE(PG8_SA(0, 1), a2 + hstep, voffA);
            PG8_WAIT_V(8); PG8_WAIT_L(0); PG8_BAR; PG8_MMA(0, 0, At, B0); PG8_MMA(0, 1, At, B1); PG8_BAR; PG8_SCHED;
            PG8_LDA(At, 1, 1); PG8_STAGE(PG8_SB(1, 0), b3, voffB); PG8_STAGE(PG8_SB(1, 1), b3 + hstep, voffB); PG8_STAGE(PG8_SA(1, 0), a3, voffA);
            PG8_WAIT_V(8); PG8_WAIT_L(0); PG8_BAR; PG8_MMA(1, 0, At, B0); PG8_MMA(1, 1, At, B1); PG8_BAR; PG8_SCHED;
            } else {
            PG8_LDB(B0, 0, 0); PG8_SCHED; PG8_LDA(At, 0, 0); PG8_STAGE(PG8_SA(1, 1), a1 + hstep, voffA);
            PG8_WAIT_L(8); PG8_BAR; PG8_WAIT_L(0); PG8_MMA(0, 0, At, B0); PG8_BAR; PG8_SCHED;
            PG8_LDB(B1, 0, 1); PG8_STAGE(PG8_SB(0, 0), b2, voffB);
            PG8_BAR; PG8_WAIT_L(0); PG8_MMA(0, 1, At, B1); PG8_BAR;
            PG8_LDA(At, 0, 1); PG8_STAGE(PG8_SA(0, 0), a2, voffA);
            PG8_BAR; PG8_WAIT_L(0); PG8_MMA(1, 0, At, B0); PG8_BAR; PG8_SCHED;
            PG8_STAGE(PG8_SB(0, 1), b2 + hstep, voffB);
            PG8_WAIT_V(6); PG8_BAR; PG8_MMA(1, 1, At, B1); PG8_BAR;
            PG8_LDB(B0, 1, 0); PG8_SCHED; PG8_LDA(At, 1, 0); PG8_STAGE(PG8_SA(0, 1), a2 + hstep, voffA);
            PG8_WAIT_L(8); PG8_BAR; PG8_WAIT_L(0); PG8_MMA(0, 0, At, B0); PG8_BAR; PG8_SCHED;
            PG8_LDB(B1, 1, 1); PG8_STAGE(PG8_SB(1, 0), b3, voffB);
            PG8_BAR; PG8_WAIT_L(0); PG8_MMA(0, 1, At, B1); PG8_BAR;
            PG8_LDA(At, 1, 1); PG8_STAGE(PG8_SA(1, 0), a3, voffA);
            PG8_BAR; PG8_WAIT_L(0); PG8_MMA(1, 0, At, B0); PG8_BAR; PG8_SCHED;
            PG8_STAGE(PG8_SB(1, 1), b3 + hstep, voffB);
            PG8_WAIT_V(6); PG8_BAR; PG8_MMA(1, 1, At, B1); PG8_BAR;
            }
        }
        if constexpr (ALIGN_EPI) { if (wr == 0) PG8_BAR; }
        if constexpr (!Epi::AFTER_DRAIN) { E(acc, cur, wr, wc, fr, fq); S.done(cur); }
        if (!has_next) break;
#pragma unroll
        for (int a = 0; a < 2; ++a)
#pragma unroll
            for (int b = 0; b < 2; ++b)
#pragma unroll
                for (int m = 0; m < 4; ++m)
#pragma unroll
                    for (int n = 0; n < 2; ++n) acc[a][b][m][n] = (f32x4){0.f, 0.f, 0.f, 0.f};
        cur = nxt; cA = nA; cB = nB; ++ui;
        if constexpr (ALIGN_EPI) { if (wr == 1) PG8_BAR; }
    }
    PG8_WAIT_V(0);
    if constexpr (!ALIGN_EPI) { if (wr == 0) PG8_BAR; }
    PG8_BAR;
    if constexpr (Epi::AFTER_DRAIN) { E.fused(acc, cur, wr, wc, fr, fq, lds, wid, lane); S.done(cur); }
#undef PG8_SA
#undef PG8_SB
#undef PG8_STAGE
#undef PG8_LDA
#undef PG8_LDB
#undef PG8_MMA
#undef PG8_WAIT_V
#undef PG8_WAIT_L
#undef PG8_BAR
#undef PG8_SCHED
}
}
#define GAS __attribute__((address_space(1)))
#define LAS __attribute__((address_space(3)))
typedef unsigned short bf16;
typedef unsigned v4u __attribute__((ext_vector_type(4)));
typedef float f32x4 __attribute__((ext_vector_type(4)));
typedef short bf16x8 __attribute__((ext_vector_type(8)));
typedef GAS unsigned gu32;
typedef GAS unsigned long long gu64;
#define RLX_AGENT __ATOMIC_RELAXED, __HIP_MEMORY_SCOPE_AGENT
#define LDS_WAIT() asm volatile("s_waitcnt lgkmcnt(0)" ::: "memory")
#define VM_WAIT() asm volatile("s_waitcnt vmcnt(0)" ::: "memory")
__device__ __forceinline__ unsigned long long rt() { return __builtin_amdgcn_s_memrealtime(); }
__device__ __forceinline__ unsigned f2bf(float f) { unsigned u = __builtin_bit_cast(unsigned, f); return (u + 0x7fffu + ((u >> 16) & 1u)) >> 16; }
__device__ __forceinline__ unsigned pk2(float lo, float hi) { return f2bf(lo) | (f2bf(hi) << 16); }
#define XB_TMO      128
#define XB_XCNT(j)  (256  + 64 * (j))
#define XB_XSUB(j)  (1280 + 64 * (j))
#define XB_XGEN(j)  (2304 + 64 * (j))
#define XB_TOP      3328
#define XB_TOPGEN   3392
#define XCD_BAR_WORDS 3456
#define XB_SPIN_CAP (1u << 18)

__device__ __forceinline__ unsigned xb_ld(unsigned* p)              { return __hip_atomic_load(p, __ATOMIC_RELAXED, __HIP_MEMORY_SCOPE_AGENT); }
__device__ __forceinline__ unsigned xb_add(unsigned* p, unsigned v) { return __hip_atomic_fetch_add(p, v, __ATOMIC_RELAXED, __HIP_MEMORY_SCOPE_AGENT); }
__device__ __forceinline__ unsigned xb_xcc_id() { return (unsigned)__builtin_amdgcn_s_getreg((3 << 11) | 20) & 0xFu; }
#define XB_SPIN(cond, bar) do { unsigned _sp = 0; while (cond) { __builtin_amdgcn_s_sleep(1); \
    if ((++_sp & 255u) == 0u) { if (xb_ld(&(bar)[XB_TMO])) break; if (_sp > XB_SPIN_CAP) { atomicAdd(&(bar)[XB_TMO], 1u); break; } } } } while (0)

struct XcdBarrier {
    unsigned* bar; unsigned x;
    volatile LAS unsigned* st;
};

__device__ __forceinline__ XcdBarrier xcd_barrier_post(unsigned* bar, volatile LAS unsigned* st) {
    XcdBarrier b; b.bar = bar; b.x = xb_xcc_id(); b.st = st;
    if (threadIdx.x == 0) (void)xb_add(&bar[XB_XCNT(b.x)], 1u);
    return b;
}
__device__ __forceinline__ void xcd_barrier_complete(unsigned* bar, unsigned x, unsigned& nloc, unsigned& nx) {
    const unsigned G = gridDim.x * gridDim.y * gridDim.z;
    unsigned sum, cnt, mine, sp = 0u;
    for (;;) {
        sum = 0u; cnt = 0u; mine = 0u;
#pragma unroll
        for (unsigned j = 0; j < 16; ++j) { const unsigned c = xb_ld(&bar[XB_XCNT(j)]); sum += c; cnt += (c > 0u) ? 1u : 0u; mine = (j == x) ? c : mine; }
        if (sum == G) break;
        __builtin_amdgcn_s_sleep(1);
        if ((++sp & 255u) == 0u) { if (xb_ld(&bar[XB_TMO])) break; if (sp > XB_SPIN_CAP) { atomicAdd(&bar[XB_TMO], 1u); break; } }
    }
    nloc = mine > 0u ? mine : 1u; nx = cnt > 0u ? cnt : 1u;
}

__device__ __forceinline__ void xcd_barrier(const XcdBarrier& b) {
    asm volatile("s_waitcnt vmcnt(0)" ::: "memory");
    __syncthreads();
    if (threadIdx.x == 0) {
        unsigned* bar = b.bar;
        __builtin_amdgcn_s_waitcnt(0);
        unsigned nloc = b.st[0], nx = b.st[1];
        if (nloc == 0u) { xcd_barrier_complete(bar, b.x, nloc, nx); b.st[0] = nloc; b.st[1] = nx; }
        const unsigned old = xb_add(&bar[XB_XSUB(b.x)], 1u);
        const unsigned gen = old / nloc;
        if (old + 1u == (gen + 1u) * nloc) {
            __builtin_amdgcn_fence(__ATOMIC_RELEASE, "agent");
            asm volatile("s_waitcnt vmcnt(0)" ::: "memory");
            const unsigned og = xb_add(&bar[XB_TOP], 1u);
            const unsigned tg = og / nx;
            if (og + 1u == (tg + 1u) * nx) xb_add(&bar[XB_TOPGEN], 1u);
            else XB_SPIN(xb_ld(&bar[XB_TOPGEN]) == tg, bar);
            __builtin_amdgcn_fence(__ATOMIC_ACQUIRE, "agent");
            xb_add(&bar[XB_XGEN(b.x)], 1u);
            asm volatile("s_waitcnt vmcnt(0)" ::: "memory");
        } else {
            XB_SPIN(xb_ld(&bar[XB_XGEN(b.x)]) == gen, bar);
            __builtin_amdgcn_fence(__ATOMIC_ACQUIRE, "agent");
            asm volatile("s_waitcnt vmcnt(0)" ::: "memory");
        }
    }
    __syncthreads();
}

constexpr int BATCH = 8, SEQ = 4096, DM = 1024, TOK = BATCH * SEQ, DEPTH = 2;
constexpr int DIN = 5572, NIN = 5632;
constexpr int NH = 8, HD = 64, AW = 512;
constexpr float EPS = 1e-6f;
constexpr float LOG2E = 1.4426950408889634f;
constexpr float C2 = 0.125f * LOG2E;
constexpr int NWAVES = 8;
constexpr int NPHASE = 1 + 5 * DEPTH;

constexpr size_t MiB = 1u << 20;
constexpr size_t WS_CTL = 0, CTL_ZERO_BYTES = 1 * MiB;
constexpr size_t WS_WIN = 1 * MiB;
constexpr size_t WS_WBR = 23 * MiB;
constexpr size_t WS_WOUT = 27 * MiB;
constexpr size_t WS_RSS = 31 * MiB;
constexpr size_t WS_KMP = 33 * MiB;
constexpr size_t WS_WI = 34 * MiB;
constexpr size_t WS_KB = 35 * MiB, WS_VB = 39 * MiB, WS_KI = 43 * MiB;
constexpr size_t WS_QI = 47 * MiB;
constexpr size_t WS_BM = 63 * MiB;
constexpr size_t WS_XB = 80 * MiB;
constexpr size_t WS_QA = 144 * MiB, WS_KA = 176 * MiB, WS_VA = 208 * MiB, WS_SGA = 240 * MiB, WS_QB = 272 * MiB, WS_SGB = 304 * MiB;
constexpr size_t WS_TMP = 144 * MiB;
constexpr size_t WS_SMA = 336 * MiB, WS_SMB = 400 * MiB;
constexpr size_t WS_END = 464 * MiB;
constexpr int CW_BAR = 4096;

constexpr int RING_BYTES = 131072;
constexpr int LDSCTL_OFF = RING_BYTES + 28672, MISC_OFF = LDSCTL_OFF + 320;
constexpr int LDS_BYTES = 163840;
static_assert(MISC_OFF + 128 <= LDS_BYTES, "LDS map");

typedef unsigned long long u64;

__device__ __forceinline__ float bf2f(unsigned short v) { return __uint_as_float(((unsigned)v) << 16); }
__device__ __forceinline__ float bflo(unsigned w) { return __uint_as_float(w << 16); }
__device__ __forceinline__ float bfhi(unsigned w) { return __uint_as_float(w & 0xffff0000u); }
__device__ __forceinline__ float sigmoidf_(float v) { return __builtin_amdgcn_rcpf(1.0f + __builtin_amdgcn_exp2f(-v * LOG2E)); }

#define PHASE_TID() int tid_o = threadIdx.x; asm volatile("" : "+v"(tid_o)); const int ptid = tid_o, plane = tid_o & 63
struct Frame {
    LAS unsigned char* lds;
    volatile LAS unsigned* MISC;
    gu32* ctl;
    int wave, vcu, G;
    unsigned char* ws;
    const float* in[11];
    float* out;
};

__host__ __device__ __forceinline__ int win_src(int n0, int& nvalid) {
    const int pn = n0 >> 8, c = n0 & 255, bj = c >> 7, wc = (c >> 5) & 3; nvalid = 32;
    if (pn < 2) return 0 + 64 * (4 * pn + wc) + 32 * bj;
    if (pn < 4) return 512 + 64 * (4 * (pn - 2) + wc) + 32 * bj;
    if (pn < 6) return 1024 + 256 * (pn - 4) + c;
    if (pn < 8) return 1536 + 256 * (pn - 6) + c;
    if (pn < 10) return 2048 + 64 * (4 * (pn - 8) + wc) + 32 * bj;
    if (pn == 10) {
        if (wc == 0) return 2560 + 32 * bj;
        if (wc == 1) return 2624 + 32 * bj;
        if (wc == 2) return 3456 + 32 * bj;
        if (bj == 0) { nvalid = 4; return 3520; }
        nvalid = 0; return 0;
    }
    if (pn == 11) return 3200 + c;
    if (pn < 14) return 2688 + 256 * (pn - 12) + c;
    if (pn < 18) return 3524 + 256 * (pn - 14) + c;
    return 4548 + 256 * (pn - 18) + c;
}

__device__ __forceinline__ float wave_sum(float v) {
#pragma unroll
    for (int o = 1; o < 64; o <<= 1) v += __shfl_xor(v, o);
    return v;
}
__device__ __forceinline__ void tr_item(const float* W, int ldw, int src0, int nvalid, const float* gk, bf16* WT, int K, int row0, int k0, LAS float* scr, int lane) {
    const int j = lane & 31;
#pragma unroll 8
    for (int i = 0; i < 32; ++i) { const int kk = 2 * i + (lane >> 5);
        float v = 0.f; if (j < nvalid) { v = W[(size_t)(k0 + kk) * ldw + src0 + j]; if (gk) v *= gk[k0 + kk]; }
        scr[kk * 33 + j] = v; }
    LDS_WAIT(); asm volatile("" ::: "memory");
    const int c = lane & 7;
#pragma unroll
    for (int jj = 0; jj < 4; ++jj) { const int n = (lane >> 3) + 8 * jj; const LAS float* s = scr + (8 * c) * 33 + n;
        v4u o; o.x = pk2(s[0 * 33], s[1 * 33]); o.y = pk2(s[2 * 33], s[3 * 33]); o.z = pk2(s[4 * 33], s[5 * 33]); o.w = pk2(s[6 * 33], s[7 * 33]);
        *(GAS v4u*)(WT + (size_t)(row0 + n) * K + k0 + 8 * c) = o; }
    LDS_WAIT(); asm volatile("" ::: "memory");
}
__device__ __forceinline__ void p0_prologue(Frame& F) {
    PHASE_TID();
    LAS float* scr = (LAS float*)(F.lds + F.wave * 16384);
    const int gw = F.vcu * NWAVES + F.wave, NGW = F.G * NWAVES;
    constexpr int I_IN = (DM / 64) * (NIN / 32), I_BR = (AW / 64) * (DM / 32), I_OUT = (DM / 64) * (DM / 32);
    constexpr int PER_L = I_IN + 2 * I_BR + I_OUT;
    for (int it = gw; it < DEPTH * PER_L; it += NGW) {
        const int l = it / PER_L; int r = it % PER_L;
        if (r < I_IN) { const int kb = r / (NIN / 32), nb = r % (NIN / 32); int nvalid; const int src0 = win_src(32 * nb, nvalid);
            tr_item(F.in[2] + (size_t)l * DM * DIN, DIN, src0, nvalid, F.in[1] + l * DM, (bf16*)(F.ws + WS_WIN) + (size_t)l * NIN * DM, DM, 32 * nb, 64 * kb, scr, plane); continue; }
        r -= I_IN;
        if (r < 2 * I_BR) { const int which = r / I_BR; r %= I_BR; const int kb = r / (DM / 32), nb = r % (DM / 32);
            tr_item((which ? F.in[8] : F.in[7]) + (size_t)l * AW * DM, DM, 32 * nb, 32, nullptr, (bf16*)(F.ws + WS_WBR) + (size_t)l * 2048 * AW, AW, which * 1024 + 32 * nb, 64 * kb, scr, plane); continue; }
        r -= 2 * I_BR;
        { const int kb = r / (DM / 32), nb = r % (DM / 32);
            tr_item(F.in[9] + (size_t)l * DM * DM, DM, 32 * nb, 32, nullptr, (bf16*)(F.ws + WS_WOUT) + (size_t)l * DM * DM, DM, 32 * nb, 64 * kb, scr, plane); }
    }
    const float* x = F.in[0]; bf16* XB = (bf16*)(F.ws + WS_XB); float* RSS = (float*)(F.ws + WS_RSS);
    for (int m = gw; m < TOK; m += NGW) {
        const GAS f32x4* xr = (const GAS f32x4*)(x + (size_t)m * DM) + plane;
        f32x4 v[4]; float s = 0.f;
#pragma unroll
        for (int j = 0; j < 4; ++j) { v[j] = xr[64 * j]; s += (v[j].x * v[j].x + v[j].y * v[j].y) + (v[j].z * v[j].z + v[j].w * v[j].w); }
        s = wave_sum(s);
        GAS u64* o8 = (GAS u64*)(XB + (size_t)m * DM) + plane;
#pragma unroll
        for (int j = 0; j < 4; ++j) o8[64 * j] = (u64)pk2(v[j].x, v[j].y) | ((u64)pk2(v[j].z, v[j].w) << 32);
        if (plane < 16) RSS[(size_t)m * 16 + plane] = (plane == 0) ? s : 0.f;
    }
}

namespace pg8 {
__device__ __forceinline__ float row_rs(const float* rss, int row, int fq) {
    const f32x4 a = *(const f32x4*)(rss + (size_t)row * 16 + 4 * fq);
    float s = (a[0] + a[1]) + (a[2] + a[3]);
    s += __shfl_xor(s, 16); s += __shfl_xor(s, 32);
    return 1.0f / sqrtf(s * (1.0f / DM) + EPS);
}
__device__ __forceinline__ u32x4 pack8(const f32x4 o0, const f32x4 o1) { u32x4 w; w.x = cvt_pk_bf16(o0[0], o0[1]); w.y = cvt_pk_bf16(o0[2], o0[3]); w.z = cvt_pk_bf16(o1[0], o1[1]); w.w = cvt_pk_bf16(o1[2], o1[3]); return w; }
struct EpiIn {
    static constexpr bool PERM = true, AFTER_DRAIN = false;
    const float* rss; const float *qna, *kna, *qnb, *knb;
    bf16_t *QA, *KA, *VA, *SGA, *QB, *SGB, *KB, *VB, *KI, *QI, *SMA, *SMB; float* WI; float* KMP;
    __device__ __forceinline__ void norm_rows(const f32x4 (&acc)[2][2][4][2], const Unit& u, int wr, int fr, int fq, const float* g, float oscale, bf16_t* dst, int ld, int coloff, float* kmp) const {
        f32x4 gv[2][2];
#pragma unroll
        for (int bj = 0; bj < 2; ++bj)
#pragma unroll
            for (int n = 0; n < 2; ++n) gv[bj][n] = *(const f32x4*)(g + 32 * bj + 8 * fq + 4 * n) * oscale;
        f32x4 cs[2][2];
#pragma unroll
        for (int bj = 0; bj < 2; ++bj)
#pragma unroll
            for (int n = 0; n < 2; ++n) cs[bj][n] = (f32x4){0.f, 0.f, 0.f, 0.f};
#pragma unroll
        for (int ai = 0; ai < 2; ++ai)
#pragma unroll
            for (int m = 0; m < 4; ++m) {
                const int row = u.pm * BM + ai * HALF + wr * 64 + m * 16 + fr; const float rs = row_rs(rss, row, fq);
                float sq = 0.f;
#pragma unroll
                for (int bj = 0; bj < 2; ++bj)
#pragma unroll
                    for (int n = 0; n < 2; ++n) { const f32x4 t = acc[ai][bj][m][n]; sq += (t[0] * t[0] + t[1] * t[1]) + (t[2] * t[2] + t[3] * t[3]); }
                sq += __shfl_xor(sq, 16); sq += __shfl_xor(sq, 32);
                const float sc = rs / sqrtf(sq * rs * rs * (1.0f / 64.0f) + EPS);
#pragma unroll
                for (int bj = 0; bj < 2; ++bj) {
                    const f32x4 o0 = acc[ai][bj][m][0] * sc * gv[bj][0], o1 = acc[ai][bj][m][1] * sc * gv[bj][1];
                    cs[bj][0] += o0; cs[bj][1] += o1;
                    *(u32x4*)(dst + (size_t)row * ld + coloff + 32 * bj + 8 * fq) = pack8(o0, o1); }
                asm volatile("" ::: "memory");
            }
        if (kmp) {
#pragma unroll
            for (int bj = 0; bj < 2; ++bj)
#pragma unroll
                for (int n = 0; n < 2; ++n) { f32x4 t = cs[bj][n];
#pragma unroll
                    for (int o = 1; o < 16; o <<= 1) { t[0] += __shfl_xor(t[0], o); t[1] += __shfl_xor(t[1], o); t[2] += __shfl_xor(t[2], o); t[3] += __shfl_xor(t[3], o); }
                    if (fr == 0) *(f32x4*)(kmp + 32 * bj + 8 * fq + 4 * n) = t; }
        }
    }
    __device__ __forceinline__ void plain_rows(const f32x4 (&acc)[2][2][4][2], const Unit& u, int wr, int fr, int fq, bf16_t* dst, int ld, int col0, int bjs, float ca, float cb, float cc, float* wi) const {
#pragma unroll
        for (int ai = 0; ai < 2; ++ai)
#pragma unroll
            for (int m = 0; m < 4; ++m) {
                const int row = u.pm * BM + ai * HALF + wr * 64 + m * 16 + fr; const float rs = row_rs(rss, row, fq);
                if (wi) { if (fq == 0) *(f32x4*)(wi + (size_t)row * 4) = acc[ai][0][m][0] * rs; }
                else {
#pragma unroll
                for (int bj = 0; bj < 2; ++bj) { f32x4 o0 = acc[ai][bj][m][0] * rs, o1 = acc[ai][bj][m][1] * rs;
#pragma unroll
                    for (int i = 0; i < 4; ++i) { const float s0 = sigmoidf_(o0[i]), s1 = sigmoidf_(o1[i]); o0[i] = ca * o0[i] + s0 * (cb + cc * o0[i]); o1[i] = ca * o1[i] + s1 * (cb + cc * o1[i]); }
                    *(u32x4*)(dst + (size_t)row * ld + col0 + bj * bjs) = pack8(o0, o1); }
                }
                asm volatile("" ::: "memory");
            }
    }
    __device__ __forceinline__ void operator()(const f32x4 (&acc)[2][2][4][2], const Unit& u, int wr, int wc, int fr, int fq) const {
        const int pn = u.pn; const int cid = wc * 32 + 8 * fq;
        bool isnorm = false; bf16_t* dst; int ld = AW, col0, bjs = HALF; const float* g = qna; float osc = 1.0f; float* kmp = nullptr; float ca = 1.f, cb = 0.f, cc = 0.f; float* wi = nullptr;
        if (pn < 2) { isnorm = true; g = qna; osc = C2; dst = QA; col0 = 64 * (4 * pn + wc); }
        else if (pn < 4) { isnorm = true; g = kna; dst = KA; const int h = 4 * (pn - 2) + wc; col0 = 64 * h; kmp = KMP + ((((size_t)(u.pm >> 4) * 16 + (u.pm & 15)) * 8 + h) * 2 + wr) * 64; }
        else if (pn < 6) { dst = VA; col0 = 256 * (pn - 4) + cid; }
        else if (pn < 8) { dst = SGA; col0 = 256 * (pn - 6) + cid; ca = 0.f; cc = 1.f; }
        else if (pn < 10) { isnorm = true; g = qnb; osc = C2; dst = QB; col0 = 64 * (4 * (pn - 8) + wc); }
        else if (pn == 10) { ld = 64; bjs = 32; col0 = 8 * fq; dst = KI;
            if (wc == 0) { isnorm = true; g = knb; dst = KB; col0 = 0; } else if (wc == 1) { dst = VB; } else if (wc == 3) { wi = WI; } }
        else if (pn == 11) { dst = QI; ld = 256; col0 = cid; }
        else if (pn < 14) { dst = SGB; col0 = 256 * (pn - 12) + cid; ca = 0.f; cc = 1.f; }
        else if (pn < 18) { dst = SMA; ld = DM; col0 = 256 * (pn - 14) + cid; ca = 0.f; cb = 1.f; }
        else { dst = SMB; ld = DM; col0 = 256 * (pn - 18) + cid; ca = 0.f; cb = 1.f; }
        if (isnorm) norm_rows(acc, u, wr, fr, fq, g, osc, dst, ld, col0, kmp);
        else plain_rows(acc, u, wr, fr, fq, dst, ld, col0, bjs, ca, cb, cc, wi);
    }
};
struct EpiMerge {
    static constexpr bool PERM = true, AFTER_DRAIN = false;
    const bf16_t* SMA; bf16_t* SMB; float* TMP;
    __device__ __forceinline__ void operator()(const f32x4 (&acc)[2][2][4][2], const Unit& u, int wr, int wc, int fr, int fq) const {
        const bool partb = u.pm >= 128; const int pm = partb ? u.pm - 128 : u.pm, pn = partb ? u.pn - 4 : u.pn;
#pragma unroll
        for (int ai = 0; ai < 2; ++ai)
#pragma unroll
            for (int m = 0; m < 4; ++m) { const int row = pm * BM + ai * HALF + wr * 64 + m * 16 + fr;
#pragma unroll
                for (int bj = 0; bj < 2; ++bj) { const size_t off = (size_t)row * DM + pn * BM + bj * HALF + wc * 32 + 8 * fq;
                    const u32x4 sg = *(const u32x4*)((partb ? SMB : SMA) + off);
                    const f32x4 s0 = (f32x4){__uint_as_float(sg.x << 16), __uint_as_float(sg.x & 0xffff0000u), __uint_as_float(sg.y << 16), __uint_as_float(sg.y & 0xffff0000u)};
                    const f32x4 s1 = (f32x4){__uint_as_float(sg.z << 16), __uint_as_float(sg.z & 0xffff0000u), __uint_as_float(sg.w << 16), __uint_as_float(sg.w & 0xffff0000u)};
                    f32x4 o0 = acc[ai][bj][m][0] * s0, o1 = acc[ai][bj][m][1] * s1;
                    if (!partb) { *(f32x4*)(TMP + off) = o0; *(f32x4*)(TMP + off + 4) = o1; }
                    else { o0 += *(const f32x4*)(TMP + off); o1 += *(const f32x4*)(TMP + off + 4);
                        u32x4 w; w.x = cvt_pk_bf16(o0[0], o0[1]); w.y = cvt_pk_bf16(o0[2], o0[3]); w.z = cvt_pk_bf16(o1[0], o1[1]); w.w = cvt_pk_bf16(o1[2], o1[3]);
                        *(u32x4*)(SMB + off) = w; } }
            }
    }
};
struct PairOrder {
    StaticOrder base;
    __device__ void init(int G_, int c_) { base.init(TOK, DM, G_, c_); }
    __device__ bool next(int i, Unit& u) const { Unit t; if (!base.next(i >> 1, t)) return false; u.pm = t.pm + (i & 1) * 128; u.pn = t.pn + (i & 1) * 4; return true; }
    __device__ __forceinline__ void a_ready(const Unit&) const {}
    __device__ __forceinline__ void done(const Unit&) const {}
};
template <bool WRITE_NEXT> struct EpiOut {
    static constexpr bool PERM = true, AFTER_DRAIN = false;
    const float* xin; float* out; bf16_t* XB; float* rss;
    __device__ __forceinline__ void operator()(const f32x4 (&acc)[2][2][4][2], const Unit& u, int wr, int wc, int fr, int fq) const {
#pragma unroll
        for (int ai = 0; ai < 2; ++ai)
#pragma unroll
            for (int m = 0; m < 4; ++m) { const int row = u.pm * BM + ai * HALF + wr * 64 + m * 16 + fr; float ss = 0.f;
#pragma unroll
                for (int bj = 0; bj < 2; ++bj) { const size_t off = (size_t)row * DM + u.pn * BM + bj * HALF + wc * 32 + 8 * fq;
                    const f32x4 o0 = acc[ai][bj][m][0] + *(const f32x4*)(xin + off), o1 = acc[ai][bj][m][1] + *(const f32x4*)(xin + off + 4);
                    *(f32x4*)(out + off) = o0; *(f32x4*)(out + off + 4) = o1;
                    if (WRITE_NEXT) { ss += (o0[0] * o0[0] + o0[1] * o0[1]) + (o0[2] * o0[2] + o0[3] * o0[3]) + (o1[0] * o1[0] + o1[1] * o1[1]) + (o1[2] * o1[2] + o1[3] * o1[3]);
                        u32x4 w; w.x = cvt_pk_bf16(o0[0], o0[1]); w.y = cvt_pk_bf16(o0[2], o0[3]); w.z = cvt_pk_bf16(o1[0], o1[1]); w.w = cvt_pk_bf16(o1[2], o1[3]);
                        *(u32x4*)(XB + off) = w; } }
                if (WRITE_NEXT) { ss += __shfl_xor(ss, 16); ss += __shfl_xor(ss, 32); if (fq == 0) rss[(size_t)row * 16 + 4 * u.pn + wc] = ss; }
            }
    }
};
}

__device__ __forceinline__ int rel_bucket_dev(int n) {
    if (n < 16) return n;
    int large = 16 + (int)(logf((float)n / 16.0f) / logf(8.0f) * 16.0f);
    return large < 31 ? large : 31;
}
__device__ __forceinline__ void build_bias_table(Frame& F, LAS float* tb, const float* gq, const float* gk, int hoff) {
    PHASE_TID(); const float* rb = F.in[10];
    float gm = 0.f;
    for (int d = 0; d < 64; ++d) gm = fmaxf(gm, fabsf(gq[d] * gk[d]));
    for (int e = ptid; e < 8 * 128; e += NWAVES * 64) { const int h = e >> 7, d = e & 127;
        float bm = -1e30f; for (int k = 0; k < 32; ++k) bm = fmaxf(bm, rb[k * 16 + hoff + h]);
        const float M0 = 64.0f * C2 * gm + bm * LOG2E;
        tb[e] = rb[rel_bucket_dev(d) * 16 + hoff + h] * LOG2E - M0; }
}

template <int MODE>
__device__ __forceinline__ void naive_attn(Frame& F, int layer) {
    PHASE_TID();
    LAS float* tb = (LAS float*)F.lds;
    const float* gq = F.in[MODE == 0 ? 3 : 5] + layer * 64; const float* gk = F.in[MODE == 0 ? 4 : 6] + layer * 64;
    build_bias_table(F, tb, gq, gk, MODE * 8);
    __syncthreads();
    const bf16* Q = (const bf16*)(F.ws + (MODE == 0 ? WS_QA : WS_QB));
    const bf16* K = (const bf16*)(F.ws + (MODE == 0 ? WS_KA : WS_KB));
    const bf16* V = (const bf16*)(F.ws + (MODE == 0 ? WS_VA : WS_VB));
    const bf16* SG = (const bf16*)(F.ws + (MODE == 0 ? WS_SGA : WS_SGB));
    bf16* Y = (bf16*)(F.ws + WS_XB) + (size_t)MODE * TOK * AW;
    const float* KMP = (const float*)(F.ws + WS_KMP);
    const u64* BM = (const u64*)(F.ws + WS_BM);
    constexpr int KLD = (MODE == 0) ? AW : 64;
    for (int item = blockIdx.x * (NWAVES * 64) + ptid; item < BATCH * NH * SEQ; item += F.G * NWAVES * 64) {
        const int q = item & (SEQ - 1), h = (item >> 12) & 7, b = item >> 15; const int qblk = q >> 8;
        const size_t tq = (size_t)b * SEQ + q;
        float qv[64];
        { const v4u* qp = (const v4u*)(Q + tq * AW + h * 64);
#pragma unroll
            for (int c = 0; c < 8; ++c) { const v4u w = qp[c]; qv[8 * c + 0] = bflo(w.x); qv[8 * c + 1] = bfhi(w.x); qv[8 * c + 2] = bflo(w.y); qv[8 * c + 3] = bfhi(w.y); qv[8 * c + 4] = bflo(w.z); qv[8 * c + 5] = bfhi(w.z); qv[8 * c + 6] = bflo(w.w); qv[8 * c + 7] = bfhi(w.w); } }
        unsigned selmask = 0;
        if (MODE == 0) {
            float gate[16];
#pragma unroll
            for (int n = 0; n < 16; ++n) { gate[n] = -INFINITY;
                if (n < qblk) { const float* k0 = KMP + ((((size_t)b * 16 + n) * 8 + h) * 2) * 64; float s = 0.f;
#pragma unroll
                    for (int d = 0; d < 64; ++d) s += qv[d] * ((k0[d] + k0[64 + d]) * (1.0f / 256.0f));
                    gate[n] = s; } }
            const int nsel = qblk < 3 ? qblk : 3;
            for (int r = 0; r < nsel; ++r) { float best = -INFINITY; int bi = -1;
#pragma unroll
                for (int n = 0; n < 16; ++n) { const bool ok = (n < qblk) && !((selmask >> n) & 1u) && (bi < 0 || gate[n] > best); if (ok) { best = gate[n]; bi = n; } }
                selmask |= 1u << bi; }
        }
        float acc[64];
#pragma unroll
        for (int d = 0; d < 64; ++d) acc[d] = 0.f;
        float l = 0.f;
        const int kend = (item | 63) & (SEQ - 1);
        const LAS float* tbh = tb + h * 128;
        u64 mw = 0;
        for (int k = 0; k <= kend; ++k) {
            bool allowed;
            if (MODE == 0) { const int n = k >> 8; allowed = (n == qblk) ? (k <= q) : (((selmask >> n) & 1u) != 0u && n < qblk); }
            else { if ((k & 63) == 0) mw = (k <= q) ? BM[tq * 64 + (k >> 6)] : 0ull; allowed = ((mw >> (k & 63)) & 1ull) != 0ull; }
            if (!__any(allowed)) continue;
            const size_t tk = (size_t)b * SEQ + k;
            const v4u* kp = (const v4u*)(K + tk * KLD + (MODE == 0 ? h * 64 : 0));
            float s = 0.f;
#pragma unroll
            for (int c = 0; c < 8; ++c) { const v4u w = kp[c];
                s += qv[8 * c + 0] * bflo(w.x); s += qv[8 * c + 1] * bfhi(w.x); s += qv[8 * c + 2] * bflo(w.y); s += qv[8 * c + 3] * bfhi(w.y);
                s += qv[8 * c + 4] * bflo(w.z); s += qv[8 * c + 5] * bfhi(w.z); s += qv[8 * c + 6] * bflo(w.w); s += qv[8 * c + 7] * bfhi(w.w); }
            int dist = q - k; dist = dist < 0 ? 0 : (dist > 127 ? 127 : dist);
            s += tbh[dist];
            const float p = allowed ? __builtin_amdgcn_exp2f(s) : 0.f;
            l += p;
            const v4u* vp = (const v4u*)(V + tk * KLD + (MODE == 0 ? h * 64 : 0));
#pragma unroll
            for (int c = 0; c < 8; ++c) { const v4u w = vp[c];
                acc[8 * c + 0] += p * bflo(w.x); acc[8 * c + 1] += p * bfhi(w.x); acc[8 * c + 2] += p * bflo(w.y); acc[8 * c + 3] += p * bfhi(w.y);
                acc[8 * c + 4] += p * bflo(w.z); acc[8 * c + 5] += p * bfhi(w.z); acc[8 * c + 6] += p * bflo(w.w); acc[8 * c + 7] += p * bfhi(w.w); }
        }
        const float il = 1.0f / l;
        const v4u* gp = (const v4u*)(SG + tq * AW + h * 64); v4u* yp = (v4u*)(Y + tq * AW + h * 64);
#pragma unroll
        for (int c = 0; c < 8; ++c) { const v4u g = gp[c]; v4u o;
            o.x = pk2(acc[8 * c + 0] * il * bflo(g.x), acc[8 * c + 1] * il * bfhi(g.x)); o.y = pk2(acc[8 * c + 2] * il * bflo(g.y), acc[8 * c + 3] * il * bfhi(g.y));
            o.z = pk2(acc[8 * c + 4] * il * bflo(g.z), acc[8 * c + 5] * il * bfhi(g.z)); o.w = pk2(acc[8 * c + 6] * il * bflo(g.w), acc[8 * c + 7] * il * bfhi(g.w));
            yp[c] = o; }
    }
}

constexpr int IDX_S_OFF = 0, IDX_Q_OFF = RING_BYTES, IDX_W_OFF = RING_BYTES + 8192, IDX_H_OFF = RING_BYTES + 8192 + 256;
static_assert(IDX_H_OFF + 8192 <= LDSCTL_OFF, "idx LDS");

__device__ __forceinline__ u64 select_row(const float (&v)[64], int n, int lane, LAS unsigned* hist) {
    const int nch = (n + 63) >> 6;
    float lo = INFINITY, hi = -INFINITY;
#pragma unroll
    for (int j = 0; j < 64; ++j) if (j < nch) { const bool val = (64 * j + lane) < n; lo = fminf(lo, val ? v[j] : INFINITY); hi = fmaxf(hi, val ? v[j] : -INFINITY); }
#pragma unroll
    for (int o = 1; o < 64; o <<= 1) { lo = fminf(lo, __shfl_xor(lo, o)); hi = fmaxf(hi, __shfl_xor(hi, o)); }
    int need = 256; float T = lo; int needT = 1 << 20;
    for (int iter = 0; iter < 48; ++iter) {
        if (!(hi > lo)) { T = lo; needT = need; break; }
        hist[lane] = 0u; hist[64 + lane] = 0u; hist[128 + lane] = 0u; hist[192 + lane] = 0u;
        LDS_WAIT(); asm volatile("" ::: "memory");
        const float inv = 1.0f / (hi - lo);
#pragma unroll
        for (int j = 0; j < 64; ++j) if (j < nch) { const float x = v[j]; const bool in = ((64 * j + lane) < n) && x >= lo && x <= hi;
            if (in) { int bin = (int)(((x - lo) * inv) * 256.0f); bin = bin > 255 ? 255 : (bin < 0 ? 0 : bin); __hip_atomic_fetch_add(hist + bin, 1u, __ATOMIC_RELAXED, __HIP_MEMORY_SCOPE_WORKGROUP); } }
        LDS_WAIT(); asm volatile("" ::: "memory");
        const unsigned h0 = hist[4 * lane], h1 = hist[4 * lane + 1], h2 = hist[4 * lane + 2], h3 = hist[4 * lane + 3];
        const unsigned s4 = h0 + h1 + h2 + h3; unsigned suf = s4;
#pragma unroll
        for (int o = 1; o < 64; o <<= 1) { const unsigned t = __shfl_down(suf, o); if (lane + o < 64) suf += t; }
        const u64 bal = __ballot(suf >= (unsigned)need);
        const int ls = 63 - __builtin_clzll(bal);
        const unsigned a3 = __shfl(h3, ls), a2 = __shfl(h2, ls), a1 = __shfl(h1, ls), a0 = __shfl(h0, ls);
        const unsigned above_lane = __shfl(suf, ls) - (a0 + a1 + a2 + a3);
        int bstar; unsigned above, cstar;
        if (above_lane + a3 >= (unsigned)need) { bstar = 4 * ls + 3; above = above_lane; cstar = a3; }
        else if (above_lane + a3 + a2 >= (unsigned)need) { bstar = 4 * ls + 2; above = above_lane + a3; cstar = a2; }
        else if (above_lane + a3 + a2 + a1 >= (unsigned)need) { bstar = 4 * ls + 1; above = above_lane + a3 + a2; cstar = a1; }
        else { bstar = 4 * ls; above = above_lane + a3 + a2 + a1; cstar = a0; }
        need -= (int)above;
        float nlo = INFINITY, nhi = -INFINITY;
#pragma unroll
        for (int j = 0; j < 64; ++j) if (j < nch) { const float x = v[j]; const bool in = ((64 * j + lane) < n) && x >= lo && x <= hi;
            int bin = (int)(((x - lo) * inv) * 256.0f); bin = bin > 255 ? 255 : (bin < 0 ? 0 : bin);
            const bool c = in && bin == bstar; nlo = fminf(nlo, c ? x : INFINITY); nhi = fmaxf(nhi, c ? x : -INFINITY); }
#pragma unroll
        for (int o = 1; o < 64; o <<= 1) { nlo = fminf(nlo, __shfl_xor(nlo, o)); nhi = fmaxf(nhi, __shfl_xor(nhi, o)); }
        if ((int)cstar == need) { T = nlo; needT = 1 << 20; break; }
        lo = nlo; hi = nhi;
    }
    u64 myword = 0ull; int run = 0;
#pragma unroll
    for (int j = 0; j < 64; ++j) {
        u64 w = 0ull;
        if (j < nch) { const float x = v[j]; const bool val = (64 * j + lane) < n;
            const bool tie = val && x == T; const u64 tbal = __ballot(tie);
            const int rank = run + __builtin_popcountll(tbal & ((1ull << lane) - 1ull)); run += __builtin_popcountll(tbal);
            w = __ballot(val && (x > T || (tie && rank < needT))); }
        if (lane == j) myword = w;
    }
    return myword;
}

__device__ __forceinline__ void idx_phase_naive(Frame& F) {
    PHASE_TID();
    LAS float* S = (LAS float*)(F.lds + IDX_S_OFF); LAS float* qs = (LAS float*)(F.lds + IDX_Q_OFF); LAS float* wsm = (LAS float*)(F.lds + IDX_W_OFF);
    LAS unsigned* hist = (LAS unsigned*)(F.lds + IDX_H_OFF) + F.wave * 256;
    const bf16* QI = (const bf16*)(F.ws + WS_QI); const bf16* KI = (const bf16*)(F.ws + WS_KI); const float* WI = (const float*)(F.ws + WS_WI); u64* BM = (u64*)(F.ws + WS_BM);
    for (int un = blockIdx.x; un < TOK / 8; un += F.G) {
        const int b = un >> 9, q0 = (un & 511) * 8; const size_t t0 = (size_t)b * SEQ + q0;
        for (int e = ptid; e < 8 * 256; e += NWAVES * 64) qs[e] = bf2f(QI[t0 * 256 + e]);
        if (ptid < 32) wsm[ptid] = WI[t0 * 4 + ptid];
        __syncthreads();
        const int nk = q0 + 8;
        for (int k = ptid; k < nk; k += NWAVES * 64) {
            float kf[64];
            { const v4u* kp = (const v4u*)(KI + ((size_t)b * SEQ + k) * 64);
#pragma unroll
                for (int c = 0; c < 8; ++c) { const v4u w = kp[c]; kf[8 * c + 0] = bflo(w.x); kf[8 * c + 1] = bfhi(w.x); kf[8 * c + 2] = bflo(w.y); kf[8 * c + 3] = bfhi(w.y); kf[8 * c + 4] = bflo(w.z); kf[8 * c + 5] = bfhi(w.z); kf[8 * c + 6] = bflo(w.w); kf[8 * c + 7] = bfhi(w.w); } }
            for (int i = 0; i < 8; ++i) { float sc = 0.f;
#pragma unroll
                for (int h = 0; h < 4; ++h) { float dot = 0.f; const LAS f32x4* qp = (const LAS f32x4*)(qs + i * 256 + h * 64);
#pragma unroll
                    for (int c = 0; c < 16; ++c) { const f32x4 qq = qp[c]; dot += kf[4 * c] * qq[0]; dot += kf[4 * c + 1] * qq[1]; dot += kf[4 * c + 2] * qq[2]; dot += kf[4 * c + 3] * qq[3]; }
                    sc += wsm[i * 4 + h] * fmaxf(dot, 0.f); }
                S[i * 4096 + k] = sc; }
        }
        __syncthreads();
        { const int i = F.wave, n = q0 + i + 1; u64 word;
            if (n <= 256) { const int full = n >> 6, rem = n & 63; word = (plane < full) ? ~0ull : (plane == full ? ((1ull << rem) - 1ull) : 0ull); }
            else { float v[64]; const int nch = (n + 63) >> 6;
#pragma unroll
                for (int j = 0; j < 64; ++j) v[j] = (j < nch) ? S[i * 4096 + 64 * j + plane] : -INFINITY;
                word = select_row(v, n, plane, hist); }
            BM[(t0 + i) * 64 + plane] = word; }
        __syncthreads();
    }
}

struct Args { const float* in[11]; float* out; unsigned char* ws; int ph_lo, ph_hi, li, pad; };
__global__ void __launch_bounds__(NWAVES * 64, 2) hyb_fwd(Args args) {
    extern __shared__ __attribute__((aligned(16))) unsigned char lds[];
    Frame F;
    F.lds = (LAS unsigned char*)lds;
    F.MISC = (volatile LAS unsigned*)(F.lds + MISC_OFF);
    F.wave = __builtin_amdgcn_readfirstlane((int)threadIdx.x >> 6);
    F.G = gridDim.x; { const int bx = blockIdx.x; F.vcu = (F.G % 8 == 0) ? (bx % 8) * (F.G / 8) + bx / 8 : bx; }
    F.ws = args.ws; F.ctl = (gu32*)(args.ws + WS_CTL); F.out = args.out;
#pragma unroll
    for (int i = 0; i < 11; ++i) F.in[i] = args.in[i];
    for (int u = threadIdx.x; u < (LDS_BYTES - LDSCTL_OFF) / 4; u += NWAVES * 64) ((LAS unsigned*)(F.lds + LDSCTL_OFF))[u] = 0u;
    __syncthreads();
    const bool one_launch = (args.ph_hi - args.ph_lo) > 1;
    XcdBarrier bar; bar.bar = (unsigned*)(F.ctl + CW_BAR); bar.x = 0; bar.st = nullptr;
    if (one_launch) bar = xcd_barrier_post((unsigned*)(F.ctl + CW_BAR), F.MISC + 8);
    const int lo = args.ph_lo, hi = args.ph_hi;
#define IN(k) (lo <= (k) && (k) < hi)
#define SEAM(k) do { if (IN(k) && IN((k) + 1)) xcd_barrier(bar); } while (0)
    unsigned char* ws = args.ws;
#ifndef NO_P0
    if (IN(0)) { p0_prologue(F); SEAM(0); }
#endif
#pragma unroll 1
    for (int l = 0; l < DEPTH; ++l) {
        const int p = 1 + 5 * l;
#ifndef NO_P1
        if (IN(p)) {
            pg8::Gemm g{(const pg8::bf16_t*)(ws + WS_XB), (const pg8::bf16_t*)(ws + WS_WIN) + (size_t)l * NIN * DM, TOK, NIN, DM};
            pg8::StaticOrder S; S.init(TOK, NIN, F.G, (int)blockIdx.x);
            pg8::EpiIn E; E.rss = (const float*)(ws + WS_RSS); E.qna = F.in[3] + l * 64; E.kna = F.in[4] + l * 64; E.qnb = F.in[5] + l * 64; E.knb = F.in[6] + l * 64;
            E.QA = (pg8::bf16_t*)(ws + WS_QA); E.KA = (pg8::bf16_t*)(ws + WS_KA); E.VA = (pg8::bf16_t*)(ws + WS_VA); E.SGA = (pg8::bf16_t*)(ws + WS_SGA); E.QB = (pg8::bf16_t*)(ws + WS_QB); E.SGB = (pg8::bf16_t*)(ws + WS_SGB);
            E.KB = (pg8::bf16_t*)(ws + WS_KB); E.VB = (pg8::bf16_t*)(ws + WS_VB); E.KI = (pg8::bf16_t*)(ws + WS_KI); E.QI = (pg8::bf16_t*)(ws + WS_QI); E.SMA = (pg8::bf16_t*)(ws + WS_SMA); E.SMB = (pg8::bf16_t*)(ws + WS_SMB);
            E.WI = (float*)(ws + WS_WI); E.KMP = (float*)(ws + WS_KMP);
            pg8::gemm_phase<pg8::EpiIn, pg8::StaticOrder, true, true>(F.lds, g, S, E);
            SEAM(p);
        }
#endif
#ifndef NO_IDX
        if (IN(p + 1)) { idx_phase_naive(F); SEAM(p + 1); }
#endif
#ifndef NO_ATT
        if (IN(p + 2)) { naive_attn<0>(F, l); __syncthreads(); naive_attn<1>(F, l); SEAM(p + 2); }
#endif
#ifndef NO_P4
        if (IN(p + 3)) {
            pg8::Gemm g{(const pg8::bf16_t*)(ws + WS_XB), (const pg8::bf16_t*)(ws + WS_WBR) + (size_t)l * 2048 * AW, 2 * TOK, 2048, AW};
            pg8::PairOrder S; S.init(F.G, (int)blockIdx.x);
            pg8::EpiMerge E{(const pg8::bf16_t*)(ws + WS_SMA), (pg8::bf16_t*)(ws + WS_SMB), (float*)(ws + WS_TMP)};
            pg8::gemm_phase<pg8::EpiMerge, pg8::PairOrder, true, true>(F.lds, g, S, E);
            SEAM(p + 3);
        }
#endif
#ifndef NO_P5
        if (IN(p + 4)) {
            pg8::Gemm g{(const pg8::bf16_t*)(ws + WS_SMB), (const pg8::bf16_t*)(ws + WS_WOUT) + (size_t)l * DM * DM, TOK, DM, DM};
            pg8::StaticOrder S; S.init(TOK, DM, F.G, (int)blockIdx.x);
            if (l == 0) { pg8::EpiOut<true> E{F.in[0], F.out, (pg8::bf16_t*)(ws + WS_XB), (float*)(ws + WS_RSS)};
                pg8::gemm_phase<pg8::EpiOut<true>, pg8::StaticOrder, true, true>(F.lds, g, S, E); }
            else { pg8::EpiOut<false> E{F.out, F.out, nullptr, nullptr};
                pg8::gemm_phase<pg8::EpiOut<false>, pg8::StaticOrder, true, true>(F.lds, g, S, E); }
            SEAM(p + 4);
        }
#endif
    }
#undef IN
#undef SEAM
}

#ifndef N_LAUNCHES
#define N_LAUNCHES 1
#endif
extern "C" void kernel_launch(void* const* d_in, const int* in_sizes, int n_in, void* d_out, int out_size, void* d_ws, size_t ws_size, hipStream_t stream) {
    static int grid = 0;
    if (grid == 0) {
        if (n_in != 11 || in_sizes[0] != TOK * DM || out_size != TOK * DM || ws_size < WS_END) { fprintf(stderr, "kernel_launch: unexpected shapes (n_in %d in0 %d out %d ws %zu)\n", n_in, n_in > 0 ? in_sizes[0] : -1, out_size, ws_size); grid = -1; return; }
        int dev = 0, cus = 0;
        if (hipGetDevice(&dev) != hipSuccess || hipDeviceGetAttribute(&cus, hipDeviceAttributeMultiprocessorCount, dev) != hipSuccess) { grid = -1; return; }
        if (hipFuncSetAttribute((const void*)hyb_fwd, hipFuncAttributeMaxDynamicSharedMemorySize, LDS_BYTES) != hipSuccess) { fprintf(stderr, "kernel_launch: hipFuncSetAttribute failed\n"); grid = -1; return; }
        int per_cu = 0;
        if (hipOccupancyMaxActiveBlocksPerMultiprocessor(&per_cu, (const void*)hyb_fwd, NWAVES * 64, LDS_BYTES) != hipSuccess || per_cu < 1) fprintf(stderr, "kernel_launch: occupancy query says %d\n", per_cu);
        (void)hipGetLastError();
        grid = cus;
    }
    if (grid < 0) return;
    if (hipMemsetAsync((char*)d_ws + WS_CTL, 0, CTL_ZERO_BYTES, stream) != hipSuccess) return;
    Args a{};
    for (int i = 0; i < 11; ++i) a.in[i] = (const float*)d_in[i];
    a.out = (float*)d_out; a.ws = (unsigned char*)d_ws;
    if (N_LAUNCHES == 1) { a.ph_lo = 0; a.ph_hi = NPHASE; a.li = 0; hipLaunchKernelGGL(hyb_fwd, dim3(grid), dim3(NWAVES * 64), LDS_BYTES, stream, a); }
    else for (int li = 0; li < NPHASE; ++li) { a.ph_lo = li; a.ph_hi = li + 1; a.li = li; hipLaunchKernelGGL(hyb_fwd, dim3(grid), dim3(NWAVES * 64), LDS_BYTES, stream, a); }
}
```

```cpp
#include <hip/hip_runtime.h>
#include <cstdio>
#include <cstdint>
#include <cmath>
namespace pg8 {
#define PG8_LAS __attribute__((address_space(3)))
typedef unsigned short bf16_t;
typedef short bf16x8 __attribute__((ext_vector_type(8)));
typedef float f32x4 __attribute__((ext_vector_type(4)));
typedef unsigned u32x4 __attribute__((ext_vector_type(4)));
constexpr int BM = 256, BK = 64, HALF = 128, HTB = HALF * BK * 2  , STAGE_BYTES = 8 * HTB, NXCD = 8, WGM = 8;

__host__ __device__ __forceinline__ int lds_byte(int r, int c) { const int st = (r >> 4) * 2 + (c >> 5), rr = r & 15, cc = c & 31, ob = rr * 64 + cc * 2; return st * 1024 + (ob ^ (((ob >> 9) & 1) << 5)); }
__host__ __device__ __forceinline__ void stage_rc(int b, int& R, int& C) { const int st = b / 1024, sb = b % 1024, swz = sb ^ (((sb >> 9) & 1) << 5); R = (st >> 1) * 16 + swz / 64; C = (st & 1) * 32 + (swz % 64) / 2; }
__host__ __device__ __forceinline__ int perm32(int rho) { const int n = rho >> 4, i = rho & 15; return 8 * (i >> 2) + 4 * n + (i & 3); }

struct Unit { int pm, pn; };
struct Gemm { const bf16_t* A; const bf16_t* Bt; int M, N, K; };

struct StaticOrder {
    int nM, nN, nwg, G, c;
    __host__ __device__ void init(int M, int N, int G_, int c_) { nM = M / BM; nN = N / BM; nwg = nM * nN; G = G_; c = c_; }
    __host__ __device__ bool next(int i, Unit& u) const {
        const long L = (long)i * G + c; if (L >= nwg) return false;
        int wgid = (int)L; { const int q = nwg / NXCD, r = nwg % NXCD, xcd = wgid % NXCD, off = wgid / NXCD; wgid = (xcd < r ? xcd * (q + 1) : r * (q + 1) + (xcd - r) * q) + off; }
        const int nig = WGM * nN, gid = wgid / nig, fm = gid * WGM, gsz = (nM - fm) < WGM ? (nM - fm) : WGM;
        u.pm = fm + ((wgid % nig) % gsz); u.pn = (wgid % nig) / gsz; return true;
    }
    __device__ __forceinline__ void a_ready(const Unit&) const {}
    __device__ __forceinline__ void done(const Unit&) const {}
};

__device__ __forceinline__ unsigned cvt_pk_bf16(float lo, float hi) { unsigned r; asm volatile("v_cvt_pk_bf16_f32 %0, %1, %2" : "=v"(r) : "v"(lo), "v"(hi)); return r; }
template <class Epi, class Sched, bool ALIGN_EPI = false, bool SP2 = false>
__device__ __forceinline__ void gemm_phase(PG8_LAS unsigned char* lds, const Gemm g, const Sched& S, const Epi& E) {
    int tid_ = threadIdx.x; asm volatile("" : "+v"(tid_));
    const int tid = tid_, wid = __builtin_amdgcn_readfirstlane(tid >> 6), lane = tid & 63, wr = wid >> 2, wc = wid & 3, fr = lane & 15, fq = lane >> 4;
    const int K = g.K, nt = K / BK;
    unsigned voffA[2], voffB[2];
#pragma unroll
    for (int i = 0; i < 2; ++i) { int R, C; stage_rc(tid * 16 + i * 8192, R, C); const int Rb = Epi::PERM ? ((R & ~31) + perm32(R & 31)) : R;
        voffA[i] = (unsigned)(R * K + C) * 2u; voffB[i] = (unsigned)(Rb * K + C) * 2u; }
    const size_t kstep = (size_t)(BK * 2);
    const size_t hstep = (size_t)HALF * K * 2;
    const size_t tstep = 2 * hstep;
    const unsigned ldsw = (unsigned)wid * 1024u;
    const int aoff = lds_byte(wr * 64 + fr, fq * 8), boff = lds_byte(wc * 32 + fr, fq * 8);
#define PG8_SA(b, h) (((b) * 2 + (h)) * HTB)
#define PG8_SB(b, h) ((4 + (b) * 2 + (h)) * HTB)
#define PG8_STAGE(bufoff, gbase, voff) do { _Pragma("unroll") for (int _i = 0; _i < 2; ++_i) \
        __builtin_amdgcn_global_load_lds((const unsigned*)((const char*)(gbase) + (voff)[_i]), (PG8_LAS unsigned*)(lds + (bufoff) + ldsw + _i * 8192), 16, 0, 0); } while (0)
#define PG8_LDA(dst, b, h) do { _Pragma("unroll") for (int m = 0; m < 4; ++m) _Pragma("unroll") for (int k = 0; k < 2; ++k) dst[m][k] = *(const PG8_LAS bf16x8*)(lds + PG8_SA(b, h) + aoff + m * 2048 + k * 1024); } while (0)
#define PG8_LDB(dst, b, h) do { _Pragma("unroll") for (int n = 0; n < 2; ++n) _Pragma("unroll") for (int k = 0; k < 2; ++k) dst[n][k] = *(const PG8_LAS bf16x8*)(lds + PG8_SB(b, h) + boff + n * 2048 + k * 1024); } while (0)
#define PG8_MMA(ai, bj, At, Bt) do { __builtin_amdgcn_s_setprio(1); _Pragma("unroll") for (int m = 0; m < 4; ++m) _Pragma("unroll") for (int n = 0; n < 2; ++n) _Pragma("unroll") for (int k = 0; k < 2; ++k) \
        acc[ai][bj][m][n] = __builtin_amdgcn_mfma_f32_16x16x32_bf16(Bt[n][k], At[m][k], acc[ai][bj][m][n], 0, 0, 0); __builtin_amdgcn_s_setprio(0); } while (0)
#define PG8_WAIT_V(n) asm volatile("s_waitcnt vmcnt(" #n ")" ::: "memory")
#define PG8_WAIT_L(n) asm volatile("s_waitcnt lgkmcnt(" #n ")" ::: "memory")
#define PG8_BAR __builtin_amdgcn_s_barrier()
#define PG8_SCHED __builtin_amdgcn_sched_barrier(0)
    Unit cur, nxt; int ui = 0;
    if (!S.next(0, cur)) return;
    f32x4 acc[2][2][4][2];
#pragma unroll
    for (int a = 0; a < 2; ++a)
#pragma unroll
        for (int b = 0; b < 2; ++b)
#pragma unroll
            for (int m = 0; m < 4; ++m)
#pragma unroll
                for (int n = 0; n < 2; ++n) acc[a][b][m][n] = (f32x4){0.f, 0.f, 0.f, 0.f};
    bf16x8 At[4][2], B0[2][2], B1[2][2];
    const char* cA = (const char*)g.A + (size_t)cur.pm * tstep; const char* cB = (const char*)g.Bt + (size_t)cur.pn * tstep;
    S.a_ready(cur);
    if constexpr (SP2) {
        PG8_STAGE(PG8_SB(0, 0), cB, voffB); PG8_STAGE(PG8_SB(0, 1), cB + hstep, voffB); PG8_STAGE(PG8_SA(0, 0), cA, voffA); PG8_STAGE(PG8_SA(0, 1), cA + hstep, voffA);
        if (wr == 1) PG8_BAR;
        PG8_WAIT_V(2); PG8_BAR;
        PG8_STAGE(PG8_SB(1, 0), cB + kstep, voffB); PG8_STAGE(PG8_SA(1, 0), cA + kstep, voffA); PG8_STAGE(PG8_SB(1, 1), cB + hstep + kstep, voffB);
        PG8_WAIT_V(6); PG8_BAR;
    } else {
        PG8_STAGE(PG8_SB(0, 0), cB, voffB); PG8_STAGE(PG8_SA(0, 0), cA, voffA); PG8_STAGE(PG8_SB(0, 1), cB + hstep, voffB); PG8_STAGE(PG8_SA(0, 1), cA + hstep, voffA);
        if (wr == 1) PG8_BAR;
        PG8_WAIT_V(4); PG8_BAR;
        PG8_STAGE(PG8_SB(1, 0), cB + kstep, voffB); PG8_STAGE(PG8_SA(1, 0), cA + kstep, voffA); PG8_STAGE(PG8_SB(1, 1), cB + hstep + kstep, voffB);
        PG8_WAIT_V(6); PG8_BAR;
    }
    for (;;) {
        const bool has_next = S.next(ui + 1, nxt);
        const char* nA = has_next ? (const char*)g.A + (size_t)nxt.pm * tstep : cA; const char* nB = has_next ? (const char*)g.Bt + (size_t)nxt.pn * tstep : cB;
        for (int t = 0; t < nt; t += 2) {
            const bool last = (t == nt - 2);
            const char* a1 = cA + (size_t)(t + 1) * kstep;
            const char* a2 = last ? nA : cA + (size_t)(t + 2) * kstep; const char* b2 = last ? nB : cB + (size_t)(t + 2) * kstep;
            const char* a3 = a2 + kstep; const char* b3 = b2 + kstep;
            if (last && has_next) S.a_ready(nxt);
            if constexpr (SP2) {
            PG8_LDB(B0, 0, 0); PG8_LDB(B1, 0, 1); PG8_SCHED; PG8_LDA(At, 0, 0); PG8_STAGE(PG8_SA(1, 1), a1 + hstep, voffA);
            PG8_WAIT_V(8); PG8_WAIT_L(0); PG8_BAR; PG8_MMA(0, 0, At, B0); PG8_MMA(0, 1, At, B1); PG8_BAR; PG8_SCHED;
            PG8_LDA(At, 0, 1); PG8_STAGE(PG8_SB(0, 0), b2, voffB); PG8_STAGE(PG8_SB(0, 1), b2 + hstep, voffB); PG8_STAGE(PG8_SA(0, 0), a2, voffA);
            PG8_WAIT_V(8); PG8_WAIT_L(0); PG8_BAR; PG8_MMA(1, 0, At, B0); PG8_MMA(1, 1, At, B1); PG8_BAR; PG8_SCHED;
            PG8_LDB(B0, 1, 0); PG8_LDB(B1, 1, 1); PG8_SCHED; PG8_LDA(At, 1, 0); PG8_STAGE(PG8_SA(0, 1), a2 + hstep, voffA);
            PG8_WAIT_V(8); PG8_WAIT_L(0); PG8_BAR; PG8_MMA(0, 0, At, B0); PG8_MMA(0, 1, At, B1); PG8_BAR; PG8_SCHED;
            PG8_LDA(At, 1, 1); PG8_STAGE(PG8_SB(1, 0), b3, voffB); PG8_STAGE(PG8_SB(1, 1), b3 + hstep, voffB); PG8_STAGE(PG8_SA(1, 0), a3, voffA);
            PG8_WAIT_V(8); PG8_WAIT_L(0); PG8_BAR; PG8_MMA(1, 0, At, B0); PG8_MMA(1, 1, At, B1); PG8_BAR; PG8_SCHED;
            } else {
            PG8_LDB(B0, 0, 0); PG8_SCHED; PG8_LDA(At, 0, 0); PG8_STAGE(PG8_SA(1, 1), a1 + hstep, voffA);
            PG8_WAIT_L(8); PG8_BAR; PG8_WAIT_L(0); PG8_MMA(0, 0, At, B0); PG8_BAR; PG8_SCHED;
            PG8_LDB(B1, 0, 1); PG8_STAGE(PG8_SB(0, 0), b2, voffB);
            PG8_BAR; PG8_WAIT_L(0); PG8_MMA(0, 1, At, B1); PG8_BAR;
            PG8_LDA(At, 0, 1); PG8_STAGE(PG8_SA(0, 0), a2, voffA);
            PG8_BAR; PG8_WAIT_L(0); PG8_MMA(1, 0, At, B0); PG8_BAR; PG8_SCHED;
            PG8_STAGE(PG8_SB(0, 1), b2 + hstep, voffB);
            PG8_WAIT_V(6); PG8_BAR; PG8_MMA(1, 1, At, B1); PG8_BAR;
            PG8_LDB(B0, 1, 0); PG8_SCHED; PG8_LDA(At, 1, 0); PG8_STAGE(PG8_SA(0, 1), a2 + hstep, voffA);
            PG8_WAIT_L(8); PG8_BAR; PG8_WAIT_L(0); PG8_MMA(0, 0, At, B0); PG8_BAR; PG8_SCHED;
            PG8_LDB(B1, 1, 1); PG8_STAGE(PG8_SB(1, 0), b3, voffB);
            PG8_BAR; PG8_WAIT_L(0); PG8_MMA(0, 1, At, B1); PG8_BAR;
            PG8_LDA(At, 1, 1); PG8_STAGE(PG8_SA(1, 0), a3, voffA);
            PG8_BAR; PG8_WAIT_L(0); PG8_MMA(1, 0, At, B0); PG8_BAR; PG8_SCHED;
            PG8_STAGE(PG8_SB(1, 1), b3 + hstep, voffB);
            PG8_WAIT_V(6); PG8_BAR; PG8_MMA(1, 1, At, B1); PG8_BAR;
            }
        }
        if constexpr (ALIGN_EPI) { if (wr == 0) PG8_BAR; }
        if constexpr (!Epi::AFTER_DRAIN) { E(acc, cur, wr, wc, fr, fq); S.done(cur); }
        if (!has_next) break;
#pragma unroll
        for (int a = 0; a < 2; ++a)
#pragma unroll
            for (int b = 0; b < 2; ++b)
#pragma unroll
                for (int m = 0; m < 4; ++m)
#pragma unroll
                    for (int n = 0; n < 2; ++n) acc[a][b][m][n] = (f32x4){0.f, 0.f, 0.f, 0.f};
        cur = nxt; cA = nA; cB = nB; ++ui;
        if constexpr (ALIGN_EPI) { if (wr == 1) PG8_BAR; }
    }
    PG8_WAIT_V(0);
    if constexpr (!ALIGN_EPI) { if (wr == 0) PG8_BAR; }
    PG8_BAR;
    if constexpr (Epi::AFTER_DRAIN) { E.fused(acc, cur, wr, wc, fr, fq, lds, wid, lane); S.done(cur); }
#undef PG8_SA
#undef PG8_SB
#undef PG8_STAGE
#undef PG8_LDA
#undef PG8_LDB
#undef PG8_MMA
#undef PG8_WAIT_V
#undef PG8_WAIT_L
#undef PG8_BAR
#undef PG8_SCHED
}
}
#define GAS __attribute__((address_space(1)))
#define LAS __attribute__((address_space(3)))
typedef unsigned short bf16;
typedef unsigned v4u __attribute__((ext_vector_type(4)));
typedef float f32x4 __attribute__((ext_vector_type(4)));
typedef short bf16x8 __attribute__((ext_vector_type(8)));
typedef GAS unsigned gu32;
typedef GAS unsigned long long gu64;
#define RLX_AGENT __ATOMIC_RELAXED, __HIP_MEMORY_SCOPE_AGENT
#define LDS_WAIT() asm volatile("s_waitcnt lgkmcnt(0)" ::: "memory")
#define VM_WAIT() asm volatile("s_waitcnt vmcnt(0)" ::: "memory")
__device__ __forceinline__ unsigned long long rt() { return __builtin_amdgcn_s_memrealtime(); }
__device__ __forceinline__ unsigned f2bf(float f) { unsigned u = __builtin_bit_cast(unsigned, f); return (u + 0x7fffu + ((u >> 16) & 1u)) >> 16; }
__device__ __forceinline__ unsigned pk2(float lo, float hi) { return f2bf(lo) | (f2bf(hi) << 16); }
#define XB_TMO      128
#define XB_XCNT(j)  (256  + 64 * (j))
#define XB_XSUB(j)  (1280 + 64 * (j))
#define XB_XGEN(j)  (2304 + 64 * (j))
#define XB_TOP      3328
#define XB_TOPGEN   3392
#define XCD_BAR_WORDS 3456
#define XB_SPIN_CAP (1u << 18)

__device__ __forceinline__ unsigned xb_ld(unsigned* p)              { return __hip_atomic_load(p, __ATOMIC_RELAXED, __HIP_MEMORY_SCOPE_AGENT); }
__device__ __forceinline__ unsigned xb_add(unsigned* p, unsigned v) { return __hip_atomic_fetch_add(p, v, __ATOMIC_RELAXED, __HIP_MEMORY_SCOPE_AGENT); }
__device__ __forceinline__ unsigned xb_xcc_id() { return (unsigned)__builtin_amdgcn_s_getreg((3 << 11) | 20) & 0xFu; }
#define XB_SPIN(cond, bar) do { unsigned _sp = 0; while (cond) { __builtin_amdgcn_s_sleep(1); \
    if ((++_sp & 255u) == 0u) { if (xb_ld(&(bar)[XB_TMO])) break; if (_sp > XB_SPIN_CAP) { atomicAdd(&(bar)[XB_TMO], 1u); break; } } } } while (0)

struct XcdBarrier {
    unsigned* bar; unsigned x;
    volatile LAS unsigned* st;
};

__device__ __forceinline__ XcdBarrier xcd_barrier_post(unsigned* bar, volatile LAS unsigned* st) {
    XcdBarrier b; b.bar = bar; b.x = xb_xcc_id(); b.st = st;
    if (threadIdx.x == 0) (void)xb_add(&bar[XB_XCNT(b.x)], 1u);
    return b;
}
__device__ __forceinline__ void xcd_barrier_complete(unsigned* bar, unsigned x, unsigned& nloc, unsigned& nx) {
    const unsigned G = gridDim.x * gridDim.y * gridDim.z;
    unsigned sum, cnt, mine, sp = 0u;
    for (;;) {
        sum = 0u; cnt = 0u; mine = 0u;
#pragma unroll
        for (unsigned j = 0; j < 16; ++j) { const unsigned c = xb_ld(&bar[XB_XCNT(j)]); sum += c; cnt += (c > 0u) ? 1u : 0u; mine = (j == x) ? c : mine; }
        if (sum == G) break;
        __builtin_amdgcn_s_sleep(1);
        if ((++sp & 255u) == 0u) { if (xb_ld(&bar[XB_TMO])) break; if (sp > XB_SPIN_CAP) { atomicAdd(&bar[XB_TMO], 1u); break; } }
    }
    nloc = mine > 0u ? mine : 1u; nx = cnt > 0u ? cnt : 1u;
}

__device__ __forceinline__ void xcd_barrier(const XcdBarrier& b) {
    asm volatile("s_waitcnt vmcnt(0)" ::: "memory");
    __syncthreads();
    if (threadIdx.x == 0) {
        unsigned* bar = b.bar; asm volatile("" : "+s"(bar));
        __builtin_amdgcn_s_waitcnt(0);
        unsigned nloc = b.st[0], nx = b.st[1];
        if (nloc == 0u) { xcd_barrier_complete(bar, b.x, nloc, nx); b.st[0] = nloc; b.st[1] = nx; }
        const unsigned old = xb_add(&bar[XB_XSUB(b.x)], 1u);
        const unsigned gen = old / nloc;
        if (old + 1u == (gen + 1u) * nloc) {
            __builtin_amdgcn_fence(__ATOMIC_RELEASE, "agent");
            asm volatile("s_waitcnt vmcnt(0)" ::: "memory");
            const unsigned og = xb_add(&bar[XB_TOP], 1u);
            const unsigned tg = og / nx;
            if (og + 1u == (tg + 1u) * nx) xb_add(&bar[XB_TOPGEN], 1u);
            else XB_SPIN(xb_ld(&bar[XB_TOPGEN]) == tg, bar);
            __builtin_amdgcn_fence(__ATOMIC_ACQUIRE, "agent");
            xb_add(&bar[XB_XGEN(b.x)], 1u);
            asm volatile("s_waitcnt vmcnt(0)" ::: "memory");
        } else {
            XB_SPIN(xb_ld(&bar[XB_XGEN(b.x)]) == gen, bar);
            __builtin_amdgcn_fence(__ATOMIC_ACQUIRE, "agent");
            asm volatile("s_waitcnt vmcnt(0)" ::: "memory");
        }
    }
    __syncthreads();
}

constexpr int BATCH = 8, SEQ = 4096, DM = 1024, TOK = BATCH * SEQ, DEPTH = 2;
constexpr int DIN = 5572, NIN = 5632;
constexpr int NH = 8, HD = 64, AW = 512;
constexpr float EPS = 1e-6f;
constexpr float LOG2E = 1.4426950408889634f;
constexpr float C2 = 0.125f * LOG2E;
constexpr int NWAVES = 8;
constexpr int NPHASE = 1 + 5 * DEPTH;

constexpr size_t MiB = 1u << 20;
constexpr size_t WS_CTL = 0, CTL_ZERO_BYTES = 1 * MiB;
constexpr size_t WS_WIN = 1 * MiB;
constexpr size_t WS_WBR = 23 * MiB;
constexpr size_t WS_WOUT = 27 * MiB;
constexpr size_t WS_RSS = 31 * MiB;
constexpr size_t WS_KMP = 33 * MiB;
constexpr size_t WS_WI = 34 * MiB;
constexpr size_t WS_KB = 35 * MiB, WS_VB = 39 * MiB, WS_KI = 43 * MiB;
constexpr size_t WS_QI = 47 * MiB;
constexpr size_t WS_BM = 63 * MiB;
constexpr size_t WS_XB = 80 * MiB;
constexpr size_t WS_QA = 144 * MiB, WS_KA = 176 * MiB, WS_VA = 208 * MiB, WS_SGA = 240 * MiB, WS_QB = 272 * MiB, WS_SGB = 304 * MiB;
constexpr size_t WS_TMP = 144 * MiB;
constexpr size_t WS_SMA = 336 * MiB, WS_SMB = 400 * MiB;
constexpr size_t WS_END = 464 * MiB;
constexpr int CW_BAR = 4096;

constexpr int RING_BYTES = 131072;
constexpr int LDSCTL_OFF = RING_BYTES + 28672, MISC_OFF = LDSCTL_OFF + 320;
constexpr int LDS_BYTES = 163840;
static_assert(MISC_OFF + 128 <= LDS_BYTES, "LDS map");

typedef unsigned long long u64;
typedef unsigned u32x4v __attribute__((ext_vector_type(4)));

__device__ __forceinline__ float bf2f(unsigned short v) { return __uint_as_float(((unsigned)v) << 16); }
__device__ __forceinline__ float bflo(unsigned w) { return __uint_as_float(w << 16); }
__device__ __forceinline__ float bfhi(unsigned w) { return __uint_as_float(w & 0xffff0000u); }
__device__ __forceinline__ float sigmoidf_(float v) { return __builtin_amdgcn_rcpf(1.0f + __builtin_amdgcn_exp2f(-v * LOG2E)); }

typedef __attribute__((address_space(4))) const char* kaptr_t;
__device__ __forceinline__ const float* in_ptr(int i) { kaptr_t ka = (kaptr_t)__builtin_amdgcn_kernarg_segment_ptr(); asm volatile("" : "+s"(ka)); return *(const float* const __attribute__((address_space(4)))*)(ka + 8 * i); }
#define PHASE_TID() int tid_o = threadIdx.x; asm volatile("" : "+v"(tid_o)); const int ptid = tid_o, plane = tid_o & 63
struct Frame {
    LAS unsigned char* lds;
    volatile LAS unsigned* MISC;
    gu32* ctl;
    int wave, vcu, G;
    unsigned char* ws;
    float* out;
};

__host__ __device__ __forceinline__ int win_src(int n0, int& nvalid) {
    const int pn = n0 >> 8, c = n0 & 255, bj = c >> 7, wc = (c >> 5) & 3; nvalid = 32;
    if (pn < 2) return 0 + 64 * (4 * pn + wc) + 32 * bj;
    if (pn < 4) return 512 + 64 * (4 * (pn - 2) + wc) + 32 * bj;
    if (pn < 6) return 1024 + 256 * (pn - 4) + c;
    if (pn < 8) return 1536 + 256 * (pn - 6) + c;
    if (pn < 10) return 2048 + 64 * (4 * (pn - 8) + wc) + 32 * bj;
    if (pn == 10) {
        if (wc == 0) return 2560 + 32 * bj;
        if (wc == 1) return 2624 + 32 * bj;
        if (wc == 2) return 3456 + 32 * bj;
        if (bj == 0) { nvalid = 4; return 3520; }
        nvalid = 0; return 0;
    }
    if (pn == 11) return 3200 + c;
    if (pn < 14) return 2688 + 256 * (pn - 12) + c;
    if (pn < 18) return 3524 + 256 * (pn - 14) + c;
    return 4548 + 256 * (pn - 18) + c;
}

__device__ __forceinline__ float wave_sum(float v) {
#pragma unroll
    for (int o = 1; o < 64; o <<= 1) v += __shfl_xor(v, o);
    return v;
}
__device__ __forceinline__ void tr_item(const float* W, int ldw, int src0, int nvalid, const float* gk, bf16* WT, int K, int row0, int k0, LAS float* scr, int lane) {
    const int j = lane & 31;
#pragma unroll 8
    for (int i = 0; i < 32; ++i) { const int kk = 2 * i + (lane >> 5);
        float v = 0.f; if (j < nvalid) { v = W[(size_t)(k0 + kk) * ldw + src0 + j]; if (gk) v *= gk[k0 + kk]; }
        scr[kk * 33 + j] = v; }
    LDS_WAIT(); asm volatile("" ::: "memory");
    const int c = lane & 7;
#pragma unroll
    for (int jj = 0; jj < 4; ++jj) { const int n = (lane >> 3) + 8 * jj; const LAS float* s = scr + (8 * c) * 33 + n;
        v4u o; o.x = pk2(s[0 * 33], s[1 * 33]); o.y = pk2(s[2 * 33], s[3 * 33]); o.z = pk2(s[4 * 33], s[5 * 33]); o.w = pk2(s[6 * 33], s[7 * 33]);
        *(GAS v4u*)(WT + (size_t)(row0 + n) * K + k0 + 8 * c) = o; }
    LDS_WAIT(); asm volatile("" ::: "memory");
}
__device__ __forceinline__ void p0_prologue(Frame& F) {
    PHASE_TID();
    LAS float* scr = (LAS float*)(F.lds + F.wave * 16384);
    const int gw = F.vcu * NWAVES + F.wave, NGW = F.G * NWAVES;
    constexpr int I_IN = (DM / 64) * (NIN / 32), I_BR = (AW / 64) * (DM / 32), I_OUT = (DM / 64) * (DM / 32);
    constexpr int PER_L = I_IN + 2 * I_BR + I_OUT;
    for (int it = gw; it < DEPTH * PER_L; it += NGW) {
        const int l = it / PER_L; int r = it % PER_L;
        if (r < I_IN) { const int kb = r / (NIN / 32), nb = r % (NIN / 32); int nvalid; const int src0 = win_src(32 * nb, nvalid);
            tr_item(in_ptr(2) + (size_t)l * DM * DIN, DIN, src0, nvalid, in_ptr(1) + l * DM, (bf16*)(F.ws + WS_WIN) + (size_t)l * NIN * DM, DM, 32 * nb, 64 * kb, scr, plane); continue; }
        r -= I_IN;
        if (r < 2 * I_BR) { const int which = r / I_BR; r %= I_BR; const int kb = r / (DM / 32), nb = r % (DM / 32);
            tr_item((which ? in_ptr(8) : in_ptr(7)) + (size_t)l * AW * DM, DM, 32 * nb, 32, nullptr, (bf16*)(F.ws + WS_WBR) + (size_t)l * 2048 * AW, AW, which * 1024 + 32 * nb, 64 * kb, scr, plane); continue; }
        r -= 2 * I_BR;
        { const int kb = r / (DM / 32), nb = r % (DM / 32);
            tr_item(in_ptr(9) + (size_t)l * DM * DM, DM, 32 * nb, 32, nullptr, (bf16*)(F.ws + WS_WOUT) + (size_t)l * DM * DM, DM, 32 * nb, 64 * kb, scr, plane); }
    }
    const float* x = in_ptr(0); bf16* XB = (bf16*)(F.ws + WS_XB); float* RSS = (float*)(F.ws + WS_RSS);
    for (int m = gw; m < TOK; m += NGW) {
        const GAS f32x4* xr = (const GAS f32x4*)(x + (size_t)m * DM) + plane;
        f32x4 v[4]; float s = 0.f;
#pragma unroll
        for (int j = 0; j < 4; ++j) { v[j] = xr[64 * j]; s += (v[j].x * v[j].x + v[j].y * v[j].y) + (v[j].z * v[j].z + v[j].w * v[j].w); }
        s = wave_sum(s);
        GAS u64* o8 = (GAS u64*)(XB + (size_t)m * DM) + plane;
#pragma unroll
        for (int j = 0; j < 4; ++j) o8[64 * j] = (u64)pk2(v[j].x, v[j].y) | ((u64)pk2(v[j].z, v[j].w) << 32);
        if (plane < 16) RSS[(size_t)m * 16 + plane] = (plane == 0) ? s : 0.f;
    }
}

namespace pg8 {
__device__ __forceinline__ float row_rs(const float* rss, int row, int fq) {
    const f32x4 a = *(const f32x4*)(rss + (size_t)row * 16 + 4 * fq);
    float s = (a[0] + a[1]) + (a[2] + a[3]);
    s += __shfl_xor(s, 16); s += __shfl_xor(s, 32);
    return 1.0f / sqrtf(s * (1.0f / DM) + EPS);
}
__device__ __forceinline__ u32x4 pack8(const f32x4 o0, const f32x4 o1) { u32x4 w; w.x = cvt_pk_bf16(o0[0], o0[1]); w.y = cvt_pk_bf16(o0[2], o0[3]); w.z = cvt_pk_bf16(o1[0], o1[1]); w.w = cvt_pk_bf16(o1[2], o1[3]); return w; }
struct EpiIn {
    static constexpr bool PERM = true, AFTER_DRAIN = false;
    const float* rss; const float *qna, *kna, *qnb, *knb;
    bf16_t *QA, *KA, *VA, *SGA, *QB, *SGB, *KB, *VB, *KI, *QI, *SMA, *SMB; float* WI; float* KMP;
    __device__ __forceinline__ void norm_rows(const f32x4 (&acc)[2][2][4][2], const Unit& u, int wr, int fr, int fq, const float* g, float oscale, bf16_t* dst, int ld, int coloff, float* kmp) const {
        f32x4 gv[2][2];
#pragma unroll
        for (int bj = 0; bj < 2; ++bj)
#pragma unroll
            for (int n = 0; n < 2; ++n) gv[bj][n] = *(const f32x4*)(g + 32 * bj + 8 * fq + 4 * n) * oscale;
        f32x4 cs[2][2];
#pragma unroll
        for (int bj = 0; bj < 2; ++bj)
#pragma unroll
            for (int n = 0; n < 2; ++n) cs[bj][n] = (f32x4){0.f, 0.f, 0.f, 0.f};
#pragma unroll
        for (int ai = 0; ai < 2; ++ai)
#pragma unroll
            for (int m = 0; m < 4; ++m) {
                const int row = u.pm * BM + ai * HALF + wr * 64 + m * 16 + fr; const float rs = row_rs(rss, row, fq);
                float sq = 0.f;
#pragma unroll
                for (int bj = 0; bj < 2; ++bj)
#pragma unroll
                    for (int n = 0; n < 2; ++n) { const f32x4 t = acc[ai][bj][m][n]; sq += (t[0] * t[0] + t[1] * t[1]) + (t[2] * t[2] + t[3] * t[3]); }
                sq += __shfl_xor(sq, 16); sq += __shfl_xor(sq, 32);
                const float sc = rs / sqrtf(sq * rs * rs * (1.0f / 64.0f) + EPS);
#pragma unroll
                for (int bj = 0; bj < 2; ++bj) {
                    const f32x4 o0 = acc[ai][bj][m][0] * sc * gv[bj][0], o1 = acc[ai][bj][m][1] * sc * gv[bj][1];
                    cs[bj][0] += o0; cs[bj][1] += o1;
                    *(u32x4*)(dst + (size_t)row * ld + coloff + 32 * bj + 8 * fq) = pack8(o0, o1); }
                asm volatile("" ::: "memory");
            }
        if (kmp) {
#pragma unroll
            for (int bj = 0; bj < 2; ++bj)
#pragma unroll
                for (int n = 0; n < 2; ++n) { f32x4 t = cs[bj][n];
#pragma unroll
                    for (int o = 1; o < 16; o <<= 1) { t[0] += __shfl_xor(t[0], o); t[1] += __shfl_xor(t[1], o); t[2] += __shfl_xor(t[2], o); t[3] += __shfl_xor(t[3], o); }
                    if (fr == 0) *(f32x4*)(kmp + 32 * bj + 8 * fq + 4 * n) = t; }
        }
    }
    __device__ __forceinline__ void plain_rows(const f32x4 (&acc)[2][2][4][2], const Unit& u, int wr, int fr, int fq, bf16_t* dst, int ld, int col0, int bjs, float ca, float cb, float cc, float* wi) const {
#pragma unroll
        for (int ai = 0; ai < 2; ++ai)
#pragma unroll
            for (int m = 0; m < 4; ++m) {
                const int row = u.pm * BM + ai * HALF + wr * 64 + m * 16 + fr; const float rs = row_rs(rss, row, fq);
                if (wi) { if (fq == 0) *(f32x4*)(wi + (size_t)row * 4) = acc[ai][0][m][0] * rs; }
                else {
#pragma unroll
                for (int bj = 0; bj < 2; ++bj) { f32x4 o0 = acc[ai][bj][m][0] * rs, o1 = acc[ai][bj][m][1] * rs;
#pragma unroll
                    for (int i = 0; i < 4; ++i) { const float s0 = sigmoidf_(o0[i]), s1 = sigmoidf_(o1[i]); o0[i] = ca * o0[i] + s0 * (cb + cc * o0[i]); o1[i] = ca * o1[i] + s1 * (cb + cc * o1[i]); }
                    *(u32x4*)(dst + (size_t)row * ld + col0 + bj * bjs) = pack8(o0, o1); }
                }
                asm volatile("" ::: "memory");
            }
    }
    __device__ __forceinline__ void operator()(const f32x4 (&acc)[2][2][4][2], const Unit& u, int wr, int wc, int fr_, int fq_) const {
        int fr = fr_, fq = fq_; asm volatile("" : "+v"(fr), "+v"(fq));
        const int pn = u.pn; const int cid = wc * 32 + 8 * fq;
        bool isnorm = false; bf16_t* dst; int ld = AW, col0, bjs = HALF; const float* g = qna; float osc = 1.0f; float* kmp = nullptr; float ca = 1.f, cb = 0.f, cc = 0.f; float* wi = nullptr;
        if (pn < 2) { isnorm = true; g = qna; osc = C2; dst = QA; col0 = 64 * (4 * pn + wc); }
        else if (pn < 4) { isnorm = true; g = kna; dst = KA; const int h = 4 * (pn - 2) + wc; col0 = 64 * h; kmp = KMP + ((((size_t)(u.pm >> 4) * 16 + (u.pm & 15)) * 8 + h) * 2 + wr) * 64; }
        else if (pn < 6) { dst = VA; col0 = 256 * (pn - 4) + cid; }
        else if (pn < 8) { dst = SGA; col0 = 256 * (pn - 6) + cid; ca = 0.f; cc = 1.f; }
        else if (pn < 10) { isnorm = true; g = qnb; osc = C2; dst = QB; col0 = 64 * (4 * (pn - 8) + wc); }
        else if (pn == 10) { ld = 64; bjs = 32; col0 = 8 * fq; dst = KI;
            if (wc == 0) { isnorm = true; g = knb; dst = KB; col0 = 0; } else if (wc == 1) { dst = VB; } else if (wc == 3) { wi = WI; } }
        else if (pn == 11) { dst = QI; ld = 256; col0 = cid; }
        else if (pn < 14) { dst = SGB; col0 = 256 * (pn - 12) + cid; ca = 0.f; cc = 1.f; }
        else if (pn < 18) { dst = SMA; ld = DM; col0 = 256 * (pn - 14) + cid; ca = 0.f; cb = 1.f; }
        else { dst = SMB; ld = DM; col0 = 256 * (pn - 18) + cid; ca = 0.f; cb = 1.f; }
        if (isnorm) norm_rows(acc, u, wr, fr, fq, g, osc, dst, ld, col0, kmp);
        else plain_rows(acc, u, wr, fr, fq, dst, ld, col0, bjs, ca, cb, cc, wi);
    }
};
struct EpiMerge {
    static constexpr bool PERM = true, AFTER_DRAIN = false;
    const bf16_t* SMA; bf16_t* SMB; float* TMP;
    __device__ __forceinline__ void operator()(const f32x4 (&acc)[2][2][4][2], const Unit& u, int wr, int wc, int fr, int fq) const {
        const bool partb = u.pm >= 128; const int pm = partb ? u.pm - 128 : u.pm, pn = partb ? u.pn - 4 : u.pn;
#pragma unroll
        for (int ai = 0; ai < 2; ++ai)
#pragma unroll
            for (int m = 0; m < 4; ++m) { const int row = pm * BM + ai * HALF + wr * 64 + m * 16 + fr;
#pragma unroll
                for (int bj = 0; bj < 2; ++bj) { const size_t off = (size_t)row * DM + pn * BM + bj * HALF + wc * 32 + 8 * fq;
                    const u32x4 sg = *(const u32x4*)((partb ? SMB : SMA) + off);
                    const f32x4 s0 = (f32x4){__uint_as_float(sg.x << 16), __uint_as_float(sg.x & 0xffff0000u), __uint_as_float(sg.y << 16), __uint_as_float(sg.y & 0xffff0000u)};
                    const f32x4 s1 = (f32x4){__uint_as_float(sg.z << 16), __uint_as_float(sg.z & 0xffff0000u), __uint_as_float(sg.w << 16), __uint_as_float(sg.w & 0xffff0000u)};
                    f32x4 o0 = acc[ai][bj][m][0] * s0, o1 = acc[ai][bj][m][1] * s1;
                    if (!partb) { *(f32x4*)(TMP + off) = o0; *(f32x4*)(TMP + off + 4) = o1; }
                    else { o0 += *(const f32x4*)(TMP + off); o1 += *(const f32x4*)(TMP + off + 4);
                        u32x4 w; w.x = cvt_pk_bf16(o0[0], o0[1]); w.y = cvt_pk_bf16(o0[2], o0[3]); w.z = cvt_pk_bf16(o1[0], o1[1]); w.w = cvt_pk_bf16(o1[2], o1[3]);
                        *(u32x4*)(SMB + off) = w; } }
            }
    }
};
struct PairOrder {
    StaticOrder base;
    __device__ void init(int G_, int c_) { base.init(TOK, DM, G_, c_); }
    __device__ bool next(int i, Unit& u) const { Unit t; if (!base.next(i >> 1, t)) return false; u.pm = t.pm + (i & 1) * 128; u.pn = t.pn + (i & 1) * 4; return true; }
    __device__ __forceinline__ void a_ready(const Unit&) const {}
    __device__ __forceinline__ void done(const Unit&) const {}
};
template <bool WRITE_NEXT> struct EpiOut {
    static constexpr bool PERM = true, AFTER_DRAIN = false;
    const float* xin; float* out; bf16_t* XB; float* rss;
    __device__ __forceinline__ void operator()(const f32x4 (&acc)[2][2][4][2], const Unit& u, int wr, int wc, int fr, int fq) const {
#pragma unroll
        for (int ai = 0; ai < 2; ++ai)
#pragma unroll
            for (int m = 0; m < 4; ++m) { const int row = u.pm * BM + ai * HALF + wr * 64 + m * 16 + fr; float ss = 0.f;
#pragma unroll
                for (int bj = 0; bj < 2; ++bj) { const size_t off = (size_t)row * DM + u.pn * BM + bj * HALF + wc * 32 + 8 * fq;
                    const f32x4 o0 = acc[ai][bj][m][0] + *(const f32x4*)(xin + off), o1 = acc[ai][bj][m][1] + *(const f32x4*)(xin + off + 4);
                    *(f32x4*)(out + off) = o0; *(f32x4*)(out + off + 4) = o1;
                    if (WRITE_NEXT) { ss += (o0[0] * o0[0] + o0[1] * o0[1]) + (o0[2] * o0[2] + o0[3] * o0[3]) + (o1[0] * o1[0] + o1[1] * o1[1]) + (o1[2] * o1[2] + o1[3] * o1[3]);
                        u32x4 w; w.x = cvt_pk_bf16(o0[0], o0[1]); w.y = cvt_pk_bf16(o0[2], o0[3]); w.z = cvt_pk_bf16(o1[0], o1[1]); w.w = cvt_pk_bf16(o1[2], o1[3]);
                        *(u32x4*)(XB + off) = w; } }
                if (WRITE_NEXT) { ss += __shfl_xor(ss, 16); ss += __shfl_xor(ss, 32); if (fq == 0) rss[(size_t)row * 16 + 4 * u.pn + wc] = ss; }
            }
    }
};
}

__device__ __forceinline__ int rel_bucket_dev(int n) {
    if (n < 16) return n;
    int large = 16 + (int)(logf((float)n / 16.0f) / logf(8.0f) * 16.0f);
    return large < 31 ? large : 31;
}
__device__ __forceinline__ void build_bias_table(Frame& F, LAS float* tb, const float* gq, const float* gk, int hoff) {
    PHASE_TID(); const float* rb = in_ptr(10);
    float gm = 0.f;
    for (int d = 0; d < 64; ++d) gm = fmaxf(gm, fabsf(gq[d] * gk[d]));
    for (int e = ptid; e < 8 * 128; e += NWAVES * 64) { const int h = e >> 7, d = e & 127;
        float bm = -1e30f; for (int k = 0; k < 32; ++k) bm = fmaxf(bm, rb[k * 16 + hoff + h]);
        const float M0 = 64.0f * C2 * gm + bm * LOG2E;
        tb[e] = rb[rel_bucket_dev(d) * 16 + hoff + h] * LOG2E - M0; }
}

template <int MODE>
__device__ __forceinline__ void naive_attn(Frame& F, int layer) {
    PHASE_TID();
    LAS float* tb = (LAS float*)F.lds;
    const float* gq = in_ptr(MODE == 0 ? 3 : 5) + layer * 64; const float* gk = in_ptr(MODE == 0 ? 4 : 6) + layer * 64;
    build_bias_table(F, tb, gq, gk, MODE * 8);
    __syncthreads();
    const bf16* Q = (const bf16*)(F.ws + (MODE == 0 ? WS_QA : WS_QB));
    const bf16* K = (const bf16*)(F.ws + (MODE == 0 ? WS_KA : WS_KB));
    const bf16* V = (const bf16*)(F.ws + (MODE == 0 ? WS_VA : WS_VB));
    const bf16* SG = (const bf16*)(F.ws + (MODE == 0 ? WS_SGA : WS_SGB));
    bf16* Y = (bf16*)(F.ws + WS_XB) + (size_t)MODE * TOK * AW;
    const float* KMP = (const float*)(F.ws + WS_KMP);
    const u64* BM = (const u64*)(F.ws + WS_BM);
    constexpr int KLD = (MODE == 0) ? AW : 64;
    for (int item = blockIdx.x * (NWAVES * 64) + ptid; item < BATCH * NH * SEQ; item += F.G * NWAVES * 64) {
        const int q = item & (SEQ - 1), h = (item >> 12) & 7, b = item >> 15; const int qblk = q >> 8;
        const size_t tq = (size_t)b * SEQ + q;
        float qv[64];
        { const v4u* qp = (const v4u*)(Q + tq * AW + h * 64);
#pragma unroll
            for (int c = 0; c < 8; ++c) { const v4u w = qp[c]; qv[8 * c + 0] = bflo(w.x); qv[8 * c + 1] = bfhi(w.x); qv[8 * c + 2] = bflo(w.y); qv[8 * c + 3] = bfhi(w.y); qv[8 * c + 4] = bflo(w.z); qv[8 * c + 5] = bfhi(w.z); qv[8 * c + 6] = bflo(w.w); qv[8 * c + 7] = bfhi(w.w); } }
        unsigned selmask = 0;
        if (MODE == 0) {
            float gate[16];
#pragma unroll
            for (int n = 0; n < 16; ++n) { gate[n] = -INFINITY;
                if (n < qblk) { const float* k0 = KMP + ((((size_t)b * 16 + n) * 8 + h) * 2) * 64; float s = 0.f;
#pragma unroll
                    for (int d = 0; d < 64; ++d) s += qv[d] * ((k0[d] + k0[64 + d]) * (1.0f / 256.0f));
                    gate[n] = s; } }
            const int nsel = qblk < 3 ? qblk : 3;
            for (int r = 0; r < nsel; ++r) { float best = -INFINITY; int bi = -1;
#pragma unroll
                for (int n = 0; n < 16; ++n) { const bool ok = (n < qblk) && !((selmask >> n) & 1u) && (bi < 0 || gate[n] > best); if (ok) { best = gate[n]; bi = n; } }
                selmask |= 1u << bi; }
        }
        float acc[64];
#pragma unroll
        for (int d = 0; d < 64; ++d) acc[d] = 0.f;
        float l = 0.f;
        const int kend = (item | 63) & (SEQ - 1);
        const LAS float* tbh = tb + h * 128;
        u64 mw = 0;
        for (int k = 0; k <= kend; ++k) {
            bool allowed;
            if (MODE == 0) { const int n = k >> 8; allowed = (n == qblk) ? (k <= q) : (((selmask >> n) & 1u) != 0u && n < qblk); }
            else { if ((k & 63) == 0) mw = (k <= q) ? BM[tq * 64 + (k >> 6)] : 0ull; allowed = ((mw >> (k & 63)) & 1ull) != 0ull; }
            if (!__any(allowed)) continue;
            const size_t tk = (size_t)b * SEQ + k;
            const v4u* kp = (const v4u*)(K + tk * KLD + (MODE == 0 ? h * 64 : 0));
            float s = 0.f;
#pragma unroll
            for (int c = 0; c < 8; ++c) { const v4u w = kp[c];
                s += qv[8 * c + 0] * bflo(w.x); s += qv[8 * c + 1] * bfhi(w.x); s += qv[8 * c + 2] * bflo(w.y); s += qv[8 * c + 3] * bfhi(w.y);
                s += qv[8 * c + 4] * bflo(w.z); s += qv[8 * c + 5] * bfhi(w.z); s += qv[8 * c + 6] * bflo(w.w); s += qv[8 * c + 7] * bfhi(w.w); }
            int dist = q - k; dist = dist < 0 ? 0 : (dist > 127 ? 127 : dist);
            s += tbh[dist];
            const float p = allowed ? __builtin_amdgcn_exp2f(s) : 0.f;
            l += p;
            const v4u* vp = (const v4u*)(V + tk * KLD + (MODE == 0 ? h * 64 : 0));
#pragma unroll
            for (int c = 0; c < 8; ++c) { const v4u w = vp[c];
                acc[8 * c + 0] += p * bflo(w.x); acc[8 * c + 1] += p * bfhi(w.x); acc[8 * c + 2] += p * bflo(w.y); acc[8 * c + 3] += p * bfhi(w.y);
                acc[8 * c + 4] += p * bflo(w.z); acc[8 * c + 5] += p * bfhi(w.z); acc[8 * c + 6] += p * bflo(w.w); acc[8 * c + 7] += p * bfhi(w.w); }
        }
        const float il = 1.0f / l;
        const v4u* gp = (const v4u*)(SG + tq * AW + h * 64); v4u* yp = (v4u*)(Y + tq * AW + h * 64);
#pragma unroll
        for (int c = 0; c < 8; ++c) { const v4u g = gp[c]; v4u o;
            o.x = pk2(acc[8 * c + 0] * il * bflo(g.x), acc[8 * c + 1] * il * bfhi(g.x)); o.y = pk2(acc[8 * c + 2] * il * bflo(g.y), acc[8 * c + 3] * il * bfhi(g.y));
            o.z = pk2(acc[8 * c + 4] * il * bflo(g.z), acc[8 * c + 5] * il * bfhi(g.z)); o.w = pk2(acc[8 * c + 6] * il * bflo(g.w), acc[8 * c + 7] * il * bfhi(g.w));
            yp[c] = o; }
    }
}

typedef float f32x16 __attribute__((ext_vector_type(16)));
typedef short s16x4 __attribute__((ext_vector_type(4)));
typedef short v4i16_t __attribute__((ext_vector_type(4)));
constexpr int AT_RING = 0, AT_STAGE = 16384, AT_TB = 32768, AT_WS = 40960, AT_OST = 43008;
static_assert(AT_OST + 8 * 8192 <= RING_BYTES, "attention LDS");
__device__ __forceinline__ int crow(int r, int hi) { return (r & 3) + 8 * (r >> 2) + 4 * hi; }
__device__ __forceinline__ unsigned cvtpk(float lo, float hi) { unsigned r; asm volatile("v_cvt_pk_bf16_f32 %0, %1, %2" : "=v"(r) : "v"(lo), "v"(hi)); return r; }

template <int MODE>
__device__ __forceinline__ void attn_unit(Frame& F, int b, int h_, int blk) {
    int tid_o = threadIdx.x; asm volatile("" : "+v"(tid_o));
    const int lane = tid_o & 63, r32 = lane & 31, hi = lane >> 5, wid = __builtin_amdgcn_readfirstlane(tid_o >> 6);
    constexpr int KLD = (MODE == 0) ? AW : 64;
    const int h = (MODE == 0) ? h_ : wid;
    const int q0 = (MODE == 0) ? 256 * blk + 32 * wid : 32 * blk;
    const int q = q0 + r32; const size_t tq = (size_t)b * SEQ + q;
    const int NT = (MODE == 0) ? 4 * (blk + 1) : (32 * blk + 31) / 64 + 1;
    const bf16* Q = (const bf16*)(F.ws + (MODE == 0 ? WS_QA : WS_QB));
    const bf16* Kg = (const bf16*)(F.ws + (MODE == 0 ? WS_KA : WS_KB)) + (size_t)b * SEQ * KLD + (MODE == 0 ? h * 64 : 0);
    const bf16* Vg = (const bf16*)(F.ws + (MODE == 0 ? WS_VA : WS_VB)) + (size_t)b * SEQ * KLD + (MODE == 0 ? h * 64 : 0);
    const bf16* SG = (const bf16*)(F.ws + (MODE == 0 ? WS_SGA : WS_SGB));
    bf16* Y = (bf16*)(F.ws + WS_XB) + (size_t)MODE * TOK * AW;
    const u64* BM = (const u64*)(F.ws + WS_BM) + tq * 64;
    LAS unsigned char* lds = F.lds;
    const LAS float* tbh = (const LAS float*)(lds + AT_TB) + (MODE * 8 + h) * 128;
    LAS float* wsf = (LAS float*)(lds + AT_WS) + wid * 64;
    LAS float* ost = (LAS float*)(lds + AT_OST) + wid * 2048;
    const bf16* ksrc = Kg + (size_t)lane * KLD + 8 * wid;
    const bf16* vsrc = Vg + (size_t)(8 * wid + ((lane & 31) >> 2)) * KLD + 32 * (lane >> 5) + 8 * (lane & 3);
#define AT_DMA(t, st) do { \
        __builtin_amdgcn_global_load_lds((const unsigned*)(ksrc + (size_t)(t) * 64 * KLD), (LAS unsigned*)(lds + AT_RING + (st) * AT_STAGE + wid * 1024), 16, 0, 0); \
        __builtin_amdgcn_global_load_lds((const unsigned*)(vsrc + (size_t)(t) * 64 * KLD), (LAS unsigned*)(lds + AT_RING + (st) * AT_STAGE + 8192 + wid * 1024), 16, 0, 0); } while (0)
    AT_DMA(0, 0);
    bf16x8 qr[4];
#pragma unroll
    for (int d0 = 0; d0 < 4; ++d0) qr[d0] = *(const bf16x8*)(Q + tq * AW + h * 64 + 16 * d0 + 8 * hi);
    unsigned selmask = 0;
    if (MODE == 0 && blk > 0) {
        float qf[64];
        { const v4u* qp = (const v4u*)(Q + tq * AW + h * 64);
#pragma unroll
            for (int c = 0; c < 8; ++c) { const v4u w = qp[c]; qf[8 * c + 0] = bflo(w.x); qf[8 * c + 1] = bfhi(w.x); qf[8 * c + 2] = bflo(w.y); qf[8 * c + 3] = bfhi(w.y); qf[8 * c + 4] = bflo(w.z); qf[8 * c + 5] = bfhi(w.z); qf[8 * c + 6] = bflo(w.w); qf[8 * c + 7] = bfhi(w.w); } }
        const float* KMP = (const float*)(F.ws + WS_KMP);
        float g8[8];
#pragma unroll
        for (int nn = 0; nn < 8; ++nn) { const int n = 8 * hi + nn; float s = -INFINITY;
            if (n < blk) { const f32x4* k0 = (const f32x4*)(KMP + ((((size_t)b * 16 + n) * 8 + h) * 2) * 64); s = 0.f;
#pragma unroll
                for (int c = 0; c < 16; ++c) { const f32x4 a = k0[c], bb = k0[16 + c];
                    s += qf[4 * c + 0] * ((a[0] + bb[0]) * (1.0f / 256.0f)); s += qf[4 * c + 1] * ((a[1] + bb[1]) * (1.0f / 256.0f)); s += qf[4 * c + 2] * ((a[2] + bb[2]) * (1.0f / 256.0f)); s += qf[4 * c + 3] * ((a[3] + bb[3]) * (1.0f / 256.0f)); } }
            g8[nn] = s; }
        float gate[16];
#pragma unroll
        for (int nn = 0; nn < 8; ++nn) { const float o = __shfl_xor(g8[nn], 32); gate[nn] = hi ? o : g8[nn]; gate[8 + nn] = hi ? g8[nn] : o; }
        const int nsel = blk < 3 ? blk : 3;
        for (int r = 0; r < nsel; ++r) { float best = -INFINITY; int bi = -1;
#pragma unroll
            for (int n = 0; n < 16; ++n) { const bool ok = (n < blk) && !((selmask >> n) & 1u) && (bi < 0 || gate[n] > best); if (ok) { best = gate[n]; bi = n; } }
            selmask |= 1u << bi; }
    }
    const float cfar = tbh[127]; const float NINF = -INFINITY;
    f32x16 o0, o1;
#pragma unroll
    for (int r = 0; r < 16; ++r) { o0[r] = 0.f; o1[r] = 0.f; }
    float lsum = 0.f;
    u64 mwn = 0ull; if (MODE == 1) mwn = BM[0];
    const int vbl = ((lane >> 4) & 1) * 32 + (lane & 3) * 8 + (4 * hi + ((lane & 15) >> 2)) * 64;
    for (int t = 0; t < NT; ++t) {
        __syncthreads();
        if (t + 1 < NT) AT_DMA(t + 1, (t + 1) & 1);
        u64 mw = mwn; if (MODE == 1 && t + 1 < NT) mwn = BM[t + 1];
        const int kv0 = 64 * t;
        const bool active = (MODE == 1) || (kv0 <= q0 + 31);
        if (active) {
            const LAS unsigned char* Kt = lds + AT_RING + (t & 1) * AT_STAGE; const LAS unsigned char* Vt = Kt + 8192;
            f32x16 c0, c1;
            const bool nearD = (q0 - (kv0 + 63)) < 113;
            bool sel = true;
            if (MODE == 0) { const int n = t >> 2; sel = (n == blk) || (((selmask >> n) & 1u) != 0u); }
            unsigned mlo = 0, mhi = 0; if (MODE == 1) { const u64 ms = mw >> (4 * hi); mlo = (unsigned)ms; mhi = (unsigned)(ms >> 32); }
            if (!nearD) {
#pragma unroll
                for (int r = 0; r < 16; ++r) { const int bp = (r & 3) + 8 * (r >> 2);
                    if (MODE == 0) { c0[r] = sel ? cfar : NINF; c1[r] = sel ? cfar : NINF; }
                    else { c0[r] = ((mlo >> bp) & 1u) ? cfar : NINF; c1[r] = ((mhi >> bp) & 1u) ? cfar : NINF; } }
            } else {
#pragma unroll
                for (int r = 0; r < 16; ++r) { const int bp = (r & 3) + 8 * (r >> 2);
                    const int d0_ = q - (kv0 + bp + 4 * hi), d1_ = d0_ - 32;
                    const float b0 = tbh[d0_ < 0 ? 0 : (d0_ > 127 ? 127 : d0_)], b1 = tbh[d1_ < 0 ? 0 : (d1_ > 127 ? 127 : d1_)];
                    if (MODE == 0) { c0[r] = (sel && d0_ >= 0) ? b0 : NINF; c1[r] = (sel && d1_ >= 0) ? b1 : NINF; }
                    else { c0[r] = ((mlo >> bp) & 1u) ? b0 : NINF; c1[r] = ((mhi >> bp) & 1u) ? b1 : NINF; } }
            }
#pragma unroll
            for (int d0 = 0; d0 < 4; ++d0) {
                const bf16x8 k0 = *(const LAS bf16x8*)(Kt + (2 * d0 + hi) * 1024 + r32 * 16);
                const bf16x8 k1 = *(const LAS bf16x8*)(Kt + (2 * d0 + hi) * 1024 + 512 + r32 * 16);
                c0 = __builtin_amdgcn_mfma_f32_32x32x16_bf16(k0, qr[d0], c0, 0, 0, 0);
                c1 = __builtin_amdgcn_mfma_f32_32x32x16_bf16(k1, qr[d0], c1, 0, 0, 0); }
            float sacc = 0.f;
#pragma unroll
            for (int r = 0; r < 16; ++r) { c0[r] = __builtin_amdgcn_exp2f(c0[r]); c1[r] = __builtin_amdgcn_exp2f(c1[r]); sacc += c0[r] + c1[r]; }
            lsum += sacc;
            u32x4v pw[4];
#pragma unroll
            for (int s = 0; s < 2; ++s) {
                pw[s] = (u32x4v){cvtpk(c0[8 * s], c0[8 * s + 1]), cvtpk(c0[8 * s + 2], c0[8 * s + 3]), cvtpk(c0[8 * s + 4], c0[8 * s + 5]), cvtpk(c0[8 * s + 6], c0[8 * s + 7])};
                pw[2 + s] = (u32x4v){cvtpk(c1[8 * s], c1[8 * s + 1]), cvtpk(c1[8 * s + 2], c1[8 * s + 3]), cvtpk(c1[8 * s + 4], c1[8 * s + 5]), cvtpk(c1[8 * s + 6], c1[8 * s + 7])}; }
#pragma unroll
            for (int ks = 0; ks < 4; ++ks) {
                const bf16x8 pa = __builtin_bit_cast(bf16x8, pw[ks]);
#pragma unroll
                for (int d0 = 0; d0 < 2; ++d0) {
                    const LAS unsigned char* vp = Vt + (2 * ks) * 1024 + d0 * 512 + vbl;
                    const s16x4 lo = __builtin_bit_cast(s16x4, __builtin_amdgcn_ds_read_tr16_b64_v4i16((LAS v4i16_t*)vp));
                    const s16x4 hh = __builtin_bit_cast(s16x4, __builtin_amdgcn_ds_read_tr16_b64_v4i16((LAS v4i16_t*)(vp + 1024)));
                    const bf16x8 vf = (bf16x8){lo[0], lo[1], lo[2], lo[3], hh[0], hh[1], hh[2], hh[3]};
                    if (d0 == 0) o0 = __builtin_amdgcn_mfma_f32_32x32x16_bf16(pa, vf, o0, 0, 0, 0);
                    else o1 = __builtin_amdgcn_mfma_f32_32x32x16_bf16(pa, vf, o1, 0, 0, 0); }
            }
        }
    }
    lsum += __shfl_xor(lsum, 32);
    if (hi == 0) wsf[r32] = lsum;
    LDS_WAIT(); asm volatile("" ::: "memory");
#pragma unroll
    for (int r = 0; r < 16; ++r) { const int orow = crow(r, hi); const float rl = 1.0f / wsf[orow];
        ost[orow * 64 + r32] = o0[r] * rl; ost[orow * 64 + 32 + r32] = o1[r] * rl; }
    LDS_WAIT(); asm volatile("" ::: "memory");
#pragma unroll
    for (int i = 0; i < 4; ++i) { const int row = i * 8 + (lane >> 3), ch = lane & 7;
        const f32x4 a = *(const LAS f32x4*)(ost + row * 64 + ch * 8), c = *(const LAS f32x4*)(ost + row * 64 + ch * 8 + 4);
        const size_t off = ((size_t)b * SEQ + q0 + row) * AW + h * 64 + ch * 8;
        const v4u g = *(const v4u*)(SG + off); v4u o;
        o.x = pk2(a[0] * bflo(g.x), a[1] * bfhi(g.x)); o.y = pk2(a[2] * bflo(g.y), a[3] * bfhi(g.y)); o.z = pk2(c[0] * bflo(g.z), c[1] * bfhi(g.z)); o.w = pk2(c[2] * bflo(g.w), c[3] * bfhi(g.w));
        *(v4u*)(Y + off) = o; }
    __syncthreads();
#undef AT_DMA
}
__device__ __forceinline__ void attn_phase_fast(Frame& F, int layer) {
    { LAS float* tb = (LAS float*)(F.lds + AT_TB);
      build_bias_table(F, tb, in_ptr(3) + layer * 64, in_ptr(4) + layer * 64, 0);
      build_bias_table(F, tb + 1024, in_ptr(5) + layer * 64, in_ptr(6) + layer * 64, 8); }
    __syncthreads();
    for (int pr = F.vcu; pr < 512; pr += F.G) {
        const int bh = pr >> 3, s = pr & 7;
        attn_unit<0>(F, bh >> 3, bh & 7, 15 - s); attn_unit<0>(F, bh >> 3, bh & 7, s); }
    for (int pr = F.vcu; pr < 512; pr += F.G) {
        const int b = pr >> 6, s = pr & 63;
        attn_unit<1>(F, b, 0, 127 - s); attn_unit<1>(F, b, 0, s); }
}

constexpr int IDX_S_OFF = 0, IDX_Q_OFF = RING_BYTES, IDX_W_OFF = RING_BYTES + 8192, IDX_H_OFF = RING_BYTES + 8192 + 256;
static_assert(IDX_H_OFF + 8192 <= LDSCTL_OFF, "idx LDS");

#define DPPI_(x, ctrl) __builtin_amdgcn_update_dpp(0, (x), (ctrl), 0xF, 0xF, true)
#define DPPF_(x, ctrl) __builtin_bit_cast(float, DPPI_(__builtin_bit_cast(int, (x)), (ctrl)))
__device__ __forceinline__ float rl_f(float x, int l) { return __builtin_bit_cast(float, __builtin_amdgcn_readlane(__builtin_bit_cast(int, x), l)); }
__device__ __forceinline__ float wave_minf(float x) {
    x = fminf(x, DPPF_(x, 0xB1)); x = fminf(x, DPPF_(x, 0x4E)); x = fminf(x, DPPF_(x, 0x141)); x = fminf(x, DPPF_(x, 0x140));
    return fminf(fminf(rl_f(x, 0), rl_f(x, 16)), fminf(rl_f(x, 32), rl_f(x, 48)));
}
__device__ __forceinline__ float wave_maxf(float x) {
    x = fmaxf(x, DPPF_(x, 0xB1)); x = fmaxf(x, DPPF_(x, 0x4E)); x = fmaxf(x, DPPF_(x, 0x141)); x = fmaxf(x, DPPF_(x, 0x140));
    return fmaxf(fmaxf(rl_f(x, 0), rl_f(x, 16)), fmaxf(rl_f(x, 32), rl_f(x, 48)));
}
#define SEL_OPAQUE() do { _Pragma("unroll") for (int j_ = 0; j_ < 64; ++j_) asm volatile("" : "+v"(v[j_])); } while (0)
__device__ __forceinline__ u64 select_row(float (&v)[64], int n, int lane, LAS unsigned* hist) {
    const int nch = (n + 63) >> 6;
    float lo = INFINITY, hi = -INFINITY;
#pragma unroll
    for (int j = 0; j < 64; ++j) if (j < nch) { const float x = v[j]; lo = fminf(lo, x == -INFINITY ? INFINITY : x); hi = fmaxf(hi, x); }
    lo = wave_minf(lo); hi = wave_maxf(hi);
    int need = 256; float T = lo; int needT = 256;
    for (int iter = 0; iter < 48; ++iter) {
        T = lo; needT = need;
        if (!(hi > lo)) break;
        hist[lane] = 0u; hist[64 + lane] = 0u; hist[128 + lane] = 0u; hist[192 + lane] = 0u;
        LDS_WAIT(); asm volatile("" ::: "memory");
        const float inv = 1.0f / (hi - lo);
        SEL_OPAQUE();
#pragma unroll
        for (int j = 0; j < 64; ++j) if (j < nch) { const float x = v[j];
            if (x >= lo && x <= hi) { int bin = (int)(((x - lo) * inv) * 256.0f); bin = bin > 255 ? 255 : bin; __hip_atomic_fetch_add(hist + bin, 1u, __ATOMIC_RELAXED, __HIP_MEMORY_SCOPE_WORKGROUP); } }
        LDS_WAIT(); asm volatile("" ::: "memory");
        const unsigned h0 = hist[4 * lane], h1 = hist[4 * lane + 1], h2 = hist[4 * lane + 2], h3 = hist[4 * lane + 3];
        unsigned suf = h0 + h1 + h2 + h3;
#pragma unroll
        for (int o = 1; o < 64; o <<= 1) { const unsigned t = __shfl_down(suf, o); if (lane + o < 64) suf += t; }
        const u64 bal = __ballot(suf >= (unsigned)need);
        if (bal == 0ull) break;
        const int ls = 63 - __builtin_clzll(bal);
        const unsigned a3 = __builtin_amdgcn_readlane(h3, ls), a2 = __builtin_amdgcn_readlane(h2, ls), a1 = __builtin_amdgcn_readlane(h1, ls), a0 = __builtin_amdgcn_readlane(h0, ls);
        const unsigned above_lane = __builtin_amdgcn_readlane(suf, ls) - (a0 + a1 + a2 + a3);
        int bstar; unsigned above, cstar;
        if (above_lane + a3 >= (unsigned)need) { bstar = 4 * ls + 3; above = above_lane; cstar = a3; }
        else if (above_lane + a3 + a2 >= (unsigned)need) { bstar = 4 * ls + 2; above = above_lane + a3; cstar = a2; }
        else if (above_lane + a3 + a2 + a1 >= (unsigned)need) { bstar = 4 * ls + 1; above = above_lane + a3 + a2; cstar = a1; }
        else { bstar = 4 * ls; above = above_lane + a3 + a2 + a1; cstar = a0; }
        need -= (int)above;
        float nlo = INFINITY, nhi = -INFINITY; int cnt = 0;
        LAS float* candx = (LAS float*)hist; LAS unsigned* candi = hist + 64;
        SEL_OPAQUE();
#pragma unroll
        for (int j = 0; j < 64; ++j) if (j < nch) { const float x = v[j];
            int bin = (int)(((x - lo) * inv) * 256.0f); bin = bin > 255 ? 255 : bin;
            const bool c = (x >= lo && x <= hi) && bin == bstar;
            const u64 cb = __ballot(c);
            if (cb != 0ull) { nlo = fminf(nlo, c ? x : INFINITY); nhi = fmaxf(nhi, c ? x : -INFINITY);
                const int pos = cnt + (int)__builtin_amdgcn_mbcnt_hi((unsigned)(cb >> 32), __builtin_amdgcn_mbcnt_lo((unsigned)cb, 0u));
                if (c && pos < 64) { candx[pos] = x; candi[pos] = (unsigned)(64 * j + lane); }
                cnt += __builtin_popcountll(cb); } }
        if (cstar <= 64u) {
            LDS_WAIT(); asm volatile("" ::: "memory");
            const bool mine = lane < (int)cstar;
            const float mx = mine ? candx[lane] : -INFINITY; const unsigned mi = candi[lane];
            int rank = 0;
            for (int i = 0; i < (int)cstar; ++i) { const float xi = rl_f(mx, i); const unsigned ii = (unsigned)__builtin_amdgcn_readlane((int)mi, i); rank += (xi > mx || (xi == mx && ii < mi)) ? 1 : 0; }
            const u64 tb_ = __ballot(mine && rank == need - 1);
            if (tb_ == 0ull) break;
            T = rl_f(mx, __builtin_ctzll(tb_));
            needT = need - __builtin_popcountll(__ballot(mine && mx > T));
            LDS_WAIT(); asm volatile("" ::: "memory");
            break;
        }
        nlo = wave_minf(nlo); nhi = wave_maxf(nhi);
        if ((int)cstar == need) { T = nlo; needT = 1 << 20; break; }
        lo = nlo; hi = nhi;
    }
    int run = 0; unsigned wlo = 0u, whi = 0u;
    SEL_OPAQUE();
#pragma unroll
    for (int j = 0; j < 64; ++j) {
        u64 w = 0ull;
        if (j < nch) { const float x = v[j];
            const bool tie = (x == T); const u64 tbal = __ballot(tie);
            if (tbal == 0ull) w = __ballot(x > T);
            else { const int rank = run + (int)__builtin_amdgcn_mbcnt_hi((unsigned)(tbal >> 32), __builtin_amdgcn_mbcnt_lo((unsigned)tbal, 0u)); run += __builtin_popcountll(tbal);
                w = __ballot(x > T || (tie && rank < needT)); } }
        if (lane == j) { wlo = (unsigned)w; whi = (unsigned)(w >> 32); }
    }
    return (u64)wlo | ((u64)whi << 32);
}

#ifdef NAIVE_IDX
__device__ __forceinline__ void idx_phase_naive(Frame& F) {
    PHASE_TID();
    LAS float* S = (LAS float*)(F.lds + IDX_S_OFF); LAS float* qs = (LAS float*)(F.lds + IDX_Q_OFF); LAS float* wsm = (LAS float*)(F.lds + IDX_W_OFF);
    LAS unsigned* hist = (LAS unsigned*)(F.lds + IDX_H_OFF) + F.wave * 256;
    const bf16* QI = (const bf16*)(F.ws + WS_QI); const bf16* KI = (const bf16*)(F.ws + WS_KI); const float* WI = (const float*)(F.ws + WS_WI); u64* BM = (u64*)(F.ws + WS_BM);
    for (int un = blockIdx.x; un < TOK / 8; un += F.G) {
        const int b = un >> 9, q0 = (un & 511) * 8; const size_t t0 = (size_t)b * SEQ + q0;
        for (int e = ptid; e < 8 * 256; e += NWAVES * 64) qs[e] = bf2f(QI[t0 * 256 + e]);
        if (ptid < 32) wsm[ptid] = WI[t0 * 4 + ptid];
        __syncthreads();
        const int nk = q0 + 8;
        for (int k = ptid; k < nk; k += NWAVES * 64) {
            float kf[64];
            { const v4u* kp = (const v4u*)(KI + ((size_t)b * SEQ + k) * 64);
#pragma unroll
                for (int c = 0; c < 8; ++c) { const v4u w = kp[c]; kf[8 * c + 0] = bflo(w.x); kf[8 * c + 1] = bfhi(w.x); kf[8 * c + 2] = bflo(w.y); kf[8 * c + 3] = bfhi(w.y); kf[8 * c + 4] = bflo(w.z); kf[8 * c + 5] = bfhi(w.z); kf[8 * c + 6] = bflo(w.w); kf[8 * c + 7] = bfhi(w.w); } }
            for (int i = 0; i < 8; ++i) { float sc = 0.f;
#pragma unroll
                for (int h = 0; h < 4; ++h) { float dot = 0.f; const LAS f32x4* qp = (const LAS f32x4*)(qs + i * 256 + h * 64);
#pragma unroll
                    for (int c = 0; c < 16; ++c) { const f32x4 qq = qp[c]; dot += kf[4 * c] * qq[0]; dot += kf[4 * c + 1] * qq[1]; dot += kf[4 * c + 2] * qq[2]; dot += kf[4 * c + 3] * qq[3]; }
                    sc += wsm[i * 4 + h] * fmaxf(dot, 0.f); }
                S[i * 4096 + k] = sc; }
        }
        __syncthreads();
        { const int i = F.wave, n = q0 + i + 1; u64 word;
            if (n <= 256) { const int full = n >> 6, rem = n & 63; word = (plane < full) ? ~0ull : (plane == full ? ((1ull << rem) - 1ull) : 0ull); }
            else { float v[64]; const int nch = (n + 63) >> 6;
#pragma unroll
                for (int j = 0; j < 64; ++j) v[j] = (j < nch && (64 * j + plane) < n) ? S[i * 4096 + 64 * j + plane] : -INFINITY;
                word = select_row(v, n, plane, hist); }
            BM[(t0 + i) * 64 + plane] = word; }
        __syncthreads();
    }
}

#endif
__device__ __forceinline__ float dpp_quad_sum(float x) {
    x += __builtin_bit_cast(float, __builtin_amdgcn_mov_dpp(__builtin_bit_cast(int, x), 0xB1, 0xF, 0xF, true));
    x += __builtin_bit_cast(float, __builtin_amdgcn_mov_dpp(__builtin_bit_cast(int, x), 0x4E, 0xF, 0xF, true));
    return x;
}
__device__ __forceinline__ void idx_phase(Frame& F) {
    PHASE_TID();
    LAS float* S = (LAS float*)(F.lds + IDX_S_OFF);
    LAS unsigned* hist = (LAS unsigned*)(F.lds + IDX_H_OFF) + F.wave * 256;
    const bf16* QI = (const bf16*)(F.ws + WS_QI); const bf16* KI = (const bf16*)(F.ws + WS_KI); const float* WI = (const float*)(F.ws + WS_WI); u64* BM = (u64*)(F.ws + WS_BM);
    const int c16 = plane & 15, kg = plane >> 4, qloc = c16 >> 2, hh = c16 & 3;
    for (int un = blockIdx.x; un < TOK / 8; un += F.G) {
        const int b = un >> 9, m_ = un & 511, q0 = (m_ < 256 ? m_ : 767 - m_) * 8; const size_t t0 = (size_t)b * SEQ + q0;
        bf16x8 qf[2][2]; float wv[2];
#pragma unroll
        for (int g = 0; g < 2; ++g) { wv[g] = WI[(t0 + 4 * g + qloc) * 4 + hh];
#pragma unroll
            for (int ks = 0; ks < 2; ++ks) qf[g][ks] = *(const bf16x8*)(QI + (t0 + 4 * g + qloc) * 256 + hh * 64 + 32 * ks + 8 * kg); }
        const int nchunk = (q0 + 8 + 15) >> 4;
        const bf16* kbase = KI + (size_t)b * SEQ * 64 + (size_t)c16 * 64 + 8 * kg;
        for (int c0 = F.wave; c0 < nchunk; c0 += 4 * NWAVES) {
            bf16x8 ka[4][2];
#pragma unroll
            for (int u = 0; u < 4; ++u) { const int c = c0 + u * NWAVES; const bf16* kp = kbase + (size_t)(c < nchunk ? c : c0) * 16 * 64;
                ka[u][0] = *(const bf16x8*)kp; ka[u][1] = *(const bf16x8*)(kp + 32); }
#pragma unroll
            for (int u = 0; u < 4; ++u) { const int c = c0 + u * NWAVES;
                if (c < nchunk) {
#pragma unroll
                    for (int g = 0; g < 2; ++g) {
                        pg8::f32x4 acc = (pg8::f32x4){0.f, 0.f, 0.f, 0.f};
                        acc = __builtin_amdgcn_mfma_f32_16x16x32_bf16(ka[u][0], qf[g][0], acc, 0, 0, 0);
                        acc = __builtin_amdgcn_mfma_f32_16x16x32_bf16(ka[u][1], qf[g][1], acc, 0, 0, 0);
                        pg8::f32x4 sc;
#pragma unroll
                        for (int i = 0; i < 4; ++i) sc[i] = dpp_quad_sum(wv[g] * fmaxf(acc[i], 0.f));
                        if (hh == 0) *(LAS pg8::f32x4*)(S + (4 * g + qloc) * 4096 + 16 * c + 4 * kg) = sc;
                    } } }
        }
        __syncthreads();
        { const int i = F.wave, n = q0 + i + 1; u64 word;
            if (n <= 256) { const int full = n >> 6, rem = n & 63; word = (plane < full) ? ~0ull : (plane == full ? ((1ull << rem) - 1ull) : 0ull); }
            else { float v[64]; const int nch = (n + 63) >> 6;
#pragma unroll
                for (int j = 0; j < 64; ++j) v[j] = (j < nch && (64 * j + plane) < n) ? S[i * 4096 + 64 * j + plane] : -INFINITY;
                word = select_row(v, n, plane, hist); }
            BM[(t0 + i) * 64 + plane] = word; }
        __syncthreads();
    }
}

struct Args { const float* in[11]; float* out; unsigned char* ws; int ph_lo, ph_hi, li, pad; };
__global__ void __launch_bounds__(NWAVES * 64, 2) hyb_fwd(Args args) {
    extern __shared__ __attribute__((aligned(16))) unsigned char lds[];
    Frame F;
    F.lds = (LAS unsigned char*)lds;
    F.MISC = (volatile LAS unsigned*)(F.lds + MISC_OFF);
    F.wave = __builtin_amdgcn_readfirstlane((int)threadIdx.x >> 6);
    F.G = gridDim.x; { const int bx = blockIdx.x; F.vcu = (F.G % 8 == 0) ? (bx % 8) * (F.G / 8) + bx / 8 : bx; }
    F.ws = args.ws; F.ctl = (gu32*)(args.ws + WS_CTL); F.out = args.out;
    for (int u = threadIdx.x; u < (LDS_BYTES - LDSCTL_OFF) / 4; u += NWAVES * 64) ((LAS unsigned*)(F.lds + LDSCTL_OFF))[u] = 0u;
    __syncthreads();
    const bool one_launch = (args.ph_hi - args.ph_lo) > 1;
    XcdBarrier bar; bar.bar = (unsigned*)(F.ctl + CW_BAR); bar.x = 0; bar.st = nullptr;
    if (one_launch) bar = xcd_barrier_post((unsigned*)(F.ctl + CW_BAR), F.MISC + 8);
    const int lo = args.ph_lo, hi = args.ph_hi;
    unsigned char* ws = args.ws;
#ifndef REP_K
#define REP_K -2
#endif
#pragma unroll 1
    for (int ph2 = 2 * lo; ph2 < 2 * hi; ++ph2) {
        const int ph = ph2 >> 1;
        const int l = (ph - 1) / 5, k = (ph == 0) ? -1 : (ph - 1) % 5;
        if ((ph2 & 1) && k != REP_K) continue;
        if (k < 0) {
#ifndef NO_P0
            p0_prologue(F);
#endif
        } else if (k == 0) {
#ifndef NO_P1
            pg8::Gemm g{(const pg8::bf16_t*)(ws + WS_XB), (const pg8::bf16_t*)(ws + WS_WIN) + (size_t)l * NIN * DM, TOK, NIN, DM};
            pg8::StaticOrder S; S.init(TOK, NIN, F.G, (int)blockIdx.x);
            pg8::EpiIn E; E.rss = (const float*)(ws + WS_RSS); E.qna = in_ptr(3) + l * 64; E.kna = in_ptr(4) + l * 64; E.qnb = in_ptr(5) + l * 64; E.knb = in_ptr(6) + l * 64;
            E.QA = (pg8::bf16_t*)(ws + WS_QA); E.KA = (pg8::bf16_t*)(ws + WS_KA); E.VA = (pg8::bf16_t*)(ws + WS_VA); E.SGA = (pg8::bf16_t*)(ws + WS_SGA); E.QB = (pg8::bf16_t*)(ws + WS_QB); E.SGB = (pg8::bf16_t*)(ws + WS_SGB);
            E.KB = (pg8::bf16_t*)(ws + WS_KB); E.VB = (pg8::bf16_t*)(ws + WS_VB); E.KI = (pg8::bf16_t*)(ws + WS_KI); E.QI = (pg8::bf16_t*)(ws + WS_QI); E.SMA = (pg8::bf16_t*)(ws + WS_SMA); E.SMB = (pg8::bf16_t*)(ws + WS_SMB);
            E.WI = (float*)(ws + WS_WI); E.KMP = (float*)(ws + WS_KMP);
            pg8::gemm_phase<pg8::EpiIn, pg8::StaticOrder, true, true>(F.lds, g, S, E);
#endif
        } else if (k == 1) {
#ifndef NO_IDX
#ifdef NAIVE_IDX
            idx_phase_naive(F);
#else
            idx_phase(F);
#endif
#endif
        } else if (k == 2) {
#ifndef NO_ATT
#ifdef NAIVE_ATT
            naive_attn<0>(F, l); __syncthreads(); naive_attn<1>(F, l);
#else
            attn_phase_fast(F, l);
#endif
#endif
        } else if (k == 3) {
#ifndef NO_P4
            pg8::Gemm g{(const pg8::bf16_t*)(ws + WS_XB), (const pg8::bf16_t*)(ws + WS_WBR) + (size_t)l * 2048 * AW, 2 * TOK, 2048, AW};
            pg8::PairOrder S; S.init(F.G, (int)blockIdx.x);
            pg8::EpiMerge E{(const pg8::bf16_t*)(ws + WS_SMA), (pg8::bf16_t*)(ws + WS_SMB), (float*)(ws + WS_TMP)};
            pg8::gemm_phase<pg8::EpiMerge, pg8::PairOrder, true, true>(F.lds, g, S, E);
#endif
        } else {
#ifndef NO_P5
            pg8::Gemm g{(const pg8::bf16_t*)(ws + WS_SMB), (const pg8::bf16_t*)(ws + WS_WOUT) + (size_t)l * DM * DM, TOK, DM, DM};
            pg8::StaticOrder S; S.init(TOK, DM, F.G, (int)blockIdx.x);
            if (l == 0) { pg8::EpiOut<true> E{in_ptr(0), F.out, (pg8::bf16_t*)(ws + WS_XB), (float*)(ws + WS_RSS)};
                pg8::gemm_phase<pg8::EpiOut<true>, pg8::StaticOrder, true, true>(F.lds, g, S, E); }
            else { pg8::EpiOut<false> E{F.out, F.out, nullptr, nullptr};
                pg8::gemm_phase<pg8::EpiOut<false>, pg8::StaticOrder, true, true>(F.lds, g, S, E); }
#endif
        }
        if (ph2 + 1 < 2 * hi) xcd_barrier(bar);
    }
}

#ifndef N_LAUNCHES
#define N_LAUNCHES 1
#endif
extern "C" void kernel_launch(void* const* d_in, const int* in_sizes, int n_in, void* d_out, int out_size, void* d_ws, size_t ws_size, hipStream_t stream) {
    static int grid = 0;
    if (grid == 0) {
        if (n_in != 11 || in_sizes[0] != TOK * DM || out_size != TOK * DM || ws_size < WS_END) { fprintf(stderr, "kernel_launch: unexpected shapes (n_in %d in0 %d out %d ws %zu)\n", n_in, n_in > 0 ? in_sizes[0] : -1, out_size, ws_size); grid = -1; return; }
        int dev = 0, cus = 0;
        if (hipGetDevice(&dev) != hipSuccess || hipDeviceGetAttribute(&cus, hipDeviceAttributeMultiprocessorCount, dev) != hipSuccess) { grid = -1; return; }
        if (hipFuncSetAttribute((const void*)hyb_fwd, hipFuncAttributeMaxDynamicSharedMemorySize, LDS_BYTES) != hipSuccess) { fprintf(stderr, "kernel_launch: hipFuncSetAttribute failed\n"); grid = -1; return; }
        int per_cu = 0;
        if (hipOccupancyMaxActiveBlocksPerMultiprocessor(&per_cu, (const void*)hyb_fwd, NWAVES * 64, LDS_BYTES) != hipSuccess || per_cu < 1) fprintf(stderr, "kernel_launch: occupancy query says %d\n", per_cu);
        (void)hipGetLastError();
        grid = cus;
    }
    if (grid < 0) return;
    if (hipMemsetAsync((char*)d_ws + WS_CTL, 0, CTL_ZERO_BYTES, stream) != hipSuccess) return;
    Args a{};
    for (int i = 0; i < 11; ++i) a.in[i] = (const float*)d_in[i];
    a.out = (float*)d_out; a.ws = (unsigned char*)d_ws;
    if (N_LAUNCHES == 1) { a.ph_lo = 0; a.ph_hi = NPHASE; a.li = 0; hipLaunchKernelGGL(hyb_fwd, dim3(grid), dim3(NWAVES * 64), LDS_BYTES, stream, a); }
    else for (int li = 0; li < NPHASE; ++li) { a.ph_lo = li; a.ph_hi = li + 1; a.li = li; hipLaunchKernelGGL(hyb_fwd, dim3(grid), dim3(NWAVES * 64), LDS_BYTES, stream, a); }
}
```

```cpp
#include <hip/hip_runtime.h>
#include <cstdio>
#include <cstdint>
#include <cmath>
namespace pg8 {
#define PG8_LAS __attribute__((address_space(3)))
typedef unsigned short bf16_t;
typedef short bf16x8 __attribute__((ext_vector_type(8)));
typedef float f32x4 __attribute__((ext_vector_type(4)));
typedef unsigned u32x4 __attribute__((ext_vector_type(4)));
constexpr int BM = 256, BK = 64, HALF = 128, HTB = HALF * BK * 2  , STAGE_BYTES = 8 * HTB, NXCD = 8, WGM = 8;

__host__ __device__ __forceinline__ int lds_byte(int r, int c) { const int st = (r >> 4) * 2 + (c >> 5), rr = r & 15, cc = c & 31, ob = rr * 64 + cc * 2; return st * 1024 + (ob ^ (((ob >> 9) & 1) << 5)); }
__host__ __device__ __forceinline__ void stage_rc(int b, int& R, int& C) { const int st = b / 1024, sb = b % 1024, swz = sb ^ (((sb >> 9) & 1) << 5); R = (st >> 1) * 16 + swz / 64; C = (st & 1) * 32 + (swz % 64) / 2; }
__host__ __device__ __forceinline__ int perm32(int rho) { const int n = rho >> 4, i = rho & 15; return 8 * (i >> 2) + 4 * n + (i & 3); }

struct Unit { int pm, pn; };
struct Gemm { const bf16_t* A; const bf16_t* Bt; int M, N, K; };

struct StaticOrder {
    int nM, nN, nwg, G, c;
    __host__ __device__ void init(int M, int N, int G_, int c_) { nM = M / BM; nN = N / BM; nwg = nM * nN; G = G_; c = c_; }
    __host__ __device__ bool next(int i, Unit& u) const {
        const long L = (long)i * G + c; if (L >= nwg) return false;
        int wgid = (int)L; { const int q = nwg / NXCD, r = nwg % NXCD, xcd = wgid % NXCD, off = wgid / NXCD; wgid = (xcd < r ? xcd * (q + 1) : r * (q + 1) + (xcd - r) * q) + off; }
        const int nig = WGM * nN, gid = wgid / nig, fm = gid * WGM, gsz = (nM - fm) < WGM ? (nM - fm) : WGM;
        u.pm = fm + ((wgid % nig) % gsz); u.pn = (wgid % nig) / gsz; return true;
    }
    __device__ __forceinline__ void a_ready(const Unit&) const {}
    __device__ __forceinline__ void done(const Unit&) const {}
};

__device__ __forceinline__ unsigned cvt_pk_bf16(float lo, float hi) { unsigned r; asm volatile("v_cvt_pk_bf16_f32 %0, %1, %2" : "=v"(r) : "v"(lo), "v"(hi)); return r; }
template <class Epi, class Sched, bool ALIGN_EPI = false, bool SP2 = false>
__device__ __forceinline__ void gemm_phase(PG8_LAS unsigned char* lds, const Gemm g, const Sched& S, const Epi& E) {
    int tid_ = threadIdx.x; asm volatile("" : "+v"(tid_));
    const int tid = tid_, wid = __builtin_amdgcn_readfirstlane(tid >> 6), lane = tid & 63, wr = wid >> 2, wc = wid & 3, fr = lane & 15, fq = lane >> 4;
    const int K = g.K, nt = K / BK;
    unsigned voffA[2], voffB[2];
#pragma unroll
    for (int i = 0; i < 2; ++i) { int R, C; stage_rc(tid * 16 + i * 8192, R, C); const int Rb = Epi::PERM ? ((R & ~31) + perm32(R & 31)) : R;
        voffA[i] = (unsigned)(R * K + C) * 2u; voffB[i] = (unsigned)(Rb * K + C) * 2u; }
    const size_t kstep = (size_t)(BK * 2);
    const size_t hstep = (size_t)HALF * K * 2;
    const size_t tstep = 2 * hstep;
    const unsigned ldsw = (unsigned)wid * 1024u;
    const int aoff = lds_byte(wr * 64 + fr, fq * 8), boff = lds_byte(wc * 32 + fr, fq * 8);
#define PG8_SA(b, h) (((b) * 2 + (h)) * HTB)
#define PG8_SB(b, h) ((4 + (b) * 2 + (h)) * HTB)
#define PG8_STAGE(bufoff, gbase, voff) do { _Pragma("unroll") for (int _i = 0; _i < 2; ++_i) \
        __builtin_amdgcn_global_load_lds((const unsigned*)((const char*)(gbase) + (voff)[_i]), (PG8_LAS unsigned*)(lds + (bufoff) + ldsw + _i * 8192), 16, 0, 0); } while (0)
#define PG8_LDA(dst, b, h) do { _Pragma("unroll") for (int m = 0; m < 4; ++m) _Pragma("unroll") for (int k = 0; k < 2; ++k) dst[m][k] = *(const PG8_LAS bf16x8*)(lds + PG8_SA(b, h) + aoff + m * 2048 + k * 1024); } while (0)
#define PG8_LDB(dst, b, h) do { _Pragma("unroll") for (int n = 0; n < 2; ++n) _Pragma("unroll") for (int k = 0; k < 2; ++k) dst[n][k] = *(const PG8_LAS bf16x8*)(lds + PG8_SB(b, h) + boff + n * 2048 + k * 1024); } while (0)
#define PG8_MMA(ai, bj, At, Bt) do { __builtin_amdgcn_s_setprio(1); _Pragma("unroll") for (int m = 0; m < 4; ++m) _Pragma("unroll") for (int n = 0; n < 2; ++n) _Pragma("unroll") for (int k = 0; k < 2; ++k) \
        acc[ai][bj][m][n] = __builtin_amdgcn_mfma_f32_16x16x32_bf16(Bt[n][k], At[m][k], acc[ai][bj][m][n], 0, 0, 0); __builtin_amdgcn_s_setprio(0); } while (0)
#define PG8_WAIT_V(n) asm volatile("s_waitcnt vmcnt(" #n ")" ::: "memory")
#define PG8_WAIT_L(n) asm volatile("s_waitcnt lgkmcnt(" #n ")" ::: "memory")
#define PG8_BAR __builtin_amdgcn_s_barrier()
#define PG8_SCHED __builtin_amdgcn_sched_barrier(0)
    Unit cur, nxt; int ui = 0;
    if (!S.next(0, cur)) return;
    f32x4 acc[2][2][4][2];
#pragma unroll
    for (int a = 0; a < 2; ++a)
#pragma unroll
        for (int b = 0; b < 2; ++b)
#pragma unroll
            for (int m = 0; m < 4; ++m)
#pragma unroll
                for (int n = 0; n < 2; ++n) acc[a][b][m][n] = (f32x4){0.f, 0.f, 0.f, 0.f};
    bf16x8 At[4][2], B0[2][2], B1[2][2];
    const char* cA = (const char*)g.A + (size_t)cur.pm * tstep; const char* cB = (const char*)g.Bt + (size_t)cur.pn * tstep;
    S.a_ready(cur);
    if constexpr (SP2) {
        PG8_STAGE(PG8_SB(0, 0), cB, voffB); PG8_STAGE(PG8_SB(0, 1), cB + hstep, voffB); PG8_STAGE(PG8_SA(0, 0), cA, voffA); PG8_STAGE(PG8_SA(0, 1), cA + hstep, voffA);
        if (wr == 1) PG8_BAR;
        PG8_WAIT_V(2); PG8_BAR;
        PG8_STAGE(PG8_SB(1, 0), cB + kstep, voffB); PG8_STAGE(PG8_SA(1, 0), cA + kstep, voffA); PG8_STAGE(PG8_SB(1, 1), cB + hstep + kstep, voffB);
        PG8_WAIT_V(6); PG8_BAR;
    } else {
        PG8_STAGE(PG8_SB(0, 0), cB, voffB); PG8_STAGE(PG8_SA(0, 0), cA, voffA); PG8_STAGE(PG8_SB(0, 1), cB + hstep, voffB); PG8_STAGE(PG8_SA(0, 1), cA + hstep, voffA);
        if (wr == 1) PG8_BAR;
        PG8_WAIT_V(4); PG8_BAR;
        PG8_STAGE(PG8_SB(1, 0), cB + kstep, voffB); PG8_STAGE(PG8_SA(1, 0), cA + kstep, voffA); PG8_STAGE(PG8_SB(1, 1), cB + hstep + kstep, voffB);
        PG8_WAIT_V(6); PG8_BAR;
    }
    for (;;) {
        const bool has_next = S.next(ui + 1, nxt);
        const char* nA = has_next ? (const char*)g.A + (size_t)nxt.pm * tstep : cA; const char* nB = has_next ? (const char*)g.Bt + (size_t)nxt.pn * tstep : cB;
        for (int t = 0; t < nt; t += 2) {
            const bool last = (t == nt - 2);
            const char* a1 = cA + (size_t)(t + 1) * kstep;
            const char* a2 = last ? nA : cA + (size_t)(t + 2) * kstep; const char* b2 = last ? nB : cB + (size_t)(t + 2) * kstep;
            const char* a3 = a2 + kstep; const char* b3 = b2 + kstep;
            if (last && has_next) S.a_ready(nxt);
            if constexpr (SP2) {
            PG8_LDB(B0, 0, 0); PG8_LDB(B1, 0, 1); PG8_SCHED; PG8_LDA(At, 0, 0); PG8_STAGE(PG8_SA(1, 1), a1 + hstep, voffA);
            PG8_WAIT_V(8); PG8_WAIT_L(0); PG8_BAR; PG8_MMA(0, 0, At, B0); PG8_MMA(0, 1, At, B1); PG8_BAR; PG8_SCHED;
            PG8_LDA(At, 0, 1); PG8_STAGE(PG8_SB(0, 0), b2, voffB); PG8_STAGE(PG8_SB(0, 1), b2 + hstep, voffB); PG8_STAGE(PG8_SA(0, 0), a2, voffA);
            PG8_WAIT_V(8); PG8_WAIT_L(0); PG8_BAR; PG8_MMA(1, 0, At, B0); PG8_MMA(1, 1, At, B1); PG8_BAR; PG8_SCHED;
            PG8_LDB(B0, 1, 0); PG8_LDB(B1, 1, 1); PG8_SCHED; PG8_LDA(At, 1, 0); PG8_STAGE(PG8_SA(0, 1), a2 + hstep, voffA);
            PG8_WAIT_V(8); PG8_WAIT_L(0); PG8_BAR; PG8_MMA(0, 0, At, B0); PG8_MMA(0, 1, At, B1); PG8_BAR; PG8_SCHED;
            PG8_LDA(At, 1, 1); PG8_STAGE(PG8_SB(1, 0), b3, voffB); PG8_STAGE(PG8_SB(1, 1), b3 + hstep, voffB); PG8_STAGE(PG8_SA(1, 0), a3, voffA);
            PG8_WAIT_V(8); PG8_WAIT_L(0); PG8_BAR; PG8_MMA(1, 0, At, B0); PG8_MMA(1, 1, At, B1); PG8_BAR; PG8_SCHED;
            } else {
            PG8_LDB(B0, 0, 0); PG8_SCHED; PG8_LDA(At, 0, 0); PG8_STAGE(PG8_SA(1, 1), a1 + hstep, voffA);
            PG8_WAIT_L(8); PG8_BAR; PG8_WAIT_L(0); PG8_MMA(0, 0, At, B0); PG8_BAR; PG8_SCHED;
            PG8_LDB(B1, 0, 1); PG8_STAGE(PG8_SB(0, 0), b2, voffB);
            PG8_BAR; PG8_WAIT_L(0); PG8_MMA(0, 1, At, B1); PG8_BAR;
            PG8_LDA(At, 0, 1); PG8_STAGE(PG8_SA(0, 0), a2, voffA);
            PG8_BAR; PG8_WAIT_L(0); PG8_MMA(1, 0, At, B0); PG8_BAR; PG8_SCHED;
            PG8_STAGE(PG8_SB(0, 1), b2 + hstep, voffB);
            PG8_WAIT_V(6); PG8_BAR; PG8_MMA(1, 1, At, B1); PG8_BAR;
            PG8_LDB(B0, 1, 0); PG8_SCHED; PG8_LDA(At, 1, 0); PG8_STAGE(PG8_SA(0, 1), a2 + hstep, voffA);
            PG8_WAIT_L(8); PG8_BAR; PG8_WAIT_L(0); PG8_MMA(0, 0, At, B0); PG8_BAR; PG8_SCHED;
            PG8_LDB(B1, 1, 1); PG8_STAGE(PG8_SB(1, 0), b3, voffB);
            PG8_BAR; PG8_WAIT_L(0); PG8_MMA(0, 1, At, B1); PG8_BAR;
            PG8_LDA(At, 1, 1); PG8_STAGE(PG8_SA(1, 0), a3, voffA);
            PG8_BAR; PG8_WAIT_L(0); PG8_MMA(1, 0, At, B0); PG8_BAR; PG8_SCHED;
            PG8_STAGE(PG8_SB(1, 1), b3 + hstep, voffB);
            PG8_WAIT_V(6); PG8_BAR; PG8_MMA(1, 1, At, B1); PG8_BAR;
            }
        }
        if constexpr (ALIGN_EPI) { if (wr == 0) PG8_BAR; }
#ifndef EPI_REP
#define EPI_REP 1
#endif
        if constexpr (!Epi::AFTER_DRAIN) { E(acc, cur, wr, wc, fr, fq); if constexpr (Epi::REPEATABLE && EPI_REP == 2) { asm volatile("" ::: "memory"); E(acc, cur, wr, wc, fr, fq); } S.done(cur); }
        if (!has_next) break;
#pragma unroll
        for (int a = 0; a < 2; ++a)
#pragma unroll
            for (int b = 0; b < 2; ++b)
#pragma unroll
                for (int m = 0; m < 4; ++m)
#pragma unroll
                    for (int n = 0; n < 2; ++n) acc[a][b][m][n] = (f32x4){0.f, 0.f, 0.f, 0.f};
        cur = nxt; cA = nA; cB = nB; ++ui;
        if constexpr (ALIGN_EPI) { if (wr == 1) PG8_BAR; }
    }
    PG8_WAIT_V(0);
    if constexpr (!ALIGN_EPI) { if (wr == 0) PG8_BAR; }
    PG8_BAR;
    if constexpr (Epi::AFTER_DRAIN) { E.fused(acc, cur, wr, wc, fr, fq, lds, wid, lane); S.done(cur); }
#undef PG8_SA
#undef PG8_SB
#undef PG8_STAGE
#undef PG8_LDA
#undef PG8_LDB
#undef PG8_MMA
#undef PG8_WAIT_V
#undef PG8_WAIT_L
#undef PG8_BAR
#undef PG8_SCHED
}
}
#define GAS __attribute__((address_space(1)))
#define LAS __attribute__((address_space(3)))
typedef unsigned short bf16;
typedef unsigned v4u __attribute__((ext_vector_type(4)));
typedef float f32x4 __attribute__((ext_vector_type(4)));
typedef short bf16x8 __attribute__((ext_vector_type(8)));
typedef GAS unsigned gu32;
typedef GAS unsigned long long gu64;
#define RLX_AGENT __ATOMIC_RELAXED, __HIP_MEMORY_SCOPE_AGENT
#define LDS_WAIT() asm volatile("s_waitcnt lgkmcnt(0)" ::: "memory")
#define VM_WAIT() asm volatile("s_waitcnt vmcnt(0)" ::: "memory")
__device__ __forceinline__ unsigned long long rt() { return __builtin_amdgcn_s_memrealtime(); }
__device__ __forceinline__ unsigned f2bf(float f) { unsigned u = __builtin_bit_cast(unsigned, f); return (u + 0x7fffu + ((u >> 16) & 1u)) >> 16; }
__device__ __forceinline__ unsigned pk2(float lo, float hi) { return f2bf(lo) | (f2bf(hi) << 16); }
#define XB_TMO      128
#define XB_XCNT(j)  (256  + 64 * (j))
#define XB_XSUB(j)  (1280 + 64 * (j))
#define XB_XGEN(j)  (2304 + 64 * (j))
#define XB_TOP      3328
#define XB_TOPGEN   3392
#define XCD_BAR_WORDS 3456
#define XB_SPIN_CAP (1u << 18)

__device__ __forceinline__ unsigned xb_ld(unsigned* p)              { return __hip_atomic_load(p, __ATOMIC_RELAXED, __HIP_MEMORY_SCOPE_AGENT); }
__device__ __forceinline__ unsigned xb_add(unsigned* p, unsigned v) { return __hip_atomic_fetch_add(p, v, __ATOMIC_RELAXED, __HIP_MEMORY_SCOPE_AGENT); }
__device__ __forceinline__ unsigned xb_xcc_id() { return (unsigned)__builtin_amdgcn_s_getreg((3 << 11) | 20) & 0xFu; }
#define XB_SPIN(cond, bar) do { unsigned _sp = 0; while (cond) { __builtin_amdgcn_s_sleep(1); \
    if ((++_sp & 255u) == 0u) { if (xb_ld(&(bar)[XB_TMO])) break; if (_sp > XB_SPIN_CAP) { atomicAdd(&(bar)[XB_TMO], 1u); break; } } } } while (0)

struct XcdBarrier {
    unsigned* bar; unsigned x;
    volatile LAS unsigned* st;
};

__device__ __forceinline__ XcdBarrier xcd_barrier_post(unsigned* bar, volatile LAS unsigned* st) {
    XcdBarrier b; b.bar = bar; b.x = xb_xcc_id(); b.st = st;
    if (threadIdx.x == 0) (void)xb_add(&bar[XB_XCNT(b.x)], 1u);
    return b;
}
__device__ __forceinline__ void xcd_barrier_complete(unsigned* bar, unsigned x, unsigned& nloc, unsigned& nx) {
    const unsigned G = gridDim.x * gridDim.y * gridDim.z;
    unsigned sum, cnt, mine, sp = 0u;
    for (;;) {
        sum = 0u; cnt = 0u; mine = 0u;
#pragma unroll
        for (unsigned j = 0; j < 16; ++j) { const unsigned c = xb_ld(&bar[XB_XCNT(j)]); sum += c; cnt += (c > 0u) ? 1u : 0u; mine = (j == x) ? c : mine; }
        if (sum == G) break;
        __builtin_amdgcn_s_sleep(1);
        if ((++sp & 255u) == 0u) { if (xb_ld(&bar[XB_TMO])) break; if (sp > XB_SPIN_CAP) { atomicAdd(&bar[XB_TMO], 1u); break; } }
    }
    nloc = mine > 0u ? mine : 1u; nx = cnt > 0u ? cnt : 1u;
}

__device__ __forceinline__ void xcd_barrier(const XcdBarrier& b) {
    asm volatile("s_waitcnt vmcnt(0)" ::: "memory");
    __syncthreads();
    if (threadIdx.x == 0) {
        unsigned* bar = b.bar; asm volatile("" : "+s"(bar));
        __builtin_amdgcn_s_waitcnt(0);
        unsigned nloc = b.st[0], nx = b.st[1];
        if (nloc == 0u) { xcd_barrier_complete(bar, b.x, nloc, nx); b.st[0] = nloc; b.st[1] = nx; }
        const unsigned old = xb_add(&bar[XB_XSUB(b.x)], 1u);
        const unsigned gen = old / nloc;
        if (old + 1u == (gen + 1u) * nloc) {
            __builtin_amdgcn_fence(__ATOMIC_RELEASE, "agent");
            asm volatile("s_waitcnt vmcnt(0)" ::: "memory");
            const unsigned og = xb_add(&bar[XB_TOP], 1u);
            const unsigned tg = og / nx;
            if (og + 1u == (tg + 1u) * nx) xb_add(&bar[XB_TOPGEN], 1u);
            else XB_SPIN(xb_ld(&bar[XB_TOPGEN]) == tg, bar);
            __builtin_amdgcn_fence(__ATOMIC_ACQUIRE, "agent");
            xb_add(&bar[XB_XGEN(b.x)], 1u);
            asm volatile("s_waitcnt vmcnt(0)" ::: "memory");
        } else {
            XB_SPIN(xb_ld(&bar[XB_XGEN(b.x)]) == gen, bar);
            __builtin_amdgcn_fence(__ATOMIC_ACQUIRE, "agent");
            asm volatile("s_waitcnt vmcnt(0)" ::: "memory");
        }
    }
    __syncthreads();
}

constexpr int BATCH = 8, SEQ = 4096, DM = 1024, TOK = BATCH * SEQ, DEPTH = 2;
constexpr int DIN = 5572, NIN = 5632;
constexpr int NH = 8, HD = 64, AW = 512;
constexpr float EPS = 1e-6f;
constexpr float LOG2E = 1.4426950408889634f;
constexpr float C2 = 0.125f * LOG2E;
constexpr int NWAVES = 8;
constexpr int NPHASE = 1 + 5 * DEPTH;

constexpr size_t MiB = 1u << 20;
constexpr size_t WS_CTL = 0, CTL_ZERO_BYTES = 1 * MiB;
constexpr size_t WS_WIN = 1 * MiB;
constexpr size_t WS_WBR = 23 * MiB;
constexpr size_t WS_WOUT = 27 * MiB;
constexpr size_t WS_RSS = 31 * MiB;
constexpr size_t WS_KMP = 33 * MiB;
constexpr size_t WS_WI = 34 * MiB;
constexpr size_t WS_KB = 35 * MiB, WS_VB = 39 * MiB, WS_KI = 43 * MiB;
constexpr size_t WS_QI = 47 * MiB;
constexpr size_t WS_BM = 63 * MiB;
constexpr size_t WS_XB = 80 * MiB;
constexpr size_t WS_QA = 144 * MiB, WS_KA = 176 * MiB, WS_VA = 208 * MiB, WS_SGA = 240 * MiB, WS_QB = 272 * MiB, WS_SGB = 304 * MiB;
constexpr size_t WS_TMP = 144 * MiB;
constexpr size_t WS_SMA = 336 * MiB, WS_SMB = 400 * MiB;
constexpr size_t WS_END = 464 * MiB;
constexpr int CW_BAR = 4096;

constexpr int RING_BYTES = 131072;
constexpr int LDSCTL_OFF = RING_BYTES + 28672, MISC_OFF = LDSCTL_OFF + 320;
constexpr int LDS_BYTES = 163840;
static_assert(MISC_OFF + 128 <= LDS_BYTES, "LDS map");

typedef unsigned long long u64;
typedef unsigned u32x4v __attribute__((ext_vector_type(4)));

__device__ __forceinline__ float bf2f(unsigned short v) { return __uint_as_float(((unsigned)v) << 16); }
__device__ __forceinline__ float bflo(unsigned w) { return __uint_as_float(w << 16); }
__device__ __forceinline__ float bfhi(unsigned w) { return __uint_as_float(w & 0xffff0000u); }
__device__ __forceinline__ float sigmoidf_(float v) { return __builtin_amdgcn_rcpf(1.0f + __builtin_amdgcn_exp2f(-v * LOG2E)); }

typedef __attribute__((address_space(4))) const char* kaptr_t;
__device__ __forceinline__ const float* in_ptr(int i) { kaptr_t ka = (kaptr_t)__builtin_amdgcn_kernarg_segment_ptr(); asm volatile("" : "+s"(ka)); return *(const float* const __attribute__((address_space(4)))*)(ka + 8 * i); }
#define PHASE_TID() int tid_o = threadIdx.x; asm volatile("" : "+v"(tid_o)); const int ptid = tid_o, plane = tid_o & 63
struct Frame {
    LAS unsigned char* lds;
    volatile LAS unsigned* MISC;
    gu32* ctl;
    int wave, vcu, G;
    unsigned char* ws;
    float* out;
};

__host__ __device__ __forceinline__ int win_src(int n0, int& nvalid) {
    const int pn = n0 >> 8, c = n0 & 255, bj = c >> 7, wc = (c >> 5) & 3; nvalid = 32;
    if (pn < 2) return 0 + 64 * (4 * pn + wc) + 32 * bj;
    if (pn < 4) return 512 + 64 * (4 * (pn - 2) + wc) + 32 * bj;
    if (pn < 6) return 1024 + 256 * (pn - 4) + c;
    if (pn < 8) return 1536 + 256 * (pn - 6) + c;
    if (pn < 10) return 2048 + 64 * (4 * (pn - 8) + wc) + 32 * bj;
    if (pn == 10) {
        if (wc == 0) return 2560 + 32 * bj;
        if (wc == 1) return 2624 + 32 * bj;
        if (wc == 2) return 3456 + 32 * bj;
        if (bj == 0) { nvalid = 4; return 3520; }
        nvalid = 0; return 0;
    }
    if (pn == 11) return 3200 + c;
    if (pn < 14) return 2688 + 256 * (pn - 12) + c;
    if (pn < 18) return 3524 + 256 * (pn - 14) + c;
    return 4548 + 256 * (pn - 18) + c;
}

__device__ __forceinline__ float wave_sum(float v) {
#pragma unroll
    for (int o = 1; o < 64; o <<= 1) v += __shfl_xor(v, o);
    return v;
}
__device__ __forceinline__ void tr_item(const float* W, int ldw, int src0, int nvalid, const float* gk, bf16* WT, int K, int row0, int k0, LAS float* scr, int lane) {
    const int j = lane & 31;
#pragma unroll 8
    for (int i = 0; i < 32; ++i) { const int kk = 2 * i + (lane >> 5);
        float v = 0.f; if (j < nvalid) { v = W[(size_t)(k0 + kk) * ldw + src0 + j]; if (gk) v *= gk[k0 + kk]; }
        scr[kk * 33 + j] = v; }
    LDS_WAIT(); asm volatile("" ::: "memory");
    const int c = lane & 7;
#pragma unroll
    for (int jj = 0; jj < 4; ++jj) { const int n = (lane >> 3) + 8 * jj; const LAS float* s = scr + (8 * c) * 33 + n;
        v4u o; o.x = pk2(s[0 * 33], s[1 * 33]); o.y = pk2(s[2 * 33], s[3 * 33]); o.z = pk2(s[4 * 33], s[5 * 33]); o.w = pk2(s[6 * 33], s[7 * 33]);
        *(GAS v4u*)(WT + (size_t)(row0 + n) * K + k0 + 8 * c) = o; }
    LDS_WAIT(); asm volatile("" ::: "memory");
}
__device__ __forceinline__ void p0_prologue(Frame& F) {
    PHASE_TID();
    LAS float* scr = (LAS float*)(F.lds + F.wave * 16384);
    const int gw = F.vcu * NWAVES + F.wave, NGW = F.G * NWAVES;
    constexpr int I_IN = (DM / 64) * (NIN / 32), I_BR = (AW / 64) * (DM / 32), I_OUT = (DM / 64) * (DM / 32);
    constexpr int PER_L = I_IN + 2 * I_BR + I_OUT;
    for (int it = gw; it < DEPTH * PER_L; it += NGW) {
        const int l = it / PER_L; int r = it % PER_L;
        if (r < I_IN) { const int kb = r / (NIN / 32), nb = r % (NIN / 32); int nvalid; const int src0 = win_src(32 * nb, nvalid);
            tr_item(in_ptr(2) + (size_t)l * DM * DIN, DIN, src0, nvalid, in_ptr(1) + l * DM, (bf16*)(F.ws + WS_WIN) + (size_t)l * NIN * DM, DM, 32 * nb, 64 * kb, scr, plane); continue; }
        r -= I_IN;
        if (r < 2 * I_BR) { const int which = r / I_BR; r %= I_BR; const int kb = r / (DM / 32), nb = r % (DM / 32);
            tr_item((which ? in_ptr(8) : in_ptr(7)) + (size_t)l * AW * DM, DM, 32 * nb, 32, nullptr, (bf16*)(F.ws + WS_WBR) + (size_t)l * 2048 * AW, AW, which * 1024 + 32 * nb, 64 * kb, scr, plane); continue; }
        r -= 2 * I_BR;
        { const int kb = r / (DM / 32), nb = r % (DM / 32);
            tr_item(in_ptr(9) + (size_t)l * DM * DM, DM, 32 * nb, 32, nullptr, (bf16*)(F.ws + WS_WOUT) + (size_t)l * DM * DM, DM, 32 * nb, 64 * kb, scr, plane); }
    }
    const float* x = in_ptr(0); bf16* XB = (bf16*)(F.ws + WS_XB); float* RSS = (float*)(F.ws + WS_RSS);
    for (int m = gw; m < TOK; m += NGW) {
        const GAS f32x4* xr = (const GAS f32x4*)(x + (size_t)m * DM) + plane;
        f32x4 v[4]; float s = 0.f;
#pragma unroll
        for (int j = 0; j < 4; ++j) { v[j] = xr[64 * j]; s += (v[j].x * v[j].x + v[j].y * v[j].y) + (v[j].z * v[j].z + v[j].w * v[j].w); }
        s = wave_sum(s);
        GAS u64* o8 = (GAS u64*)(XB + (size_t)m * DM) + plane;
#pragma unroll
        for (int j = 0; j < 4; ++j) o8[64 * j] = (u64)pk2(v[j].x, v[j].y) | ((u64)pk2(v[j].z, v[j].w) << 32);
        if (plane < 16) RSS[(size_t)m * 16 + plane] = (plane == 0) ? s : 0.f;
    }
}

namespace pg8 {
__device__ __forceinline__ float row_rs(const float* rss, int row, int fq) {
    const f32x4 a = *(const f32x4*)(rss + (size_t)row * 16 + 4 * fq);
    float s = (a[0] + a[1]) + (a[2] + a[3]);
    s += __shfl_xor(s, 16); s += __shfl_xor(s, 32);
    return __builtin_amdgcn_rsqf(s * (1.0f / DM) + EPS);
}
__device__ __forceinline__ u32x4 pack8(const f32x4 o0, const f32x4 o1) { u32x4 w; w.x = cvt_pk_bf16(o0[0], o0[1]); w.y = cvt_pk_bf16(o0[2], o0[3]); w.z = cvt_pk_bf16(o1[0], o1[1]); w.w = cvt_pk_bf16(o1[2], o1[3]); return w; }
struct EpiIn {
    static constexpr bool PERM = true, AFTER_DRAIN = false, REPEATABLE = true;
    const float* rss; const float *qna, *kna, *qnb, *knb;
    bf16_t *QA, *KA, *VA, *SGA, *QB, *SGB, *KB, *VB, *KI, *QI, *SMA, *SMB; float* WI; float* KMP;
    __device__ __forceinline__ void norm_rows(const f32x4 (&acc)[2][2][4][2], const Unit& u, int wr, int fr, int fq, const float* g, float oscale, bf16_t* dst, int ld, int coloff, float* kmp) const {
        f32x4 gv[2][2];
#pragma unroll
        for (int bj = 0; bj < 2; ++bj)
#pragma unroll
            for (int n = 0; n < 2; ++n) gv[bj][n] = *(const f32x4*)(g + 32 * bj + 8 * fq + 4 * n) * oscale;
        f32x4 cs[2][2];
#pragma unroll
        for (int bj = 0; bj < 2; ++bj)
#pragma unroll
            for (int n = 0; n < 2; ++n) cs[bj][n] = (f32x4){0.f, 0.f, 0.f, 0.f};
#pragma unroll
        for (int ai = 0; ai < 2; ++ai)
#pragma unroll
            for (int m = 0; m < 4; ++m) {
                const int row = u.pm * BM + ai * HALF + wr * 64 + m * 16 + fr; const float rs = row_rs(rss, row, fq);
                float sq = 0.f;
#pragma unroll
                for (int bj = 0; bj < 2; ++bj)
#pragma unroll
                    for (int n = 0; n < 2; ++n) { const f32x4 t = acc[ai][bj][m][n]; sq += (t[0] * t[0] + t[1] * t[1]) + (t[2] * t[2] + t[3] * t[3]); }
                sq += __shfl_xor(sq, 16); sq += __shfl_xor(sq, 32);
                const float sc = rs * __builtin_amdgcn_rsqf(sq * rs * rs * (1.0f / 64.0f) + EPS);
#pragma unroll
                for (int bj = 0; bj < 2; ++bj) {
                    const f32x4 o0 = acc[ai][bj][m][0] * sc * gv[bj][0], o1 = acc[ai][bj][m][1] * sc * gv[bj][1];
                    cs[bj][0] += o0; cs[bj][1] += o1;
                    *(u32x4*)(dst + (size_t)row * ld + coloff + 32 * bj + 8 * fq) = pack8(o0, o1); }
                asm volatile("" ::: "memory");
            }
        if (kmp) {
#pragma unroll
            for (int bj = 0; bj < 2; ++bj)
#pragma unroll
                for (int n = 0; n < 2; ++n) { f32x4 t = cs[bj][n];
#pragma unroll
                    for (int o = 1; o < 16; o <<= 1) { t[0] += __shfl_xor(t[0], o); t[1] += __shfl_xor(t[1], o); t[2] += __shfl_xor(t[2], o); t[3] += __shfl_xor(t[3], o); }
                    if (fr == 0) *(f32x4*)(kmp + 32 * bj + 8 * fq + 4 * n) = t; }
        }
    }
    __device__ __forceinline__ void plain_rows(const f32x4 (&acc)[2][2][4][2], const Unit& u, int wr, int fr, int fq, bf16_t* dst, int ld, int col0, int bjs, float ca, float cb, float cc, float* wi) const {
#pragma unroll
        for (int ai = 0; ai < 2; ++ai)
#pragma unroll
            for (int m = 0; m < 4; ++m) {
                const int row = u.pm * BM + ai * HALF + wr * 64 + m * 16 + fr; const float rs = row_rs(rss, row, fq);
                if (wi) { if (fq == 0) *(f32x4*)(wi + (size_t)row * 4) = acc[ai][0][m][0] * rs; }
                else {
#pragma unroll
                for (int bj = 0; bj < 2; ++bj) { f32x4 o0 = acc[ai][bj][m][0] * rs, o1 = acc[ai][bj][m][1] * rs;
#pragma unroll
                    for (int i = 0; i < 4; ++i) { const float s0 = sigmoidf_(o0[i]), s1 = sigmoidf_(o1[i]); o0[i] = ca * o0[i] + s0 * (cb + cc * o0[i]); o1[i] = ca * o1[i] + s1 * (cb + cc * o1[i]); }
                    *(u32x4*)(dst + (size_t)row * ld + col0 + bj * bjs) = pack8(o0, o1); }
                }
                asm volatile("" ::: "memory");
            }
    }
    __device__ __forceinline__ void operator()(const f32x4 (&acc)[2][2][4][2], const Unit& u, int wr, int wc, int fr_, int fq_) const {
        int fr = fr_, fq = fq_; asm volatile("" : "+v"(fr), "+v"(fq));
        const int pn = u.pn; const int cid = wc * 32 + 8 * fq;
        bool isnorm = false; bf16_t* dst; int ld = AW, col0, bjs = HALF; const float* g = qna; float osc = 1.0f; float* kmp = nullptr; float ca = 1.f, cb = 0.f, cc = 0.f; float* wi = nullptr;
        if (pn < 2) { isnorm = true; g = qna; osc = C2; dst = QA; col0 = 64 * (4 * pn + wc); }
        else if (pn < 4) { isnorm = true; g = kna; dst = KA; const int h = 4 * (pn - 2) + wc; col0 = 64 * h; kmp = KMP + ((((size_t)(u.pm >> 4) * 16 + (u.pm & 15)) * 8 + h) * 2 + wr) * 64; }
        else if (pn < 6) { dst = VA; col0 = 256 * (pn - 4) + cid; }
        else if (pn < 8) { dst = SGA; col0 = 256 * (pn - 6) + cid; ca = 0.f; cc = 1.f; }
        else if (pn < 10) { isnorm = true; g = qnb; osc = C2; dst = QB; col0 = 64 * (4 * (pn - 8) + wc); }
        else if (pn == 10) { ld = 64; bjs = 32; col0 = 8 * fq; dst = KI;
            if (wc == 0) { isnorm = true; g = knb; dst = KB; col0 = 0; } else if (wc == 1) { dst = VB; } else if (wc == 3) { wi = WI; } }
        else if (pn == 11) { dst = QI; ld = 256; col0 = cid; }
        else if (pn < 14) { dst = SGB; col0 = 256 * (pn - 12) + cid; ca = 0.f; cc = 1.f; }
        else if (pn < 18) { dst = SMA; ld = DM; col0 = 256 * (pn - 14) + cid; ca = 0.f; cb = 1.f; }
        else { dst = SMB; ld = DM; col0 = 256 * (pn - 18) + cid; ca = 0.f; cb = 1.f; }
        if (isnorm) norm_rows(acc, u, wr, fr, fq, g, osc, dst, ld, col0, kmp);
        else plain_rows(acc, u, wr, fr, fq, dst, ld, col0, bjs, ca, cb, cc, wi);
    }
};
struct EpiMerge {
    static constexpr bool PERM = true, AFTER_DRAIN = false, REPEATABLE = false;
    const bf16_t* SMA; bf16_t* SMB; float* TMP;
    __device__ __forceinline__ void operator()(const f32x4 (&acc)[2][2][4][2], const Unit& u, int wr, int wc, int fr, int fq) const {
        const bool partb = u.pm >= 128; const int pm = partb ? u.pm - 128 : u.pm, pn = partb ? u.pn - 4 : u.pn;
#pragma unroll
        for (int ai = 0; ai < 2; ++ai)
#pragma unroll
            for (int m = 0; m < 4; ++m) { const int row = pm * BM + ai * HALF + wr * 64 + m * 16 + fr;
#pragma unroll
                for (int bj = 0; bj < 2; ++bj) { const size_t off = (size_t)row * DM + pn * BM + bj * HALF + wc * 32 + 8 * fq;
                    const u32x4 sg = *(const u32x4*)((partb ? SMB : SMA) + off);
                    const f32x4 s0 = (f32x4){__uint_as_float(sg.x << 16), __uint_as_float(sg.x & 0xffff0000u), __uint_as_float(sg.y << 16), __uint_as_float(sg.y & 0xffff0000u)};
                    const f32x4 s1 = (f32x4){__uint_as_float(sg.z << 16), __uint_as_float(sg.z & 0xffff0000u), __uint_as_float(sg.w << 16), __uint_as_float(sg.w & 0xffff0000u)};
                    f32x4 o0 = acc[ai][bj][m][0] * s0, o1 = acc[ai][bj][m][1] * s1;
                    if (!partb) { *(f32x4*)(TMP + off) = o0; *(f32x4*)(TMP + off + 4) = o1; }
                    else { o0 += *(const f32x4*)(TMP + off); o1 += *(const f32x4*)(TMP + off + 4);
                        u32x4 w; w.x = cvt_pk_bf16(o0[0], o0[1]); w.y = cvt_pk_bf16(o0[2], o0[3]); w.z = cvt_pk_bf16(o1[0], o1[1]); w.w = cvt_pk_bf16(o1[2], o1[3]);
                        *(u32x4*)(SMB + off) = w; } }
            }
    }
};
struct PairOrder {
    StaticOrder base;
    __device__ void init(int G_, int c_) { base.init(TOK, DM, G_, c_); }
    __device__ bool next(int i, Unit& u) const { Unit t; if (!base.next(i >> 1, t)) return false; u.pm = t.pm + (i & 1) * 128; u.pn = t.pn + (i & 1) * 4; return true; }
    __device__ __forceinline__ void a_ready(const Unit&) const {}
    __device__ __forceinline__ void done(const Unit&) const {}
};
template <bool WRITE_NEXT> struct EpiOut {
    static constexpr bool PERM = true, AFTER_DRAIN = false, REPEATABLE = false;
    const float* xin; float* out; bf16_t* XB; float* rss;
    __device__ __forceinline__ void operator()(const f32x4 (&acc)[2][2][4][2], const Unit& u, int wr, int wc, int fr, int fq) const {
#pragma unroll
        for (int ai = 0; ai < 2; ++ai)
#pragma unroll
            for (int m = 0; m < 4; ++m) { const int row = u.pm * BM + ai * HALF + wr * 64 + m * 16 + fr; float ss = 0.f;
#pragma unroll
                for (int bj = 0; bj < 2; ++bj) { const size_t off = (size_t)row * DM + u.pn * BM + bj * HALF + wc * 32 + 8 * fq;
                    const f32x4 o0 = acc[ai][bj][m][0] + *(const f32x4*)(xin + off), o1 = acc[ai][bj][m][1] + *(const f32x4*)(xin + off + 4);
                    *(f32x4*)(out + off) = o0; *(f32x4*)(out + off + 4) = o1;
                    if (WRITE_NEXT) { ss += (o0[0] * o0[0] + o0[1] * o0[1]) + (o0[2] * o0[2] + o0[3] * o0[3]) + (o1[0] * o1[0] + o1[1] * o1[1]) + (o1[2] * o1[2] + o1[3] * o1[3]);
                        u32x4 w; w.x = cvt_pk_bf16(o0[0], o0[1]); w.y = cvt_pk_bf16(o0[2], o0[3]); w.z = cvt_pk_bf16(o1[0], o1[1]); w.w = cvt_pk_bf16(o1[2], o1[3]);
                        *(u32x4*)(XB + off) = w; } }
                if (WRITE_NEXT) { ss += __shfl_xor(ss, 16); ss += __shfl_xor(ss, 32); if (fq == 0) rss[(size_t)row * 16 + 4 * u.pn + wc] = ss; }
            }
    }
};
}

__device__ __forceinline__ int rel_bucket_dev(int n) {
    if (n < 16) return n;
    int large = 16 + (int)(logf((float)n / 16.0f) / logf(8.0f) * 16.0f);
    return large < 31 ? large : 31;
}
__device__ __forceinline__ void build_bias_table(Frame& F, LAS float* tb, const float* gq, const float* gk, int hoff) {
    PHASE_TID(); const float* rb = in_ptr(10);
    float gm = 0.f;
    for (int d = 0; d < 64; ++d) gm = fmaxf(gm, fabsf(gq[d] * gk[d]));
    for (int e = ptid; e < 8 * 128; e += NWAVES * 64) { const int h = e >> 7, d = e & 127;
        float bm = -1e30f; for (int k = 0; k < 32; ++k) bm = fmaxf(bm, rb[k * 16 + hoff + h]);
        const float M0 = 64.0f * C2 * gm + bm * LOG2E;
        tb[e] = rb[rel_bucket_dev(d) * 16 + hoff + h] * LOG2E - M0; }
}

template <int MODE>
__device__ __forceinline__ void naive_attn(Frame& F, int layer) {
    PHASE_TID();
    LAS float* tb = (LAS float*)F.lds;
    const float* gq = in_ptr(MODE == 0 ? 3 : 5) + layer * 64; const float* gk = in_ptr(MODE == 0 ? 4 : 6) + layer * 64;
    build_bias_table(F, tb, gq, gk, MODE * 8);
    __syncthreads();
    const bf16* Q = (const bf16*)(F.ws + (MODE == 0 ? WS_QA : WS_QB));
    const bf16* K = (const bf16*)(F.ws + (MODE == 0 ? WS_KA : WS_KB));
    const bf16* V = (const bf16*)(F.ws + (MODE == 0 ? WS_VA : WS_VB));
    const bf16* SG = (const bf16*)(F.ws + (MODE == 0 ? WS_SGA : WS_SGB));
    bf16* Y = (bf16*)(F.ws + WS_XB) + (size_t)MODE * TOK * AW;
    const float* KMP = (const float*)(F.ws + WS_KMP);
    const u64* BM = (const u64*)(F.ws + WS_BM);
    constexpr int KLD = (MODE == 0) ? AW : 64;
    for (int item = blockIdx.x * (NWAVES * 64) + ptid; item < BATCH * NH * SEQ; item += F.G * NWAVES * 64) {
        const int q = item & (SEQ - 1), h = (item >> 12) & 7, b = item >> 15; const int qblk = q >> 8;
        const size_t tq = (size_t)b * SEQ + q;
        float qv[64];
        { const v4u* qp = (const v4u*)(Q + tq * AW + h * 64);
#pragma unroll
            for (int c = 0; c < 8; ++c) { const v4u w = qp[c]; qv[8 * c + 0] = bflo(w.x); qv[8 * c + 1] = bfhi(w.x); qv[8 * c + 2] = bflo(w.y); qv[8 * c + 3] = bfhi(w.y); qv[8 * c + 4] = bflo(w.z); qv[8 * c + 5] = bfhi(w.z); qv[8 * c + 6] = bflo(w.w); qv[8 * c + 7] = bfhi(w.w); } }
        unsigned selmask = 0;
        if (MODE == 0) {
            float gate[16];
#pragma unroll
            for (int n = 0; n < 16; ++n) { gate[n] = -INFINITY;
                if (n < qblk) { const float* k0 = KMP + ((((size_t)b * 16 + n) * 8 + h) * 2) * 64; float s = 0.f;
#pragma unroll
                    for (int d = 0; d < 64; ++d) s += qv[d] * ((k0[d] + k0[64 + d]) * (1.0f / 256.0f));
                    gate[n] = s; } }
            const int nsel = qblk < 3 ? qblk : 3;
            for (int r = 0; r < nsel; ++r) { float best = -INFINITY; int bi = -1;
#pragma unroll
                for (int n = 0; n < 16; ++n) { const bool ok = (n < qblk) && !((selmask >> n) & 1u) && (bi < 0 || gate[n] > best); if (ok) { best = gate[n]; bi = n; } }
                selmask |= 1u << bi; }
        }
        float acc[64];
#pragma unroll
        for (int d = 0; d < 64; ++d) acc[d] = 0.f;
        float l = 0.f;
        const int kend = (item | 63) & (SEQ - 1);
        const LAS float* tbh = tb + h * 128;
        u64 mw = 0;
        for (int k = 0; k <= kend; ++k) {
            bool allowed;
            if (MODE == 0) { const int n = k >> 8; allowed = (n == qblk) ? (k <= q) : (((selmask >> n) & 1u) != 0u && n < qblk); }
            else { if ((k & 63) == 0) mw = (k <= q) ? BM[tq * 64 + (k >> 6)] : 0ull; allowed = ((mw >> (k & 63)) & 1ull) != 0ull; }
            if (!__any(allowed)) continue;
            const size_t tk = (size_t)b * SEQ + k;
            const v4u* kp = (const v4u*)(K + tk * KLD + (MODE == 0 ? h * 64 : 0));
            float s = 0.f;
#pragma unroll
            for (int c = 0; c < 8; ++c) { const v4u w = kp[c];
                s += qv[8 * c + 0] * bflo(w.x); s += qv[8 * c + 1] * bfhi(w.x); s += qv[8 * c + 2] * bflo(w.y); s += qv[8 * c + 3] * bfhi(w.y);
                s += qv[8 * c + 4] * bflo(w.z); s += qv[8 * c + 5] * bfhi(w.z); s += qv[8 * c + 6] * bflo(w.w); s += qv[8 * c + 7] * bfhi(w.w); }
            int dist = q - k; dist = dist < 0 ? 0 : (dist > 127 ? 127 : dist);
            s += tbh[dist];
            const float p = allowed ? __builtin_amdgcn_exp2f(s) : 0.f;
            l += p;
            const v4u* vp = (const v4u*)(V + tk * KLD + (MODE == 0 ? h * 64 : 0));
#pragma unroll
            for (int c = 0; c < 8; ++c) { const v4u w = vp[c];
                acc[8 * c + 0] += p * bflo(w.x); acc[8 * c + 1] += p * bfhi(w.x); acc[8 * c + 2] += p * bflo(w.y); acc[8 * c + 3] += p * bfhi(w.y);
                acc[8 * c + 4] += p * bflo(w.z); acc[8 * c + 5] += p * bfhi(w.z); acc[8 * c + 6] += p * bflo(w.w); acc[8 * c + 7] += p * bfhi(w.w); }
        }
        const float il = 1.0f / l;
        const v4u* gp = (const v4u*)(SG + tq * AW + h * 64); v4u* yp = (v4u*)(Y + tq * AW + h * 64);
#pragma unroll
        for (int c = 0; c < 8; ++c) { const v4u g = gp[c]; v4u o;
            o.x = pk2(acc[8 * c + 0] * il * bflo(g.x), acc[8 * c + 1] * il * bfhi(g.x)); o.y = pk2(acc[8 * c + 2] * il * bflo(g.y), acc[8 * c + 3] * il * bfhi(g.y));
            o.z = pk2(acc[8 * c + 4] * il * bflo(g.z), acc[8 * c + 5] * il * bfhi(g.z)); o.w = pk2(acc[8 * c + 6] * il * bflo(g.w), acc[8 * c + 7] * il * bfhi(g.w));
            yp[c] = o; }
    }
}

typedef float f32x16 __attribute__((ext_vector_type(16)));
typedef short s16x4 __attribute__((ext_vector_type(4)));
typedef short v4i16_t __attribute__((ext_vector_type(4)));
constexpr int AT_D = 4, AT_R = AT_D + 2;
constexpr int AT_RING = 0, AT_STAGE = 16384, AT_OST = 0  , AT_TB = AT_R * AT_STAGE, AT_WS = AT_TB + 8192, AT_BM = AT_WS + 2048;
static_assert(8 * 8192 <= AT_R * AT_STAGE && AT_BM + 16384 <= LDSCTL_OFF, "attention LDS");
__device__ __forceinline__ void glds16(const void* gsrc, unsigned lds_dst) { unsigned keep;
    asm volatile("s_mov_b32 %0, m0\n\ts_mov_b32 m0, %2\n\ts_nop 0\n\tglobal_load_lds_dwordx4 %1, off\n\ts_mov_b32 m0, %0" : "=&s"(keep) : "v"(gsrc), "s"(lds_dst) : "memory"); }
#define AT_WAIT_BAR() asm volatile("s_waitcnt vmcnt(0) lgkmcnt(0)\n\ts_barrier" ::: "memory")
#define AT_WAIT_BAR_N(N) asm volatile("s_waitcnt vmcnt(%0) lgkmcnt(0)\n\ts_barrier" :: "n"(N) : "memory")
__device__ __forceinline__ int crow(int r, int hi) { return (r & 3) + 8 * (r >> 2) + 4 * hi; }
__device__ __forceinline__ unsigned cvtpk(float lo, float hi) { unsigned r; asm volatile("v_cvt_pk_bf16_f32 %0, %1, %2" : "=v"(r) : "v"(lo), "v"(hi)); return r; }

template <int MODE>
__device__ __forceinline__ void attn_unit(Frame& F, int b, int h_, int blk) {
    int tid_o = threadIdx.x; asm volatile("" : "+v"(tid_o));
    const int lane = tid_o & 63, r32 = lane & 31, hi = lane >> 5, wid = __builtin_amdgcn_readfirstlane(tid_o >> 6);
    constexpr int KLD = (MODE == 0) ? AW : 64;
    const int h = (MODE == 0) ? h_ : wid;
    const int q0 = (MODE == 0) ? 256 * blk + 32 * wid : 32 * blk;
    const int q = q0 + r32; const size_t tq = (size_t)b * SEQ + q;
    const int NT = (MODE == 0) ? 4 * (blk + 1) : (32 * blk + 31) / 64 + 1;
    const bf16* Q = (const bf16*)(F.ws + (MODE == 0 ? WS_QA : WS_QB));
    const bf16* Kg = (const bf16*)(F.ws + (MODE == 0 ? WS_KA : WS_KB)) + (size_t)b * SEQ * KLD + (MODE == 0 ? h * 64 : 0);
    const bf16* Vg = (const bf16*)(F.ws + (MODE == 0 ? WS_VA : WS_VB)) + (size_t)b * SEQ * KLD + (MODE == 0 ? h * 64 : 0);
    const bf16* SG = (const bf16*)(F.ws + (MODE == 0 ? WS_SGA : WS_SGB));
    bf16* Y = (bf16*)(F.ws + WS_XB) + (size_t)MODE * TOK * AW;
    const u64* BM = (const u64*)(F.ws + WS_BM) + tq * 64;
    LAS unsigned char* lds = F.lds;
    const LAS float* tbh = (const LAS float*)(lds + AT_TB) + (MODE * 8 + h) * 128;
    LAS float* wsf = (LAS float*)(lds + AT_WS) + wid * 64;
    LAS float* ost = (LAS float*)(lds + AT_OST) + wid * 2048;
    const int krow_ = 8 * wid + (lane >> 3);
    const bf16* ksrc = Kg + (size_t)krow_ * KLD + 8 * ((lane & 7) ^ ((krow_ ^ (krow_ >> 3)) & 7));
    const bf16* vsrc = Vg + (size_t)(8 * wid + ((lane & 31) >> 2)) * KLD + 32 * (lane >> 5) + 8 * (lane & 3);
    const unsigned lds0 = (unsigned)(uintptr_t)lds;
#define AT_DMA(t, so) do { \
        glds16(ksrc + (size_t)(t) * 64 * KLD, (unsigned)__builtin_amdgcn_readfirstlane((int)(lds0 + AT_RING + (so) + wid * 1024))); \
        glds16(vsrc + (size_t)(t) * 64 * KLD, (unsigned)__builtin_amdgcn_readfirstlane((int)(lds0 + AT_RING + (so) + 8192 + wid * 1024))); } while (0)
#pragma unroll
    for (int i = 0; i < AT_D; ++i) AT_DMA((i < NT ? i : NT - 1), i * AT_STAGE);
    bf16x8 qr[4];
#pragma unroll
    for (int d0 = 0; d0 < 4; ++d0) qr[d0] = *(const bf16x8*)(Q + tq * AW + h * 64 + 16 * d0 + 8 * hi);
    LAS u64* bmL = (LAS u64*)(lds + AT_BM);
    if (MODE == 1) {
        const u64* BMu = (const u64*)(F.ws + WS_BM) + ((size_t)b * SEQ + q0) * 64;
#pragma unroll
        for (int ps = 0; ps < 2; ++ps) { const int it = ps * 512 + (tid_o & 511), row = it >> 5, j2 = (it & 31) * 2;
            const v4u w = *(const v4u*)(BMu + (size_t)row * 64 + j2);
            bmL[j2 * 32 + row] = (u64)w.x | ((u64)w.y << 32); bmL[(j2 + 1) * 32 + row] = (u64)w.z | ((u64)w.w << 32); }
    }
    unsigned selmask = 0;
    if (MODE == 0 && blk > 0) {
        float qf[64];
        { const v4u* qp = (const v4u*)(Q + tq * AW + h * 64);
#pragma unroll
            for (int c = 0; c < 8; ++c) { const v4u w = qp[c]; qf[8 * c + 0] = bflo(w.x); qf[8 * c + 1] = bfhi(w.x); qf[8 * c + 2] = bflo(w.y); qf[8 * c + 3] = bfhi(w.y); qf[8 * c + 4] = bflo(w.z); qf[8 * c + 5] = bfhi(w.z); qf[8 * c + 6] = bflo(w.w); qf[8 * c + 7] = bfhi(w.w); } }
        const float* KMP = (const float*)(F.ws + WS_KMP);
        float g8[8];
#pragma unroll
        for (int nn = 0; nn < 8; ++nn) { const int n = 8 * hi + nn; float s = -INFINITY;
            if (n < blk) { const f32x4* k0 = (const f32x4*)(KMP + ((((size_t)b * 16 + n) * 8 + h) * 2) * 64); s = 0.f;
#pragma unroll
                for (int c = 0; c < 16; ++c) { const f32x4 a = k0[c], bb = k0[16 + c];
                    s += qf[4 * c + 0] * ((a[0] + bb[0]) * (1.0f / 256.0f)); s += qf[4 * c + 1] * ((a[1] + bb[1]) * (1.0f / 256.0f)); s += qf[4 * c + 2] * ((a[2] + bb[2]) * (1.0f / 256.0f)); s += qf[4 * c + 3] * ((a[3] + bb[3]) * (1.0f / 256.0f)); } }
            g8[nn] = s; }
        float gate[16];
#pragma unroll
        for (int nn = 0; nn < 8; ++nn) { const float o = __shfl_xor(g8[nn], 32); gate[nn] = hi ? o : g8[nn]; gate[8 + nn] = hi ? g8[nn] : o; }
        const int nsel = blk < 3 ? blk : 3;
        for (int r = 0; r < nsel; ++r) { float best = -INFINITY; int bi = -1;
#pragma unroll
            for (int n = 0; n < 16; ++n) { const bool ok = (n < blk) && !((selmask >> n) & 1u) && (bi < 0 || gate[n] > best); if (ok) { best = gate[n]; bi = n; } }
            selmask |= 1u << bi; }
    }
    const float cfar = tbh[127]; const float NINF = -INFINITY;
#define AT_INIT_NEAR(t, c0, c1, mw) do { \
        const int kv0_ = 64 * (t); \
        bool sel_ = (t) < NT; \
        if (MODE == 0) { const int n_ = (t) >> 2; sel_ = sel_ && ((n_ == blk) || (((selmask >> (n_ & 15)) & 1u) != 0u)); } \
        unsigned mlo_ = 0, mhi_ = 0; if (MODE == 1) { const u64 ms_ = (mw) >> (4 * hi); mlo_ = (unsigned)ms_; mhi_ = (unsigned)(ms_ >> 32); } \
        _Pragma("unroll") for (int r = 0; r < 16; ++r) { const int bp = (r & 3) + 8 * (r >> 2); \
            const int d0_ = q - (kv0_ + bp + 4 * hi), d1_ = d0_ - 32; \
            const float b0_ = tbh[d0_ < 0 ? 0 : (d0_ > 127 ? 127 : d0_)], b1_ = tbh[d1_ < 0 ? 0 : (d1_ > 127 ? 127 : d1_)]; \
            if (MODE == 0) { c0[r] = (sel_ && d0_ >= 0) ? b0_ : NINF; c1[r] = (sel_ && d1_ >= 0) ? b1_ : NINF; } \
            else { c0[r] = (sel_ && ((mlo_ >> bp) & 1u)) ? b0_ : NINF; c1[r] = (sel_ && ((mhi_ >> bp) & 1u)) ? b1_ : NINF; } } } while (0)
#define AT_INIT_FARB(t, c0, c1, mw) do { \
        const u64 ms_ = ((t) < NT) ? ((mw) >> (4 * hi)) : 0ull; const int mlo_ = (int)(unsigned)ms_, mhi_ = (int)(unsigned)(ms_ >> 32); \
        const unsigned cf_ = __float_as_uint(cfar), nf_ = 0xff800000u; \
        _Pragma("unroll") for (int r = 0; r < 16; ++r) { const int bp = (r & 3) + 8 * (r >> 2); \
            const unsigned m0_ = (unsigned)__builtin_amdgcn_sbfe(mlo_, bp, 1), m1_ = (unsigned)__builtin_amdgcn_sbfe(mhi_, bp, 1); \
            c0[r] = __uint_as_float((m0_ & cf_) | (~m0_ & nf_)); c1[r] = __uint_as_float((m1_ & cf_) | (~m1_ & nf_)); } } while (0)
    const int kswz = (r32 ^ (r32 >> 3)) & 7;
#define AT_KF(Kt_, d0, p) (*(const LAS bf16x8*)((Kt_) + (p) * 4096 + (((2 * (d0) + hi) ^ kswz ^ (4 * (p))) << 4)))
#define AT_QK(so, c0, c1, i0, i1) do { const LAS unsigned char* Kt_ = lds + AT_RING + (so) + r32 * 128; \
        c0 = __builtin_amdgcn_mfma_f32_32x32x16_bf16(AT_KF(Kt_, 0, 0), qr[0], i0, 0, 0, 0); \
        c1 = __builtin_amdgcn_mfma_f32_32x32x16_bf16(AT_KF(Kt_, 0, 1), qr[0], i1, 0, 0, 0); \
        _Pragma("unroll") for (int d0 = 1; d0 < 4; ++d0) { \
            c0 = __builtin_amdgcn_mfma_f32_32x32x16_bf16(AT_KF(Kt_, d0, 0), qr[d0], c0, 0, 0, 0); \
            c1 = __builtin_amdgcn_mfma_f32_32x32x16_bf16(AT_KF(Kt_, d0, 1), qr[d0], c1, 0, 0, 0); } } while (0)
#define AT_SCORES(t, kf, c0, c1, mw) do { \
        const bool nearD_ = (q0 - (64 * (t) + 63)) < 113; \
        if (nearD_) { AT_INIT_NEAR(t, c0, c1, mw); AT_QK(kf, c0, c1, c0, c1); } \
        else if (MODE == 0) { AT_QK(kf, c0, c1, ivec, ivec); } \
        else { AT_INIT_FARB(t, c0, c1, mw); AT_QK(kf, c0, c1, c0, c1); } } while (0)
#define AT_IVEC(t) do { if (MODE == 0) { const int n_ = (t) >> 2; const bool s_ = ((t) < NT) && ((n_ == blk) || (((selmask >> (n_ & 15)) & 1u) != 0u)); const float v_ = s_ ? cfar : NINF; \
        _Pragma("unroll") for (int r = 0; r < 16; ++r) ivec[r] = v_; asm volatile("" : "+v"(ivec)); } } while (0)
#ifndef EXP_LDS
#define EXP_LDS 0
#endif
#ifndef EXP_EXP
#define EXP_EXP 0
#endif
#ifndef EXP_MFMA
#define EXP_MFMA 0
#endif
    f32x16 o0, o1, ivec; pg8::f32x4 dm4a = (pg8::f32x4){0.f,0.f,0.f,0.f}, dm4b = (pg8::f32x4){0.f,0.f,0.f,0.f}; f32x16 dmy; if (EXP_MFMA) { _Pragma("unroll") for (int r = 0; r < 16; ++r) dmy[r] = 0.f; }
#pragma unroll
    for (int r = 0; r < 16; ++r) { o0[r] = 0.f; o1[r] = 0.f; ivec[r] = NINF; }
    float lsum = 0.f;
    f32x16 ca0, ca1, cb0, cb1;
    AT_WAIT_BAR_N(2 * (AT_D - 1));
    AT_IVEC(0);
    { u64 mw0 = 0ull; if (MODE == 1) mw0 = bmL[r32];
      AT_SCORES(0, 0, ca0, ca1, mw0); }
    const int vbl = ((lane >> 4) & 1) * 32 + (lane & 3) * 8 + (4 * hi + ((lane & 15) >> 2)) * 64;
    int so_cur = 0, so_nxt = AT_STAGE, so_dma = AT_D * AT_STAGE;
#define AT_STEP(t, C0, C1, N0, N1) do { \
        u64 mw1_ = 0ull; if (MODE == 1) mw1_ = bmL[(((t) + 1) & 63) * 32 + r32]; \
        const LAS unsigned char* Vt_ = lds + AT_RING + so_cur + 8192; \
        asm volatile("" ::: "memory"); \
        if ((((t) + 1) & 3) == 0) AT_IVEC((t) + 1); \
        AT_SCORES((t) + 1, so_nxt, N0, N1, mw1_); \
        float sacc_ = 0.f; \
        if (EXP_EXP) { _Pragma("unroll") for (int r = 0; r < 16; ++r) { float e0_ = __builtin_amdgcn_exp2f(C0[r] + 1.0f), e1_ = __builtin_amdgcn_exp2f(C1[r] + 1.0f); asm volatile("" :: "v"(e0_), "v"(e1_)); } } \
        _Pragma("unroll") for (int r = 0; r < 16; ++r) { C0[r] = __builtin_amdgcn_exp2f(C0[r]); C1[r] = __builtin_amdgcn_exp2f(C1[r]); sacc_ += C0[r] + C1[r]; } \
        lsum += sacc_; \
        u32x4v pw_[4]; \
        _Pragma("unroll") for (int s_ = 0; s_ < 2; ++s_) { \
            pw_[s_] = (u32x4v){cvtpk(C0[8 * s_], C0[8 * s_ + 1]), cvtpk(C0[8 * s_ + 2], C0[8 * s_ + 3]), cvtpk(C0[8 * s_ + 4], C0[8 * s_ + 5]), cvtpk(C0[8 * s_ + 6], C0[8 * s_ + 7])}; \
            pw_[2 + s_] = (u32x4v){cvtpk(C1[8 * s_], C1[8 * s_ + 1]), cvtpk(C1[8 * s_ + 2], C1[8 * s_ + 3]), cvtpk(C1[8 * s_ + 4], C1[8 * s_ + 5]), cvtpk(C1[8 * s_ + 6], C1[8 * s_ + 7])}; } \
        _Pragma("unroll") for (int ks = 0; ks < 4; ++ks) { const bf16x8 pa_ = __builtin_bit_cast(bf16x8, pw_[ks]); \
            _Pragma("unroll") for (int d0 = 0; d0 < 2; ++d0) { const LAS unsigned char* vp_ = Vt_ + (2 * ks) * 1024 + d0 * 512 + vbl; \
                const s16x4 lo_ = __builtin_bit_cast(s16x4, __builtin_amdgcn_ds_read_tr16_b64_v4i16((LAS v4i16_t*)vp_)), hh_ = __builtin_bit_cast(s16x4, __builtin_amdgcn_ds_read_tr16_b64_v4i16((LAS v4i16_t*)(vp_ + 1024))); \
                if (EXP_LDS) { s16x4 l2_ = __builtin_bit_cast(s16x4, __builtin_amdgcn_ds_read_tr16_b64_v4i16((LAS v4i16_t*)(vp_ + 2048))), h2_ = __builtin_bit_cast(s16x4, __builtin_amdgcn_ds_read_tr16_b64_v4i16((LAS v4i16_t*)(vp_ + 3072))); asm volatile("" :: "v"(l2_), "v"(h2_)); } \
                const bf16x8 vf_ = (bf16x8){lo_[0], lo_[1], lo_[2], lo_[3], hh_[0], hh_[1], hh_[2], hh_[3]}; \
                if (d0 == 0) o0 = __builtin_amdgcn_mfma_f32_32x32x16_bf16(pa_, vf_, o0, 0, 0, 0); else o1 = __builtin_amdgcn_mfma_f32_32x32x16_bf16(pa_, vf_, o1, 0, 0, 0); \
                if (EXP_MFMA == 1) { dmy = __builtin_amdgcn_mfma_f32_32x32x16_bf16(pa_, vf_, dmy, 0, 0, 0); } \
                if (EXP_MFMA == 2) { dm4a = __builtin_amdgcn_mfma_f32_16x16x32_bf16(pa_, vf_, dm4a, 0, 0, 0); dm4b = __builtin_amdgcn_mfma_f32_16x16x32_bf16(vf_, pa_, dm4b, 0, 0, 0); } } } \
        so_cur = so_nxt; so_nxt = (so_nxt == (AT_R - 1) * AT_STAGE) ? 0 : so_nxt + AT_STAGE; } while (0)
    for (int t = 0; t < NT; t += 2) {
        AT_WAIT_BAR_N(2 * (AT_D - 3));
        { const int td_ = t + AT_D; AT_DMA((td_ < NT ? td_ : NT - 1), so_dma); so_dma = (so_dma == (AT_R - 1) * AT_STAGE) ? 0 : so_dma + AT_STAGE; }
        { const int td_ = t + AT_D + 1; AT_DMA((td_ < NT ? td_ : NT - 1), so_dma); so_dma = (so_dma == (AT_R - 1) * AT_STAGE) ? 0 : so_dma + AT_STAGE; }
        AT_STEP(t, ca0, ca1, cb0, cb1);
        AT_STEP(t + 1, cb0, cb1, ca0, ca1);
    }
    if (EXP_MFMA == 1) asm volatile("" :: "v"(dmy));
    if (EXP_MFMA == 2) asm volatile("" :: "v"(dm4a), "v"(dm4b));
    AT_WAIT_BAR();
    lsum += __shfl_xor(lsum, 32);
    if (hi == 0) wsf[r32] = lsum;
    LDS_WAIT(); asm volatile("" ::: "memory");
#pragma unroll
    for (int r = 0; r < 16; ++r) { const int orow = crow(r, hi); const float rl = __builtin_amdgcn_rcpf(wsf[orow]);
        ost[orow * 64 + r32] = o0[r] * rl; ost[orow * 64 + 32 + r32] = o1[r] * rl; }
    LDS_WAIT(); asm volatile("" ::: "memory");
#pragma unroll
    for (int i = 0; i < 4; ++i) { const int row = i * 8 + (lane >> 3), ch = lane & 7;
        const f32x4 a = *(const LAS f32x4*)(ost + row * 64 + ch * 8), c = *(const LAS f32x4*)(ost + row * 64 + ch * 8 + 4);
        const size_t off = ((size_t)b * SEQ + q0 + row) * AW + h * 64 + ch * 8;
        const v4u g = *(const v4u*)(SG + off); v4u o;
        o.x = pk2(a[0] * bflo(g.x), a[1] * bfhi(g.x)); o.y = pk2(a[2] * bflo(g.y), a[3] * bfhi(g.y)); o.z = pk2(c[0] * bflo(g.z), c[1] * bfhi(g.z)); o.w = pk2(c[2] * bflo(g.w), c[3] * bfhi(g.w));
        *(v4u*)(Y + off) = o; }
    AT_WAIT_BAR();
#undef AT_DMA
#undef AT_INIT_NEAR
#undef AT_INIT_FARB
#undef AT_QK
#undef AT_KF
#undef AT_SCORES
#undef AT_IVEC
#undef AT_STEP
}
__device__ __forceinline__ void attn_phase_fast(Frame& F, int layer) {
    { LAS float* tb = (LAS float*)(F.lds + AT_TB);
      build_bias_table(F, tb, in_ptr(3) + layer * 64, in_ptr(4) + layer * 64, 0);
      build_bias_table(F, tb + 1024, in_ptr(5) + layer * 64, in_ptr(6) + layer * 64, 8); }
    __syncthreads();
#ifndef REP_ATT_A
#define REP_ATT_A 1
#endif
#ifndef REP_ATT_B
#define REP_ATT_B 1
#endif
    for (int rep = 0; rep < REP_ATT_A; ++rep)
    for (int pr = F.vcu; pr < 512; pr += F.G) {
        const int bh = pr >> 3, s = pr & 7;
        attn_unit<0>(F, bh >> 3, bh & 7, 15 - s); attn_unit<0>(F, bh >> 3, bh & 7, s); }
    for (int rep = 0; rep < REP_ATT_B; ++rep)
    for (int pr = F.vcu; pr < 512; pr += F.G) {
        const int b = pr >> 6, s = pr & 63;
        attn_unit<1>(F, b, 0, 127 - s); attn_unit<1>(F, b, 0, s); }
}

constexpr int IDX_S_OFF = 0, IDX_Q_OFF = RING_BYTES, IDX_W_OFF = RING_BYTES + 8192, IDX_H_OFF = RING_BYTES + 8192 + 256;
static_assert(IDX_H_OFF + 8 * 1280 <= LDSCTL_OFF, "idx LDS");

#define DPPI_(x, ctrl) __builtin_amdgcn_update_dpp(0, (x), (ctrl), 0xF, 0xF, true)
#define DPPF_(x, ctrl) __builtin_bit_cast(float, DPPI_(__builtin_bit_cast(int, (x)), (ctrl)))
__device__ __forceinline__ float rl_f(float x, int l) { return __builtin_bit_cast(float, __builtin_amdgcn_readlane(__builtin_bit_cast(int, x), l)); }
__device__ __forceinline__ float wave_minf(float x) {
    x = fminf(x, DPPF_(x, 0xB1)); x = fminf(x, DPPF_(x, 0x4E)); x = fminf(x, DPPF_(x, 0x141)); x = fminf(x, DPPF_(x, 0x140));
    return fminf(fminf(rl_f(x, 0), rl_f(x, 16)), fminf(rl_f(x, 32), rl_f(x, 48)));
}
__device__ __forceinline__ float wave_maxf(float x) {
    x = fmaxf(x, DPPF_(x, 0xB1)); x = fmaxf(x, DPPF_(x, 0x4E)); x = fmaxf(x, DPPF_(x, 0x141)); x = fmaxf(x, DPPF_(x, 0x140));
    return fmaxf(fmaxf(rl_f(x, 0), rl_f(x, 16)), fmaxf(rl_f(x, 32), rl_f(x, 48)));
}
#define SEL_OPAQUE() do { _Pragma("unroll") for (int j_ = 0; j_ < 64; ++j_) asm volatile("" : "+v"(v[j_])); } while (0)
__device__ __forceinline__ unsigned bin_of(float x, float lo, float scale) {
    int r; const float t = (x - lo) * scale; asm("v_cvt_i32_f32 %0, %1" : "=v"(r) : "v"(t)); const unsigned u = (unsigned)r; return u < 256u ? u : 256u;
}
__device__ __forceinline__ u64 select_row(LAS float* R, int n, int lane, LAS unsigned* hist) {
    const int nch = (n + 63) >> 6;
    if (64 * (nch - 1) + lane >= n) R[64 * (nch - 1) + lane] = -INFINITY;
    LDS_WAIT(); asm volatile("" ::: "memory");
    const LAS float* Rl = R + lane;
    float lo = INFINITY, hi = -INFINITY;
#pragma unroll 4
    for (int j = 0; j < nch; ++j) { const float x = Rl[64 * j]; lo = fminf(lo, x == -INFINITY ? INFINITY : x); hi = fmaxf(hi, x); }
    lo = wave_minf(lo); hi = wave_maxf(hi);
    int need = 256; float T = lo; int needT = 256;
    for (int iter = 0; iter < 48; ++iter) {
        T = lo; needT = need;
        if (!(hi > lo)) break;
        hist[lane] = 0u; hist[64 + lane] = 0u; hist[128 + lane] = 0u; hist[192 + lane] = 0u; hist[256 + (lane & 3)] = 0u;
        LDS_WAIT(); asm volatile("" ::: "memory");
        const float scale = 255.99f / (hi - lo);
#pragma unroll 4
        for (int j = 0; j < nch; ++j) __hip_atomic_fetch_add(hist + bin_of(Rl[64 * j], lo, scale), 1u, __ATOMIC_RELAXED, __HIP_MEMORY_SCOPE_WORKGROUP);
        LDS_WAIT(); asm volatile("" ::: "memory");
        const unsigned h0 = hist[4 * lane], h1 = hist[4 * lane + 1], h2 = hist[4 * lane + 2], h3 = hist[4 * lane + 3];
        unsigned suf = h0 + h1 + h2 + h3;
#pragma unroll
        for (int o = 1; o < 64; o <<= 1) { const unsigned t = __shfl_down(suf, o); if (lane + o < 64) suf += t; }
        const u64 bal = __ballot(suf >= (unsigned)need);
        if (bal == 0ull) break;
        const int ls = 63 - __builtin_clzll(bal);
        const unsigned a3 = __builtin_amdgcn_readlane(h3, ls), a2 = __builtin_amdgcn_readlane(h2, ls), a1 = __builtin_amdgcn_readlane(h1, ls), a0 = __builtin_amdgcn_readlane(h0, ls);
        const unsigned above_lane = __builtin_amdgcn_readlane(suf, ls) - (a0 + a1 + a2 + a3);
        unsigned bstar, above, cstar;
        if (above_lane + a3 >= (unsigned)need) { bstar = 4 * ls + 3; above = above_lane; cstar = a3; }
        else if (above_lane + a3 + a2 >= (unsigned)need) { bstar = 4 * ls + 2; above = above_lane + a3; cstar = a2; }
        else if (above_lane + a3 + a2 + a1 >= (unsigned)need) { bstar = 4 * ls + 1; above = above_lane + a3 + a2; cstar = a1; }
        else { bstar = 4 * ls; above = above_lane + a3 + a2 + a1; cstar = a0; }
        need -= (int)above;
        float nlo = INFINITY, nhi = -INFINITY; int cnt = 0;
        LAS float* candx = (LAS float*)hist; LAS unsigned* candi = hist + 64;
#pragma unroll 4
        for (int j = 0; j < nch; ++j) { const float x = Rl[64 * j];
            const bool c = bin_of(x, lo, scale) == bstar;
            const u64 cb = __ballot(c);
            if (cb != 0ull) { nlo = fminf(nlo, c ? x : INFINITY); nhi = fmaxf(nhi, c ? x : -INFINITY);
                const int pos = cnt + (int)__builtin_amdgcn_mbcnt_hi((unsigned)(cb >> 32), __builtin_amdgcn_mbcnt_lo((unsigned)cb, 0u));
                if (c && pos < 64) { candx[pos] = x; candi[pos] = (unsigned)(64 * j + lane); }
                cnt += __builtin_popcountll(cb); } }
        if (cstar <= 64u) {
            LDS_WAIT(); asm volatile("" ::: "memory");
            const bool mine = lane < (int)cstar;
            const float mx = mine ? candx[lane] : -INFINITY; const unsigned mi = candi[lane];
            int rank = 0;
            for (int i = 0; i < (int)cstar; ++i) { const float xi = rl_f(mx, i); const unsigned ii = (unsigned)__builtin_amdgcn_readlane((int)mi, i); rank += (xi > mx || (xi == mx && ii < mi)) ? 1 : 0; }
            const u64 tb_ = __ballot(mine && rank == need - 1);
            if (tb_ == 0ull) break;
            T = rl_f(mx, __builtin_ctzll(tb_));
            needT = need - __builtin_popcountll(__ballot(mine && mx > T));
            LDS_WAIT(); asm volatile("" ::: "memory");
            break;
        }
        nlo = wave_minf(nlo); nhi = wave_maxf(nhi);
        if ((int)cstar == need) { T = nlo; needT = 1 << 20; break; }
        lo = nlo; hi = nhi;
    }
    int run = 0; unsigned wlo = 0u, whi = 0u;
#pragma unroll 4
    for (int j = 0; j < nch; ++j) { const float x = Rl[64 * j];
        u64 w;
        const bool tie = (x == T); const u64 tbal = __ballot(tie);
        if (tbal == 0ull) w = __ballot(x > T);
        else { const int rank = run + (int)__builtin_amdgcn_mbcnt_hi((unsigned)(tbal >> 32), __builtin_amdgcn_mbcnt_lo((unsigned)tbal, 0u)); run += __builtin_popcountll(tbal);
            w = __ballot(x > T || (tie && rank < needT)); }
        if (lane == j) { wlo = (unsigned)w; whi = (unsigned)(w >> 32); }
    }
    return (u64)wlo | ((u64)whi << 32);
}

#ifdef NAIVE_IDX
__device__ __forceinline__ void idx_phase_naive(Frame& F) {
    PHASE_TID();
    LAS float* S = (LAS float*)(F.lds + IDX_S_OFF); LAS float* qs = (LAS float*)(F.lds + IDX_Q_OFF); LAS float* wsm = (LAS float*)(F.lds + IDX_W_OFF);
    LAS unsigned* hist = (LAS unsigned*)(F.lds + IDX_H_OFF) + F.wave * 320;
    const bf16* QI = (const bf16*)(F.ws + WS_QI); const bf16* KI = (const bf16*)(F.ws + WS_KI); const float* WI = (const float*)(F.ws + WS_WI); u64* BM = (u64*)(F.ws + WS_BM);
    for (int un = blockIdx.x; un < TOK / 8; un += F.G) {
        const int b = un >> 9, q0 = (un & 511) * 8; const size_t t0 = (size_t)b * SEQ + q0;
        for (int e = ptid; e < 8 * 256; e += NWAVES * 64) qs[e] = bf2f(QI[t0 * 256 + e]);
        if (ptid < 32) wsm[ptid] = WI[t0 * 4 + ptid];
        __syncthreads();
        const int nk = q0 + 8;
        for (int k = ptid; k < nk; k += NWAVES * 64) {
            float kf[64];
            { const v4u* kp = (const v4u*)(KI + ((size_t)b * SEQ + k) * 64);
#pragma unroll
                for (int c = 0; c < 8; ++c) { const v4u w = kp[c]; kf[8 * c + 0] = bflo(w.x); kf[8 * c + 1] = bfhi(w.x); kf[8 * c + 2] = bflo(w.y); kf[8 * c + 3] = bfhi(w.y); kf[8 * c + 4] = bflo(w.z); kf[8 * c + 5] = bfhi(w.z); kf[8 * c + 6] = bflo(w.w); kf[8 * c + 7] = bfhi(w.w); } }
            for (int i = 0; i < 8; ++i) { float sc = 0.f;
#pragma unroll
                for (int h = 0; h < 4; ++h) { float dot = 0.f; const LAS f32x4* qp = (const LAS f32x4*)(qs + i * 256 + h * 64);
#pragma unroll
                    for (int c = 0; c < 16; ++c) { const f32x4 qq = qp[c]; dot += kf[4 * c] * qq[0]; dot += kf[4 * c + 1] * qq[1]; dot += kf[4 * c + 2] * qq[2]; dot += kf[4 * c + 3] * qq[3]; }
                    sc += wsm[i * 4 + h] * fmaxf(dot, 0.f); }
                S[i * 4096 + k] = sc; }
        }
        __syncthreads();
        { const int i = F.wave, n = q0 + i + 1; u64 word;
            if (n <= 256) { const int full = n >> 6, rem = n & 63; word = (plane < full) ? ~0ull : (plane == full ? ((1ull << rem) - 1ull) : 0ull); }
            else word = select_row(S + i * 4096, n, plane, hist);
            BM[(t0 + i) * 64 + plane] = word; }
        __syncthreads();
    }
}

#endif
__device__ __forceinline__ float dpp_quad_sum(float x) {
    x += __builtin_bit_cast(float, __builtin_amdgcn_mov_dpp(__builtin_bit_cast(int, x), 0xB1, 0xF, 0xF, true));
    x += __builtin_bit_cast(float, __builtin_amdgcn_mov_dpp(__builtin_bit_cast(int, x), 0x4E, 0xF, 0xF, true));
    return x;
}
__device__ __forceinline__ void idx_phase(Frame& F) {
    PHASE_TID();
    LAS float* S = (LAS float*)(F.lds + IDX_S_OFF);
    LAS unsigned* hist = (LAS unsigned*)(F.lds + IDX_H_OFF) + F.wave * 320;
    const bf16* QI = (const bf16*)(F.ws + WS_QI); const bf16* KI = (const bf16*)(F.ws + WS_KI); const float* WI = (const float*)(F.ws + WS_WI); u64* BM = (u64*)(F.ws + WS_BM);
    const int c16 = plane & 15, kg = plane >> 4, qloc = c16 >> 2, hh = c16 & 3;
    for (int un = blockIdx.x; un < TOK / 8; un += F.G) {
        const int b = un >> 9, m_ = un & 511, q0 = (m_ < 256 ? m_ : 767 - m_) * 8; const size_t t0 = (size_t)b * SEQ + q0;
        bf16x8 qf[2][2]; float wv[2];
#pragma unroll
        for (int g = 0; g < 2; ++g) { wv[g] = WI[(t0 + 4 * g + qloc) * 4 + hh];
#pragma unroll
            for (int ks = 0; ks < 2; ++ks) qf[g][ks] = *(const bf16x8*)(QI + (t0 + 4 * g + qloc) * 256 + hh * 64 + 32 * ks + 8 * kg); }
        const int nchunk = (q0 + 8 + 15) >> 4;
        const bf16* kbase = KI + (size_t)b * SEQ * 64 + (size_t)c16 * 64 + 8 * kg;
#define IDX_LOAD(KA, c0_) do { _Pragma("unroll") for (int u = 0; u < 4; ++u) { const int c = (c0_) + u * NWAVES; const bf16* kp = kbase + (size_t)(c < nchunk ? c : F.wave) * 16 * 64; \
            KA[u][0] = *(const bf16x8*)kp; KA[u][1] = *(const bf16x8*)(kp + 32); } } while (0)
#define IDX_COMP(KA, c0_) do { _Pragma("unroll") for (int u = 0; u < 4; ++u) { const int c = (c0_) + u * NWAVES; \
            if (c < nchunk) { _Pragma("unroll") for (int g = 0; g < 2; ++g) { \
                pg8::f32x4 acc = (pg8::f32x4){0.f, 0.f, 0.f, 0.f}; \
                acc = __builtin_amdgcn_mfma_f32_16x16x32_bf16(KA[u][0], qf[g][0], acc, 0, 0, 0); \
                acc = __builtin_amdgcn_mfma_f32_16x16x32_bf16(KA[u][1], qf[g][1], acc, 0, 0, 0); \
                pg8::f32x4 sc; \
                _Pragma("unroll") for (int i = 0; i < 4; ++i) sc[i] = dpp_quad_sum(wv[g] * fmaxf(acc[i], 0.f)); \
                if (hh == 0) *(LAS pg8::f32x4*)(S + (4 * g + qloc) * 4096 + 16 * c + 4 * kg) = sc; } } } } while (0)
        { bf16x8 kaA[4][2], kaB[4][2];
          IDX_LOAD(kaA, F.wave);
          for (int c0 = F.wave; c0 < nchunk; c0 += 8 * NWAVES) {
              IDX_LOAD(kaB, c0 + 4 * NWAVES);
              IDX_COMP(kaA, c0);
              IDX_LOAD(kaA, c0 + 8 * NWAVES);
              IDX_COMP(kaB, c0 + 4 * NWAVES);
          } }
#undef IDX_LOAD
#undef IDX_COMP
        __syncthreads();
        { const int i = F.wave, n = q0 + i + 1; u64 word;
            if (n <= 256) { const int full = n >> 6, rem = n & 63; word = (plane < full) ? ~0ull : (plane == full ? ((1ull << rem) - 1ull) : 0ull); }
            else word = select_row(S + i * 4096, n, plane, hist);
            BM[(t0 + i) * 64 + plane] = word; }
        __syncthreads();
    }
}

struct Args { const float* in[11]; float* out; unsigned char* ws; int ph_lo, ph_hi, li, pad; };
__global__ void __launch_bounds__(NWAVES * 64, 2) hyb_fwd(Args args) {
    extern __shared__ __attribute__((aligned(16))) unsigned char lds[];
    Frame F;
    F.lds = (LAS unsigned char*)lds;
    F.MISC = (volatile LAS unsigned*)(F.lds + MISC_OFF);
    F.wave = __builtin_amdgcn_readfirstlane((int)threadIdx.x >> 6);
    F.G = gridDim.x; { const int bx = blockIdx.x; F.vcu = (F.G % 8 == 0) ? (bx % 8) * (F.G / 8) + bx / 8 : bx; }
    F.ws = args.ws; F.ctl = (gu32*)(args.ws + WS_CTL); F.out = args.out;
    for (int u = threadIdx.x; u < (LDS_BYTES - LDSCTL_OFF) / 4; u += NWAVES * 64) ((LAS unsigned*)(F.lds + LDSCTL_OFF))[u] = 0u;
    __syncthreads();
    const bool one_launch = (args.ph_hi - args.ph_lo) > 1;
    XcdBarrier bar; bar.bar = (unsigned*)(F.ctl + CW_BAR); bar.x = 0; bar.st = nullptr;
    if (one_launch) bar = xcd_barrier_post((unsigned*)(F.ctl + CW_BAR), F.MISC + 8);
    const int lo = args.ph_lo, hi = args.ph_hi;
    unsigned char* ws = args.ws;
#ifndef REP_K
#define REP_K -2
#endif
#pragma unroll 1
    for (int ph2 = 2 * lo; ph2 < 2 * hi; ++ph2) {
        const int ph = ph2 >> 1;
        const int l = (ph - 1) / 5, k = (ph == 0) ? -1 : (ph - 1) % 5;
        if ((ph2 & 1) && k != REP_K) continue;
        if (k < 0) {
#ifndef NO_P0
            p0_prologue(F);
#endif
        } else if (k == 0) {
#ifndef NO_P1
            pg8::Gemm g{(const pg8::bf16_t*)(ws + WS_XB), (const pg8::bf16_t*)(ws + WS_WIN) + (size_t)l * NIN * DM, TOK, NIN, DM};
            pg8::StaticOrder S; S.init(TOK, NIN, F.G, (int)blockIdx.x);
            pg8::EpiIn E; E.rss = (const float*)(ws + WS_RSS); E.qna = in_ptr(3) + l * 64; E.kna = in_ptr(4) + l * 64; E.qnb = in_ptr(5) + l * 64; E.knb = in_ptr(6) + l * 64;
            E.QA = (pg8::bf16_t*)(ws + WS_QA); E.KA = (pg8::bf16_t*)(ws + WS_KA); E.VA = (pg8::bf16_t*)(ws + WS_VA); E.SGA = (pg8::bf16_t*)(ws + WS_SGA); E.QB = (pg8::bf16_t*)(ws + WS_QB); E.SGB = (pg8::bf16_t*)(ws + WS_SGB);
            E.KB = (pg8::bf16_t*)(ws + WS_KB); E.VB = (pg8::bf16_t*)(ws + WS_VB); E.KI = (pg8::bf16_t*)(ws + WS_KI); E.QI = (pg8::bf16_t*)(ws + WS_QI); E.SMA = (pg8::bf16_t*)(ws + WS_SMA); E.SMB = (pg8::bf16_t*)(ws + WS_SMB);
            E.WI = (float*)(ws + WS_WI); E.KMP = (float*)(ws + WS_KMP);
            pg8::gemm_phase<pg8::EpiIn, pg8::StaticOrder, true, true>(F.lds, g, S, E);
#endif
        } else if (k == 1) {
#ifndef NO_IDX
#ifdef NAIVE_IDX
            idx_phase_naive(F);
#else
            idx_phase(F);
#endif
#endif
        } else if (k == 2) {
#ifndef NO_ATT
#ifdef NAIVE_ATT
            naive_attn<0>(F, l); __syncthreads(); naive_attn<1>(F, l);
#else
#ifdef CLOCK_PROBE
            if (blockIdx.x == 0 && threadIdx.x == 0 && l == 0) { F.MISC[16] = (unsigned)__builtin_amdgcn_s_memtime(); F.MISC[17] = (unsigned)__builtin_amdgcn_s_memrealtime(); }
#endif
            attn_phase_fast(F, l);
#ifdef CLOCK_PROBE
            if (blockIdx.x == 0 && threadIdx.x == 0 && l == 0) { const unsigned dt = (unsigned)__builtin_amdgcn_s_memtime() - F.MISC[16], dr = (unsigned)__builtin_amdgcn_s_memrealtime() - F.MISC[17]; F.MISC[18] = (unsigned)((unsigned long long)dt * 100ull / (dr ? dr : 1u)); }
#endif
#endif
#endif
        } else if (k == 3) {
#ifndef NO_P4
            pg8::Gemm g{(const pg8::bf16_t*)(ws + WS_XB), (const pg8::bf16_t*)(ws + WS_WBR) + (size_t)l * 2048 * AW, 2 * TOK, 2048, AW};
            pg8::PairOrder S; S.init(F.G, (int)blockIdx.x);
            pg8::EpiMerge E{(const pg8::bf16_t*)(ws + WS_SMA), (pg8::bf16_t*)(ws + WS_SMB), (float*)(ws + WS_TMP)};
            pg8::gemm_phase<pg8::EpiMerge, pg8::PairOrder, true, true>(F.lds, g, S, E);
#endif
        } else {
#ifndef NO_P5
            pg8::Gemm g{(const pg8::bf16_t*)(ws + WS_SMB), (const pg8::bf16_t*)(ws + WS_WOUT) + (size_t)l * DM * DM, TOK, DM, DM};
            pg8::StaticOrder S; S.init(TOK, DM, F.G, (int)blockIdx.x);
            if (l == 0) { pg8::EpiOut<true> E{in_ptr(0), F.out, (pg8::bf16_t*)(ws + WS_XB), (float*)(ws + WS_RSS)};
                pg8::gemm_phase<pg8::EpiOut<true>, pg8::StaticOrder, true, true>(F.lds, g, S, E); }
            else { pg8::EpiOut<false> E{F.out, F.out, nullptr, nullptr};
                pg8::gemm_phase<pg8::EpiOut<false>, pg8::StaticOrder, true, true>(F.lds, g, S, E); }
#endif
        }
        if (!((ph == hi - 1) && ((ph2 & 1) || k != REP_K))) xcd_barrier(bar);
    }
#ifdef CLOCK_PROBE
    if (blockIdx.x == 0 && threadIdx.x == 0) {
        const unsigned long long t0 = __builtin_amdgcn_s_memrealtime(); const unsigned long long want = (unsigned long long)F.MISC[18] * 100ull;
        while (__builtin_amdgcn_s_memrealtime() - t0 < want) __builtin_amdgcn_s_sleep(16);
    }
#endif
}

#ifndef N_LAUNCHES
#define N_LAUNCHES 1
#endif
extern "C" void kernel_launch(void* const* d_in, const int* in_sizes, int n_in, void* d_out, int out_size, void* d_ws, size_t ws_size, hipStream_t stream) {
    static int grid = 0;
    if (grid == 0) {
        if (n_in != 11 || in_sizes[0] != TOK * DM || out_size != TOK * DM || ws_size < WS_END) { fprintf(stderr, "kernel_launch: unexpected shapes (n_in %d in0 %d out %d ws %zu)\n", n_in, n_in > 0 ? in_sizes[0] : -1, out_size, ws_size); grid = -1; return; }
        int dev = 0, cus = 0;
        if (hipGetDevice(&dev) != hipSuccess || hipDeviceGetAttribute(&cus, hipDeviceAttributeMultiprocessorCount, dev) != hipSuccess) { grid = -1; return; }
        if (hipFuncSetAttribute((const void*)hyb_fwd, hipFuncAttributeMaxDynamicSharedMemorySize, LDS_BYTES) != hipSuccess) { fprintf(stderr, "kernel_launch: hipFuncSetAttribute failed\n"); grid = -1; return; }
        int per_cu = 0;
        if (hipOccupancyMaxActiveBlocksPerMultiprocessor(&per_cu, (const void*)hyb_fwd, NWAVES * 64, LDS_BYTES) != hipSuccess || per_cu < 1) fprintf(stderr, "kernel_launch: occupancy query says %d\n", per_cu);
        (void)hipGetLastError();
        grid = cus;
    }
    if (grid < 0) return;
    if (hipMemsetAsync((char*)d_ws + WS_CTL, 0, CTL_ZERO_BYTES, stream) != hipSuccess) return;
    Args a{};
    for (int i = 0; i < 11; ++i) a.in[i] = (const float*)d_in[i];
    a.out = (float*)d_out; a.ws = (unsigned char*)d_ws;
    if (N_LAUNCHES == 1) { a.ph_lo = 0; a.ph_hi = NPHASE; a.li = 0; hipLaunchKernelGGL(hyb_fwd, dim3(grid), dim3(NWAVES * 64), LDS_BYTES, stream, a); }
    else for (int li = 0; li < NPHASE; ++li) { a.ph_lo = li; a.ph_hi = li + 1; a.li = li; hipLaunchKernelGGL(hyb_fwd, dim3(grid), dim3(NWAVES * 64), LDS_BYTES, stream, a); }
}
```

```cpp
#include <hip/hip_runtime.h>
#include <cstdio>
#include <cstdint>
#include <cmath>
namespace pg8 {
#define PG8_LAS __attribute__((address_space(3)))
typedef unsigned short bf16_t;
typedef short bf16x8 __attribute__((ext_vector_type(8)));
typedef float f32x4 __attribute__((ext_vector_type(4)));
typedef unsigned u32x4 __attribute__((ext_vector_type(4)));
constexpr int BM = 256, BK = 64, HALF = 128, HTB = HALF * BK * 2  , STAGE_BYTES = 8 * HTB, NXCD = 8, WGM = 8;

__host__ __device__ __forceinline__ int lds_byte(int r, int c) { const int st = (r >> 4) * 2 + (c >> 5), rr = r & 15, cc = c & 31, ob = rr * 64 + cc * 2; return st * 1024 + (ob ^ (((ob >> 9) & 1) << 5)); }
__host__ __device__ __forceinline__ void stage_rc(int b, int& R, int& C) { const int st = b / 1024, sb = b % 1024, swz = sb ^ (((sb >> 9) & 1) << 5); R = (st >> 1) * 16 + swz / 64; C = (st & 1) * 32 + (swz % 64) / 2; }
__host__ __device__ __forceinline__ int perm32(int rho) { const int n = rho >> 4, i = rho & 15; return 8 * (i >> 2) + 4 * n + (i & 3); }

struct Unit { int pm, pn; };
struct Gemm { const bf16_t* A; const bf16_t* Bt; int M, N, K; };

struct StaticOrder {
    int nM, nN, nwg, G, c;
    __host__ __device__ void init(int M, int N, int G_, int c_) { nM = M / BM; nN = N / BM; nwg = nM * nN; G = G_; c = c_; }
    __host__ __device__ bool next(int i, Unit& u) const {
        const long L = (long)i * G + c; if (L >= nwg) return false;
        int wgid = (int)L; { const int q = nwg / NXCD, r = nwg % NXCD, xcd = wgid % NXCD, off = wgid / NXCD; wgid = (xcd < r ? xcd * (q + 1) : r * (q + 1) + (xcd - r) * q) + off; }
        const int nig = WGM * nN, gid = wgid / nig, fm = gid * WGM, gsz = (nM - fm) < WGM ? (nM - fm) : WGM;
        u.pm = fm + ((wgid % nig) % gsz); u.pn = (wgid % nig) / gsz; return true;
    }
    __device__ __forceinline__ void a_ready(const Unit&) const {}
    __device__ __forceinline__ void done(const Unit&) const {}
};

__device__ __forceinline__ unsigned cvt_pk_bf16(float lo, float hi) { unsigned r; asm volatile("v_cvt_pk_bf16_f32 %0, %1, %2" : "=v"(r) : "v"(lo), "v"(hi)); return r; }
template <class Epi, class Sched, bool ALIGN_EPI = false, bool SP2 = false>
__device__ __forceinline__ void gemm_phase(PG8_LAS unsigned char* lds, const Gemm g, const Sched& S, const Epi& E) {
    int tid_ = threadIdx.x; asm volatile("" : "+v"(tid_));
    const int tid = tid_, wid = __builtin_amdgcn_readfirstlane(tid >> 6), lane = tid & 63, wr = wid >> 2, wc = wid & 3, fr = lane & 15, fq = lane >> 4;
    const int K = g.K, nt = K / BK;
    unsigned voffA[2], voffB[2];
#pragma unroll
    for (int i = 0; i < 2; ++i) { int R, C; stage_rc(tid * 16 + i * 8192, R, C); const int Rb = Epi::PERM ? ((R & ~31) + perm32(R & 31)) : R;
        voffA[i] = (unsigned)(R * K + C) * 2u; voffB[i] = (unsigned)(Rb * K + C) * 2u; }
    const size_t kstep = (size_t)(BK * 2);
    const size_t hstep = (size_t)HALF * K * 2;
    const size_t tstep = 2 * hstep;
    const unsigned ldsw = (unsigned)wid * 1024u;
    const int aoff = lds_byte(wr * 64 + fr, fq * 8), boff = lds_byte(wc * 32 + fr, fq * 8);
#define PG8_SA(b, h) (((b) * 2 + (h)) * HTB)
#define PG8_SB(b, h) ((4 + (b) * 2 + (h)) * HTB)
#define PG8_STAGE(bufoff, gbase, voff) do { _Pragma("unroll") for (int _i = 0; _i < 2; ++_i) \
        __builtin_amdgcn_global_load_lds((const unsigned*)((const char*)(gbase) + (voff)[_i]), (PG8_LAS unsigned*)(lds + (bufoff) + ldsw + _i * 8192), 16, 0, 0); } while (0)
#define PG8_LDA(dst, b, h) do { _Pragma("unroll") for (int m = 0; m < 4; ++m) _Pragma("unroll") for (int k = 0; k < 2; ++k) dst[m][k] = *(const PG8_LAS bf16x8*)(lds + PG8_SA(b, h) + aoff + m * 2048 + k * 1024); } while (0)
#define PG8_LDB(dst, b, h) do { _Pragma("unroll") for (int n = 0; n < 2; ++n) _Pragma("unroll") for (int k = 0; k < 2; ++k) dst[n][k] = *(const PG8_LAS bf16x8*)(lds + PG8_SB(b, h) + boff + n * 2048 + k * 1024); } while (0)
#define PG8_MMA(ai, bj, At, Bt) do { __builtin_amdgcn_s_setprio(1); _Pragma("unroll") for (int m = 0; m < 4; ++m) _Pragma("unroll") for (int n = 0; n < 2; ++n) _Pragma("unroll") for (int k = 0; k < 2; ++k) \
        acc[ai][bj][m][n] = __builtin_amdgcn_mfma_f32_16x16x32_bf16(Bt[n][k], At[m][k], acc[ai][bj][m][n], 0, 0, 0); __builtin_amdgcn_s_setprio(0); } while (0)
#define PG8_WAIT_V(n) asm volatile("s_waitcnt vmcnt(" #n ")" ::: "memory")
#define PG8_WAIT_L(n) asm volatile("s_waitcnt lgkmcnt(" #n ")" ::: "memory")
#define PG8_BAR __builtin_amdgcn_s_barrier()
#define PG8_SCHED __builtin_amdgcn_sched_barrier(0)
    Unit cur, nxt; int ui = 0;
    if (!S.next(0, cur)) return;
    f32x4 acc[2][2][4][2];
#pragma unroll
    for (int a = 0; a < 2; ++a)
#pragma unroll
        for (int b = 0; b < 2; ++b)
#pragma unroll
            for (int m = 0; m < 4; ++m)
#pragma unroll
                for (int n = 0; n < 2; ++n) acc[a][b][m][n] = (f32x4){0.f, 0.f, 0.f, 0.f};
    bf16x8 At[4][2], B0[2][2], B1[2][2];
    const char* cA = (const char*)g.A + (size_t)cur.pm * tstep; const char* cB = (const char*)g.Bt + (size_t)cur.pn * tstep;
    S.a_ready(cur);
    if constexpr (SP2) {
        PG8_STAGE(PG8_SB(0, 0), cB, voffB); PG8_STAGE(PG8_SB(0, 1), cB + hstep, voffB); PG8_STAGE(PG8_SA(0, 0), cA, voffA); PG8_STAGE(PG8_SA(0, 1), cA + hstep, voffA);
        if (wr == 1) PG8_BAR;
        PG8_WAIT_V(2); PG8_BAR;
        PG8_STAGE(PG8_SB(1, 0), cB + kstep, voffB); PG8_STAGE(PG8_SA(1, 0), cA + kstep, voffA); PG8_STAGE(PG8_SB(1, 1), cB + hstep + kstep, voffB);
        PG8_WAIT_V(6); PG8_BAR;
    } else {
        PG8_STAGE(PG8_SB(0, 0), cB, voffB); PG8_STAGE(PG8_SA(0, 0), cA, voffA); PG8_STAGE(PG8_SB(0, 1), cB + hstep, voffB); PG8_STAGE(PG8_SA(0, 1), cA + hstep, voffA);
        if (wr == 1) PG8_BAR;
        PG8_WAIT_V(4); PG8_BAR;
        PG8_STAGE(PG8_SB(1, 0), cB + kstep, voffB); PG8_STAGE(PG8_SA(1, 0), cA + kstep, voffA); PG8_STAGE(PG8_SB(1, 1), cB + hstep + kstep, voffB);
        PG8_WAIT_V(6); PG8_BAR;
    }
    for (;;) {
        const bool has_next = S.next(ui + 1, nxt);
        const char* nA = has_next ? (const char*)g.A + (size_t)nxt.pm * tstep : cA; const char* nB = has_next ? (const char*)g.Bt + (size_t)nxt.pn * tstep : cB;
        for (int t = 0; t < nt; t += 2) {
            const bool last = (t == nt - 2);
            const char* a1 = cA + (size_t)(t + 1) * kstep;
            const char* a2 = last ? nA : cA + (size_t)(t + 2) * kstep; const char* b2 = last ? nB : cB + (size_t)(t + 2) * kstep;
            const char* a3 = a2 + kstep; const char* b3 = b2 + kstep;
            if (last && has_next) S.a_ready(nxt);
            if constexpr (SP2) {
            PG8_LDB(B0, 0, 0); PG8_LDB(B1, 0, 1); PG8_SCHED; PG8_LDA(At, 0, 0); PG8_STAGE(PG8_SA(1, 1), a1 + hstep, voffA);
            PG8_WAIT_V(8); PG8_WAIT_L(0); PG8_BAR; PG8_MMA(0, 0, At, B0); PG8_MMA(0, 1, At, B1); PG8_BAR; PG8_SCHED;
            PG8_LDA(At, 0, 1); PG8_STAGE(PG8_SB(0, 0), b2, voffB); PG8_STAGE(PG8_SB(0, 1), b2 + hstep, voffB); PG8_STAGE(PG8_SA(0, 0), a2, voffA);
            PG8_WAIT_V(8); PG8_WAIT_L(0); PG8_BAR; PG8_MMA(1, 0, At, B0); PG8_MMA(1, 1, At, B1); PG8_BAR; PG8_SCHED;
            PG8_LDB(B0, 1, 0); PG8_LDB(B1, 1, 1); PG8_SCHED; PG8_LDA(At, 1, 0); PG8_STAGE(PG8_SA(0, 1), a2 + hstep, voffA);
            PG8_WAIT_V(8); PG8_WAIT_L(0); PG8_BAR; PG8_MMA(0, 0, At, B0); PG8_MMA(0, 1, At, B1); PG8_BAR; PG8_SCHED;
            PG8_LDA(At, 1, 1); PG8_STAGE(PG8_SB(1, 0), b3, voffB); PG8_STAGE(PG8_SB(1, 1), b3 + hstep, voffB); PG8_STAGE(PG8_SA(1, 0), a3, voffA);
            PG8_WAIT_V(8); PG8_WAIT_L(0); PG8_BAR; PG8_MMA(1, 0, At, B0); PG8_MMA(1, 1, At, B1); PG8_BAR; PG8_SCHED;
            } else {
            PG8_LDB(B0, 0, 0); PG8_SCHED; PG8_LDA(At, 0, 0); PG8_STAGE(PG8_SA(1, 1), a1 + hstep, voffA);
            PG8_WAIT_L(8); PG8_BAR; PG8_WAIT_L(0); PG8_MMA(0, 0, At, B0); PG8_BAR; PG8_SCHED;
            PG8_LDB(B1, 0, 1); PG8_STAGE(PG8_SB(0, 0), b2, voffB);
            PG8_BAR; PG8_WAIT_L(0); PG8_MMA(0, 1, At, B1); PG8_BAR;
            PG8_LDA(At, 0, 1); PG8_STAGE(PG8_SA(0, 0), a2, voffA);
            PG8_BAR; PG8_WAIT_L(0); PG8_MMA(1, 0, At, B0); PG8_BAR; PG8_SCHED;
            PG8_STAGE(PG8_SB(0, 1), b2 + hstep, voffB);
            PG8_WAIT_V(6); PG8_BAR; PG8_MMA(1, 1, At, B1); PG8_BAR;
            PG8_LDB(B0, 1, 0); PG8_SCHED; PG8_LDA(At, 1, 0); PG8_STAGE(PG8_SA(0, 1), a2 + hstep, voffA);
            PG8_WAIT_L(8); PG8_BAR; PG8_WAIT_L(0); PG8_MMA(0, 0, At, B0); PG8_BAR; PG8_SCHED;
            PG8_LDB(B1, 1, 1); PG8_STAGE(PG8_SB(1, 0), b3, voffB);
            PG8_BAR; PG8_WAIT_L(0); PG8_MMA(0, 1, At, B1); PG8_BAR;
            PG8_LDA(At, 1, 1); PG8_STAGE(PG8_SA(1, 0), a3, voffA);
            PG8_BAR; PG8_WAIT_L(0); PG8_MMA(1, 0, At, B0); PG8_BAR; PG8_SCHED;
            PG8_STAGE(PG8_SB(1, 1), b3 + hstep, voffB);
            PG8_WAIT_V(6); PG8_BAR; PG8_MMA(1, 1, At, B1); PG8_BAR;
            }
        }
        if constexpr (ALIGN_EPI) { if (wr == 0) PG8_BAR; }
#ifndef EPI_REP
#define EPI_REP 1
#endif
        if constexpr (!Epi::AFTER_DRAIN) { E(acc, cur, wr, wc, fr, fq); if constexpr (Epi::REPEATABLE && EPI_REP == 2) { asm volatile("" ::: "memory"); E(acc, cur, wr, wc, fr, fq); } S.done(cur); }
        if (!has_next) break;
#pragma unroll
        for (int a = 0; a < 2; ++a)
#pragma unroll
            for (int b = 0; b < 2; ++b)
#pragma unroll
                for (int m = 0; m < 4; ++m)
#pragma unroll
                    for (int n = 0; n < 2; ++n) acc[a][b][m][n] = (f32x4){0.f, 0.f, 0.f, 0.f};
        cur = nxt; cA = nA; cB = nB; ++ui;
        if constexpr (ALIGN_EPI) { if (wr == 1) PG8_BAR; }
    }
    PG8_WAIT_V(0);
    if constexpr (!ALIGN_EPI) { if (wr == 0) PG8_BAR; }
    PG8_BAR;
    if constexpr (Epi::AFTER_DRAIN) { E.fused(acc, cur, wr, wc, fr, fq, lds, wid, lane); S.done(cur); }
#undef PG8_SA
#undef PG8_SB
#undef PG8_STAGE
#undef PG8_LDA
#undef PG8_LDB
#undef PG8_MMA
#undef PG8_WAIT_V
#undef PG8_WAIT_L
#undef PG8_BAR
#undef PG8_SCHED
}
}
#define GAS __attribute__((address_space(1)))
#define LAS __attribute__((address_space(3)))
typedef unsigned short bf16;
typedef unsigned v4u __attribute__((ext_vector_type(4)));
typedef float f32x4 __attribute__((ext_vector_type(4)));
typedef short bf16x8 __attribute__((ext_vector_type(8)));
typedef GAS unsigned gu32;
typedef GAS unsigned long long gu64;
#define RLX_AGENT __ATOMIC_RELAXED, __HIP_MEMORY_SCOPE_AGENT
#define LDS_WAIT() asm volatile("s_waitcnt lgkmcnt(0)" ::: "memory")
#define VM_WAIT() asm volatile("s_waitcnt vmcnt(0)" ::: "memory")
__device__ __forceinline__ unsigned long long rt() { return __builtin_amdgcn_s_memrealtime(); }
__device__ __forceinline__ unsigned f2bf(float f) { unsigned u = __builtin_bit_cast(unsigned, f); return (u + 0x7fffu + ((u >> 16) & 1u)) >> 16; }
__device__ __forceinline__ unsigned pk2(float lo, float hi) { return f2bf(lo) | (f2bf(hi) << 16); }
#define XB_TMO      128
#define XB_XCNT(j)  (256  + 64 * (j))
#define XB_XSUB(j)  (1280 + 64 * (j))
#define XB_XGEN(j)  (2304 + 64 * (j))
#define XB_TOP      3328
#define XB_TOPGEN   3392
#define XCD_BAR_WORDS 3456
#define XB_SPIN_CAP (1u << 18)

__device__ __forceinline__ unsigned xb_ld(unsigned* p)              { return __hip_atomic_load(p, __ATOMIC_RELAXED, __HIP_MEMORY_SCOPE_AGENT); }
__device__ __forceinline__ unsigned xb_add(unsigned* p, unsigned v) { return __hip_atomic_fetch_add(p, v, __ATOMIC_RELAXED, __HIP_MEMORY_SCOPE_AGENT); }
__device__ __forceinline__ unsigned xb_xcc_id() { return (unsigned)__builtin_amdgcn_s_getreg((3 << 11) | 20) & 0xFu; }
#define XB_SPIN(cond, bar) do { unsigned _sp = 0; while (cond) { __builtin_amdgcn_s_sleep(1); \
    if ((++_sp & 255u) == 0u) { if (xb_ld(&(bar)[XB_TMO])) break; if (_sp > XB_SPIN_CAP) { atomicAdd(&(bar)[XB_TMO], 1u); break; } } } } while (0)

struct XcdBarrier {
    unsigned* bar; unsigned x;
    volatile LAS unsigned* st;
};

__device__ __forceinline__ XcdBarrier xcd_barrier_post(unsigned* bar, volatile LAS unsigned* st) {
    XcdBarrier b; b.bar = bar; b.x = xb_xcc_id(); b.st = st;
    if (threadIdx.x == 0) (void)xb_add(&bar[XB_XCNT(b.x)], 1u);
    return b;
}
__device__ __forceinline__ void xcd_barrier_complete(unsigned* bar, unsigned x, unsigned& nloc, unsigned& nx) {
    const unsigned G = gridDim.x * gridDim.y * gridDim.z;
    unsigned sum, cnt, mine, sp = 0u;
    for (;;) {
        sum = 0u; cnt = 0u; mine = 0u;
#pragma unroll
        for (unsigned j = 0; j < 16; ++j) { const unsigned c = xb_ld(&bar[XB_XCNT(j)]); sum += c; cnt += (c > 0u) ? 1u : 0u; mine = (j == x) ? c : mine; }
        if (sum == G) break;
        __builtin_amdgcn_s_sleep(1);
        if ((++sp & 255u) == 0u) { if (xb_ld(&bar[XB_TMO])) break; if (sp > XB_SPIN_CAP) { atomicAdd(&bar[XB_TMO], 1u); break; } }
    }
    nloc = mine > 0u ? mine : 1u; nx = cnt > 0u ? cnt : 1u;
}

__device__ __forceinline__ void xcd_barrier(const XcdBarrier& b) {
    asm volatile("s_waitcnt vmcnt(0)" ::: "memory");
    __syncthreads();
    if (threadIdx.x == 0) {
        unsigned* bar = b.bar; asm volatile("" : "+s"(bar));
        __builtin_amdgcn_s_waitcnt(0);
        unsigned nloc = b.st[0], nx = b.st[1];
        if (nloc == 0u) { xcd_barrier_complete(bar, b.x, nloc, nx); b.st[0] = nloc; b.st[1] = nx; }
        const unsigned old = xb_add(&bar[XB_XSUB(b.x)], 1u);
        const unsigned gen = old / nloc;
        if (old + 1u == (gen + 1u) * nloc) {
            __builtin_amdgcn_fence(__ATOMIC_RELEASE, "agent");
            asm volatile("s_waitcnt vmcnt(0)" ::: "memory");
            const unsigned og = xb_add(&bar[XB_TOP], 1u);
            const unsigned tg = og / nx;
            if (og + 1u == (tg + 1u) * nx) xb_add(&bar[XB_TOPGEN], 1u);
            else XB_SPIN(xb_ld(&bar[XB_TOPGEN]) == tg, bar);
            __builtin_amdgcn_fence(__ATOMIC_ACQUIRE, "agent");
            xb_add(&bar[XB_XGEN(b.x)], 1u);
            asm volatile("s_waitcnt vmcnt(0)" ::: "memory");
        } else {
            XB_SPIN(xb_ld(&bar[XB_XGEN(b.x)]) == gen, bar);
            __builtin_amdgcn_fence(__ATOMIC_ACQUIRE, "agent");
            asm volatile("s_waitcnt vmcnt(0)" ::: "memory");
        }
    }
    __syncthreads();
}

constexpr int BATCH = 8, SEQ = 4096, DM = 1024, TOK = BATCH * SEQ, DEPTH = 2;
constexpr int DIN = 5572, NIN = 5632;
constexpr int NH = 8, HD = 64, AW = 512;
constexpr float EPS = 1e-6f;
constexpr float LOG2E = 1.4426950408889634f;
constexpr float C2 = 0.125f * LOG2E;
constexpr int NWAVES = 8;
constexpr int NPHASE = 1 + 5 * DEPTH;

constexpr size_t MiB = 1u << 20;
constexpr size_t WS_CTL = 0, CTL_ZERO_BYTES = 1 * MiB;
constexpr size_t WS_WIN = 1 * MiB;
constexpr size_t WS_WBR = 23 * MiB;
constexpr size_t WS_WOUT = 27 * MiB;
constexpr size_t WS_RSS = 31 * MiB;
constexpr size_t WS_KMP = 33 * MiB;
constexpr size_t WS_WI = 34 * MiB;
constexpr size_t WS_KB = 35 * MiB, WS_VB = 39 * MiB, WS_KI = 43 * MiB;
constexpr size_t WS_QI = 47 * MiB;
constexpr size_t WS_BM = 63 * MiB;
constexpr size_t WS_XB = 80 * MiB;
constexpr size_t WS_QA = 144 * MiB, WS_KA = 176 * MiB, WS_VA = 208 * MiB, WS_SGA = 240 * MiB, WS_QB = 272 * MiB, WS_SGB = 304 * MiB;
constexpr size_t WS_TMP = 144 * MiB;
constexpr size_t WS_SMA = 336 * MiB, WS_SMB = 400 * MiB;
constexpr size_t WS_END = 464 * MiB;
constexpr int CW_BAR = 4096;

constexpr int RING_BYTES = 131072;
constexpr int LDSCTL_OFF = RING_BYTES + 28672, MISC_OFF = LDSCTL_OFF + 320;
constexpr int LDS_BYTES = 163840;
static_assert(MISC_OFF + 128 <= LDS_BYTES, "LDS map");

typedef unsigned long long u64;
typedef unsigned u32x4v __attribute__((ext_vector_type(4)));

__device__ __forceinline__ float bf2f(unsigned short v) { return __uint_as_float(((unsigned)v) << 16); }
__device__ __forceinline__ float bflo(unsigned w) { return __uint_as_float(w << 16); }
__device__ __forceinline__ float bfhi(unsigned w) { return __uint_as_float(w & 0xffff0000u); }
__device__ __forceinline__ float sigmoidf_(float v) { return __builtin_amdgcn_rcpf(1.0f + __builtin_amdgcn_exp2f(-v * LOG2E)); }

typedef __attribute__((address_space(4))) const char* kaptr_t;
__device__ __forceinline__ const float* in_ptr(int i) { kaptr_t ka = (kaptr_t)__builtin_amdgcn_kernarg_segment_ptr(); asm volatile("" : "+s"(ka)); return *(const float* const __attribute__((address_space(4)))*)(ka + 8 * i); }
#define PHASE_TID() int tid_o = threadIdx.x; asm volatile("" : "+v"(tid_o)); const int ptid = tid_o, plane = tid_o & 63
struct Frame {
    LAS unsigned char* lds;
    volatile LAS unsigned* MISC;
    gu32* ctl;
    int wave, vcu, G;
    unsigned char* ws;
    float* out;
};

__host__ __device__ __forceinline__ int win_src(int n0, int& nvalid) {
    const int pn = n0 >> 8, c = n0 & 255, bj = c >> 7, wc = (c >> 5) & 3; nvalid = 32;
    if (pn < 2) return 0 + 64 * (4 * pn + wc) + 32 * bj;
    if (pn < 4) return 512 + 64 * (4 * (pn - 2) + wc) + 32 * bj;
    if (pn < 6) return 1024 + 256 * (pn - 4) + c;
    if (pn < 8) return 1536 + 256 * (pn - 6) + c;
    if (pn < 10) return 2048 + 64 * (4 * (pn - 8) + wc) + 32 * bj;
    if (pn == 10) {
        if (wc == 0) return 2560 + 32 * bj;
        if (wc == 1) return 2624 + 32 * bj;
        if (wc == 2) return 3456 + 32 * bj;
        if (bj == 0) { nvalid = 4; return 3520; }
        nvalid = 0; return 0;
    }
    if (pn == 11) return 3200 + c;
    if (pn < 14) return 2688 + 256 * (pn - 12) + c;
    if (pn < 18) return 3524 + 256 * (pn - 14) + c;
    return 4548 + 256 * (pn - 18) + c;
}

__device__ __forceinline__ float wave_sum(float v) {
#pragma unroll
    for (int o = 1; o < 64; o <<= 1) v += __shfl_xor(v, o);
    return v;
}
__device__ __forceinline__ void tr_item(const float* W, int ldw, int src0, int nvalid, const float* gk, bf16* WT, int K, int row0, int k0, LAS float* scr, int lane) {
    const int j = lane & 31;
#pragma unroll 8
    for (int i = 0; i < 32; ++i) { const int kk = 2 * i + (lane >> 5);
        float v = 0.f; if (j < nvalid) { v = W[(size_t)(k0 + kk) * ldw + src0 + j]; if (gk) v *= gk[k0 + kk]; }
        scr[kk * 33 + j] = v; }
    LDS_WAIT(); asm volatile("" ::: "memory");
    const int c = lane & 7;
#pragma unroll
    for (int jj = 0; jj < 4; ++jj) { const int n = (lane >> 3) + 8 * jj; const LAS float* s = scr + (8 * c) * 33 + n;
        v4u o; o.x = pk2(s[0 * 33], s[1 * 33]); o.y = pk2(s[2 * 33], s[3 * 33]); o.z = pk2(s[4 * 33], s[5 * 33]); o.w = pk2(s[6 * 33], s[7 * 33]);
        *(GAS v4u*)(WT + (size_t)(row0 + n) * K + k0 + 8 * c) = o; }
    LDS_WAIT(); asm volatile("" ::: "memory");
}
__device__ __forceinline__ void p0_prologue(Frame& F) {
    PHASE_TID();
    LAS float* scr = (LAS float*)(F.lds + F.wave * 16384);
    const int gw = F.vcu * NWAVES + F.wave, NGW = F.G * NWAVES;
    constexpr int I_IN = (DM / 64) * (NIN / 32), I_BR = (AW / 64) * (DM / 32), I_OUT = (DM / 64) * (DM / 32);
    constexpr int PER_L = I_IN + 2 * I_BR + I_OUT;
    for (int it = gw; it < DEPTH * PER_L; it += NGW) {
        const int l = it / PER_L; int r = it % PER_L;
        if (r < I_IN) { const int kb = r / (NIN / 32), nb = r % (NIN / 32); int nvalid; const int src0 = win_src(32 * nb, nvalid);
            tr_item(in_ptr(2) + (size_t)l * DM * DIN, DIN, src0, nvalid, in_ptr(1) + l * DM, (bf16*)(F.ws + WS_WIN) + (size_t)l * NIN * DM, DM, 32 * nb, 64 * kb, scr, plane); continue; }
        r -= I_IN;
        if (r < 2 * I_BR) { const int which = r / I_BR; r %= I_BR; const int kb = r / (DM / 32), nb = r % (DM / 32);
            tr_item((which ? in_ptr(8) : in_ptr(7)) + (size_t)l * AW * DM, DM, 32 * nb, 32, nullptr, (bf16*)(F.ws + WS_WBR) + (size_t)l * 2048 * AW, AW, which * 1024 + 32 * nb, 64 * kb, scr, plane); continue; }
        r -= 2 * I_BR;
        { const int kb = r / (DM / 32), nb = r % (DM / 32);
            tr_item(in_ptr(9) + (size_t)l * DM * DM, DM, 32 * nb, 32, nullptr, (bf16*)(F.ws + WS_WOUT) + (size_t)l * DM * DM, DM, 32 * nb, 64 * kb, scr, plane); }
    }
    const float* x = in_ptr(0); bf16* XB = (bf16*)(F.ws + WS_XB); float* RSS = (float*)(F.ws + WS_RSS);
    for (int m = gw; m < TOK; m += NGW) {
        const GAS f32x4* xr = (const GAS f32x4*)(x + (size_t)m * DM) + plane;
        f32x4 v[4]; float s = 0.f;
#pragma unroll
        for (int j = 0; j < 4; ++j) { v[j] = xr[64 * j]; s += (v[j].x * v[j].x + v[j].y * v[j].y) + (v[j].z * v[j].z + v[j].w * v[j].w); }
        s = wave_sum(s);
        GAS u64* o8 = (GAS u64*)(XB + (size_t)m * DM) + plane;
#pragma unroll
        for (int j = 0; j < 4; ++j) o8[64 * j] = (u64)pk2(v[j].x, v[j].y) | ((u64)pk2(v[j].z, v[j].w) << 32);
        if (plane < 16) RSS[(size_t)m * 16 + plane] = (plane == 0) ? s : 0.f;
    }
}

namespace pg8 {
__device__ __forceinline__ float row_rs(const float* rss, int row, int fq) {
    const f32x4 a = *(const f32x4*)(rss + (size_t)row * 16 + 4 * fq);
    float s = (a[0] + a[1]) + (a[2] + a[3]);
    s += __shfl_xor(s, 16); s += __shfl_xor(s, 32);
    return __builtin_amdgcn_rsqf(s * (1.0f / DM) + EPS);
}
__device__ __forceinline__ u32x4 pack8(const f32x4 o0, const f32x4 o1) { u32x4 w; w.x = cvt_pk_bf16(o0[0], o0[1]); w.y = cvt_pk_bf16(o0[2], o0[3]); w.z = cvt_pk_bf16(o1[0], o1[1]); w.w = cvt_pk_bf16(o1[2], o1[3]); return w; }
struct EpiIn {
    static constexpr bool PERM = true, AFTER_DRAIN = false, REPEATABLE = true;
    const float* rss; const float *qna, *kna, *qnb, *knb;
    bf16_t *QA, *KA, *VA, *SGA, *QB, *SGB, *KB, *VB, *KI, *QI, *SMA, *SMB; float* WI; float* KMP;
    __device__ __forceinline__ void norm_rows(const f32x4 (&acc)[2][2][4][2], const Unit& u, int wr, int fr, int fq, const float* g, float oscale, bf16_t* dst, int ld, int coloff, float* kmp) const {
        f32x4 gv[2][2];
#pragma unroll
        for (int bj = 0; bj < 2; ++bj)
#pragma unroll
            for (int n = 0; n < 2; ++n) gv[bj][n] = *(const f32x4*)(g + 32 * bj + 8 * fq + 4 * n) * oscale;
        f32x4 cs[2][2];
#pragma unroll
        for (int bj = 0; bj < 2; ++bj)
#pragma unroll
            for (int n = 0; n < 2; ++n) cs[bj][n] = (f32x4){0.f, 0.f, 0.f, 0.f};
#pragma unroll
        for (int ai = 0; ai < 2; ++ai)
#pragma unroll
            for (int m = 0; m < 4; ++m) {
                const int row = u.pm * BM + ai * HALF + wr * 64 + m * 16 + fr; const float rs = row_rs(rss, row, fq);
                float sq = 0.f;
#pragma unroll
                for (int bj = 0; bj < 2; ++bj)
#pragma unroll
                    for (int n = 0; n < 2; ++n) { const f32x4 t = acc[ai][bj][m][n]; sq += (t[0] * t[0] + t[1] * t[1]) + (t[2] * t[2] + t[3] * t[3]); }
                sq += __shfl_xor(sq, 16); sq += __shfl_xor(sq, 32);
                const float sc = rs * __builtin_amdgcn_rsqf(sq * rs * rs * (1.0f / 64.0f) + EPS);
#pragma unroll
                for (int bj = 0; bj < 2; ++bj) {
                    const f32x4 o0 = acc[ai][bj][m][0] * sc * gv[bj][0], o1 = acc[ai][bj][m][1] * sc * gv[bj][1];
                    cs[bj][0] += o0; cs[bj][1] += o1;
                    *(u32x4*)(dst + (size_t)row * ld + coloff + 32 * bj + 8 * fq) = pack8(o0, o1); }
                asm volatile("" ::: "memory");
            }
        if (kmp) {
#pragma unroll
            for (int bj = 0; bj < 2; ++bj)
#pragma unroll
                for (int n = 0; n < 2; ++n) { f32x4 t = cs[bj][n];
#pragma unroll
                    for (int o = 1; o < 16; o <<= 1) { t[0] += __shfl_xor(t[0], o); t[1] += __shfl_xor(t[1], o); t[2] += __shfl_xor(t[2], o); t[3] += __shfl_xor(t[3], o); }
                    if (fr == 0) *(f32x4*)(kmp + 32 * bj + 8 * fq + 4 * n) = t; }
        }
    }
    __device__ __forceinline__ void plain_rows(const f32x4 (&acc)[2][2][4][2], const Unit& u, int wr, int fr, int fq, bf16_t* dst, int ld, int col0, int bjs, float ca, float cb, float cc, float* wi) const {
#pragma unroll
        for (int ai = 0; ai < 2; ++ai)
#pragma unroll
            for (int m = 0; m < 4; ++m) {
                const int row = u.pm * BM + ai * HALF + wr * 64 + m * 16 + fr; const float rs = row_rs(rss, row, fq);
                if (wi) { if (fq == 0) *(f32x4*)(wi + (size_t)row * 4) = acc[ai][0][m][0] * rs; }
                else {
#pragma unroll
                for (int bj = 0; bj < 2; ++bj) { f32x4 o0 = acc[ai][bj][m][0] * rs, o1 = acc[ai][bj][m][1] * rs;
#pragma unroll
                    for (int i = 0; i < 4; ++i) { const float s0 = sigmoidf_(o0[i]), s1 = sigmoidf_(o1[i]); o0[i] = ca * o0[i] + s0 * (cb + cc * o0[i]); o1[i] = ca * o1[i] + s1 * (cb + cc * o1[i]); }
                    *(u32x4*)(dst + (size_t)row * ld + col0 + bj * bjs) = pack8(o0, o1); }
                }
                asm volatile("" ::: "memory");
            }
    }
    __device__ __forceinline__ void operator()(const f32x4 (&acc)[2][2][4][2], const Unit& u, int wr, int wc, int fr_, int fq_) const {
        int fr = fr_, fq = fq_; asm volatile("" : "+v"(fr), "+v"(fq));
        const int pn = u.pn; const int cid = wc * 32 + 8 * fq;
        bool isnorm = false; bf16_t* dst; int ld = AW, col0, bjs = HALF; const float* g = qna; float osc = 1.0f; float* kmp = nullptr; float ca = 1.f, cb = 0.f, cc = 0.f; float* wi = nullptr;
        if (pn < 2) { isnorm = true; g = qna; osc = C2; dst = QA; col0 = 64 * (4 * pn + wc); }
        else if (pn < 4) { isnorm = true; g = kna; dst = KA; const int h = 4 * (pn - 2) + wc; col0 = 64 * h; kmp = KMP + ((((size_t)(u.pm >> 4) * 16 + (u.pm & 15)) * 8 + h) * 2 + wr) * 64; }
        else if (pn < 6) { dst = VA; col0 = 256 * (pn - 4) + cid; }
        else if (pn < 8) { dst = SGA; col0 = 256 * (pn - 6) + cid; ca = 0.f; cc = 1.f; }
        else if (pn < 10) { isnorm = true; g = qnb; osc = C2; dst = QB; col0 = 64 * (4 * (pn - 8) + wc); }
        else if (pn == 10) { ld = 64; bjs = 32; col0 = 8 * fq; dst = KI;
            if (wc == 0) { isnorm = true; g = knb; dst = KB; col0 = 0; } else if (wc == 1) { dst = VB; } else if (wc == 3) { wi = WI; } }
        else if (pn == 11) { dst = QI; ld = 256; col0 = cid; }
        else if (pn < 14) { dst = SGB; col0 = 256 * (pn - 12) + cid; ca = 0.f; cc = 1.f; }
        else if (pn < 18) { dst = SMA; ld = DM; col0 = 256 * (pn - 14) + cid; ca = 0.f; cb = 1.f; }
        else { dst = SMB; ld = DM; col0 = 256 * (pn - 18) + cid; ca = 0.f; cb = 1.f; }
        if (isnorm) norm_rows(acc, u, wr, fr, fq, g, osc, dst, ld, col0, kmp);
        else plain_rows(acc, u, wr, fr, fq, dst, ld, col0, bjs, ca, cb, cc, wi);
    }
};
struct EpiMerge {
    static constexpr bool PERM = true, AFTER_DRAIN = false, REPEATABLE = false;
    const bf16_t* SMA; bf16_t* SMB; float* TMP;
    __device__ __forceinline__ void operator()(const f32x4 (&acc)[2][2][4][2], const Unit& u, int wr, int wc, int fr, int fq) const {
        const bool partb = u.pm >= 128; const int pm = partb ? u.pm - 128 : u.pm, pn = partb ? u.pn - 4 : u.pn;
#pragma unroll
        for (int ai = 0; ai < 2; ++ai)
#pragma unroll
            for (int m = 0; m < 4; ++m) { const int row = pm * BM + ai * HALF + wr * 64 + m * 16 + fr;
#pragma unroll
                for (int bj = 0; bj < 2; ++bj) { const size_t off = (size_t)row * DM + pn * BM + bj * HALF + wc * 32 + 8 * fq;
                    const u32x4 sg = *(const u32x4*)((partb ? SMB : SMA) + off);
                    const f32x4 s0 = (f32x4){__uint_as_float(sg.x << 16), __uint_as_float(sg.x & 0xffff0000u), __uint_as_float(sg.y << 16), __uint_as_float(sg.y & 0xffff0000u)};
                    const f32x4 s1 = (f32x4){__uint_as_float(sg.z << 16), __uint_as_float(sg.z & 0xffff0000u), __uint_as_float(sg.w << 16), __uint_as_float(sg.w & 0xffff0000u)};
                    f32x4 o0 = acc[ai][bj][m][0] * s0, o1 = acc[ai][bj][m][1] * s1;
                    if (!partb) { *(f32x4*)(TMP + off) = o0; *(f32x4*)(TMP + off + 4) = o1; }
                    else { o0 += *(const f32x4*)(TMP + off); o1 += *(const f32x4*)(TMP + off + 4);
                        u32x4 w; w.x = cvt_pk_bf16(o0[0], o0[1]); w.y = cvt_pk_bf16(o0[2], o0[3]); w.z = cvt_pk_bf16(o1[0], o1[1]); w.w = cvt_pk_bf16(o1[2], o1[3]);
                        *(u32x4*)(SMB + off) = w; } }
            }
    }
};
struct PairOrder {
    StaticOrder base;
    __device__ void init(int G_, int c_) { base.init(TOK, DM, G_, c_); }
    __device__ bool next(int i, Unit& u) const { Unit t; if (!base.next(i >> 1, t)) return false; u.pm = t.pm + (i & 1) * 128; u.pn = t.pn + (i & 1) * 4; return true; }
    __device__ __forceinline__ void a_ready(const Unit&) const {}
    __device__ __forceinline__ void done(const Unit&) const {}
};
template <bool WRITE_NEXT> struct EpiOut {
    static constexpr bool PERM = true, AFTER_DRAIN = false, REPEATABLE = false;
    const float* xin; float* out; bf16_t* XB; float* rss;
    __device__ __forceinline__ void operator()(const f32x4 (&acc)[2][2][4][2], const Unit& u, int wr, int wc, int fr, int fq) const {
#pragma unroll
        for (int ai = 0; ai < 2; ++ai)
#pragma unroll
            for (int m = 0; m < 4; ++m) { const int row = u.pm * BM + ai * HALF + wr * 64 + m * 16 + fr; float ss = 0.f;
#pragma unroll
                for (int bj = 0; bj < 2; ++bj) { const size_t off = (size_t)row * DM + u.pn * BM + bj * HALF + wc * 32 + 8 * fq;
                    const f32x4 o0 = acc[ai][bj][m][0] + *(const f32x4*)(xin + off), o1 = acc[ai][bj][m][1] + *(const f32x4*)(xin + off + 4);
                    *(f32x4*)(out + off) = o0; *(f32x4*)(out + off + 4) = o1;
                    if (WRITE_NEXT) { ss += (o0[0] * o0[0] + o0[1] * o0[1]) + (o0[2] * o0[2] + o0[3] * o0[3]) + (o1[0] * o1[0] + o1[1] * o1[1]) + (o1[2] * o1[2] + o1[3] * o1[3]);
                        u32x4 w; w.x = cvt_pk_bf16(o0[0], o0[1]); w.y = cvt_pk_bf16(o0[2], o0[3]); w.z = cvt_pk_bf16(o1[0], o1[1]); w.w = cvt_pk_bf16(o1[2], o1[3]);
                        *(u32x4*)(XB + off) = w; } }
                if (WRITE_NEXT) { ss += __shfl_xor(ss, 16); ss += __shfl_xor(ss, 32); if (fq == 0) rss[(size_t)row * 16 + 4 * u.pn + wc] = ss; }
            }
    }
};
}

__device__ __forceinline__ int rel_bucket_dev(int n) {
    if (n < 16) return n;
    int large = 16 + (int)(logf((float)n / 16.0f) / logf(8.0f) * 16.0f);
    return large < 31 ? large : 31;
}
__device__ __forceinline__ void build_bias_table(Frame& F, LAS float* tb, const float* gq, const float* gk, int hoff) {
    PHASE_TID(); const float* rb = in_ptr(10);
    float gm = 0.f;
    for (int d = 0; d < 64; ++d) gm = fmaxf(gm, fabsf(gq[d] * gk[d]));
    for (int e = ptid; e < 8 * 128; e += NWAVES * 64) { const int h = e >> 7, d = e & 127;
        float bm = -1e30f; for (int k = 0; k < 32; ++k) bm = fmaxf(bm, rb[k * 16 + hoff + h]);
        const float M0 = 64.0f * C2 * gm + bm * LOG2E;
        tb[e] = rb[rel_bucket_dev(d) * 16 + hoff + h] * LOG2E - M0; }
}

template <int MODE>
__device__ __forceinline__ void naive_attn(Frame& F, int layer) {
    PHASE_TID();
    LAS float* tb = (LAS float*)F.lds;
    const float* gq = in_ptr(MODE == 0 ? 3 : 5) + layer * 64; const float* gk = in_ptr(MODE == 0 ? 4 : 6) + layer * 64;
    build_bias_table(F, tb, gq, gk, MODE * 8);
    __syncthreads();
    const bf16* Q = (const bf16*)(F.ws + (MODE == 0 ? WS_QA : WS_QB));
    const bf16* K = (const bf16*)(F.ws + (MODE == 0 ? WS_KA : WS_KB));
    const bf16* V = (const bf16*)(F.ws + (MODE == 0 ? WS_VA : WS_VB));
    const bf16* SG = (const bf16*)(F.ws + (MODE == 0 ? WS_SGA : WS_SGB));
    bf16* Y = (bf16*)(F.ws + WS_XB) + (size_t)MODE * TOK * AW;
    const float* KMP = (const float*)(F.ws + WS_KMP);
    const u64* BM = (const u64*)(F.ws + WS_BM);
    constexpr int KLD = (MODE == 0) ? AW : 64;
    for (int item = blockIdx.x * (NWAVES * 64) + ptid; item < BATCH * NH * SEQ; item += F.G * NWAVES * 64) {
        const int q = item & (SEQ - 1), h = (item >> 12) & 7, b = item >> 15; const int qblk = q >> 8;
        const size_t tq = (size_t)b * SEQ + q;
        float qv[64];
        { const v4u* qp = (const v4u*)(Q + tq * AW + h * 64);
#pragma unroll
            for (int c = 0; c < 8; ++c) { const v4u w = qp[c]; qv[8 * c + 0] = bflo(w.x); qv[8 * c + 1] = bfhi(w.x); qv[8 * c + 2] = bflo(w.y); qv[8 * c + 3] = bfhi(w.y); qv[8 * c + 4] = bflo(w.z); qv[8 * c + 5] = bfhi(w.z); qv[8 * c + 6] = bflo(w.w); qv[8 * c + 7] = bfhi(w.w); } }
        unsigned selmask = 0;
        if (MODE == 0) {
            float gate[16];
#pragma unroll
            for (int n = 0; n < 16; ++n) { gate[n] = -INFINITY;
                if (n < qblk) { const float* k0 = KMP + ((((size_t)b * 16 + n) * 8 + h) * 2) * 64; float s = 0.f;
#pragma unroll
                    for (int d = 0; d < 64; ++d) s += qv[d] * ((k0[d] + k0[64 + d]) * (1.0f / 256.0f));
                    gate[n] = s; } }
            const int nsel = qblk < 3 ? qblk : 3;
            for (int r = 0; r < nsel; ++r) { float best = -INFINITY; int bi = -1;
#pragma unroll
                for (int n = 0; n < 16; ++n) { const bool ok = (n < qblk) && !((selmask >> n) & 1u) && (bi < 0 || gate[n] > best); if (ok) { best = gate[n]; bi = n; } }
                selmask |= 1u << bi; }
        }
        float acc[64];
#pragma unroll
        for (int d = 0; d < 64; ++d) acc[d] = 0.f;
        float l = 0.f;
        const int kend = (item | 63) & (SEQ - 1);
        const LAS float* tbh = tb + h * 128;
        u64 mw = 0;
        for (int k = 0; k <= kend; ++k) {
            bool allowed;
            if (MODE == 0) { const int n = k >> 8; allowed = (n == qblk) ? (k <= q) : (((selmask >> n) & 1u) != 0u && n < qblk); }
            else { if ((k & 63) == 0) mw = (k <= q) ? BM[tq * 64 + (k >> 6)] : 0ull; allowed = ((mw >> (k & 63)) & 1ull) != 0ull; }
            if (!__any(allowed)) continue;
            const size_t tk = (size_t)b * SEQ + k;
            const v4u* kp = (const v4u*)(K + tk * KLD + (MODE == 0 ? h * 64 : 0));
            float s = 0.f;
#pragma unroll
            for (int c = 0; c < 8; ++c) { const v4u w = kp[c];
                s += qv[8 * c + 0] * bflo(w.x); s += qv[8 * c + 1] * bfhi(w.x); s += qv[8 * c + 2] * bflo(w.y); s += qv[8 * c + 3] * bfhi(w.y);
                s += qv[8 * c + 4] * bflo(w.z); s += qv[8 * c + 5] * bfhi(w.z); s += qv[8 * c + 6] * bflo(w.w); s += qv[8 * c + 7] * bfhi(w.w); }
            int dist = q - k; dist = dist < 0 ? 0 : (dist > 127 ? 127 : dist);
            s += tbh[dist];
            const float p = allowed ? __builtin_amdgcn_exp2f(s) : 0.f;
            l += p;
            const v4u* vp = (const v4u*)(V + tk * KLD + (MODE == 0 ? h * 64 : 0));
#pragma unroll
            for (int c = 0; c < 8; ++c) { const v4u w = vp[c];
                acc[8 * c + 0] += p * bflo(w.x); acc[8 * c + 1] += p * bfhi(w.x); acc[8 * c + 2] += p * bflo(w.y); acc[8 * c + 3] += p * bfhi(w.y);
                acc[8 * c + 4] += p * bflo(w.z); acc[8 * c + 5] += p * bfhi(w.z); acc[8 * c + 6] += p * bflo(w.w); acc[8 * c + 7] += p * bfhi(w.w); }
        }
        const float il = 1.0f / l;
        const v4u* gp = (const v4u*)(SG + tq * AW + h * 64); v4u* yp = (v4u*)(Y + tq * AW + h * 64);
#pragma unroll
        for (int c = 0; c < 8; ++c) { const v4u g = gp[c]; v4u o;
            o.x = pk2(acc[8 * c + 0] * il * bflo(g.x), acc[8 * c + 1] * il * bfhi(g.x)); o.y = pk2(acc[8 * c + 2] * il * bflo(g.y), acc[8 * c + 3] * il * bfhi(g.y));
            o.z = pk2(acc[8 * c + 4] * il * bflo(g.z), acc[8 * c + 5] * il * bfhi(g.z)); o.w = pk2(acc[8 * c + 6] * il * bflo(g.w), acc[8 * c + 7] * il * bfhi(g.w));
            yp[c] = o; }
    }
}

typedef float f32x16 __attribute__((ext_vector_type(16)));
typedef short s16x4 __attribute__((ext_vector_type(4)));
typedef short v4i16_t __attribute__((ext_vector_type(4)));
constexpr int AT_D = 4, AT_R = AT_D + 2;
constexpr int AT_RING = 0, AT_STAGE = 16384, AT_OST = 0  , AT_TB = AT_R * AT_STAGE, AT_WS = AT_TB + 8192, AT_BM = AT_WS + 2048;
static_assert(8 * 8192 <= AT_R * AT_STAGE && AT_BM + 16384 <= LDSCTL_OFF, "attention LDS");
__device__ __forceinline__ void glds16(const void* gsrc, unsigned lds_dst) { unsigned keep;
    asm volatile("s_mov_b32 %0, m0\n\ts_mov_b32 m0, %2\n\ts_nop 0\n\tglobal_load_lds_dwordx4 %1, off\n\ts_mov_b32 m0, %0" : "=&s"(keep) : "v"(gsrc), "s"(lds_dst) : "memory"); }
#define AT_WAIT_BAR() asm volatile("s_waitcnt vmcnt(0) lgkmcnt(0)\n\ts_barrier" ::: "memory")
#define AT_WAIT_BAR_N(N) asm volatile("s_waitcnt vmcnt(%0) lgkmcnt(0)\n\ts_barrier" :: "n"(N) : "memory")
__device__ __forceinline__ int crow(int r, int hi) { return (r & 3) + 8 * (r >> 2) + 4 * hi; }
__device__ __forceinline__ unsigned cvtpk(float lo, float hi) { unsigned r; asm volatile("v_cvt_pk_bf16_f32 %0, %1, %2" : "=v"(r) : "v"(lo), "v"(hi)); return r; }

template <int MODE>
__device__ __forceinline__ void attn_unit(Frame& F, int b, int h_, int blk) {
    int tid_o = threadIdx.x; asm volatile("" : "+v"(tid_o));
    const int lane = tid_o & 63, r32 = lane & 31, hi = lane >> 5, wid = __builtin_amdgcn_readfirstlane(tid_o >> 6);
    constexpr int KLD = (MODE == 0) ? AW : 64;
    const int h = (MODE == 0) ? h_ : wid;
    const int q0 = (MODE == 0) ? 256 * blk + 32 * wid : 32 * blk;
    const int q = q0 + r32; const size_t tq = (size_t)b * SEQ + q;
    const int NT = (MODE == 0) ? 4 * (blk + 1) : (32 * blk + 31) / 64 + 1;
    const bf16* Q = (const bf16*)(F.ws + (MODE == 0 ? WS_QA : WS_QB));
    const bf16* Kg = (const bf16*)(F.ws + (MODE == 0 ? WS_KA : WS_KB)) + (size_t)b * SEQ * KLD + (MODE == 0 ? h * 64 : 0);
    const bf16* Vg = (const bf16*)(F.ws + (MODE == 0 ? WS_VA : WS_VB)) + (size_t)b * SEQ * KLD + (MODE == 0 ? h * 64 : 0);
    const bf16* SG = (const bf16*)(F.ws + (MODE == 0 ? WS_SGA : WS_SGB));
    bf16* Y = (bf16*)(F.ws + WS_XB) + (size_t)MODE * TOK * AW;
    const u64* BM = (const u64*)(F.ws + WS_BM) + tq * 64;
    LAS unsigned char* lds = F.lds;
    const LAS float* tbh = (const LAS float*)(lds + AT_TB) + (MODE * 8 + h) * 128;
    LAS float* wsf = (LAS float*)(lds + AT_WS) + wid * 64;
    LAS float* ost = (LAS float*)(lds + AT_OST) + wid * 2048;
    const int krow_ = 8 * wid + (lane >> 3);
    const bf16* ksrc = Kg + (size_t)krow_ * KLD + 8 * ((lane & 7) ^ ((krow_ ^ (krow_ >> 3)) & 7));
    const bf16* vsrc = Vg + (size_t)(8 * wid + ((lane & 31) >> 2)) * KLD + 32 * (lane >> 5) + 8 * (lane & 3);
    const unsigned lds0 = (unsigned)(uintptr_t)lds;
#define AT_DMA(t, so) do { \
        glds16(ksrc + (size_t)(t) * 64 * KLD, (unsigned)__builtin_amdgcn_readfirstlane((int)(lds0 + AT_RING + (so) + wid * 1024))); \
        glds16(vsrc + (size_t)(t) * 64 * KLD, (unsigned)__builtin_amdgcn_readfirstlane((int)(lds0 + AT_RING + (so) + 8192 + wid * 1024))); } while (0)
#pragma unroll
    for (int i = 0; i < AT_D; ++i) AT_DMA((i < NT ? i : NT - 1), i * AT_STAGE);
    bf16x8 qr[4];
#pragma unroll
    for (int d0 = 0; d0 < 4; ++d0) qr[d0] = *(const bf16x8*)(Q + tq * AW + h * 64 + 16 * d0 + 8 * hi);
    LAS u64* bmL = (LAS u64*)(lds + AT_BM);
    if (MODE == 1) {
        const u64* BMu = (const u64*)(F.ws + WS_BM) + ((size_t)b * SEQ + q0) * 64;
#pragma unroll
        for (int ps = 0; ps < 2; ++ps) { const int it = ps * 512 + (tid_o & 511), row = it >> 5, j2 = (it & 31) * 2;
            const v4u w = *(const v4u*)(BMu + (size_t)row * 64 + j2);
            bmL[j2 * 32 + row] = (u64)w.x | ((u64)w.y << 32); bmL[(j2 + 1) * 32 + row] = (u64)w.z | ((u64)w.w << 32); }
    }
    unsigned selmask = 0;
    if (MODE == 0 && blk > 0) {
        float qf[64];
        { const v4u* qp = (const v4u*)(Q + tq * AW + h * 64);
#pragma unroll
            for (int c = 0; c < 8; ++c) { const v4u w = qp[c]; qf[8 * c + 0] = bflo(w.x); qf[8 * c + 1] = bfhi(w.x); qf[8 * c + 2] = bflo(w.y); qf[8 * c + 3] = bfhi(w.y); qf[8 * c + 4] = bflo(w.z); qf[8 * c + 5] = bfhi(w.z); qf[8 * c + 6] = bflo(w.w); qf[8 * c + 7] = bfhi(w.w); } }
        const float* KMP = (const float*)(F.ws + WS_KMP);
        float g8[8];
#pragma unroll
        for (int nn = 0; nn < 8; ++nn) { const int n = 8 * hi + nn; float s = -INFINITY;
            if (n < blk) { const f32x4* k0 = (const f32x4*)(KMP + ((((size_t)b * 16 + n) * 8 + h) * 2) * 64); s = 0.f;
#pragma unroll
                for (int c = 0; c < 16; ++c) { const f32x4 a = k0[c], bb = k0[16 + c];
                    s += qf[4 * c + 0] * ((a[0] + bb[0]) * (1.0f / 256.0f)); s += qf[4 * c + 1] * ((a[1] + bb[1]) * (1.0f / 256.0f)); s += qf[4 * c + 2] * ((a[2] + bb[2]) * (1.0f / 256.0f)); s += qf[4 * c + 3] * ((a[3] + bb[3]) * (1.0f / 256.0f)); } }
            g8[nn] = s; }
        float gate[16];
#pragma unroll
        for (int nn = 0; nn < 8; ++nn) { const float o = __shfl_xor(g8[nn], 32); gate[nn] = hi ? o : g8[nn]; gate[8 + nn] = hi ? g8[nn] : o; }
        const int nsel = blk < 3 ? blk : 3;
        for (int r = 0; r < nsel; ++r) { float best = -INFINITY; int bi = -1;
#pragma unroll
            for (int n = 0; n < 16; ++n) { const bool ok = (n < blk) && !((selmask >> n) & 1u) && (bi < 0 || gate[n] > best); if (ok) { best = gate[n]; bi = n; } }
            selmask |= 1u << bi; }
    }
    const float cfar = tbh[127]; const float NINF = -INFINITY;
#define AT_INIT_NEAR(t, c0, c1, mw) do { \
        const int kv0_ = 64 * (t); \
        bool sel_ = (t) < NT; \
        if (MODE == 0) { const int n_ = (t) >> 2; sel_ = sel_ && ((n_ == blk) || (((selmask >> (n_ & 15)) & 1u) != 0u)); } \
        unsigned mlo_ = 0, mhi_ = 0; if (MODE == 1) { const u64 ms_ = (mw) >> (4 * hi); mlo_ = (unsigned)ms_; mhi_ = (unsigned)(ms_ >> 32); } \
        _Pragma("unroll") for (int r = 0; r < 16; ++r) { const int bp = (r & 3) + 8 * (r >> 2); \
            const int d0_ = q - (kv0_ + bp + 4 * hi), d1_ = d0_ - 32; \
            const float b0_ = tbh[d0_ < 0 ? 0 : (d0_ > 127 ? 127 : d0_)], b1_ = tbh[d1_ < 0 ? 0 : (d1_ > 127 ? 127 : d1_)]; \
            if (MODE == 0) { c0[r] = (sel_ && d0_ >= 0) ? b0_ : NINF; c1[r] = (sel_ && d1_ >= 0) ? b1_ : NINF; } \
            else { c0[r] = (sel_ && ((mlo_ >> bp) & 1u)) ? b0_ : NINF; c1[r] = (sel_ && ((mhi_ >> bp) & 1u)) ? b1_ : NINF; } } } while (0)
#define AT_INIT_FARB(t, c0, c1, mw) do { \
        const u64 ms_ = ((t) < NT) ? ((mw) >> (4 * hi)) : 0ull; const int mlo_ = (int)(unsigned)ms_, mhi_ = (int)(unsigned)(ms_ >> 32); \
        const unsigned cf_ = __float_as_uint(cfar), nf_ = 0xff800000u; \
        _Pragma("unroll") for (int r = 0; r < 16; ++r) { const int bp = (r & 3) + 8 * (r >> 2); \
            const unsigned m0_ = (unsigned)__builtin_amdgcn_sbfe(mlo_, bp, 1), m1_ = (unsigned)__builtin_amdgcn_sbfe(mhi_, bp, 1); \
            c0[r] = __uint_as_float((m0_ & cf_) | (~m0_ & nf_)); c1[r] = __uint_as_float((m1_ & cf_) | (~m1_ & nf_)); } } while (0)
    const int kswz = (r32 ^ (r32 >> 3)) & 7;
#define AT_KF(Kt_, d0, p) (*(const LAS bf16x8*)((Kt_) + (p) * 4096 + (((2 * (d0) + hi) ^ kswz ^ (4 * (p))) << 4)))
#define AT_QK(so, c0, c1, i0, i1) do { const LAS unsigned char* Kt_ = lds + AT_RING + (so) + r32 * 128; \
        c0 = __builtin_amdgcn_mfma_f32_32x32x16_bf16(AT_KF(Kt_, 0, 0), qr[0], i0, 0, 0, 0); \
        c1 = __builtin_amdgcn_mfma_f32_32x32x16_bf16(AT_KF(Kt_, 0, 1), qr[0], i1, 0, 0, 0); \
        _Pragma("unroll") for (int d0 = 1; d0 < 4; ++d0) { \
            c0 = __builtin_amdgcn_mfma_f32_32x32x16_bf16(AT_KF(Kt_, d0, 0), qr[d0], c0, 0, 0, 0); \
            c1 = __builtin_amdgcn_mfma_f32_32x32x16_bf16(AT_KF(Kt_, d0, 1), qr[d0], c1, 0, 0, 0); } } while (0)
#define AT_SCORES(t, kf, c0, c1, mw) do { \
        const bool nearD_ = (q0 - (64 * (t) + 63)) < 113; \
        if (nearD_) { AT_INIT_NEAR(t, c0, c1, mw); AT_QK(kf, c0, c1, c0, c1); } \
        else if (MODE == 0) { AT_QK(kf, c0, c1, ivec, ivec); } \
        else { AT_INIT_FARB(t, c0, c1, mw); AT_QK(kf, c0, c1, c0, c1); } } while (0)
#define AT_IVEC(t) do { if (MODE == 0) { const int n_ = (t) >> 2; const bool s_ = ((t) < NT) && ((n_ == blk) || (((selmask >> (n_ & 15)) & 1u) != 0u)); const float v_ = s_ ? cfar : NINF; \
        _Pragma("unroll") for (int r = 0; r < 16; ++r) ivec[r] = v_; asm volatile("" : "+v"(ivec)); } } while (0)
#ifndef EXP_LDS
#define EXP_LDS 0
#endif
#ifndef EXP_EXP
#define EXP_EXP 0
#endif
#ifndef EXP_MFMA
#define EXP_MFMA 0
#endif
    f32x16 o0, o1, ivec; pg8::f32x4 dm4a = (pg8::f32x4){0.f,0.f,0.f,0.f}, dm4b = (pg8::f32x4){0.f,0.f,0.f,0.f}; f32x16 dmy; if (EXP_MFMA) { _Pragma("unroll") for (int r = 0; r < 16; ++r) dmy[r] = 0.f; }
#pragma unroll
    for (int r = 0; r < 16; ++r) { o0[r] = 0.f; o1[r] = 0.f; ivec[r] = NINF; }
    float lsum = 0.f;
    f32x16 ca0, ca1, cb0, cb1;
    AT_WAIT_BAR_N(2 * (AT_D - 1));
    AT_IVEC(0);
    { u64 mw0 = 0ull; if (MODE == 1) mw0 = bmL[r32];
      AT_SCORES(0, 0, ca0, ca1, mw0); }
    const int vbl = ((lane >> 4) & 1) * 32 + (lane & 3) * 8 + (4 * hi + ((lane & 15) >> 2)) * 64;
    int so_cur = 0, so_nxt = AT_STAGE, so_dma = AT_D * AT_STAGE;
#define AT_STEP(t, C0, C1, N0, N1) do { \
        u64 mw1_ = 0ull; if (MODE == 1) mw1_ = bmL[(((t) + 1) & 63) * 32 + r32]; \
        const LAS unsigned char* Vt_ = lds + AT_RING + so_cur + 8192; \
        asm volatile("" ::: "memory"); \
        if ((((t) + 1) & 3) == 0) AT_IVEC((t) + 1); \
        AT_SCORES((t) + 1, so_nxt, N0, N1, mw1_); \
        float sacc_ = 0.f; \
        if (EXP_EXP) { _Pragma("unroll") for (int r = 0; r < 16; ++r) { float e0_ = __builtin_amdgcn_exp2f(C0[r] + 1.0f), e1_ = __builtin_amdgcn_exp2f(C1[r] + 1.0f); asm volatile("" :: "v"(e0_), "v"(e1_)); } } \
        _Pragma("unroll") for (int r = 0; r < 16; ++r) { C0[r] = __builtin_amdgcn_exp2f(C0[r]); C1[r] = __builtin_amdgcn_exp2f(C1[r]); sacc_ += C0[r] + C1[r]; } \
        lsum += sacc_; \
        u32x4v pw_[4]; \
        _Pragma("unroll") for (int s_ = 0; s_ < 2; ++s_) { \
            pw_[s_] = (u32x4v){cvtpk(C0[8 * s_], C0[8 * s_ + 1]), cvtpk(C0[8 * s_ + 2], C0[8 * s_ + 3]), cvtpk(C0[8 * s_ + 4], C0[8 * s_ + 5]), cvtpk(C0[8 * s_ + 6], C0[8 * s_ + 7])}; \
            pw_[2 + s_] = (u32x4v){cvtpk(C1[8 * s_], C1[8 * s_ + 1]), cvtpk(C1[8 * s_ + 2], C1[8 * s_ + 3]), cvtpk(C1[8 * s_ + 4], C1[8 * s_ + 5]), cvtpk(C1[8 * s_ + 6], C1[8 * s_ + 7])}; } \
        _Pragma("unroll") for (int ks = 0; ks < 4; ++ks) { const bf16x8 pa_ = __builtin_bit_cast(bf16x8, pw_[ks]); \
            _Pragma("unroll") for (int d0 = 0; d0 < 2; ++d0) { const LAS unsigned char* vp_ = Vt_ + (2 * ks) * 1024 + d0 * 512 + vbl; \
                const s16x4 lo_ = __builtin_bit_cast(s16x4, __builtin_amdgcn_ds_read_tr16_b64_v4i16((LAS v4i16_t*)vp_)), hh_ = __builtin_bit_cast(s16x4, __builtin_amdgcn_ds_read_tr16_b64_v4i16((LAS v4i16_t*)(vp_ + 1024))); \
                if (EXP_LDS) { s16x4 l2_ = __builtin_bit_cast(s16x4, __builtin_amdgcn_ds_read_tr16_b64_v4i16((LAS v4i16_t*)(vp_ + 2048))), h2_ = __builtin_bit_cast(s16x4, __builtin_amdgcn_ds_read_tr16_b64_v4i16((LAS v4i16_t*)(vp_ + 3072))); asm volatile("" :: "v"(l2_), "v"(h2_)); } \
                const bf16x8 vf_ = (bf16x8){lo_[0], lo_[1], lo_[2], lo_[3], hh_[0], hh_[1], hh_[2], hh_[3]}; \
                if (d0 == 0) o0 = __builtin_amdgcn_mfma_f32_32x32x16_bf16(pa_, vf_, o0, 0, 0, 0); else o1 = __builtin_amdgcn_mfma_f32_32x32x16_bf16(pa_, vf_, o1, 0, 0, 0); \
                if (EXP_MFMA == 1) { dmy = __builtin_amdgcn_mfma_f32_32x32x16_bf16(pa_, vf_, dmy, 0, 0, 0); } \
                if (EXP_MFMA == 2) { dm4a = __builtin_amdgcn_mfma_f32_16x16x32_bf16(pa_, vf_, dm4a, 0, 0, 0); dm4b = __builtin_amdgcn_mfma_f32_16x16x32_bf16(vf_, pa_, dm4b, 0, 0, 0); } } } \
        so_cur = so_nxt; so_nxt = (so_nxt == (AT_R - 1) * AT_STAGE) ? 0 : so_nxt + AT_STAGE; } while (0)
    for (int t = 0; t < NT; t += 2) {
        AT_WAIT_BAR_N(2 * (AT_D - 3));
        { const int td_ = t + AT_D; AT_DMA((td_ < NT ? td_ : NT - 1), so_dma); so_dma = (so_dma == (AT_R - 1) * AT_STAGE) ? 0 : so_dma + AT_STAGE; }
        { const int td_ = t + AT_D + 1; AT_DMA((td_ < NT ? td_ : NT - 1), so_dma); so_dma = (so_dma == (AT_R - 1) * AT_STAGE) ? 0 : so_dma + AT_STAGE; }
        AT_STEP(t, ca0, ca1, cb0, cb1);
        AT_STEP(t + 1, cb0, cb1, ca0, ca1);
    }
    if (EXP_MFMA == 1) asm volatile("" :: "v"(dmy));
    if (EXP_MFMA == 2) asm volatile("" :: "v"(dm4a), "v"(dm4b));
    AT_WAIT_BAR();
    lsum += __shfl_xor(lsum, 32);
    if (hi == 0) wsf[r32] = lsum;
    LDS_WAIT(); asm volatile("" ::: "memory");
#pragma unroll
    for (int r = 0; r < 16; ++r) { const int orow = crow(r, hi); const float rl = __builtin_amdgcn_rcpf(wsf[orow]);
        ost[orow * 64 + r32] = o0[r] * rl; ost[orow * 64 + 32 + r32] = o1[r] * rl; }
    LDS_WAIT(); asm volatile("" ::: "memory");
#pragma unroll
    for (int i = 0; i < 4; ++i) { const int row = i * 8 + (lane >> 3), ch = lane & 7;
        const f32x4 a = *(const LAS f32x4*)(ost + row * 64 + ch * 8), c = *(const LAS f32x4*)(ost + row * 64 + ch * 8 + 4);
        const size_t off = ((size_t)b * SEQ + q0 + row) * AW + h * 64 + ch * 8;
        const v4u g = *(const v4u*)(SG + off); v4u o;
        o.x = pk2(a[0] * bflo(g.x), a[1] * bfhi(g.x)); o.y = pk2(a[2] * bflo(g.y), a[3] * bfhi(g.y)); o.z = pk2(c[0] * bflo(g.z), c[1] * bfhi(g.z)); o.w = pk2(c[2] * bflo(g.w), c[3] * bfhi(g.w));
        *(v4u*)(Y + off) = o; }
    AT_WAIT_BAR();
#undef AT_DMA
#undef AT_INIT_NEAR
#undef AT_INIT_FARB
#undef AT_QK
#undef AT_KF
#undef AT_SCORES
#undef AT_IVEC
#undef AT_STEP
}
__device__ __forceinline__ void attn_phase_fast(Frame& F, int layer) {
    { LAS float* tb = (LAS float*)(F.lds + AT_TB);
      build_bias_table(F, tb, in_ptr(3) + layer * 64, in_ptr(4) + layer * 64, 0);
      build_bias_table(F, tb + 1024, in_ptr(5) + layer * 64, in_ptr(6) + layer * 64, 8); }
    __syncthreads();
#ifndef REP_ATT_A
#define REP_ATT_A 1
#endif
#ifndef REP_ATT_B
#define REP_ATT_B 1
#endif
    for (int rep = 0; rep < REP_ATT_A; ++rep)
    for (int pr = F.vcu; pr < 512; pr += F.G) {
        const int bh = pr >> 3, s = pr & 7;
        attn_unit<0>(F, bh >> 3, bh & 7, 15 - s); attn_unit<0>(F, bh >> 3, bh & 7, s); }
    for (int rep = 0; rep < REP_ATT_B; ++rep)
    for (int pr = F.vcu; pr < 512; pr += F.G) {
        const int b = pr >> 6, s = pr & 63;
        attn_unit<1>(F, b, 0, 127 - s); attn_unit<1>(F, b, 0, s); }
}

constexpr int IDX_S_OFF = 0, IDX_Q_OFF = RING_BYTES, IDX_W_OFF = RING_BYTES + 8192, IDX_H_OFF = RING_BYTES;
static_assert(IDX_H_OFF + 8 * 3328 <= LDSCTL_OFF, "idx LDS");

#define DPPI_(x, ctrl) __builtin_amdgcn_update_dpp(0, (x), (ctrl), 0xF, 0xF, true)
#define DPPF_(x, ctrl) __builtin_bit_cast(float, DPPI_(__builtin_bit_cast(int, (x)), (ctrl)))
__device__ __forceinline__ float rl_f(float x, int l) { return __builtin_bit_cast(float, __builtin_amdgcn_readlane(__builtin_bit_cast(int, x), l)); }
__device__ __forceinline__ float wave_minf(float x) {
    x = fminf(x, DPPF_(x, 0xB1)); x = fminf(x, DPPF_(x, 0x4E)); x = fminf(x, DPPF_(x, 0x141)); x = fminf(x, DPPF_(x, 0x140));
    return fminf(fminf(rl_f(x, 0), rl_f(x, 16)), fminf(rl_f(x, 32), rl_f(x, 48)));
}
__device__ __forceinline__ float wave_maxf(float x) {
    x = fmaxf(x, DPPF_(x, 0xB1)); x = fmaxf(x, DPPF_(x, 0x4E)); x = fmaxf(x, DPPF_(x, 0x141)); x = fmaxf(x, DPPF_(x, 0x140));
    return fmaxf(fmaxf(rl_f(x, 0), rl_f(x, 16)), fmaxf(rl_f(x, 32), rl_f(x, 48)));
}
#define SEL_OPAQUE() do { _Pragma("unroll") for (int j_ = 0; j_ < 64; ++j_) asm volatile("" : "+v"(v[j_])); } while (0)
__device__ __forceinline__ unsigned bin_of(float x, float lo, float scale) {
    int r; const float t = (x - lo) * scale; asm("v_cvt_i32_f32 %0, %1" : "=v"(r) : "v"(t)); const unsigned u = (unsigned)r; return u < 256u ? u : 256u;
}
__device__ __forceinline__ void select_core(LAS float* R, int n, int lane, LAS unsigned* hist, float& T_out, int& needT_out) {
    const int nch = (n + 63) >> 6;
    if (64 * (nch - 1) + lane >= n) R[64 * (nch - 1) + lane] = -INFINITY;
    LDS_WAIT(); asm volatile("" ::: "memory");
    const LAS float* Rl = R + lane;
    float lo = INFINITY, hi = -INFINITY;
#pragma unroll 4
    for (int j = 0; j < nch; ++j) { const float x = Rl[64 * j]; lo = fminf(lo, x == -INFINITY ? INFINITY : x); hi = fmaxf(hi, x); }
    lo = wave_minf(lo); hi = wave_maxf(hi);
    int need = 256; float T = lo; int needT = 256;
    for (int iter = 0; iter < 48; ++iter) {
        T = lo; needT = need;
        if (!(hi > lo)) break;
        hist[lane] = 0u; hist[64 + lane] = 0u; hist[128 + lane] = 0u; hist[192 + lane] = 0u; hist[256 + (lane & 3)] = 0u;
        LDS_WAIT(); asm volatile("" ::: "memory");
        const float scale = 255.99f / (hi - lo);
#pragma unroll 4
        for (int j = 0; j < nch; ++j) __hip_atomic_fetch_add(hist + bin_of(Rl[64 * j], lo, scale), 1u, __ATOMIC_RELAXED, __HIP_MEMORY_SCOPE_WORKGROUP);
        LDS_WAIT(); asm volatile("" ::: "memory");
        const unsigned h0 = hist[4 * lane], h1 = hist[4 * lane + 1], h2 = hist[4 * lane + 2], h3 = hist[4 * lane + 3];
        unsigned suf = h0 + h1 + h2 + h3;
#pragma unroll
        for (int o = 1; o < 64; o <<= 1) { const unsigned t = __shfl_down(suf, o); if (lane + o < 64) suf += t; }
        const u64 bal = __ballot(suf >= (unsigned)need);
        if (bal == 0ull) break;
        const int ls = 63 - __builtin_clzll(bal);
        const unsigned a3 = __builtin_amdgcn_readlane(h3, ls), a2 = __builtin_amdgcn_readlane(h2, ls), a1 = __builtin_amdgcn_readlane(h1, ls), a0 = __builtin_amdgcn_readlane(h0, ls);
        const unsigned above_lane = __builtin_amdgcn_readlane(suf, ls) - (a0 + a1 + a2 + a3);
        unsigned bstar, above, cstar;
        if (above_lane + a3 >= (unsigned)need) { bstar = 4 * ls + 3; above = above_lane; cstar = a3; }
        else if (above_lane + a3 + a2 >= (unsigned)need) { bstar = 4 * ls + 2; above = above_lane + a3; cstar = a2; }
        else if (above_lane + a3 + a2 + a1 >= (unsigned)need) { bstar = 4 * ls + 1; above = above_lane + a3 + a2; cstar = a1; }
        else { bstar = 4 * ls; above = above_lane + a3 + a2 + a1; cstar = a0; }
        need -= (int)above;
        float nlo = INFINITY, nhi = -INFINITY; int cnt = 0;
        LAS float* candx = (LAS float*)hist; LAS unsigned* candi = hist + 64;
#pragma unroll 4
        for (int j = 0; j < nch; ++j) { const float x = Rl[64 * j];
            const bool c = bin_of(x, lo, scale) == bstar;
            const u64 cb = __ballot(c);
            if (cb != 0ull) { nlo = fminf(nlo, c ? x : INFINITY); nhi = fmaxf(nhi, c ? x : -INFINITY);
                const int pos = cnt + (int)__builtin_amdgcn_mbcnt_hi((unsigned)(cb >> 32), __builtin_amdgcn_mbcnt_lo((unsigned)cb, 0u));
                if (c && pos < 64) { candx[pos] = x; candi[pos] = (unsigned)(64 * j + lane); }
                cnt += __builtin_popcountll(cb); } }
        if (cstar <= 64u) {
            LDS_WAIT(); asm volatile("" ::: "memory");
            const bool mine = lane < (int)cstar;
            const float mx = mine ? candx[lane] : -INFINITY; const unsigned mi = candi[lane];
            int rank = 0;
            for (int i = 0; i < (int)cstar; ++i) { const float xi = rl_f(mx, i); const unsigned ii = (unsigned)__builtin_amdgcn_readlane((int)mi, i); rank += (xi > mx || (xi == mx && ii < mi)) ? 1 : 0; }
            const u64 tb_ = __ballot(mine && rank == need - 1);
            if (tb_ == 0ull) break;
            T = rl_f(mx, __builtin_ctzll(tb_));
            needT = need - __builtin_popcountll(__ballot(mine && mx > T));
            LDS_WAIT(); asm volatile("" ::: "memory");
            break;
        }
        nlo = wave_minf(nlo); nhi = wave_maxf(nhi);
        if ((int)cstar == need) { T = nlo; needT = 1 << 20; break; }
        lo = nlo; hi = nhi;
    }
    T_out = T; needT_out = needT;
}

__device__ __forceinline__ u64 bitmap_row(const LAS float* R, int n, int lane, float T, int needT) {
    const int nch = (n + 63) >> 6; const LAS float* Rl = R + lane;
    int run = 0; unsigned wlo = 0u, whi = 0u;
#pragma unroll 4
    for (int j = 0; j < nch; ++j) { const float x = Rl[64 * j];
        u64 w;
        const bool tie = (x == T); const u64 tbal = __ballot(tie);
        if (tbal == 0ull) w = __ballot(x > T);
        else { const int rank = run + (int)__builtin_amdgcn_mbcnt_hi((unsigned)(tbal >> 32), __builtin_amdgcn_mbcnt_lo((unsigned)tbal, 0u)); run += __builtin_popcountll(tbal);
            w = __ballot(x > T || (tie && rank < needT)); }
        if (lane == j) { wlo = (unsigned)w; whi = (unsigned)(w >> 32); }
    }
    return (u64)wlo | ((u64)whi << 32);
}
__device__ __forceinline__ u64 select_row(LAS float* R, int n, int lane, LAS unsigned* hist) {
    const int nch = (n + 63) >> 6;
    if (64 * (nch - 1) + lane >= n) R[64 * (nch - 1) + lane] = -INFINITY;
    LDS_WAIT(); asm volatile("" ::: "memory");
    const LAS float* Rl = R + lane;
    LAS unsigned short* idx16 = (LAS unsigned short*)(hist + 320);
    float T; int needT;
    bool fast = n >= 768;
    float L = 0.f; int cnt = 0;
    if (fast) {
        const float x0 = Rl[0];
        int kth = (64 * 640) / n; kth = kth < 4 ? 4 : (kth > 60 ? 60 : kth);
        int rk = 0;
        for (int i = 0; i < 64; ++i) { const float xi = rl_f(x0, i); rk += (xi > x0 || (xi == x0 && i < lane)) ? 1 : 0; }
        const u64 kb = __ballot(rk == kth);
        L = rl_f(x0, kb ? __builtin_ctzll(kb) : 0);
#pragma unroll 4
        for (int j = 0; j < nch; ++j) cnt += __builtin_popcountll(__ballot(Rl[64 * j] >= L));
        fast = (kb != 0ull) && cnt >= 256 && cnt <= 1024;
    }
    if (!fast) { select_core(R, n, lane, hist, T, needT); return bitmap_row(R, n, lane, T, needT); }
    int pos = 0;
    for (int j = 0; j < nch; ++j) { const float x = Rl[64 * j]; const bool c = x >= L; const u64 cb = __ballot(c);
        if (cb != 0ull) { const int p = pos + (int)__builtin_amdgcn_mbcnt_hi((unsigned)(cb >> 32), __builtin_amdgcn_mbcnt_lo((unsigned)cb, 0u));
            LDS_WAIT(); asm volatile("" ::: "memory");
            if (c) { R[p] = x; idx16[p] = (unsigned short)(64 * j + lane); }
            pos += __builtin_popcountll(cb); } }
    LDS_WAIT(); asm volatile("" ::: "memory");
    select_core(R, cnt, lane, hist, T, needT);
    hist[lane] = 0u; hist[64 + lane] = 0u;
    LDS_WAIT(); asm volatile("" ::: "memory");
    const int ncl = (cnt + 63) >> 6; int run = 0;
    for (int j = 0; j < ncl; ++j) { const float x = Rl[64 * j];
        const bool tie = (x == T); const u64 tbal = __ballot(tie);
        const int rank = run + (int)__builtin_amdgcn_mbcnt_hi((unsigned)(tbal >> 32), __builtin_amdgcn_mbcnt_lo((unsigned)tbal, 0u)); run += __builtin_popcountll(tbal);
        const bool selb = x > T || (tie && rank < needT);
        if (selb) { const unsigned id = idx16[64 * j + lane]; __hip_atomic_fetch_or(hist + (id >> 5), 1u << (id & 31u), __ATOMIC_RELAXED, __HIP_MEMORY_SCOPE_WORKGROUP); } }
    LDS_WAIT(); asm volatile("" ::: "memory");
    const u64 myword = (u64)hist[2 * lane] | ((u64)hist[2 * lane + 1] << 32);
    LDS_WAIT(); asm volatile("" ::: "memory");
    return myword;
}

#ifdef NAIVE_IDX
__device__ __forceinline__ void idx_phase_naive(Frame& F) {
    PHASE_TID();
    LAS float* S = (LAS float*)(F.lds + IDX_S_OFF); LAS float* qs = (LAS float*)(F.lds + IDX_Q_OFF); LAS float* wsm = (LAS float*)(F.lds + IDX_W_OFF);
    LAS unsigned* hist = (LAS unsigned*)(F.lds + IDX_H_OFF) + F.wave * 832;
    const bf16* QI = (const bf16*)(F.ws + WS_QI); const bf16* KI = (const bf16*)(F.ws + WS_KI); const float* WI = (const float*)(F.ws + WS_WI); u64* BM = (u64*)(F.ws + WS_BM);
    for (int un = blockIdx.x; un < TOK / 8; un += F.G) {
        const int b = un >> 9, q0 = (un & 511) * 8; const size_t t0 = (size_t)b * SEQ + q0;
        for (int e = ptid; e < 8 * 256; e += NWAVES * 64) qs[e] = bf2f(QI[t0 * 256 + e]);
        if (ptid < 32) wsm[ptid] = WI[t0 * 4 + ptid];
        __syncthreads();
        const int nk = q0 + 8;
        for (int k = ptid; k < nk; k += NWAVES * 64) {
            float kf[64];
            { const v4u* kp = (const v4u*)(KI + ((size_t)b * SEQ + k) * 64);
#pragma unroll
                for (int c = 0; c < 8; ++c) { const v4u w = kp[c]; kf[8 * c + 0] = bflo(w.x); kf[8 * c + 1] = bfhi(w.x); kf[8 * c + 2] = bflo(w.y); kf[8 * c + 3] = bfhi(w.y); kf[8 * c + 4] = bflo(w.z); kf[8 * c + 5] = bfhi(w.z); kf[8 * c + 6] = bflo(w.w); kf[8 * c + 7] = bfhi(w.w); } }
            for (int i = 0; i < 8; ++i) { float sc = 0.f;
#pragma unroll
                for (int h = 0; h < 4; ++h) { float dot = 0.f; const LAS f32x4* qp = (const LAS f32x4*)(qs + i * 256 + h * 64);
#pragma unroll
                    for (int c = 0; c < 16; ++c) { const f32x4 qq = qp[c]; dot += kf[4 * c] * qq[0]; dot += kf[4 * c + 1] * qq[1]; dot += kf[4 * c + 2] * qq[2]; dot += kf[4 * c + 3] * qq[3]; }
                    sc += wsm[i * 4 + h] * fmaxf(dot, 0.f); }
                S[i * 4096 + k] = sc; }
        }
        __syncthreads();
        { const int i = F.wave, n = q0 + i + 1; u64 word;
            if (n <= 256) { const int full = n >> 6, rem = n & 63; word = (plane < full) ? ~0ull : (plane == full ? ((1ull << rem) - 1ull) : 0ull); }
            else word = select_row(S + i * 4096, n, plane, hist);
            BM[(t0 + i) * 64 + plane] = word; }
        __syncthreads();
    }
}

#endif
__device__ __forceinline__ float dpp_quad_sum(float x) {
    x += __builtin_bit_cast(float, __builtin_amdgcn_mov_dpp(__builtin_bit_cast(int, x), 0xB1, 0xF, 0xF, true));
    x += __builtin_bit_cast(float, __builtin_amdgcn_mov_dpp(__builtin_bit_cast(int, x), 0x4E, 0xF, 0xF, true));
    return x;
}
__device__ __forceinline__ void idx_phase(Frame& F) {
    PHASE_TID();
    LAS float* S = (LAS float*)(F.lds + IDX_S_OFF);
    LAS unsigned* hist = (LAS unsigned*)(F.lds + IDX_H_OFF) + F.wave * 832;
    const bf16* QI = (const bf16*)(F.ws + WS_QI); const bf16* KI = (const bf16*)(F.ws + WS_KI); const float* WI = (const float*)(F.ws + WS_WI); u64* BM = (u64*)(F.ws + WS_BM);
    const int c16 = plane & 15, kg = plane >> 4, qloc = c16 >> 2, hh = c16 & 3;
    for (int un = blockIdx.x; un < TOK / 8; un += F.G) {
        const int b = un >> 9, m_ = un & 511, q0 = (m_ < 256 ? m_ : 767 - m_) * 8; const size_t t0 = (size_t)b * SEQ + q0;
        bf16x8 qf[2][2]; float wv[2];
#pragma unroll
        for (int g = 0; g < 2; ++g) { wv[g] = WI[(t0 + 4 * g + qloc) * 4 + hh];
#pragma unroll
            for (int ks = 0; ks < 2; ++ks) qf[g][ks] = *(const bf16x8*)(QI + (t0 + 4 * g + qloc) * 256 + hh * 64 + 32 * ks + 8 * kg); }
        const int nchunk = (q0 + 8 + 15) >> 4;
        const bf16* kbase = KI + (size_t)b * SEQ * 64 + (size_t)c16 * 64 + 8 * kg;
#define IDX_LOAD(KA, c0_) do { _Pragma("unroll") for (int u = 0; u < 4; ++u) { const int c = (c0_) + u * NWAVES; const bf16* kp = kbase + (size_t)(c < nchunk ? c : F.wave) * 16 * 64; \
            KA[u][0] = *(const bf16x8*)kp; KA[u][1] = *(const bf16x8*)(kp + 32); } } while (0)
#define IDX_COMP(KA, c0_) do { _Pragma("unroll") for (int u = 0; u < 4; ++u) { const int c = (c0_) + u * NWAVES; \
            if (c < nchunk) { _Pragma("unroll") for (int g = 0; g < 2; ++g) { \
                pg8::f32x4 acc = (pg8::f32x4){0.f, 0.f, 0.f, 0.f}; \
                acc = __builtin_amdgcn_mfma_f32_16x16x32_bf16(KA[u][0], qf[g][0], acc, 0, 0, 0); \
                acc = __builtin_amdgcn_mfma_f32_16x16x32_bf16(KA[u][1], qf[g][1], acc, 0, 0, 0); \
                pg8::f32x4 sc; \
                _Pragma("unroll") for (int i = 0; i < 4; ++i) sc[i] = dpp_quad_sum(wv[g] * fmaxf(acc[i], 0.f)); \
                if (hh == 0) *(LAS pg8::f32x4*)(S + (4 * g + qloc) * 4096 + 16 * c + 4 * kg) = sc; } } } } while (0)
        { bf16x8 kaA[4][2], kaB[4][2];
          IDX_LOAD(kaA, F.wave);
          for (int c0 = F.wave; c0 < nchunk; c0 += 8 * NWAVES) {
              IDX_LOAD(kaB, c0 + 4 * NWAVES);
              IDX_COMP(kaA, c0);
              IDX_LOAD(kaA, c0 + 8 * NWAVES);
              IDX_COMP(kaB, c0 + 4 * NWAVES);
          } }
#undef IDX_LOAD
#undef IDX_COMP
        __syncthreads();
        { const int i = F.wave, n = q0 + i + 1; u64 word;
            if (n <= 256) { const int full = n >> 6, rem = n & 63; word = (plane < full) ? ~0ull : (plane == full ? ((1ull << rem) - 1ull) : 0ull); }
            else word = select_row(S + i * 4096, n, plane, hist);
            BM[(t0 + i) * 64 + plane] = word; }
        __syncthreads();
    }
}

struct Args { const float* in[11]; float* out; unsigned char* ws; int ph_lo, ph_hi, li, pad; };
__global__ void __launch_bounds__(NWAVES * 64, 2) hyb_fwd(Args args) {
    extern __shared__ __attribute__((aligned(16))) unsigned char lds[];
    Frame F;
    F.lds = (LAS unsigned char*)lds;
    F.MISC = (volatile LAS unsigned*)(F.lds + MISC_OFF);
    F.wave = __builtin_amdgcn_readfirstlane((int)threadIdx.x >> 6);
    F.G = gridDim.x; { const int bx = blockIdx.x; F.vcu = (F.G % 8 == 0) ? (bx % 8) * (F.G / 8) + bx / 8 : bx; }
    F.ws = args.ws; F.ctl = (gu32*)(args.ws + WS_CTL); F.out = args.out;
    for (int u = threadIdx.x; u < (LDS_BYTES - LDSCTL_OFF) / 4; u += NWAVES * 64) ((LAS unsigned*)(F.lds + LDSCTL_OFF))[u] = 0u;
    __syncthreads();
    const bool one_launch = (args.ph_hi - args.ph_lo) > 1;
    XcdBarrier bar; bar.bar = (unsigned*)(F.ctl + CW_BAR); bar.x = 0; bar.st = nullptr;
    if (one_launch) bar = xcd_barrier_post((unsigned*)(F.ctl + CW_BAR), F.MISC + 8);
    const int lo = args.ph_lo, hi = args.ph_hi;
    unsigned char* ws = args.ws;
#ifndef REP_K
#define REP_K -2
#endif
#pragma unroll 1
    for (int ph2 = 2 * lo; ph2 < 2 * hi; ++ph2) {
        const int ph = ph2 >> 1;
        const int l = (ph - 1) / 5, k = (ph == 0) ? -1 : (ph - 1) % 5;
        if ((ph2 & 1) && k != REP_K) continue;
        if (k < 0) {
#ifndef NO_P0
            p0_prologue(F);
#endif
        } else if (k == 0) {
#ifndef NO_P1
            pg8::Gemm g{(const pg8::bf16_t*)(ws + WS_XB), (const pg8::bf16_t*)(ws + WS_WIN) + (size_t)l * NIN * DM, TOK, NIN, DM};
            pg8::StaticOrder S; S.init(TOK, NIN, F.G, (int)blockIdx.x);
            pg8::EpiIn E; E.rss = (const float*)(ws + WS_RSS); E.qna = in_ptr(3) + l * 64; E.kna = in_ptr(4) + l * 64; E.qnb = in_ptr(5) + l * 64; E.knb = in_ptr(6) + l * 64;
            E.QA = (pg8::bf16_t*)(ws + WS_QA); E.KA = (pg8::bf16_t*)(ws + WS_KA); E.VA = (pg8::bf16_t*)(ws + WS_VA); E.SGA = (pg8::bf16_t*)(ws + WS_SGA); E.QB = (pg8::bf16_t*)(ws + WS_QB); E.SGB = (pg8::bf16_t*)(ws + WS_SGB);
            E.KB = (pg8::bf16_t*)(ws + WS_KB); E.VB = (pg8::bf16_t*)(ws + WS_VB); E.KI = (pg8::bf16_t*)(ws + WS_KI); E.QI = (pg8::bf16_t*)(ws + WS_QI); E.SMA = (pg8::bf16_t*)(ws + WS_SMA); E.SMB = (pg8::bf16_t*)(ws + WS_SMB);
            E.WI = (float*)(ws + WS_WI); E.KMP = (float*)(ws + WS_KMP);
            pg8::gemm_phase<pg8::EpiIn, pg8::StaticOrder, true, true>(F.lds, g, S, E);
#endif
        } else if (k == 1) {
#ifndef NO_IDX
#ifdef NAIVE_IDX
            idx_phase_naive(F);
#else
            idx_phase(F);
#endif
#endif
        } else if (k == 2) {
#ifndef NO_ATT
#ifdef NAIVE_ATT
            naive_attn<0>(F, l); __syncthreads(); naive_attn<1>(F, l);
#else
#ifdef CLOCK_PROBE
            if (blockIdx.x == 0 && threadIdx.x == 0 && l == 0) { F.MISC[16] = (unsigned)__builtin_amdgcn_s_memtime(); F.MISC[17] = (unsigned)__builtin_amdgcn_s_memrealtime(); }
#endif
            attn_phase_fast(F, l);
#ifdef CLOCK_PROBE
            if (blockIdx.x == 0 && threadIdx.x == 0 && l == 0) { const unsigned dt = (unsigned)__builtin_amdgcn_s_memtime() - F.MISC[16], dr = (unsigned)__builtin_amdgcn_s_memrealtime() - F.MISC[17]; F.MISC[18] = (unsigned)((unsigned long long)dt * 100ull / (dr ? dr : 1u)); }
#endif
#endif
#endif
        } else if (k == 3) {
#ifndef NO_P4
            pg8::Gemm g{(const pg8::bf16_t*)(ws + WS_XB), (const pg8::bf16_t*)(ws + WS_WBR) + (size_t)l * 2048 * AW, 2 * TOK, 2048, AW};
            pg8::PairOrder S; S.init(F.G, (int)blockIdx.x);
            pg8::EpiMerge E{(const pg8::bf16_t*)(ws + WS_SMA), (pg8::bf16_t*)(ws + WS_SMB), (float*)(ws + WS_TMP)};
            pg8::gemm_phase<pg8::EpiMerge, pg8::PairOrder, true, true>(F.lds, g, S, E);
#endif
        } else {
#ifndef NO_P5
            pg8::Gemm g{(const pg8::bf16_t*)(ws + WS_SMB), (const pg8::bf16_t*)(ws + WS_WOUT) + (size_t)l * DM * DM, TOK, DM, DM};
            pg8::StaticOrder S; S.init(TOK, DM, F.G, (int)blockIdx.x);
            if (l == 0) { pg8::EpiOut<true> E{in_ptr(0), F.out, (pg8::bf16_t*)(ws + WS_XB), (float*)(ws + WS_RSS)};
                pg8::gemm_phase<pg8::EpiOut<true>, pg8::StaticOrder, true, true>(F.lds, g, S, E); }
            else { pg8::EpiOut<false> E{F.out, F.out, nullptr, nullptr};
                pg8::gemm_phase<pg8::EpiOut<false>, pg8::StaticOrder, true, true>(F.lds, g, S, E); }
#endif
        }
        if (!((ph == hi - 1) && ((ph2 & 1) || k != REP_K))) xcd_barrier(bar);
    }
#ifdef CLOCK_PROBE
    if (blockIdx.x == 0 && threadIdx.x == 0) {
        const unsigned long long t0 = __builtin_amdgcn_s_memrealtime(); const unsigned long long want = (unsigned long long)F.MISC[18] * 100ull;
        while (__builtin_amdgcn_s_memrealtime() - t0 < want) __builtin_amdgcn_s_sleep(16);
    }
#endif
}

#ifndef N_LAUNCHES
#define N_LAUNCHES 1
#endif
extern "C" void kernel_launch(void* const* d_in, const int* in_sizes, int n_in, void* d_out, int out_size, void* d_ws, size_t ws_size, hipStream_t stream) {
    static int grid = 0;
    if (grid == 0) {
        if (n_in != 11 || in_sizes[0] != TOK * DM || out_size != TOK * DM || ws_size < WS_END) { fprintf(stderr, "kernel_launch: unexpected shapes (n_in %d in0 %d out %d ws %zu)\n", n_in, n_in > 0 ? in_sizes[0] : -1, out_size, ws_size); grid = -1; return; }
        int dev = 0, cus = 0;
        if (hipGetDevice(&dev) != hipSuccess || hipDeviceGetAttribute(&cus, hipDeviceAttributeMultiprocessorCount, dev) != hipSuccess) { grid = -1; return; }
        if (hipFuncSetAttribute((const void*)hyb_fwd, hipFuncAttributeMaxDynamicSharedMemorySize, LDS_BYTES) != hipSuccess) { fprintf(stderr, "kernel_launch: hipFuncSetAttribute failed\n"); grid = -1; return; }
        int per_cu = 0;
        if (hipOccupancyMaxActiveBlocksPerMultiprocessor(&per_cu, (const void*)hyb_fwd, NWAVES * 64, LDS_BYTES) != hipSuccess || per_cu < 1) fprintf(stderr, "kernel_launch: occupancy query says %d\n", per_cu);
        (void)hipGetLastError();
        grid = cus;
    }
    if (grid < 0) return;
    if (hipMemsetAsync((char*)d_ws + WS_CTL, 0, CTL_ZERO_BYTES, stream) != hipSuccess) return;
    Args a{};
    for (int i = 0; i < 11; ++i) a.in[i] = (const float*)d_in[i];
    a.out = (float*)d_out; a.ws = (unsigned char*)d_ws;
    if (N_LAUNCHES == 1) { a.ph_lo = 0; a.ph_hi = NPHASE; a.li = 0; hipLaunchKernelGGL(hyb_fwd, dim3(grid), dim3(NWAVES * 64), LDS_BYTES, stream, a); }
    else for (int li = 0; li < NPHASE; ++li) { a.ph_lo = li; a.ph_hi = li + 1; a.li = li; hipLaunchKernelGGL(hyb_fwd, dim3(grid), dim3(NWAVES * 64), LDS_BYTES, stream, a); }
}
```

```cpp
#include <hip/hip_runtime.h>
#include <cstdio>
#include <cstdint>
#include <cmath>
namespace pg8 {
#define PG8_LAS __attribute__((address_space(3)))
typedef unsigned short bf16_t;
typedef short bf16x8 __attribute__((ext_vector_type(8)));
typedef float f32x4 __attribute__((ext_vector_type(4)));
typedef unsigned u32x4 __attribute__((ext_vector_type(4)));
constexpr int BM = 256, BK = 64, HALF = 128, HTB = HALF * BK * 2  , STAGE_BYTES = 8 * HTB, NXCD = 8, WGM = 8;

__host__ __device__ __forceinline__ int lds_byte(int r, int c) { const int st = (r >> 4) * 2 + (c >> 5), rr = r & 15, cc = c & 31, ob = rr * 64 + cc * 2; return st * 1024 + (ob ^ (((ob >> 9) & 1) << 5)); }
__host__ __device__ __forceinline__ void stage_rc(int b, int& R, int& C) { const int st = b / 1024, sb = b % 1024, swz = sb ^ (((sb >> 9) & 1) << 5); R = (st >> 1) * 16 + swz / 64; C = (st & 1) * 32 + (swz % 64) / 2; }
__host__ __device__ __forceinline__ int perm32(int rho) { const int n = rho >> 4, i = rho & 15; return 8 * (i >> 2) + 4 * n + (i & 3); }

struct Unit { int pm, pn; };
struct Gemm { const bf16_t* A; const bf16_t* Bt; int M, N, K; };

struct StaticOrder {
    int nM, nN, nwg, G, c;
    __host__ __device__ void init(int M, int N, int G_, int c_) { nM = M / BM; nN = N / BM; nwg = nM * nN; G = G_; c = c_; }
    __host__ __device__ bool next(int i, Unit& u) const {
        const long L = (long)i * G + c; if (L >= nwg) return false;
        int wgid = (int)L; { const int q = nwg / NXCD, r = nwg % NXCD, xcd = wgid % NXCD, off = wgid / NXCD; wgid = (xcd < r ? xcd * (q + 1) : r * (q + 1) + (xcd - r) * q) + off; }
        const int nig = WGM * nN, gid = wgid / nig, fm = gid * WGM, gsz = (nM - fm) < WGM ? (nM - fm) : WGM;
        u.pm = fm + ((wgid % nig) % gsz); u.pn = (wgid % nig) / gsz; return true;
    }
    __device__ __forceinline__ void a_ready(const Unit&) const {}
    __device__ __forceinline__ void done(const Unit&) const {}
};

__device__ __forceinline__ unsigned cvt_pk_bf16(float lo, float hi) { unsigned r; asm volatile("v_cvt_pk_bf16_f32 %0, %1, %2" : "=v"(r) : "v"(lo), "v"(hi)); return r; }
template <class Epi, class Sched, bool ALIGN_EPI = false, bool SP2 = false>
__device__ __forceinline__ void gemm_phase(PG8_LAS unsigned char* lds, const Gemm g, const Sched& S, const Epi& E) {
    int tid_ = threadIdx.x; asm volatile("" : "+v"(tid_));
    const int tid = tid_, wid = __builtin_amdgcn_readfirstlane(tid >> 6), lane = tid & 63, wr = wid >> 2, wc = wid & 3, fr = lane & 15, fq = lane >> 4;
    const int K = g.K, nt = K / BK;
    unsigned voffA[2], voffB[2];
#pragma unroll
    for (int i = 0; i < 2; ++i) { int R, C; stage_rc(tid * 16 + i * 8192, R, C); const int Rb = Epi::PERM ? ((R & ~31) + perm32(R & 31)) : R;
        voffA[i] = (unsigned)(R * K + C) * 2u; voffB[i] = (unsigned)(Rb * K + C) * 2u; }
    const size_t kstep = (size_t)(BK * 2);
    const size_t hstep = (size_t)HALF * K * 2;
    const size_t tstep = 2 * hstep;
    const unsigned ldsw = (unsigned)wid * 1024u;
    const int aoff = lds_byte(wr * 64 + fr, fq * 8), boff = lds_byte(wc * 32 + fr, fq * 8);
#define PG8_SA(b, h) (((b) * 2 + (h)) * HTB)
#define PG8_SB(b, h) ((4 + (b) * 2 + (h)) * HTB)
#define PG8_STAGE(bufoff, gbase, voff) do { _Pragma("unroll") for (int _i = 0; _i < 2; ++_i) \
        __builtin_amdgcn_global_load_lds((const unsigned*)((const char*)(gbase) + (voff)[_i]), (PG8_LAS unsigned*)(lds + (bufoff) + ldsw + _i * 8192), 16, 0, 0); } while (0)
#define PG8_LDA(dst, b, h) do { _Pragma("unroll") for (int m = 0; m < 4; ++m) _Pragma("unroll") for (int k = 0; k < 2; ++k) dst[m][k] = *(const PG8_LAS bf16x8*)(lds + PG8_SA(b, h) + aoff + m * 2048 + k * 1024); } while (0)
#define PG8_LDB(dst, b, h) do { _Pragma("unroll") for (int n = 0; n < 2; ++n) _Pragma("unroll") for (int k = 0; k < 2; ++k) dst[n][k] = *(const PG8_LAS bf16x8*)(lds + PG8_SB(b, h) + boff + n * 2048 + k * 1024); } while (0)
#define PG8_MMA(ai, bj, At, Bt) do { __builtin_amdgcn_s_setprio(1); _Pragma("unroll") for (int m = 0; m < 4; ++m) _Pragma("unroll") for (int n = 0; n < 2; ++n) _Pragma("unroll") for (int k = 0; k < 2; ++k) \
        acc[ai][bj][m][n] = __builtin_amdgcn_mfma_f32_16x16x32_bf16(Bt[n][k], At[m][k], acc[ai][bj][m][n], 0, 0, 0); __builtin_amdgcn_s_setprio(0); } while (0)
#define PG8_WAIT_V(n) asm volatile("s_waitcnt vmcnt(" #n ")" ::: "memory")
#define PG8_WAIT_L(n) asm volatile("s_waitcnt lgkmcnt(" #n ")" ::: "memory")
#define PG8_BAR __builtin_amdgcn_s_barrier()
#define PG8_SCHED __builtin_amdgcn_sched_barrier(0)
    Unit cur, nxt; int ui = 0;
    if (!S.next(0, cur)) return;
    f32x4 acc[2][2][4][2];
#pragma unroll
    for (int a = 0; a < 2; ++a)
#pragma unroll
        for (int b = 0; b < 2; ++b)
#pragma unroll
            for (int m = 0; m < 4; ++m)
#pragma unroll
                for (int n = 0; n < 2; ++n) acc[a][b][m][n] = (f32x4){0.f, 0.f, 0.f, 0.f};
    bf16x8 At[4][2], B0[2][2], B1[2][2];
    const char* cA = (const char*)g.A + (size_t)cur.pm * tstep; const char* cB = (const char*)g.Bt + (size_t)cur.pn * tstep;
    S.a_ready(cur);
    if constexpr (SP2) {
        PG8_STAGE(PG8_SB(0, 0), cB, voffB); PG8_STAGE(PG8_SB(0, 1), cB + hstep, voffB); PG8_STAGE(PG8_SA(0, 0), cA, voffA); PG8_STAGE(PG8_SA(0, 1), cA + hstep, voffA);
        if (wr == 1) PG8_BAR;
        PG8_WAIT_V(2); PG8_BAR;
        PG8_STAGE(PG8_SB(1, 0), cB + kstep, voffB); PG8_STAGE(PG8_SA(1, 0), cA + kstep, voffA); PG8_STAGE(PG8_SB(1, 1), cB + hstep + kstep, voffB);
        PG8_WAIT_V(6); PG8_BAR;
    } else {
        PG8_STAGE(PG8_SB(0, 0), cB, voffB); PG8_STAGE(PG8_SA(0, 0), cA, voffA); PG8_STAGE(PG8_SB(0, 1), cB + hstep, voffB); PG8_STAGE(PG8_SA(0, 1), cA + hstep, voffA);
        if (wr == 1) PG8_BAR;
        PG8_WAIT_V(4); PG8_BAR;
        PG8_STAGE(PG8_SB(1, 0), cB + kstep, voffB); PG8_STAGE(PG8_SA(1, 0), cA + kstep, voffA); PG8_STAGE(PG8_SB(1, 1), cB + hstep + kstep, voffB);
        PG8_WAIT_V(6); PG8_BAR;
    }
    for (;;) {
        const bool has_next = S.next(ui + 1, nxt);
        const char* nA = has_next ? (const char*)g.A + (size_t)nxt.pm * tstep : cA; const char* nB = has_next ? (const char*)g.Bt + (size_t)nxt.pn * tstep : cB;
        for (int t = 0; t < nt; t += 2) {
            const bool last = (t == nt - 2);
            const char* a1 = cA + (size_t)(t + 1) * kstep;
            const char* a2 = last ? nA : cA + (size_t)(t + 2) * kstep; const char* b2 = last ? nB : cB + (size_t)(t + 2) * kstep;
            const char* a3 = a2 + kstep; const char* b3 = b2 + kstep;
            if (last && has_next) S.a_ready(nxt);
            if constexpr (SP2) {
            PG8_LDB(B0, 0, 0); PG8_LDB(B1, 0, 1); PG8_SCHED; PG8_LDA(At, 0, 0); PG8_STAGE(PG8_SA(1, 1), a1 + hstep, voffA);
            PG8_WAIT_V(8); PG8_WAIT_L(0); PG8_BAR; PG8_MMA(0, 0, At, B0); PG8_MMA(0, 1, At, B1); PG8_BAR; PG8_SCHED;
            PG8_LDA(At, 0, 1); PG8_STAGE(PG8_SB(0, 0), b2, voffB); PG8_STAGE(PG8_SB(0, 1), b2 + hstep, voffB); PG8_STAGE(PG8_SA(0, 0), a2, voffA);
            PG8_WAIT_V(8); PG8_WAIT_L(0); PG8_BAR; PG8_MMA(1, 0, At, B0); PG8_MMA(1, 1, At, B1); PG8_BAR; PG8_SCHED;
            PG8_LDB(B0, 1, 0); PG8_LDB(B1, 1, 1); PG8_SCHED; PG8_LDA(At, 1, 0); PG8_STAGE(PG8_SA(0, 1), a2 + hstep, voffA);
            PG8_WAIT_V(8); PG8_WAIT_L(0); PG8_BAR; PG8_MMA(0, 0, At, B0); PG8_MMA(0, 1, At, B1); PG8_BAR; PG8_SCHED;
            PG8_LDA(At, 1, 1); PG8_STAGE(PG8_SB(1, 0), b3, voffB); PG8_STAGE(PG8_SB(1, 1), b3 + hstep, voffB); PG8_STAGE(PG8_SA(1, 0), a3, voffA);
            PG8_WAIT_V(8); PG8_WAIT_L(0); PG8_BAR; PG8_MMA(1, 0, At, B0); PG8_MMA(1, 1, At, B1); PG8_BAR; PG8_SCHED;
            } else {
            PG8_LDB(B0, 0, 0); PG8_SCHED; PG8_LDA(At, 0, 0); PG8_STAGE(PG8_SA(1, 1), a1 + hstep, voffA);
            PG8_WAIT_L(8); PG8_BAR; PG8_WAIT_L(0); PG8_MMA(0, 0, At, B0); PG8_BAR; PG8_SCHED;
            PG8_LDB(B1, 0, 1); PG8_STAGE(PG8_SB(0, 0), b2, voffB);
            PG8_BAR; PG8_WAIT_L(0); PG8_MMA(0, 1, At, B1); PG8_BAR;
            PG8_LDA(At, 0, 1); PG8_STAGE(PG8_SA(0, 0), a2, voffA);
            PG8_BAR; PG8_WAIT_L(0); PG8_MMA(1, 0, At, B0); PG8_BAR; PG8_SCHED;
            PG8_STAGE(PG8_SB(0, 1), b2 + hstep, voffB);
            PG8_WAIT_V(6); PG8_BAR; PG8_MMA(1, 1, At, B1); PG8_BAR;
            PG8_LDB(B0, 1, 0); PG8_SCHED; PG8_LDA(At, 1, 0); PG8_STAGE(PG8_SA(0, 1), a2 + hstep, voffA);
            PG8_WAIT_L(8); PG8_BAR; PG8_WAIT_L(0); PG8_MMA(0, 0, At, B0); PG8_BAR; PG8_SCHED;
            PG8_LDB(B1, 1, 1); PG8_STAGE(PG8_SB(1, 0), b3, voffB);
            PG8_BAR; PG8_WAIT_L(0); PG8_MMA(0, 1, At, B1); PG8_BAR;
            PG8_LDA(At, 1, 1); PG8_STAGE(PG8_SA(1, 0), a3, voffA);
            PG8_BAR; PG8_WAIT_L(0); PG8_MMA(1, 0, At, B0); PG8_BAR; PG8_SCHED;
            PG8_STAGE(PG8_SB(1, 1), b3 + hstep, voffB);
            PG8_WAIT_V(6); PG8_BAR; PG8_MMA(1, 1, At, B1); PG8_BAR;
            }
        }
        if constexpr (ALIGN_EPI) { if (wr == 0) PG8_BAR; }
#ifndef EPI_REP
#define EPI_REP 1
#endif
        if constexpr (!Epi::AFTER_DRAIN) { E(acc, cur, wr, wc, fr, fq); if constexpr (Epi::REPEATABLE && EPI_REP == 2) { asm volatile("" ::: "memory"); E(acc, cur, wr, wc, fr, fq); } S.done(cur); }
        if (!has_next) break;
#pragma unroll
        for (int a = 0; a < 2; ++a)
#pragma unroll
            for (int b = 0; b < 2; ++b)
#pragma unroll
                for (int m = 0; m < 4; ++m)
#pragma unroll
                    for (int n = 0; n < 2; ++n) acc[a][b][m][n] = (f32x4){0.f, 0.f, 0.f, 0.f};
        cur = nxt; cA = nA; cB = nB; ++ui;
        if constexpr (ALIGN_EPI) { if (wr == 1) PG8_BAR; }
    }
    PG8_WAIT_V(0);
    if constexpr (!ALIGN_EPI) { if (wr == 0) PG8_BAR; }
    PG8_BAR;
    if constexpr (Epi::AFTER_DRAIN) { E.fused(acc, cur, wr, wc, fr, fq, lds, wid, lane); S.done(cur); }
#undef PG8_SA
#undef PG8_SB
#undef PG8_STAGE
#undef PG8_LDA
#undef PG8_LDB
#undef PG8_MMA
#undef PG8_WAIT_V
#undef PG8_WAIT_L
#undef PG8_BAR
#undef PG8_SCHED
}
}
#define GAS __attribute__((address_space(1)))
#define LAS __attribute__((address_space(3)))
typedef unsigned short bf16;
typedef unsigned v4u __attribute__((ext_vector_type(4)));
typedef float f32x4 __attribute__((ext_vector_type(4)));
typedef short bf16x8 __attribute__((ext_vector_type(8)));
typedef GAS unsigned gu32;
typedef GAS unsigned long long gu64;
#define RLX_AGENT __ATOMIC_RELAXED, __HIP_MEMORY_SCOPE_AGENT
#define LDS_WAIT() asm volatile("s_waitcnt lgkmcnt(0)" ::: "memory")
#define VM_WAIT() asm volatile("s_waitcnt vmcnt(0)" ::: "memory")
__device__ __forceinline__ unsigned long long rt() { return __builtin_amdgcn_s_memrealtime(); }
__device__ __forceinline__ unsigned f2bf(float f) { unsigned u = __builtin_bit_cast(unsigned, f); return (u + 0x7fffu + ((u >> 16) & 1u)) >> 16; }
__device__ __forceinline__ unsigned pk2(float lo, float hi) { return f2bf(lo) | (f2bf(hi) << 16); }
#define XB_TMO      128
#define XB_XCNT(j)  (256  + 64 * (j))
#define XB_XSUB(j)  (1280 + 64 * (j))
#define XB_XGEN(j)  (2304 + 64 * (j))
#define XB_TOP      3328
#define XB_TOPGEN   3392
#define XCD_BAR_WORDS 3456
#define XB_SPIN_CAP (1u << 18)

__device__ __forceinline__ unsigned xb_ld(unsigned* p)              { return __hip_atomic_load(p, __ATOMIC_RELAXED, __HIP_MEMORY_SCOPE_AGENT); }
__device__ __forceinline__ unsigned xb_add(unsigned* p, unsigned v) { return __hip_atomic_fetch_add(p, v, __ATOMIC_RELAXED, __HIP_MEMORY_SCOPE_AGENT); }
__device__ __forceinline__ unsigned xb_xcc_id() { return (unsigned)__builtin_amdgcn_s_getreg((3 << 11) | 20) & 0xFu; }
#define XB_SPIN(cond, bar) do { unsigned _sp = 0; while (cond) { __builtin_amdgcn_s_sleep(1); \
    if ((++_sp & 255u) == 0u) { if (xb_ld(&(bar)[XB_TMO])) break; if (_sp > XB_SPIN_CAP) { atomicAdd(&(bar)[XB_TMO], 1u); break; } } } } while (0)

struct XcdBarrier {
    unsigned* bar; unsigned x;
    volatile LAS unsigned* st;
};

__device__ __forceinline__ XcdBarrier xcd_barrier_post(unsigned* bar, volatile LAS unsigned* st) {
    XcdBarrier b; b.bar = bar; b.x = xb_xcc_id(); b.st = st;
    if (threadIdx.x == 0) (void)xb_add(&bar[XB_XCNT(b.x)], 1u);
    return b;
}
__device__ __forceinline__ void xcd_barrier_complete(unsigned* bar, unsigned x, unsigned& nloc, unsigned& nx) {
    const unsigned G = gridDim.x * gridDim.y * gridDim.z;
    unsigned sum, cnt, mine, sp = 0u;
    for (;;) {
        sum = 0u; cnt = 0u; mine = 0u;
#pragma unroll
        for (unsigned j = 0; j < 16; ++j) { const unsigned c = xb_ld(&bar[XB_XCNT(j)]); sum += c; cnt += (c > 0u) ? 1u : 0u; mine = (j == x) ? c : mine; }
        if (sum == G) break;
        __builtin_amdgcn_s_sleep(1);
        if ((++sp & 255u) == 0u) { if (xb_ld(&bar[XB_TMO])) break; if (sp > XB_SPIN_CAP) { atomicAdd(&bar[XB_TMO], 1u); break; } }
    }
    nloc = mine > 0u ? mine : 1u; nx = cnt > 0u ? cnt : 1u;
}

__device__ __forceinline__ void xcd_barrier(const XcdBarrier& b) {
    asm volatile("s_waitcnt vmcnt(0)" ::: "memory");
    __syncthreads();
    if (threadIdx.x == 0) {
        unsigned* bar = b.bar; asm volatile("" : "+s"(bar));
        __builtin_amdgcn_s_waitcnt(0);
        unsigned nloc = b.st[0], nx = b.st[1];
        if (nloc == 0u) { xcd_barrier_complete(bar, b.x, nloc, nx); b.st[0] = nloc; b.st[1] = nx; }
        const unsigned old = xb_add(&bar[XB_XSUB(b.x)], 1u);
        const unsigned gen = old / nloc;
        if (old + 1u == (gen + 1u) * nloc) {
            __builtin_amdgcn_fence(__ATOMIC_RELEASE, "agent");
            asm volatile("s_waitcnt vmcnt(0)" ::: "memory");
            const unsigned og = xb_add(&bar[XB_TOP], 1u);
            const unsigned tg = og / nx;
            if (og + 1u == (tg + 1u) * nx) xb_add(&bar[XB_TOPGEN], 1u);
            else XB_SPIN(xb_ld(&bar[XB_TOPGEN]) == tg, bar);
            __builtin_amdgcn_fence(__ATOMIC_ACQUIRE, "agent");
            xb_add(&bar[XB_XGEN(b.x)], 1u);
            asm volatile("s_waitcnt vmcnt(0)" ::: "memory");
        } else {
            XB_SPIN(xb_ld(&bar[XB_XGEN(b.x)]) == gen, bar);
            __builtin_amdgcn_fence(__ATOMIC_ACQUIRE, "agent");
            asm volatile("s_waitcnt vmcnt(0)" ::: "memory");
        }
    }
    __syncthreads();
}

constexpr int BATCH = 8, SEQ = 4096, DM = 1024, TOK = BATCH * SEQ, DEPTH = 2;
constexpr int DIN = 5572, NIN = 5632;
constexpr int NH = 8, HD = 64, AW = 512;
constexpr float EPS = 1e-6f;
constexpr float LOG2E = 1.4426950408889634f;
constexpr float C2 = 0.125f * LOG2E;
constexpr int NWAVES = 8;
constexpr int NPHASE = 1 + 5 * DEPTH;

constexpr size_t MiB = 1u << 20;
constexpr size_t WS_CTL = 0, CTL_ZERO_BYTES = 1 * MiB;
constexpr size_t WS_WIN = 1 * MiB;
constexpr size_t WS_WBR = 23 * MiB;
constexpr size_t WS_WOUT = 27 * MiB;
constexpr size_t WS_RSS = 31 * MiB;
constexpr size_t WS_KMP = 33 * MiB;
constexpr size_t WS_WI = 34 * MiB;
constexpr size_t WS_KB = 35 * MiB, WS_VB = 39 * MiB, WS_KI = 43 * MiB;
constexpr size_t WS_QI = 47 * MiB;
constexpr size_t WS_BM = 63 * MiB;
constexpr size_t WS_KMH = 79 * MiB, WS_KML = 79 * MiB + 262144;
constexpr size_t WS_XB = 80 * MiB;
constexpr size_t WS_QA = 144 * MiB, WS_KA = 176 * MiB, WS_VA = 208 * MiB, WS_SGA = 240 * MiB, WS_QB = 272 * MiB, WS_SGB = 304 * MiB;
constexpr size_t WS_TMP = 144 * MiB;
constexpr size_t WS_SMA = 336 * MiB, WS_SMB = 400 * MiB;
constexpr size_t WS_END = 464 * MiB;
constexpr int CW_BAR = 4096;

constexpr int RING_BYTES = 131072;
constexpr int LDSCTL_OFF = RING_BYTES + 28672, MISC_OFF = LDSCTL_OFF + 320;
constexpr int LDS_BYTES = 163840;
static_assert(MISC_OFF + 128 <= LDS_BYTES, "LDS map");

typedef unsigned long long u64;
typedef unsigned u32x4v __attribute__((ext_vector_type(4)));

__device__ __forceinline__ float bf2f(unsigned short v) { return __uint_as_float(((unsigned)v) << 16); }
__device__ __forceinline__ float bflo(unsigned w) { return __uint_as_float(w << 16); }
__device__ __forceinline__ float bfhi(unsigned w) { return __uint_as_float(w & 0xffff0000u); }
__device__ __forceinline__ float sigmoidf_(float v) { return __builtin_amdgcn_rcpf(1.0f + __builtin_amdgcn_exp2f(-v * LOG2E)); }

typedef __attribute__((address_space(4))) const char* kaptr_t;
__device__ __forceinline__ const float* in_ptr(int i) { kaptr_t ka = (kaptr_t)__builtin_amdgcn_kernarg_segment_ptr(); asm volatile("" : "+s"(ka)); return *(const float* const __attribute__((address_space(4)))*)(ka + 8 * i); }
#define PHASE_TID() int tid_o = threadIdx.x; asm volatile("" : "+v"(tid_o)); const int ptid = tid_o, plane = tid_o & 63
struct Frame {
    LAS unsigned char* lds;
    volatile LAS unsigned* MISC;
    gu32* ctl;
    int wave, vcu, G;
    unsigned char* ws;
    float* out;
};

__host__ __device__ __forceinline__ int win_src(int n0, int& nvalid) {
    const int pn = n0 >> 8, c = n0 & 255, bj = c >> 7, wc = (c >> 5) & 3; nvalid = 32;
    if (pn < 2) return 0 + 64 * (4 * pn + wc) + 32 * bj;
    if (pn < 4) return 512 + 64 * (4 * (pn - 2) + wc) + 32 * bj;
    if (pn < 6) return 1024 + 256 * (pn - 4) + c;
    if (pn < 8) return 1536 + 256 * (pn - 6) + c;
    if (pn < 10) return 2048 + 64 * (4 * (pn - 8) + wc) + 32 * bj;
    if (pn == 10) {
        if (wc == 0) return 2560 + 32 * bj;
        if (wc == 1) return 2624 + 32 * bj;
        if (wc == 2) return 3456 + 32 * bj;
        if (bj == 0) { nvalid = 4; return 3520; }
        nvalid = 0; return 0;
    }
    if (pn == 11) return 3200 + c;
    if (pn < 14) return 2688 + 256 * (pn - 12) + c;
    if (pn < 18) return 3524 + 256 * (pn - 14) + c;
    return 4548 + 256 * (pn - 18) + c;
}

__device__ __forceinline__ float wave_sum(float v) {
#pragma unroll
    for (int o = 1; o < 64; o <<= 1) v += __shfl_xor(v, o);
    return v;
}
__device__ __forceinline__ void tr_item(const float* W, int ldw, int src0, int nvalid, const float* gk, bf16* WT, int K, int row0, int k0, LAS float* scr, int lane) {
    const int j = lane & 31;
#pragma unroll 8
    for (int i = 0; i < 32; ++i) { const int kk = 2 * i + (lane >> 5);
        float v = 0.f; if (j < nvalid) { v = W[(size_t)(k0 + kk) * ldw + src0 + j]; if (gk) v *= gk[k0 + kk]; }
        scr[kk * 33 + j] = v; }
    LDS_WAIT(); asm volatile("" ::: "memory");
    const int c = lane & 7;
#pragma unroll
    for (int jj = 0; jj < 4; ++jj) { const int n = (lane >> 3) + 8 * jj; const LAS float* s = scr + (8 * c) * 33 + n;
        v4u o; o.x = pk2(s[0 * 33], s[1 * 33]); o.y = pk2(s[2 * 33], s[3 * 33]); o.z = pk2(s[4 * 33], s[5 * 33]); o.w = pk2(s[6 * 33], s[7 * 33]);
        *(GAS v4u*)(WT + (size_t)(row0 + n) * K + k0 + 8 * c) = o; }
    LDS_WAIT(); asm volatile("" ::: "memory");
}
__device__ __forceinline__ void p0_prologue(Frame& F) {
    PHASE_TID();
    LAS float* scr = (LAS float*)(F.lds + F.wave * 16384);
    const int gw = F.vcu * NWAVES + F.wave, NGW = F.G * NWAVES;
    constexpr int I_IN = (DM / 64) * (NIN / 32), I_BR = (AW / 64) * (DM / 32), I_OUT = (DM / 64) * (DM / 32);
    constexpr int PER_L = I_IN + 2 * I_BR + I_OUT;
    for (int it = gw; it < DEPTH * PER_L; it += NGW) {
        const int l = it / PER_L; int r = it % PER_L;
        if (r < I_IN) { const int kb = r / (NIN / 32), nb = r % (NIN / 32); int nvalid; const int src0 = win_src(32 * nb, nvalid);
            tr_item(in_ptr(2) + (size_t)l * DM * DIN, DIN, src0, nvalid, in_ptr(1) + l * DM, (bf16*)(F.ws + WS_WIN) + (size_t)l * NIN * DM, DM, 32 * nb, 64 * kb, scr, plane); continue; }
        r -= I_IN;
        if (r < 2 * I_BR) { const int which = r / I_BR; r %= I_BR; const int kb = r / (DM / 32), nb = r % (DM / 32);
            tr_item((which ? in_ptr(8) : in_ptr(7)) + (size_t)l * AW * DM, DM, 32 * nb, 32, nullptr, (bf16*)(F.ws + WS_WBR) + (size_t)l * 2048 * AW, AW, which * 1024 + 32 * nb, 64 * kb, scr, plane); continue; }
        r -= 2 * I_BR;
        { const int kb = r / (DM / 32), nb = r % (DM / 32);
            tr_item(in_ptr(9) + (size_t)l * DM * DM, DM, 32 * nb, 32, nullptr, (bf16*)(F.ws + WS_WOUT) + (size_t)l * DM * DM, DM, 32 * nb, 64 * kb, scr, plane); }
    }
    const float* x = in_ptr(0); bf16* XB = (bf16*)(F.ws + WS_XB); float* RSS = (float*)(F.ws + WS_RSS);
    for (int m = gw; m < TOK; m += NGW) {
        const GAS f32x4* xr = (const GAS f32x4*)(x + (size_t)m * DM) + plane;
        f32x4 v[4]; float s = 0.f;
#pragma unroll
        for (int j = 0; j < 4; ++j) { v[j] = xr[64 * j]; s += (v[j].x * v[j].x + v[j].y * v[j].y) + (v[j].z * v[j].z + v[j].w * v[j].w); }
        s = wave_sum(s);
        GAS u64* o8 = (GAS u64*)(XB + (size_t)m * DM) + plane;
#pragma unroll
        for (int j = 0; j < 4; ++j) o8[64 * j] = (u64)pk2(v[j].x, v[j].y) | ((u64)pk2(v[j].z, v[j].w) << 32);
        if (plane < 16) RSS[(size_t)m * 16 + plane] = (plane == 0) ? s : 0.f;
    }
}

namespace pg8 {
__device__ __forceinline__ float row_rs(const float* rss, int row, int fq) {
    const f32x4 a = *(const f32x4*)(rss + (size_t)row * 16 + 4 * fq);
    float s = (a[0] + a[1]) + (a[2] + a[3]);
    s += __shfl_xor(s, 16); s += __shfl_xor(s, 32);
    return __builtin_amdgcn_rsqf(s * (1.0f / DM) + EPS);
}
__device__ __forceinline__ u32x4 pack8(const f32x4 o0, const f32x4 o1) { u32x4 w; w.x = cvt_pk_bf16(o0[0], o0[1]); w.y = cvt_pk_bf16(o0[2], o0[3]); w.z = cvt_pk_bf16(o1[0], o1[1]); w.w = cvt_pk_bf16(o1[2], o1[3]); return w; }
struct EpiIn {
    static constexpr bool PERM = true, AFTER_DRAIN = false, REPEATABLE = true;
    const float* rss; const float *qna, *kna, *qnb, *knb;
    bf16_t *QA, *KA, *VA, *SGA, *QB, *SGB, *KB, *VB, *KI, *QI, *SMA, *SMB; float* WI; float* KMP;
    __device__ __forceinline__ void norm_rows(const f32x4 (&acc)[2][2][4][2], const Unit& u, int wr, int fr, int fq, const float* g, float oscale, bf16_t* dst, int ld, int coloff, float* kmp) const {
        f32x4 gv[2][2];
#pragma unroll
        for (int bj = 0; bj < 2; ++bj)
#pragma unroll
            for (int n = 0; n < 2; ++n) gv[bj][n] = *(const f32x4*)(g + 32 * bj + 8 * fq + 4 * n) * oscale;
        f32x4 cs[2][2];
#pragma unroll
        for (int bj = 0; bj < 2; ++bj)
#pragma unroll
            for (int n = 0; n < 2; ++n) cs[bj][n] = (f32x4){0.f, 0.f, 0.f, 0.f};
#pragma unroll
        for (int ai = 0; ai < 2; ++ai)
#pragma unroll
            for (int m = 0; m < 4; ++m) {
                const int row = u.pm * BM + ai * HALF + wr * 64 + m * 16 + fr; const float rs = row_rs(rss, row, fq);
                float sq = 0.f;
#pragma unroll
                for (int bj = 0; bj < 2; ++bj)
#pragma unroll
                    for (int n = 0; n < 2; ++n) { const f32x4 t = acc[ai][bj][m][n]; sq += (t[0] * t[0] + t[1] * t[1]) + (t[2] * t[2] + t[3] * t[3]); }
                sq += __shfl_xor(sq, 16); sq += __shfl_xor(sq, 32);
                const float sc = rs * __builtin_amdgcn_rsqf(sq * rs * rs * (1.0f / 64.0f) + EPS);
#pragma unroll
                for (int bj = 0; bj < 2; ++bj) {
                    const f32x4 o0 = acc[ai][bj][m][0] * sc * gv[bj][0], o1 = acc[ai][bj][m][1] * sc * gv[bj][1];
                    cs[bj][0] += o0; cs[bj][1] += o1;
                    *(u32x4*)(dst + (size_t)row * ld + coloff + 32 * bj + 8 * fq) = pack8(o0, o1); }
                asm volatile("" ::: "memory");
            }
        if (kmp) {
#pragma unroll
            for (int bj = 0; bj < 2; ++bj)
#pragma unroll
                for (int n = 0; n < 2; ++n) { f32x4 t = cs[bj][n];
#pragma unroll
                    for (int o = 1; o < 16; o <<= 1) { t[0] += __shfl_xor(t[0], o); t[1] += __shfl_xor(t[1], o); t[2] += __shfl_xor(t[2], o); t[3] += __shfl_xor(t[3], o); }
                    if (fr == 0) *(f32x4*)(kmp + 32 * bj + 8 * fq + 4 * n) = t; }
        }
    }
    __device__ __forceinline__ void plain_rows(const f32x4 (&acc)[2][2][4][2], const Unit& u, int wr, int fr, int fq, bf16_t* dst, int ld, int col0, int bjs, float ca, float cb, float cc, float* wi) const {
#pragma unroll
        for (int ai = 0; ai < 2; ++ai)
#pragma unroll
            for (int m = 0; m < 4; ++m) {
                const int row = u.pm * BM + ai * HALF + wr * 64 + m * 16 + fr; const float rs = row_rs(rss, row, fq);
                if (wi) { if (fq == 0) *(f32x4*)(wi + (size_t)row * 4) = acc[ai][0][m][0] * rs; }
                else {
#pragma unroll
                for (int bj = 0; bj < 2; ++bj) { f32x4 o0 = acc[ai][bj][m][0] * rs, o1 = acc[ai][bj][m][1] * rs;
#pragma unroll
                    for (int i = 0; i < 4; ++i) { const float s0 = sigmoidf_(o0[i]), s1 = sigmoidf_(o1[i]); o0[i] = ca * o0[i] + s0 * (cb + cc * o0[i]); o1[i] = ca * o1[i] + s1 * (cb + cc * o1[i]); }
                    *(u32x4*)(dst + (size_t)row * ld + col0 + bj * bjs) = pack8(o0, o1); }
                }
                asm volatile("" ::: "memory");
            }
    }
    __device__ __forceinline__ void operator()(const f32x4 (&acc)[2][2][4][2], const Unit& u, int wr, int wc, int fr_, int fq_) const {
        int fr = fr_, fq = fq_; asm volatile("" : "+v"(fr), "+v"(fq));
        const int pn = u.pn; const int cid = wc * 32 + 8 * fq;
        bool isnorm = false; bf16_t* dst; int ld = AW, col0, bjs = HALF; const float* g = qna; float osc = 1.0f; float* kmp = nullptr; float ca = 1.f, cb = 0.f, cc = 0.f; float* wi = nullptr;
        if (pn < 2) { isnorm = true; g = qna; osc = C2; dst = QA; col0 = 64 * (4 * pn + wc); }
        else if (pn < 4) { isnorm = true; g = kna; dst = KA; const int h = 4 * (pn - 2) + wc; col0 = 64 * h; kmp = KMP + ((((size_t)(u.pm >> 4) * 16 + (u.pm & 15)) * 8 + h) * 2 + wr) * 64; }
        else if (pn < 6) { dst = VA; col0 = 256 * (pn - 4) + cid; }
        else if (pn < 8) { dst = SGA; col0 = 256 * (pn - 6) + cid; ca = 0.f; cc = 1.f; }
        else if (pn < 10) { isnorm = true; g = qnb; osc = C2; dst = QB; col0 = 64 * (4 * (pn - 8) + wc); }
        else if (pn == 10) { ld = 64; bjs = 32; col0 = 8 * fq; dst = KI;
            if (wc == 0) { isnorm = true; g = knb; dst = KB; col0 = 0; } else if (wc == 1) { dst = VB; } else if (wc == 3) { wi = WI; } }
        else if (pn == 11) { dst = QI; ld = 256; col0 = cid; }
        else if (pn < 14) { dst = SGB; col0 = 256 * (pn - 12) + cid; ca = 0.f; cc = 1.f; }
        else if (pn < 18) { dst = SMA; ld = DM; col0 = 256 * (pn - 14) + cid; ca = 0.f; cb = 1.f; }
        else { dst = SMB; ld = DM; col0 = 256 * (pn - 18) + cid; ca = 0.f; cb = 1.f; }
        if (isnorm) norm_rows(acc, u, wr, fr, fq, g, osc, dst, ld, col0, kmp);
        else plain_rows(acc, u, wr, fr, fq, dst, ld, col0, bjs, ca, cb, cc, wi);
    }
};
struct EpiMerge {
    static constexpr bool PERM = true, AFTER_DRAIN = false, REPEATABLE = false;
    const bf16_t* SMA; bf16_t* SMB; float* TMP;
    __device__ __forceinline__ void operator()(const f32x4 (&acc)[2][2][4][2], const Unit& u, int wr, int wc, int fr, int fq) const {
        const bool partb = u.pm >= 128; const int pm = partb ? u.pm - 128 : u.pm, pn = partb ? u.pn - 4 : u.pn;
#pragma unroll
        for (int ai = 0; ai < 2; ++ai)
#pragma unroll
            for (int m = 0; m < 4; ++m) { const int row = pm * BM + ai * HALF + wr * 64 + m * 16 + fr;
#pragma unroll
                for (int bj = 0; bj < 2; ++bj) { const size_t off = (size_t)row * DM + pn * BM + bj * HALF + wc * 32 + 8 * fq;
                    const u32x4 sg = *(const u32x4*)((partb ? SMB : SMA) + off);
                    const f32x4 s0 = (f32x4){__uint_as_float(sg.x << 16), __uint_as_float(sg.x & 0xffff0000u), __uint_as_float(sg.y << 16), __uint_as_float(sg.y & 0xffff0000u)};
                    const f32x4 s1 = (f32x4){__uint_as_float(sg.z << 16), __uint_as_float(sg.z & 0xffff0000u), __uint_as_float(sg.w << 16), __uint_as_float(sg.w & 0xffff0000u)};
                    f32x4 o0 = acc[ai][bj][m][0] * s0, o1 = acc[ai][bj][m][1] * s1;
                    if (!partb) { *(f32x4*)(TMP + off) = o0; *(f32x4*)(TMP + off + 4) = o1; }
                    else { o0 += *(const f32x4*)(TMP + off); o1 += *(const f32x4*)(TMP + off + 4);
                        u32x4 w; w.x = cvt_pk_bf16(o0[0], o0[1]); w.y = cvt_pk_bf16(o0[2], o0[3]); w.z = cvt_pk_bf16(o1[0], o1[1]); w.w = cvt_pk_bf16(o1[2], o1[3]);
                        *(u32x4*)(SMB + off) = w; } }
            }
    }
};
struct PairOrder {
    StaticOrder base;
    __device__ void init(int G_, int c_) { base.init(TOK, DM, G_, c_); }
    __device__ bool next(int i, Unit& u) const { Unit t; if (!base.next(i >> 1, t)) return false; u.pm = t.pm + (i & 1) * 128; u.pn = t.pn + (i & 1) * 4; return true; }
    __device__ __forceinline__ void a_ready(const Unit&) const {}
    __device__ __forceinline__ void done(const Unit&) const {}
};
template <bool WRITE_NEXT> struct EpiOut {
    static constexpr bool PERM = true, AFTER_DRAIN = false, REPEATABLE = false;
    const float* xin; float* out; bf16_t* XB; float* rss;
    __device__ __forceinline__ void operator()(const f32x4 (&acc)[2][2][4][2], const Unit& u, int wr, int wc, int fr, int fq) const {
#pragma unroll
        for (int ai = 0; ai < 2; ++ai)
#pragma unroll
            for (int m = 0; m < 4; ++m) { const int row = u.pm * BM + ai * HALF + wr * 64 + m * 16 + fr; float ss = 0.f;
#pragma unroll
                for (int bj = 0; bj < 2; ++bj) { const size_t off = (size_t)row * DM + u.pn * BM + bj * HALF + wc * 32 + 8 * fq;
                    const f32x4 o0 = acc[ai][bj][m][0] + *(const f32x4*)(xin + off), o1 = acc[ai][bj][m][1] + *(const f32x4*)(xin + off + 4);
                    *(f32x4*)(out + off) = o0; *(f32x4*)(out + off + 4) = o1;
                    if (WRITE_NEXT) { ss += (o0[0] * o0[0] + o0[1] * o0[1]) + (o0[2] * o0[2] + o0[3] * o0[3]) + (o1[0] * o1[0] + o1[1] * o1[1]) + (o1[2] * o1[2] + o1[3] * o1[3]);
                        u32x4 w; w.x = cvt_pk_bf16(o0[0], o0[1]); w.y = cvt_pk_bf16(o0[2], o0[3]); w.z = cvt_pk_bf16(o1[0], o1[1]); w.w = cvt_pk_bf16(o1[2], o1[3]);
                        *(u32x4*)(XB + off) = w; } }
                if (WRITE_NEXT) { ss += __shfl_xor(ss, 16); ss += __shfl_xor(ss, 32); if (fq == 0) rss[(size_t)row * 16 + 4 * u.pn + wc] = ss; }
            }
    }
};
}

__device__ __forceinline__ int rel_bucket_dev(int n) {
    if (n < 16) return n;
    int large = 16 + (int)(logf((float)n / 16.0f) / logf(8.0f) * 16.0f);
    return large < 31 ? large : 31;
}
__device__ __forceinline__ void build_bias_table(Frame& F, LAS float* tb, const float* gq, const float* gk, int hoff) {
    PHASE_TID(); const float* rb = in_ptr(10);
    float gm = 0.f;
    for (int d = 0; d < 64; ++d) gm = fmaxf(gm, fabsf(gq[d] * gk[d]));
    for (int e = ptid; e < 8 * 128; e += NWAVES * 64) { const int h = e >> 7, d = e & 127;
        float bm = -1e30f; for (int k = 0; k < 32; ++k) bm = fmaxf(bm, rb[k * 16 + hoff + h]);
        const float M0 = 64.0f * C2 * gm + bm * LOG2E;
        tb[e] = rb[rel_bucket_dev(d) * 16 + hoff + h] * LOG2E - M0; }
}

template <int MODE>
__device__ __forceinline__ void naive_attn(Frame& F, int layer) {
    PHASE_TID();
    LAS float* tb = (LAS float*)F.lds;
    const float* gq = in_ptr(MODE == 0 ? 3 : 5) + layer * 64; const float* gk = in_ptr(MODE == 0 ? 4 : 6) + layer * 64;
    build_bias_table(F, tb, gq, gk, MODE * 8);
    __syncthreads();
    const bf16* Q = (const bf16*)(F.ws + (MODE == 0 ? WS_QA : WS_QB));
    const bf16* K = (const bf16*)(F.ws + (MODE == 0 ? WS_KA : WS_KB));
    const bf16* V = (const bf16*)(F.ws + (MODE == 0 ? WS_VA : WS_VB));
    const bf16* SG = (const bf16*)(F.ws + (MODE == 0 ? WS_SGA : WS_SGB));
    bf16* Y = (bf16*)(F.ws + WS_XB) + (size_t)MODE * TOK * AW;
    const float* KMP = (const float*)(F.ws + WS_KMP);
    const u64* BM = (const u64*)(F.ws + WS_BM);
    constexpr int KLD = (MODE == 0) ? AW : 64;
    for (int item = blockIdx.x * (NWAVES * 64) + ptid; item < BATCH * NH * SEQ; item += F.G * NWAVES * 64) {
        const int q = item & (SEQ - 1), h = (item >> 12) & 7, b = item >> 15; const int qblk = q >> 8;
        const size_t tq = (size_t)b * SEQ + q;
        float qv[64];
        { const v4u* qp = (const v4u*)(Q + tq * AW + h * 64);
#pragma unroll
            for (int c = 0; c < 8; ++c) { const v4u w = qp[c]; qv[8 * c + 0] = bflo(w.x); qv[8 * c + 1] = bfhi(w.x); qv[8 * c + 2] = bflo(w.y); qv[8 * c + 3] = bfhi(w.y); qv[8 * c + 4] = bflo(w.z); qv[8 * c + 5] = bfhi(w.z); qv[8 * c + 6] = bflo(w.w); qv[8 * c + 7] = bfhi(w.w); } }
        unsigned selmask = 0;
        if (MODE == 0) {
            float gate[16];
#pragma unroll
            for (int n = 0; n < 16; ++n) { gate[n] = -INFINITY;
                if (n < qblk) { const float* k0 = KMP + ((((size_t)b * 16 + n) * 8 + h) * 2) * 64; float s = 0.f;
#pragma unroll
                    for (int d = 0; d < 64; ++d) s += qv[d] * ((k0[d] + k0[64 + d]) * (1.0f / 256.0f));
                    gate[n] = s; } }
            const int nsel = qblk < 3 ? qblk : 3;
            for (int r = 0; r < nsel; ++r) { float best = -INFINITY; int bi = -1;
#pragma unroll
                for (int n = 0; n < 16; ++n) { const bool ok = (n < qblk) && !((selmask >> n) & 1u) && (bi < 0 || gate[n] > best); if (ok) { best = gate[n]; bi = n; } }
                selmask |= 1u << bi; }
        }
        float acc[64];
#pragma unroll
        for (int d = 0; d < 64; ++d) acc[d] = 0.f;
        float l = 0.f;
        const int kend = (item | 63) & (SEQ - 1);
        const LAS float* tbh = tb + h * 128;
        u64 mw = 0;
        for (int k = 0; k <= kend; ++k) {
            bool allowed;
            if (MODE == 0) { const int n = k >> 8; allowed = (n == qblk) ? (k <= q) : (((selmask >> n) & 1u) != 0u && n < qblk); }
            else { if ((k & 63) == 0) mw = (k <= q) ? BM[tq * 64 + (k >> 6)] : 0ull; allowed = ((mw >> (k & 63)) & 1ull) != 0ull; }
            if (!__any(allowed)) continue;
            const size_t tk = (size_t)b * SEQ + k;
            const v4u* kp = (const v4u*)(K + tk * KLD + (MODE == 0 ? h * 64 : 0));
            float s = 0.f;
#pragma unroll
            for (int c = 0; c < 8; ++c) { const v4u w = kp[c];
                s += qv[8 * c + 0] * bflo(w.x); s += qv[8 * c + 1] * bfhi(w.x); s += qv[8 * c + 2] * bflo(w.y); s += qv[8 * c + 3] * bfhi(w.y);
                s += qv[8 * c + 4] * bflo(w.z); s += qv[8 * c + 5] * bfhi(w.z); s += qv[8 * c + 6] * bflo(w.w); s += qv[8 * c + 7] * bfhi(w.w); }
            int dist = q - k; dist = dist < 0 ? 0 : (dist > 127 ? 127 : dist);
            s += tbh[dist];
            const float p = allowed ? __builtin_amdgcn_exp2f(s) : 0.f;
            l += p;
            const v4u* vp = (const v4u*)(V + tk * KLD + (MODE == 0 ? h * 64 : 0));
#pragma unroll
            for (int c = 0; c < 8; ++c) { const v4u w = vp[c];
                acc[8 * c + 0] += p * bflo(w.x); acc[8 * c + 1] += p * bfhi(w.x); acc[8 * c + 2] += p * bflo(w.y); acc[8 * c + 3] += p * bfhi(w.y);
                acc[8 * c + 4] += p * bflo(w.z); acc[8 * c + 5] += p * bfhi(w.z); acc[8 * c + 6] += p * bflo(w.w); acc[8 * c + 7] += p * bfhi(w.w); }
        }
        const float il = 1.0f / l;
        const v4u* gp = (const v4u*)(SG + tq * AW + h * 64); v4u* yp = (v4u*)(Y + tq * AW + h * 64);
#pragma unroll
        for (int c = 0; c < 8; ++c) { const v4u g = gp[c]; v4u o;
            o.x = pk2(acc[8 * c + 0] * il * bflo(g.x), acc[8 * c + 1] * il * bfhi(g.x)); o.y = pk2(acc[8 * c + 2] * il * bflo(g.y), acc[8 * c + 3] * il * bfhi(g.y));
            o.z = pk2(acc[8 * c + 4] * il * bflo(g.z), acc[8 * c + 5] * il * bfhi(g.z)); o.w = pk2(acc[8 * c + 6] * il * bflo(g.w), acc[8 * c + 7] * il * bfhi(g.w));
            yp[c] = o; }
    }
}

typedef float f32x16 __attribute__((ext_vector_type(16)));
typedef short s16x4 __attribute__((ext_vector_type(4)));
typedef short v4i16_t __attribute__((ext_vector_type(4)));
constexpr int AT_D = 4, AT_R = AT_D + 2;
constexpr int AT_RING = 0, AT_STAGE = 16384, AT_OST = 0  , AT_TB = AT_R * AT_STAGE, AT_WS = AT_TB + 8192, AT_BM = AT_WS + 2048;
static_assert(8 * 8192 <= AT_R * AT_STAGE && AT_BM + 16384 <= LDSCTL_OFF, "attention LDS");
__device__ __forceinline__ void glds16(const void* gsrc, unsigned lds_dst) { unsigned keep;
    asm volatile("s_mov_b32 %0, m0\n\ts_mov_b32 m0, %2\n\ts_nop 0\n\tglobal_load_lds_dwordx4 %1, off\n\ts_mov_b32 m0, %0" : "=&s"(keep) : "v"(gsrc), "s"(lds_dst) : "memory"); }
#define AT_WAIT_BAR() asm volatile("s_waitcnt vmcnt(0) lgkmcnt(0)\n\ts_barrier" ::: "memory")
#define AT_WAIT_BAR_N(N) asm volatile("s_waitcnt vmcnt(%0) lgkmcnt(0)\n\ts_barrier" :: "n"(N) : "memory")
__device__ __forceinline__ int crow(int r, int hi) { return (r & 3) + 8 * (r >> 2) + 4 * hi; }
__device__ __forceinline__ unsigned cvtpk(float lo, float hi) { unsigned r; asm volatile("v_cvt_pk_bf16_f32 %0, %1, %2" : "=v"(r) : "v"(lo), "v"(hi)); return r; }

template <int MODE>
__device__ __forceinline__ void attn_unit(Frame& F, int b, int h_, int blk) {
    int tid_o = threadIdx.x; asm volatile("" : "+v"(tid_o));
    const int lane = tid_o & 63, r32 = lane & 31, hi = lane >> 5, wid = __builtin_amdgcn_readfirstlane(tid_o >> 6);
    constexpr int KLD = (MODE == 0) ? AW : 64;
    const int h = (MODE == 0) ? h_ : wid;
    const int q0 = (MODE == 0) ? 256 * blk + 32 * wid : 32 * blk;
    const int q = q0 + r32; const size_t tq = (size_t)b * SEQ + q;
    const int NT = (MODE == 0) ? 4 * (blk + 1) : (32 * blk + 31) / 64 + 1;
    const bf16* Q = (const bf16*)(F.ws + (MODE == 0 ? WS_QA : WS_QB));
    const bf16* Kg = (const bf16*)(F.ws + (MODE == 0 ? WS_KA : WS_KB)) + (size_t)b * SEQ * KLD + (MODE == 0 ? h * 64 : 0);
    const bf16* Vg = (const bf16*)(F.ws + (MODE == 0 ? WS_VA : WS_VB)) + (size_t)b * SEQ * KLD + (MODE == 0 ? h * 64 : 0);
    const bf16* SG = (const bf16*)(F.ws + (MODE == 0 ? WS_SGA : WS_SGB));
    bf16* Y = (bf16*)(F.ws + WS_XB) + (size_t)MODE * TOK * AW;
    const u64* BM = (const u64*)(F.ws + WS_BM) + tq * 64;
    LAS unsigned char* lds = F.lds;
    const LAS float* tbh = (const LAS float*)(lds + AT_TB) + (MODE * 8 + h) * 128;
    LAS float* wsf = (LAS float*)(lds + AT_WS) + wid * 64;
    LAS float* ost = (LAS float*)(lds + AT_OST) + wid * 2048;
    const int krow_ = 8 * wid + (lane >> 3);
    const bf16* ksrc = Kg + (size_t)krow_ * KLD + 8 * ((lane & 7) ^ ((krow_ ^ (krow_ >> 3)) & 7));
    const bf16* vsrc = Vg + (size_t)(8 * wid + ((lane & 31) >> 2)) * KLD + 32 * (lane >> 5) + 8 * (lane & 3);
    const unsigned lds0 = (unsigned)(uintptr_t)lds;
#define AT_DMA(t, so) do { \
        glds16(ksrc + (size_t)(t) * 64 * KLD, (unsigned)__builtin_amdgcn_readfirstlane((int)(lds0 + AT_RING + (so) + wid * 1024))); \
        glds16(vsrc + (size_t)(t) * 64 * KLD, (unsigned)__builtin_amdgcn_readfirstlane((int)(lds0 + AT_RING + (so) + 8192 + wid * 1024))); } while (0)
#pragma unroll
    for (int i = 0; i < AT_D; ++i) AT_DMA((i < NT ? i : NT - 1), i * AT_STAGE);
    bf16x8 qr[4];
#pragma unroll
    for (int d0 = 0; d0 < 4; ++d0) qr[d0] = *(const bf16x8*)(Q + tq * AW + h * 64 + 16 * d0 + 8 * hi);
    LAS u64* bmL = (LAS u64*)(lds + AT_BM);
    if (MODE == 1) {
        const u64* BMu = (const u64*)(F.ws + WS_BM) + ((size_t)b * SEQ + q0) * 64;
#pragma unroll
        for (int ps = 0; ps < 2; ++ps) { const int it = ps * 512 + (tid_o & 511), row = it >> 5, j2 = (it & 31) * 2;
            const v4u w = *(const v4u*)(BMu + (size_t)row * 64 + j2);
            bmL[j2 * 32 + row] = (u64)w.x | ((u64)w.y << 32); bmL[(j2 + 1) * 32 + row] = (u64)w.z | ((u64)w.w << 32); }
    }
    unsigned selmask = 0;
    if (MODE == 0 && blk > 0) {
        const bf16* kmh = (const bf16*)(F.ws + WS_KMH) + ((size_t)(b * 8 + h) * 32 + r32) * 64 + 8 * hi;
        const bf16* kml = (const bf16*)(F.ws + WS_KML) + ((size_t)(b * 8 + h) * 32 + r32) * 64 + 8 * hi;
        f32x16 gg;
#pragma unroll
        for (int r = 0; r < 16; ++r) gg[r] = 0.f;
#pragma unroll
        for (int d0 = 0; d0 < 4; ++d0) {
            gg = __builtin_amdgcn_mfma_f32_32x32x16_bf16(*(const bf16x8*)(kmh + 16 * d0), qr[d0], gg, 0, 0, 0);
            gg = __builtin_amdgcn_mfma_f32_32x32x16_bf16(*(const bf16x8*)(kml + 16 * d0), qr[d0], gg, 0, 0, 0); }
        float gate[16];
#pragma unroll
        for (int r = 0; r < 8; ++r) { const float o = __shfl_xor(gg[r], 32); const int nb_ = (r & 3) + 8 * (r >> 2); gate[nb_] = hi ? o : gg[r]; gate[nb_ + 4] = hi ? gg[r] : o; }
        const int nsel = blk < 3 ? blk : 3;
        for (int r = 0; r < nsel; ++r) { float best = -INFINITY; int bi = -1;
#pragma unroll
            for (int n = 0; n < 16; ++n) { const bool ok = (n < blk) && !((selmask >> n) & 1u) && (bi < 0 || gate[n] > best); if (ok) { best = gate[n]; bi = n; } }
            selmask |= 1u << bi; }
    }
    const float cfar = tbh[127]; const float NINF = -INFINITY;
#define AT_INIT_NEAR(t, c0, c1, mw) do { \
        const int kv0_ = 64 * (t); \
        bool sel_ = (t) < NT; \
        if (MODE == 0) { const int n_ = (t) >> 2; sel_ = sel_ && ((n_ == blk) || (((selmask >> (n_ & 15)) & 1u) != 0u)); } \
        unsigned mlo_ = 0, mhi_ = 0; if (MODE == 1) { const u64 ms_ = (mw) >> (4 * hi); mlo_ = (unsigned)ms_; mhi_ = (unsigned)(ms_ >> 32); } \
        _Pragma("unroll") for (int r = 0; r < 16; ++r) { const int bp = (r & 3) + 8 * (r >> 2); \
            const int d0_ = q - (kv0_ + bp + 4 * hi), d1_ = d0_ - 32; \
            const float b0_ = tbh[d0_ < 0 ? 0 : (d0_ > 127 ? 127 : d0_)], b1_ = tbh[d1_ < 0 ? 0 : (d1_ > 127 ? 127 : d1_)]; \
            if (MODE == 0) { c0[r] = (sel_ && d0_ >= 0) ? b0_ : NINF; c1[r] = (sel_ && d1_ >= 0) ? b1_ : NINF; } \
            else { c0[r] = (sel_ && ((mlo_ >> bp) & 1u)) ? b0_ : NINF; c1[r] = (sel_ && ((mhi_ >> bp) & 1u)) ? b1_ : NINF; } } } while (0)
#define AT_INIT_FARB(t, c0, c1, mw) do { \
        const u64 ms_ = ((t) < NT) ? ((mw) >> (4 * hi)) : 0ull; const int mlo_ = (int)(unsigned)ms_, mhi_ = (int)(unsigned)(ms_ >> 32); \
        const unsigned cf_ = __float_as_uint(cfar), nf_ = 0xff800000u; \
        _Pragma("unroll") for (int r = 0; r < 16; ++r) { const int bp = (r & 3) + 8 * (r >> 2); \
            const unsigned m0_ = (unsigned)__builtin_amdgcn_sbfe(mlo_, bp, 1), m1_ = (unsigned)__builtin_amdgcn_sbfe(mhi_, bp, 1); \
            c0[r] = __uint_as_float((m0_ & cf_) | (~m0_ & nf_)); c1[r] = __uint_as_float((m1_ & cf_) | (~m1_ & nf_)); } } while (0)
    const int kswz = (r32 ^ (r32 >> 3)) & 7;
#define AT_KF(Kt_, d0, p) (*(const LAS bf16x8*)((Kt_) + (p) * 4096 + (((2 * (d0) + hi) ^ kswz ^ (4 * (p))) << 4)))
#define AT_QK(so, c0, c1, i0, i1) do { const LAS unsigned char* Kt_ = lds + AT_RING + (so) + r32 * 128; \
        c0 = __builtin_amdgcn_mfma_f32_32x32x16_bf16(AT_KF(Kt_, 0, 0), qr[0], i0, 0, 0, 0); \
        c1 = __builtin_amdgcn_mfma_f32_32x32x16_bf16(AT_KF(Kt_, 0, 1), qr[0], i1, 0, 0, 0); \
        _Pragma("unroll") for (int d0 = 1; d0 < 4; ++d0) { \
            c0 = __builtin_amdgcn_mfma_f32_32x32x16_bf16(AT_KF(Kt_, d0, 0), qr[d0], c0, 0, 0, 0); \
            c1 = __builtin_amdgcn_mfma_f32_32x32x16_bf16(AT_KF(Kt_, d0, 1), qr[d0], c1, 0, 0, 0); } } while (0)
#define AT_SCORES(t, kf, c0, c1, mw) do { \
        const bool nearD_ = (q0 - (64 * (t) + 63)) < 113; \
        if (nearD_) { AT_INIT_NEAR(t, c0, c1, mw); AT_QK(kf, c0, c1, c0, c1); } \
        else if (MODE == 0) { AT_QK(kf, c0, c1, ivec, ivec); } \
        else { AT_INIT_FARB(t, c0, c1, mw); AT_QK(kf, c0, c1, c0, c1); } } while (0)
#define AT_IVEC(t) do { if (MODE == 0) { const int n_ = (t) >> 2; const bool s_ = ((t) < NT) && ((n_ == blk) || (((selmask >> (n_ & 15)) & 1u) != 0u)); const float v_ = s_ ? cfar : NINF; \
        _Pragma("unroll") for (int r = 0; r < 16; ++r) ivec[r] = v_; asm volatile("" : "+v"(ivec)); } } while (0)
#ifndef EXP_LDS
#define EXP_LDS 0
#endif
#ifndef EXP_EXP
#define EXP_EXP 0
#endif
#ifndef EXP_MFMA
#define EXP_MFMA 0
#endif
    f32x16 o0, o1, ivec; pg8::f32x4 dm4a = (pg8::f32x4){0.f,0.f,0.f,0.f}, dm4b = (pg8::f32x4){0.f,0.f,0.f,0.f}; f32x16 dmy; if (EXP_MFMA) { _Pragma("unroll") for (int r = 0; r < 16; ++r) dmy[r] = 0.f; }
#pragma unroll
    for (int r = 0; r < 16; ++r) { o0[r] = 0.f; o1[r] = 0.f; ivec[r] = NINF; }
    float lsum = 0.f;
    f32x16 ca0, ca1, cb0, cb1;
    AT_WAIT_BAR_N(2 * (AT_D - 1));
    AT_IVEC(0);
    { u64 mw0 = 0ull; if (MODE == 1) mw0 = bmL[r32];
      AT_SCORES(0, 0, ca0, ca1, mw0); }
    const int vbl = ((lane >> 4) & 1) * 32 + (lane & 3) * 8 + (4 * hi + ((lane & 15) >> 2)) * 64;
    int so_cur = 0, so_nxt = AT_STAGE, so_dma = AT_D * AT_STAGE;
#define AT_STEP(t, C0, C1, N0, N1) do { \
        u64 mw1_ = 0ull; if (MODE == 1) mw1_ = bmL[(((t) + 1) & 63) * 32 + r32]; \
        const LAS unsigned char* Vt_ = lds + AT_RING + so_cur + 8192; \
        asm volatile("" ::: "memory"); \
        if ((((t) + 1) & 3) == 0) AT_IVEC((t) + 1); \
        AT_SCORES((t) + 1, so_nxt, N0, N1, mw1_); \
        float sacc_ = 0.f; \
        if (EXP_EXP) { _Pragma("unroll") for (int r = 0; r < 16; ++r) { float e0_ = __builtin_amdgcn_exp2f(C0[r] + 1.0f), e1_ = __builtin_amdgcn_exp2f(C1[r] + 1.0f); asm volatile("" :: "v"(e0_), "v"(e1_)); } } \
        _Pragma("unroll") for (int r = 0; r < 16; ++r) { C0[r] = __builtin_amdgcn_exp2f(C0[r]); C1[r] = __builtin_amdgcn_exp2f(C1[r]); sacc_ += C0[r] + C1[r]; } \
        lsum += sacc_; \
        u32x4v pw_[4]; \
        _Pragma("unroll") for (int s_ = 0; s_ < 2; ++s_) { \
            pw_[s_] = (u32x4v){cvtpk(C0[8 * s_], C0[8 * s_ + 1]), cvtpk(C0[8 * s_ + 2], C0[8 * s_ + 3]), cvtpk(C0[8 * s_ + 4], C0[8 * s_ + 5]), cvtpk(C0[8 * s_ + 6], C0[8 * s_ + 7])}; \
            pw_[2 + s_] = (u32x4v){cvtpk(C1[8 * s_], C1[8 * s_ + 1]), cvtpk(C1[8 * s_ + 2], C1[8 * s_ + 3]), cvtpk(C1[8 * s_ + 4], C1[8 * s_ + 5]), cvtpk(C1[8 * s_ + 6], C1[8 * s_ + 7])}; } \
        _Pragma("unroll") for (int ks = 0; ks < 4; ++ks) { const bf16x8 pa_ = __builtin_bit_cast(bf16x8, pw_[ks]); \
            _Pragma("unroll") for (int d0 = 0; d0 < 2; ++d0) { const LAS unsigned char* vp_ = Vt_ + (2 * ks) * 1024 + d0 * 512 + vbl; \
                const s16x4 lo_ = __builtin_bit_cast(s16x4, __builtin_amdgcn_ds_read_tr16_b64_v4i16((LAS v4i16_t*)vp_)), hh_ = __builtin_bit_cast(s16x4, __builtin_amdgcn_ds_read_tr16_b64_v4i16((LAS v4i16_t*)(vp_ + 1024))); \
                if (EXP_LDS) { s16x4 l2_ = __builtin_bit_cast(s16x4, __builtin_amdgcn_ds_read_tr16_b64_v4i16((LAS v4i16_t*)(vp_ + 2048))), h2_ = __builtin_bit_cast(s16x4, __builtin_amdgcn_ds_read_tr16_b64_v4i16((LAS v4i16_t*)(vp_ + 3072))); asm volatile("" :: "v"(l2_), "v"(h2_)); } \
                const bf16x8 vf_ = (bf16x8){lo_[0], lo_[1], lo_[2], lo_[3], hh_[0], hh_[1], hh_[2], hh_[3]}; \
                if (d0 == 0) o0 = __builtin_amdgcn_mfma_f32_32x32x16_bf16(pa_, vf_, o0, 0, 0, 0); else o1 = __builtin_amdgcn_mfma_f32_32x32x16_bf16(pa_, vf_, o1, 0, 0, 0); \
                if (EXP_MFMA == 1) { dmy = __builtin_amdgcn_mfma_f32_32x32x16_bf16(pa_, vf_, dmy, 0, 0, 0); } \
                if (EXP_MFMA == 2) { dm4a = __builtin_amdgcn_mfma_f32_16x16x32_bf16(pa_, vf_, dm4a, 0, 0, 0); dm4b = __builtin_amdgcn_mfma_f32_16x16x32_bf16(vf_, pa_, dm4b, 0, 0, 0); } } } \
        so_cur = so_nxt; so_nxt = (so_nxt == (AT_R - 1) * AT_STAGE) ? 0 : so_nxt + AT_STAGE; } while (0)
    for (int t = 0; t < NT; t += 2) {
        AT_WAIT_BAR_N(2 * (AT_D - 3));
        { const int td_ = t + AT_D; AT_DMA((td_ < NT ? td_ : NT - 1), so_dma); so_dma = (so_dma == (AT_R - 1) * AT_STAGE) ? 0 : so_dma + AT_STAGE; }
        { const int td_ = t + AT_D + 1; AT_DMA((td_ < NT ? td_ : NT - 1), so_dma); so_dma = (so_dma == (AT_R - 1) * AT_STAGE) ? 0 : so_dma + AT_STAGE; }
        AT_STEP(t, ca0, ca1, cb0, cb1);
        AT_STEP(t + 1, cb0, cb1, ca0, ca1);
    }
    if (EXP_MFMA == 1) asm volatile("" :: "v"(dmy));
    if (EXP_MFMA == 2) asm volatile("" :: "v"(dm4a), "v"(dm4b));
    AT_WAIT_BAR();
    lsum += __shfl_xor(lsum, 32);
    if (hi == 0) wsf[r32] = lsum;
    LDS_WAIT(); asm volatile("" ::: "memory");
#pragma unroll
    for (int r = 0; r < 16; ++r) { const int orow = crow(r, hi); const float rl = __builtin_amdgcn_rcpf(wsf[orow]);
        ost[orow * 64 + r32] = o0[r] * rl; ost[orow * 64 + 32 + r32] = o1[r] * rl; }
    LDS_WAIT(); asm volatile("" ::: "memory");
#pragma unroll
    for (int i = 0; i < 4; ++i) { const int row = i * 8 + (lane >> 3), ch = lane & 7;
        const f32x4 a = *(const LAS f32x4*)(ost + row * 64 + ch * 8), c = *(const LAS f32x4*)(ost + row * 64 + ch * 8 + 4);
        const size_t off = ((size_t)b * SEQ + q0 + row) * AW + h * 64 + ch * 8;
        const v4u g = *(const v4u*)(SG + off); v4u o;
        o.x = pk2(a[0] * bflo(g.x), a[1] * bfhi(g.x)); o.y = pk2(a[2] * bflo(g.y), a[3] * bfhi(g.y)); o.z = pk2(c[0] * bflo(g.z), c[1] * bfhi(g.z)); o.w = pk2(c[2] * bflo(g.w), c[3] * bfhi(g.w));
        *(v4u*)(Y + off) = o; }
    AT_WAIT_BAR();
#undef AT_DMA
#undef AT_INIT_NEAR
#undef AT_INIT_FARB
#undef AT_QK
#undef AT_KF
#undef AT_SCORES
#undef AT_IVEC
#undef AT_STEP
}
__device__ __forceinline__ void attn_phase_fast(Frame& F, int layer) {
    { LAS float* tb = (LAS float*)(F.lds + AT_TB);
      build_bias_table(F, tb, in_ptr(3) + layer * 64, in_ptr(4) + layer * 64, 0);
      build_bias_table(F, tb + 1024, in_ptr(5) + layer * 64, in_ptr(6) + layer * 64, 8); }
    __syncthreads();
#ifndef REP_ATT_A
#define REP_ATT_A 1
#endif
#ifndef REP_ATT_B
#define REP_ATT_B 1
#endif
    for (int rep = 0; rep < REP_ATT_A; ++rep)
    for (int pr = F.vcu; pr < 512; pr += F.G) {
        const int bh = pr >> 3, s = pr & 7;
        attn_unit<0>(F, bh >> 3, bh & 7, 15 - s); attn_unit<0>(F, bh >> 3, bh & 7, s); }
    for (int rep = 0; rep < REP_ATT_B; ++rep)
    for (int pr = F.vcu; pr < 512; pr += F.G) {
        const int b = pr >> 6, s = pr & 63;
        attn_unit<1>(F, b, 0, 127 - s); attn_unit<1>(F, b, 0, s); }
}

constexpr int IDX_S_OFF = 0, IDX_Q_OFF = RING_BYTES, IDX_W_OFF = RING_BYTES + 8192, IDX_H_OFF = RING_BYTES;
static_assert(IDX_H_OFF + 8 * 3328 <= LDSCTL_OFF, "idx LDS");

#define DPPI_(x, ctrl) __builtin_amdgcn_update_dpp(0, (x), (ctrl), 0xF, 0xF, true)
#define DPPF_(x, ctrl) __builtin_bit_cast(float, DPPI_(__builtin_bit_cast(int, (x)), (ctrl)))
__device__ __forceinline__ float rl_f(float x, int l) { return __builtin_bit_cast(float, __builtin_amdgcn_readlane(__builtin_bit_cast(int, x), l)); }
__device__ __forceinline__ float wave_minf(float x) {
    x = fminf(x, DPPF_(x, 0xB1)); x = fminf(x, DPPF_(x, 0x4E)); x = fminf(x, DPPF_(x, 0x141)); x = fminf(x, DPPF_(x, 0x140));
    return fminf(fminf(rl_f(x, 0), rl_f(x, 16)), fminf(rl_f(x, 32), rl_f(x, 48)));
}
__device__ __forceinline__ float wave_maxf(float x) {
    x = fmaxf(x, DPPF_(x, 0xB1)); x = fmaxf(x, DPPF_(x, 0x4E)); x = fmaxf(x, DPPF_(x, 0x141)); x = fmaxf(x, DPPF_(x, 0x140));
    return fmaxf(fmaxf(rl_f(x, 0), rl_f(x, 16)), fmaxf(rl_f(x, 32), rl_f(x, 48)));
}
#define SEL_OPAQUE() do { _Pragma("unroll") for (int j_ = 0; j_ < 64; ++j_) asm volatile("" : "+v"(v[j_])); } while (0)
__device__ __forceinline__ unsigned bin_of(float x, float lo, float scale) {
    int r; const float t = (x - lo) * scale; asm("v_cvt_i32_f32 %0, %1" : "=v"(r) : "v"(t)); const unsigned u = (unsigned)r; return u < 256u ? u : 256u;
}
__device__ __forceinline__ void select_core(LAS float* R, int n, int lane, LAS unsigned* hist, float& T_out, int& needT_out) {
    const int nch = (n + 63) >> 6;
    if (64 * (nch - 1) + lane >= n) R[64 * (nch - 1) + lane] = -INFINITY;
    LDS_WAIT(); asm volatile("" ::: "memory");
    const LAS float* Rl = R + lane;
    float lo = INFINITY, hi = -INFINITY;
#pragma unroll 4
    for (int j = 0; j < nch; ++j) { const float x = Rl[64 * j]; lo = fminf(lo, x == -INFINITY ? INFINITY : x); hi = fmaxf(hi, x); }
    lo = wave_minf(lo); hi = wave_maxf(hi);
    int need = 256; float T = lo; int needT = 256;
    for (int iter = 0; iter < 48; ++iter) {
        T = lo; needT = need;
        if (!(hi > lo)) break;
        hist[lane] = 0u; hist[64 + lane] = 0u; hist[128 + lane] = 0u; hist[192 + lane] = 0u; hist[256 + (lane & 3)] = 0u;
        LDS_WAIT(); asm volatile("" ::: "memory");
        const float scale = 255.99f / (hi - lo);
#pragma unroll 4
        for (int j = 0; j < nch; ++j) __hip_atomic_fetch_add(hist + bin_of(Rl[64 * j], lo, scale), 1u, __ATOMIC_RELAXED, __HIP_MEMORY_SCOPE_WORKGROUP);
        LDS_WAIT(); asm volatile("" ::: "memory");
        const unsigned h0 = hist[4 * lane], h1 = hist[4 * lane + 1], h2 = hist[4 * lane + 2], h3 = hist[4 * lane + 3];
        unsigned suf = h0 + h1 + h2 + h3;
#pragma unroll
        for (int o = 1; o < 64; o <<= 1) { const unsigned t = __shfl_down(suf, o); if (lane + o < 64) suf += t; }
        const u64 bal = __ballot(suf >= (unsigned)need);
        if (bal == 0ull) break;
        const int ls = 63 - __builtin_clzll(bal);
        const unsigned a3 = __builtin_amdgcn_readlane(h3, ls), a2 = __builtin_amdgcn_readlane(h2, ls), a1 = __builtin_amdgcn_readlane(h1, ls), a0 = __builtin_amdgcn_readlane(h0, ls);
        const unsigned above_lane = __builtin_amdgcn_readlane(suf, ls) - (a0 + a1 + a2 + a3);
        unsigned bstar, above, cstar;
        if (above_lane + a3 >= (unsigned)need) { bstar = 4 * ls + 3; above = above_lane; cstar = a3; }
        else if (above_lane + a3 + a2 >= (unsigned)need) { bstar = 4 * ls + 2; above = above_lane + a3; cstar = a2; }
        else if (above_lane + a3 + a2 + a1 >= (unsigned)need) { bstar = 4 * ls + 1; above = above_lane + a3 + a2; cstar = a1; }
        else { bstar = 4 * ls; above = above_lane + a3 + a2 + a1; cstar = a0; }
        need -= (int)above;
        float nlo = INFINITY, nhi = -INFINITY; int cnt = 0;
        LAS float* candx = (LAS float*)hist; LAS unsigned* candi = hist + 64;
#pragma unroll 4
        for (int j = 0; j < nch; ++j) { const float x = Rl[64 * j];
            const bool c = bin_of(x, lo, scale) == bstar;
            const u64 cb = __ballot(c);
            if (cb != 0ull) { nlo = fminf(nlo, c ? x : INFINITY); nhi = fmaxf(nhi, c ? x : -INFINITY);
                const int pos = cnt + (int)__builtin_amdgcn_mbcnt_hi((unsigned)(cb >> 32), __builtin_amdgcn_mbcnt_lo((unsigned)cb, 0u));
                if (c && pos < 64) { candx[pos] = x; candi[pos] = (unsigned)(64 * j + lane); }
                cnt += __builtin_popcountll(cb); } }
        if (cstar <= 64u) {
            LDS_WAIT(); asm volatile("" ::: "memory");
            const bool mine = lane < (int)cstar;
            const float mx = mine ? candx[lane] : -INFINITY; const unsigned mi = candi[lane];
            int rank = 0;
            for (int i = 0; i < (int)cstar; ++i) { const float xi = rl_f(mx, i); const unsigned ii = (unsigned)__builtin_amdgcn_readlane((int)mi, i); rank += (xi > mx || (xi == mx && ii < mi)) ? 1 : 0; }
            const u64 tb_ = __ballot(mine && rank == need - 1);
            if (tb_ == 0ull) break;
            T = rl_f(mx, __builtin_ctzll(tb_));
            needT = need - __builtin_popcountll(__ballot(mine && mx > T));
            LDS_WAIT(); asm volatile("" ::: "memory");
            break;
        }
        nlo = wave_minf(nlo); nhi = wave_maxf(nhi);
        if ((int)cstar == need) { T = nlo; needT = 1 << 20; break; }
        lo = nlo; hi = nhi;
    }
    T_out = T; needT_out = needT;
}

__device__ __forceinline__ u64 bitmap_row(const LAS float* R, int n, int lane, float T, int needT) {
    const int nch = (n + 63) >> 6; const LAS float* Rl = R + lane;
    int run = 0; unsigned wlo = 0u, whi = 0u;
#pragma unroll 4
    for (int j = 0; j < nch; ++j) { const float x = Rl[64 * j];
        u64 w;
        const bool tie = (x == T); const u64 tbal = __ballot(tie);
        if (tbal == 0ull) w = __ballot(x > T);
        else { const int rank = run + (int)__builtin_amdgcn_mbcnt_hi((unsigned)(tbal >> 32), __builtin_amdgcn_mbcnt_lo((unsigned)tbal, 0u)); run += __builtin_popcountll(tbal);
            w = __ballot(x > T || (tie && rank < needT)); }
        if (lane == j) { wlo = (unsigned)w; whi = (unsigned)(w >> 32); }
    }
    return (u64)wlo | ((u64)whi << 32);
}
__device__ __forceinline__ u64 select_row(LAS float* R, int n, int lane, LAS unsigned* hist) {
    const int nch = (n + 63) >> 6;
    if (64 * (nch - 1) + lane >= n) R[64 * (nch - 1) + lane] = -INFINITY;
    LDS_WAIT(); asm volatile("" ::: "memory");
    const LAS float* Rl = R + lane;
    LAS unsigned short* idx16 = (LAS unsigned short*)(hist + 320);
    float T; int needT;
    bool fast = n >= 768;
    float L = 0.f; int cnt = 0;
    if (fast) {
        const float x0 = Rl[0];
        int kth = (64 * 640) / n; kth = kth < 4 ? 4 : (kth > 60 ? 60 : kth);
        int rk = 0;
        for (int i = 0; i < 64; ++i) { const float xi = rl_f(x0, i); rk += (xi > x0 || (xi == x0 && i < lane)) ? 1 : 0; }
        const u64 kb = __ballot(rk == kth);
        L = rl_f(x0, kb ? __builtin_ctzll(kb) : 0);
#pragma unroll 4
        for (int j = 0; j < nch; ++j) cnt += __builtin_popcountll(__ballot(Rl[64 * j] >= L));
        fast = (kb != 0ull) && cnt >= 256 && cnt <= 1024;
    }
    if (!fast) { select_core(R, n, lane, hist, T, needT); return bitmap_row(R, n, lane, T, needT); }
    int pos = 0;
    for (int j = 0; j < nch; ++j) { const float x = Rl[64 * j]; const bool c = x >= L; const u64 cb = __ballot(c);
        if (cb != 0ull) { const int p = pos + (int)__builtin_amdgcn_mbcnt_hi((unsigned)(cb >> 32), __builtin_amdgcn_mbcnt_lo((unsigned)cb, 0u));
            LDS_WAIT(); asm volatile("" ::: "memory");
            if (c) { R[p] = x; idx16[p] = (unsigned short)(64 * j + lane); }
            pos += __builtin_popcountll(cb); } }
    LDS_WAIT(); asm volatile("" ::: "memory");
    select_core(R, cnt, lane, hist, T, needT);
    hist[lane] = 0u; hist[64 + lane] = 0u;
    LDS_WAIT(); asm volatile("" ::: "memory");
    const int ncl = (cnt + 63) >> 6; int run = 0;
    for (int j = 0; j < ncl; ++j) { const float x = Rl[64 * j];
        const bool tie = (x == T); const u64 tbal = __ballot(tie);
        const int rank = run + (int)__builtin_amdgcn_mbcnt_hi((unsigned)(tbal >> 32), __builtin_amdgcn_mbcnt_lo((unsigned)tbal, 0u)); run += __builtin_popcountll(tbal);
        const bool selb = x > T || (tie && rank < needT);
        if (selb) { const unsigned id = idx16[64 * j + lane]; __hip_atomic_fetch_or(hist + (id >> 5), 1u << (id & 31u), __ATOMIC_RELAXED, __HIP_MEMORY_SCOPE_WORKGROUP); } }
    LDS_WAIT(); asm volatile("" ::: "memory");
    const u64 myword = (u64)hist[2 * lane] | ((u64)hist[2 * lane + 1] << 32);
    LDS_WAIT(); asm volatile("" ::: "memory");
    return myword;
}

#ifdef NAIVE_IDX
__device__ __forceinline__ void idx_phase_naive(Frame& F) {
    PHASE_TID();
    LAS float* S = (LAS float*)(F.lds + IDX_S_OFF); LAS float* qs = (LAS float*)(F.lds + IDX_Q_OFF); LAS float* wsm = (LAS float*)(F.lds + IDX_W_OFF);
    LAS unsigned* hist = (LAS unsigned*)(F.lds + IDX_H_OFF) + F.wave * 832;
    const bf16* QI = (const bf16*)(F.ws + WS_QI); const bf16* KI = (const bf16*)(F.ws + WS_KI); const float* WI = (const float*)(F.ws + WS_WI); u64* BM = (u64*)(F.ws + WS_BM);
    for (int un = blockIdx.x; un < TOK / 8; un += F.G) {
        const int b = un >> 9, q0 = (un & 511) * 8; const size_t t0 = (size_t)b * SEQ + q0;
        for (int e = ptid; e < 8 * 256; e += NWAVES * 64) qs[e] = bf2f(QI[t0 * 256 + e]);
        if (ptid < 32) wsm[ptid] = WI[t0 * 4 + ptid];
        __syncthreads();
        const int nk = q0 + 8;
        for (int k = ptid; k < nk; k += NWAVES * 64) {
            float kf[64];
            { const v4u* kp = (const v4u*)(KI + ((size_t)b * SEQ + k) * 64);
#pragma unroll
                for (int c = 0; c < 8; ++c) { const v4u w = kp[c]; kf[8 * c + 0] = bflo(w.x); kf[8 * c + 1] = bfhi(w.x); kf[8 * c + 2] = bflo(w.y); kf[8 * c + 3] = bfhi(w.y); kf[8 * c + 4] = bflo(w.z); kf[8 * c + 5] = bfhi(w.z); kf[8 * c + 6] = bflo(w.w); kf[8 * c + 7] = bfhi(w.w); } }
            for (int i = 0; i < 8; ++i) { float sc = 0.f;
#pragma unroll
                for (int h = 0; h < 4; ++h) { float dot = 0.f; const LAS f32x4* qp = (const LAS f32x4*)(qs + i * 256 + h * 64);
#pragma unroll
                    for (int c = 0; c < 16; ++c) { const f32x4 qq = qp[c]; dot += kf[4 * c] * qq[0]; dot += kf[4 * c + 1] * qq[1]; dot += kf[4 * c + 2] * qq[2]; dot += kf[4 * c + 3] * qq[3]; }
                    sc += wsm[i * 4 + h] * fmaxf(dot, 0.f); }
                S[i * 4096 + k] = sc; }
        }
        __syncthreads();
        { const int i = F.wave, n = q0 + i + 1; u64 word;
            if (n <= 256) { const int full = n >> 6, rem = n & 63; word = (plane < full) ? ~0ull : (plane == full ? ((1ull << rem) - 1ull) : 0ull); }
            else word = select_row(S + i * 4096, n, plane, hist);
            BM[(t0 + i) * 64 + plane] = word; }
        __syncthreads();
    }
}

#endif
__device__ __forceinline__ float dpp_quad_sum(float x) {
    x += __builtin_bit_cast(float, __builtin_amdgcn_mov_dpp(__builtin_bit_cast(int, x), 0xB1, 0xF, 0xF, true));
    x += __builtin_bit_cast(float, __builtin_amdgcn_mov_dpp(__builtin_bit_cast(int, x), 0x4E, 0xF, 0xF, true));
    return x;
}
__device__ __forceinline__ void idx_phase(Frame& F) {
    PHASE_TID();
    LAS float* S = (LAS float*)(F.lds + IDX_S_OFF);
    LAS unsigned* hist = (LAS unsigned*)(F.lds + IDX_H_OFF) + F.wave * 832;
    const bf16* QI = (const bf16*)(F.ws + WS_QI); const bf16* KI = (const bf16*)(F.ws + WS_KI); const float* WI = (const float*)(F.ws + WS_WI); u64* BM = (u64*)(F.ws + WS_BM);
    const int c16 = plane & 15, kg = plane >> 4, qloc = c16 >> 2, hh = c16 & 3;
    {
        const float* KMP = (const float*)(F.ws + WS_KMP); bf16* KMH = (bf16*)(F.ws + WS_KMH); bf16* KML = (bf16*)(F.ws + WS_KML);
        for (int e = blockIdx.x * (NWAVES * 64) + ptid; e < BATCH * NH * 32 * 64; e += F.G * NWAVES * 64) {
            const int d = e & 63, n = (e >> 6) & 31, h = (e >> 11) & 7, b = e >> 14; unsigned vh = 0, vl = 0;
            if (n < 16) { const float* p = KMP + ((((size_t)b * 16 + n) * 8 + h) * 2) * 64 + d; const float v = (p[0] + p[64]) * (1.0f / 256.0f);
                vh = f2bf(v); vl = f2bf(v - __uint_as_float(vh << 16)); }
            KMH[e] = (bf16)vh; KML[e] = (bf16)vl; }
    }
    for (int un = blockIdx.x; un < TOK / 8; un += F.G) {
        const int b = un >> 9, m_ = un & 511, q0 = (m_ < 256 ? m_ : 767 - m_) * 8; const size_t t0 = (size_t)b * SEQ + q0;
        bf16x8 qf[2][2]; float wv[2];
#pragma unroll
        for (int g = 0; g < 2; ++g) { wv[g] = WI[(t0 + 4 * g + qloc) * 4 + hh];
#pragma unroll
            for (int ks = 0; ks < 2; ++ks) qf[g][ks] = *(const bf16x8*)(QI + (t0 + 4 * g + qloc) * 256 + hh * 64 + 32 * ks + 8 * kg); }
        const int nchunk = (q0 + 8 + 15) >> 4;
        const bf16* kbase = KI + (size_t)b * SEQ * 64 + (size_t)c16 * 64 + 8 * kg;
#define IDX_LOAD(KA, c0_) do { _Pragma("unroll") for (int u = 0; u < 4; ++u) { const int c = (c0_) + u * NWAVES; const bf16* kp = kbase + (size_t)(c < nchunk ? c : F.wave) * 16 * 64; \
            KA[u][0] = *(const bf16x8*)kp; KA[u][1] = *(const bf16x8*)(kp + 32); } } while (0)
#define IDX_COMP(KA, c0_) do { _Pragma("unroll") for (int u = 0; u < 4; ++u) { const int c = (c0_) + u * NWAVES; \
            if (c < nchunk) { _Pragma("unroll") for (int g = 0; g < 2; ++g) { \
                pg8::f32x4 acc = (pg8::f32x4){0.f, 0.f, 0.f, 0.f}; \
                acc = __builtin_amdgcn_mfma_f32_16x16x32_bf16(KA[u][0], qf[g][0], acc, 0, 0, 0); \
                acc = __builtin_amdgcn_mfma_f32_16x16x32_bf16(KA[u][1], qf[g][1], acc, 0, 0, 0); \
                pg8::f32x4 sc; \
                _Pragma("unroll") for (int i = 0; i < 4; ++i) sc[i] = dpp_quad_sum(wv[g] * fmaxf(acc[i], 0.f)); \
                if (hh == 0) *(LAS pg8::f32x4*)(S + (4 * g + qloc) * 4096 + 16 * c + 4 * kg) = sc; } } } } while (0)
        { bf16x8 kaA[4][2], kaB[4][2];
          IDX_LOAD(kaA, F.wave);
          for (int c0 = F.wave; c0 < nchunk; c0 += 8 * NWAVES) {
              IDX_LOAD(kaB, c0 + 4 * NWAVES);
              IDX_COMP(kaA, c0);
              IDX_LOAD(kaA, c0 + 8 * NWAVES);
              IDX_COMP(kaB, c0 + 4 * NWAVES);
          } }
#undef IDX_LOAD
#undef IDX_COMP
        __syncthreads();
        { const int i = F.wave, n = q0 + i + 1; u64 word;
            if (n <= 256) { const int full = n >> 6, rem = n & 63; word = (plane < full) ? ~0ull : (plane == full ? ((1ull << rem) - 1ull) : 0ull); }
            else word = select_row(S + i * 4096, n, plane, hist);
            BM[(t0 + i) * 64 + plane] = word; }
        __syncthreads();
    }
}

struct Args { const float* in[11]; float* out; unsigned char* ws; int ph_lo, ph_hi, li, pad; };
__global__ void __launch_bounds__(NWAVES * 64, 2) hyb_fwd(Args args) {
    extern __shared__ __attribute__((aligned(16))) unsigned char lds[];
    Frame F;
    F.lds = (LAS unsigned char*)lds;
    F.MISC = (volatile LAS unsigned*)(F.lds + MISC_OFF);
    F.wave = __builtin_amdgcn_readfirstlane((int)threadIdx.x >> 6);
    F.G = gridDim.x; { const int bx = blockIdx.x; F.vcu = (F.G % 8 == 0) ? (bx % 8) * (F.G / 8) + bx / 8 : bx; }
    F.ws = args.ws; F.ctl = (gu32*)(args.ws + WS_CTL); F.out = args.out;
    for (int u = threadIdx.x; u < (LDS_BYTES - LDSCTL_OFF) / 4; u += NWAVES * 64) ((LAS unsigned*)(F.lds + LDSCTL_OFF))[u] = 0u;
    __syncthreads();
    const bool one_launch = (args.ph_hi - args.ph_lo) > 1;
    XcdBarrier bar; bar.bar = (unsigned*)(F.ctl + CW_BAR); bar.x = 0; bar.st = nullptr;
    if (one_launch) bar = xcd_barrier_post((unsigned*)(F.ctl + CW_BAR), F.MISC + 8);
    const int lo = args.ph_lo, hi = args.ph_hi;
    unsigned char* ws = args.ws;
#ifndef REP_K
#define REP_K -2
#endif
#pragma unroll 1
    for (int ph2 = 2 * lo; ph2 < 2 * hi; ++ph2) {
        const int ph = ph2 >> 1;
        const int l = (ph - 1) / 5, k = (ph == 0) ? -1 : (ph - 1) % 5;
        if ((ph2 & 1) && k != REP_K) continue;
        if (k < 0) {
#ifndef NO_P0
            p0_prologue(F);
#endif
        } else if (k == 0) {
#ifndef NO_P1
            pg8::Gemm g{(const pg8::bf16_t*)(ws + WS_XB), (const pg8::bf16_t*)(ws + WS_WIN) + (size_t)l * NIN * DM, TOK, NIN, DM};
            pg8::StaticOrder S; S.init(TOK, NIN, F.G, (int)blockIdx.x);
            pg8::EpiIn E; E.rss = (const float*)(ws + WS_RSS); E.qna = in_ptr(3) + l * 64; E.kna = in_ptr(4) + l * 64; E.qnb = in_ptr(5) + l * 64; E.knb = in_ptr(6) + l * 64;
            E.QA = (pg8::bf16_t*)(ws + WS_QA); E.KA = (pg8::bf16_t*)(ws + WS_KA); E.VA = (pg8::bf16_t*)(ws + WS_VA); E.SGA = (pg8::bf16_t*)(ws + WS_SGA); E.QB = (pg8::bf16_t*)(ws + WS_QB); E.SGB = (pg8::bf16_t*)(ws + WS_SGB);
            E.KB = (pg8::bf16_t*)(ws + WS_KB); E.VB = (pg8::bf16_t*)(ws + WS_VB); E.KI = (pg8::bf16_t*)(ws + WS_KI); E.QI = (pg8::bf16_t*)(ws + WS_QI); E.SMA = (pg8::bf16_t*)(ws + WS_SMA); E.SMB = (pg8::bf16_t*)(ws + WS_SMB);
            E.WI = (float*)(ws + WS_WI); E.KMP = (float*)(ws + WS_KMP);
            pg8::gemm_phase<pg8::EpiIn, pg8::StaticOrder, true, true>(F.lds, g, S, E);
#endif
        } else if (k == 1) {
#ifndef NO_IDX
#ifdef NAIVE_IDX
            idx_phase_naive(F);
#else
            idx_phase(F);
#endif
#endif
        } else if (k == 2) {
#ifndef NO_ATT
#ifdef NAIVE_ATT
            naive_attn<0>(F, l); __syncthreads(); naive_attn<1>(F, l);
#else
#ifdef CLOCK_PROBE
            if (blockIdx.x == 0 && threadIdx.x == 0 && l == 0) { F.MISC[16] = (unsigned)__builtin_amdgcn_s_memtime(); F.MISC[17] = (unsigned)__builtin_amdgcn_s_memrealtime(); }
#endif
            attn_phase_fast(F, l);
#ifdef CLOCK_PROBE
            if (blockIdx.x == 0 && threadIdx.x == 0 && l == 0) { const unsigned dt = (unsigned)__builtin_amdgcn_s_memtime() - F.MISC[16], dr = (unsigned)__builtin_amdgcn_s_memrealtime() - F.MISC[17]; F.MISC[18] = (unsigned)((unsigned long long)dt * 100ull / (dr ? dr : 1u)); }
#endif
#endif
#endif
        } else if (k == 3) {
#ifndef NO_P4
            pg8::Gemm g{(const pg8::bf16_t*)(ws + WS_XB), (const pg8::bf16_t*)(ws + WS_WBR) + (size_t)l * 2048 * AW, 2 * TOK, 2048, AW};
            pg8::PairOrder S; S.init(F.G, (int)blockIdx.x);
            pg8::EpiMerge E{(const pg8::bf16_t*)(ws + WS_SMA), (pg8::bf16_t*)(ws + WS_SMB), (float*)(ws + WS_TMP)};
            pg8::gemm_phase<pg8::EpiMerge, pg8::PairOrder, true, true>(F.lds, g, S, E);
#endif
        } else {
#ifndef NO_P5
            pg8::Gemm g{(const pg8::bf16_t*)(ws + WS_SMB), (const pg8::bf16_t*)(ws + WS_WOUT) + (size_t)l * DM * DM, TOK, DM, DM};
            pg8::StaticOrder S; S.init(TOK, DM, F.G, (int)blockIdx.x);
            if (l == 0) { pg8::EpiOut<true> E{in_ptr(0), F.out, (pg8::bf16_t*)(ws + WS_XB), (float*)(ws + WS_RSS)};
                pg8::gemm_phase<pg8::EpiOut<true>, pg8::StaticOrder, true, true>(F.lds, g, S, E); }
            else { pg8::EpiOut<false> E{F.out, F.out, nullptr, nullptr};
                pg8::gemm_phase<pg8::EpiOut<false>, pg8::StaticOrder, true, true>(F.lds, g, S, E); }
#endif
        }
        if (!((ph == hi - 1) && ((ph2 & 1) || k != REP_K))) xcd_barrier(bar);
    }
#ifdef CLOCK_PROBE
    if (blockIdx.x == 0 && threadIdx.x == 0) {
        const unsigned long long t0 = __builtin_amdgcn_s_memrealtime(); const unsigned long long want = (unsigned long long)F.MISC[18] * 100ull;
        while (__builtin_amdgcn_s_memrealtime() - t0 < want) __builtin_amdgcn_s_sleep(16);
    }
#endif
}

#ifndef N_LAUNCHES
#define N_LAUNCHES 1
#endif
extern "C" void kernel_launch(void* const* d_in, const int* in_sizes, int n_in, void* d_out, int out_size, void* d_ws, size_t ws_size, hipStream_t stream) {
    static int grid = 0;
    if (grid == 0) {
        if (n_in != 11 || in_sizes[0] != TOK * DM || out_size != TOK * DM || ws_size < WS_END) { fprintf(stderr, "kernel_launch: unexpected shapes (n_in %d in0 %d out %d ws %zu)\n", n_in, n_in > 0 ? in_sizes[0] : -1, out_size, ws_size); grid = -1; return; }
        int dev = 0, cus = 0;
        if (hipGetDevice(&dev) != hipSuccess || hipDeviceGetAttribute(&cus, hipDeviceAttributeMultiprocessorCount, dev) != hipSuccess) { grid = -1; return; }
        if (hipFuncSetAttribute((const void*)hyb_fwd, hipFuncAttributeMaxDynamicSharedMemorySize, LDS_BYTES) != hipSuccess) { fprintf(stderr, "kernel_launch: hipFuncSetAttribute failed\n"); grid = -1; return; }
        int per_cu = 0;
        if (hipOccupancyMaxActiveBlocksPerMultiprocessor(&per_cu, (const void*)hyb_fwd, NWAVES * 64, LDS_BYTES) != hipSuccess || per_cu < 1) fprintf(stderr, "kernel_launch: occupancy query says %d\n", per_cu);
        (void)hipGetLastError();
        grid = cus;
    }
    if (grid < 0) return;
    if (hipMemsetAsync((char*)d_ws + WS_CTL, 0, CTL_ZERO_BYTES, stream) != hipSuccess) return;
    Args a{};
    for (int i = 0; i < 11; ++i) a.in[i] = (const float*)d_in[i];
    a.out = (float*)d_out; a.ws = (unsigned char*)d_ws;
    if (N_LAUNCHES == 1) { a.ph_lo = 0; a.ph_hi = NPHASE; a.li = 0; hipLaunchKernelGGL(hyb_fwd, dim3(grid), dim3(NWAVES * 64), LDS_BYTES, stream, a); }
    else for (int li = 0; li < NPHASE; ++li) { a.ph_lo = li; a.ph_hi = li + 1; a.li = li; hipLaunchKernelGGL(hyb_fwd, dim3(grid), dim3(NWAVES * 64), LDS_BYTES, stream, a); }
}
```

```cpp
#include <hip/hip_runtime.h>
#include <cstdio>
#include <cstdint>
#include <cmath>
namespace pg8 {
#define PG8_LAS __attribute__((address_space(3)))
typedef unsigned short bf16_t;
typedef short bf16x8 __attribute__((ext_vector_type(8)));
typedef float f32x4 __attribute__((ext_vector_type(4)));
typedef unsigned u32x4 __attribute__((ext_vector_type(4)));
constexpr int BM = 256, BK = 64, HALF = 128, HTB = HALF * BK * 2  , STAGE_BYTES = 8 * HTB, NXCD = 8, WGM = 8;

__host__ __device__ __forceinline__ int lds_byte(int r, int c) { const int st = (r >> 4) * 2 + (c >> 5), rr = r & 15, cc = c & 31, ob = rr * 64 + cc * 2; return st * 1024 + (ob ^ (((ob >> 9) & 1) << 5)); }
__host__ __device__ __forceinline__ void stage_rc(int b, int& R, int& C) { const int st = b / 1024, sb = b % 1024, swz = sb ^ (((sb >> 9) & 1) << 5); R = (st >> 1) * 16 + swz / 64; C = (st & 1) * 32 + (swz % 64) / 2; }
__host__ __device__ __forceinline__ int perm32(int rho) { const int n = rho >> 4, i = rho & 15; return 8 * (i >> 2) + 4 * n + (i & 3); }

struct Unit { int pm, pn; };
struct Gemm { const bf16_t* A; const bf16_t* Bt; int M, N, K; };

struct StaticOrder {
    int nM, nN, nwg, G, c;
    __host__ __device__ void init(int M, int N, int G_, int c_) { nM = M / BM; nN = N / BM; nwg = nM * nN; G = G_; c = c_; }
    __host__ __device__ bool next(int i, Unit& u) const {
        const long L = (long)i * G + c; if (L >= nwg) return false;
        int wgid = (int)L; { const int q = nwg / NXCD, r = nwg % NXCD, xcd = wgid % NXCD, off = wgid / NXCD; wgid = (xcd < r ? xcd * (q + 1) : r * (q + 1) + (xcd - r) * q) + off; }
        const int nig = WGM * nN, gid = wgid / nig, fm = gid * WGM, gsz = (nM - fm) < WGM ? (nM - fm) : WGM;
        u.pm = fm + ((wgid % nig) % gsz); u.pn = (wgid % nig) / gsz; return true;
    }
    __device__ __forceinline__ void a_ready(const Unit&) const {}
    __device__ __forceinline__ void done(const Unit&) const {}
};

__device__ __forceinline__ unsigned cvt_pk_bf16(float lo, float hi) { unsigned r; asm volatile("v_cvt_pk_bf16_f32 %0, %1, %2" : "=v"(r) : "v"(lo), "v"(hi)); return r; }
template <class Epi, class Sched, bool ALIGN_EPI = false, bool SP2 = false>
__device__ __forceinline__ void gemm_phase(PG8_LAS unsigned char* lds, const Gemm g, const Sched& S, const Epi& E) {
    int tid_ = threadIdx.x; asm volatile("" : "+v"(tid_));
    const int tid = tid_, wid = __builtin_amdgcn_readfirstlane(tid >> 6), lane = tid & 63, wr = wid >> 2, wc = wid & 3, fr = lane & 15, fq = lane >> 4;
    const int K = g.K, nt = K / BK;
    unsigned voffA[2], voffB[2];
#pragma unroll
    for (int i = 0; i < 2; ++i) { int R, C; stage_rc(tid * 16 + i * 8192, R, C); const int Rb = Epi::PERM ? ((R & ~31) + perm32(R & 31)) : R;
        voffA[i] = (unsigned)(R * K + C) * 2u; voffB[i] = (unsigned)(Rb * K + C) * 2u; }
    const size_t kstep = (size_t)(BK * 2);
    const size_t hstep = (size_t)HALF * K * 2;
    const size_t tstep = 2 * hstep;
    const unsigned ldsw = (unsigned)wid * 1024u;
    const int aoff = lds_byte(wr * 64 + fr, fq * 8), boff = lds_byte(wc * 32 + fr, fq * 8);
#define PG8_SA(b, h) (((b) * 2 + (h)) * HTB)
#define PG8_SB(b, h) ((4 + (b) * 2 + (h)) * HTB)
#define PG8_STAGE(bufoff, gbase, voff) do { _Pragma("unroll") for (int _i = 0; _i < 2; ++_i) \
        __builtin_amdgcn_global_load_lds((const unsigned*)((const char*)(gbase) + (voff)[_i]), (PG8_LAS unsigned*)(lds + (bufoff) + ldsw + _i * 8192), 16, 0, 0); } while (0)
#define PG8_LDA(dst, b, h) do { _Pragma("unroll") for (int m = 0; m < 4; ++m) _Pragma("unroll") for (int k = 0; k < 2; ++k) dst[m][k] = *(const PG8_LAS bf16x8*)(lds + PG8_SA(b, h) + aoff + m * 2048 + k * 1024); } while (0)
#define PG8_LDB(dst, b, h) do { _Pragma("unroll") for (int n = 0; n < 2; ++n) _Pragma("unroll") for (int k = 0; k < 2; ++k) dst[n][k] = *(const PG8_LAS bf16x8*)(lds + PG8_SB(b, h) + boff + n * 2048 + k * 1024); } while (0)
#define PG8_MMA(ai, bj, At, Bt) do { __builtin_amdgcn_s_setprio(1); _Pragma("unroll") for (int m = 0; m < 4; ++m) _Pragma("unroll") for (int n = 0; n < 2; ++n) _Pragma("unroll") for (int k = 0; k < 2; ++k) \
        acc[ai][bj][m][n] = __builtin_amdgcn_mfma_f32_16x16x32_bf16(Bt[n][k], At[m][k], acc[ai][bj][m][n], 0, 0, 0); __builtin_amdgcn_s_setprio(0); } while (0)
#define PG8_WAIT_V(n) asm volatile("s_waitcnt vmcnt(" #n ")" ::: "memory")
#define PG8_WAIT_L(n) asm volatile("s_waitcnt lgkmcnt(" #n ")" ::: "memory")
#define PG8_BAR __builtin_amdgcn_s_barrier()
#define PG8_SCHED __builtin_amdgcn_sched_barrier(0)
    Unit cur, nxt; int ui = 0;
    if (!S.next(0, cur)) return;
    f32x4 acc[2][2][4][2];
#pragma unroll
    for (int a = 0; a < 2; ++a)
#pragma unroll
        for (int b = 0; b < 2; ++b)
#pragma unroll
            for (int m = 0; m < 4; ++m)
#pragma unroll
                for (int n = 0; n < 2; ++n) acc[a][b][m][n] = (f32x4){0.f, 0.f, 0.f, 0.f};
    bf16x8 At[4][2], B0[2][2], B1[2][2];
    const char* cA = (const char*)g.A + (size_t)cur.pm * tstep; const char* cB = (const char*)g.Bt + (size_t)cur.pn * tstep;
    S.a_ready(cur);
    if constexpr (SP2) {
        PG8_STAGE(PG8_SB(0, 0), cB, voffB); PG8_STAGE(PG8_SB(0, 1), cB + hstep, voffB); PG8_STAGE(PG8_SA(0, 0), cA, voffA); PG8_STAGE(PG8_SA(0, 1), cA + hstep, voffA);
        if (wr == 1) PG8_BAR;
        PG8_WAIT_V(2); PG8_BAR;
        PG8_STAGE(PG8_SB(1, 0), cB + kstep, voffB); PG8_STAGE(PG8_SA(1, 0), cA + kstep, voffA); PG8_STAGE(PG8_SB(1, 1), cB + hstep + kstep, voffB);
        PG8_WAIT_V(6); PG8_BAR;
    } else {
        PG8_STAGE(PG8_SB(0, 0), cB, voffB); PG8_STAGE(PG8_SA(0, 0), cA, voffA); PG8_STAGE(PG8_SB(0, 1), cB + hstep, voffB); PG8_STAGE(PG8_SA(0, 1), cA + hstep, voffA);
        if (wr == 1) PG8_BAR;
        PG8_WAIT_V(4); PG8_BAR;
        PG8_STAGE(PG8_SB(1, 0), cB + kstep, voffB); PG8_STAGE(PG8_SA(1, 0), cA + kstep, voffA); PG8_STAGE(PG8_SB(1, 1), cB + hstep + kstep, voffB);
        PG8_WAIT_V(6); PG8_BAR;
    }
    for (;;) {
        const bool has_next = S.next(ui + 1, nxt);
        const char* nA = has_next ? (const char*)g.A + (size_t)nxt.pm * tstep : cA; const char* nB = has_next ? (const char*)g.Bt + (size_t)nxt.pn * tstep : cB;
        for (int t = 0; t < nt; t += 2) {
            const bool last = (t == nt - 2);
            const char* a1 = cA + (size_t)(t + 1) * kstep;
            const char* a2 = last ? nA : cA + (size_t)(t + 2) * kstep; const char* b2 = last ? nB : cB + (size_t)(t + 2) * kstep;
            const char* a3 = a2 + kstep; const char* b3 = b2 + kstep;
            if (last && has_next) S.a_ready(nxt);
            if constexpr (SP2) {
            PG8_LDB(B0, 0, 0); PG8_LDB(B1, 0, 1); PG8_SCHED; PG8_LDA(At, 0, 0); PG8_STAGE(PG8_SA(1, 1), a1 + hstep, voffA);
            PG8_WAIT_V(8); PG8_WAIT_L(0); PG8_BAR; PG8_MMA(0, 0, At, B0); PG8_MMA(0, 1, At, B1); PG8_BAR; PG8_SCHED;
            PG8_LDA(At, 0, 1); PG8_STAGE(PG8_SB(0, 0), b2, voffB); PG8_STAGE(PG8_SB(0, 1), b2 + hstep, voffB); PG8_STAGE(PG8_SA(0, 0), a2, voffA);
            PG8_WAIT_V(8); PG8_WAIT_L(0); PG8_BAR; PG8_MMA(1, 0, At, B0); PG8_MMA(1, 1, At, B1); PG8_BAR; PG8_SCHED;
            PG8_LDB(B0, 1, 0); PG8_LDB(B1, 1, 1); PG8_SCHED; PG8_LDA(At, 1, 0); PG8_STAGE(PG8_SA(0, 1), a2 + hstep, voffA);
            PG8_WAIT_V(8); PG8_WAIT_L(0); PG8_BAR; PG8_MMA(0, 0, At, B0); PG8_MMA(0, 1, At, B1); PG8_BAR; PG8_SCHED;
            PG8_LDA(At, 1, 1); PG8_STAGE(PG8_SB(1, 0), b3, voffB); PG8_STAGE(PG8_SB(1, 1), b3 + hstep, voffB); PG8_STAGE(PG8_SA(1, 0), a3, voffA);
            PG8_WAIT_V(8); PG8_WAIT_L(0); PG8_BAR; PG8_MMA(1, 0, At, B0); PG8_MMA(1, 1, At, B1); PG8_BAR; PG8_SCHED;
            } else {
            PG8_LDB(B0, 0, 0); PG8_SCHED; PG8_LDA(At, 0, 0); PG8_STAGE(PG8_SA(1, 1), a1 + hstep, voffA);
            PG8_WAIT_L(8); PG8_BAR; PG8_WAIT_L(0); PG8_MMA(0, 0, At, B0); PG8_BAR; PG8_SCHED;
            PG8_LDB(B1, 0, 1); PG8_STAGE(PG8_SB(0, 0), b2, voffB);
            PG8_BAR; PG8_WAIT_L(0); PG8_MMA(0, 1, At, B1); PG8_BAR;
            PG8_LDA(At, 0, 1); PG8_STAGE(PG8_SA(0, 0), a2, voffA);
            PG8_BAR; PG8_WAIT_L(0); PG8_MMA(1, 0, At, B0); PG8_BAR; PG8_SCHED;
            PG8_STAGE(PG8_SB(0, 1), b2 + hstep, voffB);
            PG8_WAIT_V(6); PG8_BAR; PG8_MMA(1, 1, At, B1); PG8_BAR;
            PG8_LDB(B0, 1, 0); PG8_SCHED; PG8_LDA(At, 1, 0); PG8_STAGE(PG8_SA(0, 1), a2 + hstep, voffA);
            PG8_WAIT_L(8); PG8_BAR; PG8_WAIT_L(0); PG8_MMA(0, 0, At, B0); PG8_BAR; PG8_SCHED;
            PG8_LDB(B1, 1, 1); PG8_STAGE(PG8_SB(1, 0), b3, voffB);
            PG8_BAR; PG8_WAIT_L(0); PG8_MMA(0, 1, At, B1); PG8_BAR;
            PG8_LDA(At, 1, 1); PG8_STAGE(PG8_SA(1, 0), a3, voffA);
            PG8_BAR; PG8_WAIT_L(0); PG8_MMA(1, 0, At, B0); PG8_BAR; PG8_SCHED;
            PG8_STAGE(PG8_SB(1, 1), b3 + hstep, voffB);
            PG8_WAIT_V(6); PG8_BAR; PG8_MMA(1, 1, At, B1); PG8_BAR;
            }
        }
        if constexpr (ALIGN_EPI) { if (wr == 0) PG8_BAR; }
#ifndef EPI_REP
#define EPI_REP 1
#endif
        if constexpr (!Epi::AFTER_DRAIN) { E(acc, cur, wr, wc, fr, fq); if constexpr (Epi::REPEATABLE && EPI_REP == 2) { asm volatile("" ::: "memory"); E(acc, cur, wr, wc, fr, fq); } S.done(cur); }
        if (!has_next) break;
#pragma unroll
        for (int a = 0; a < 2; ++a)
#pragma unroll
            for (int b = 0; b < 2; ++b)
#pragma unroll
                for (int m = 0; m < 4; ++m)
#pragma unroll
                    for (int n = 0; n < 2; ++n) acc[a][b][m][n] = (f32x4){0.f, 0.f, 0.f, 0.f};
        cur = nxt; cA = nA; cB = nB; ++ui;
        if constexpr (ALIGN_EPI) { if (wr == 1) PG8_BAR; }
    }
    PG8_WAIT_V(0);
    if constexpr (!ALIGN_EPI) { if (wr == 0) PG8_BAR; }
    PG8_BAR;
    if constexpr (Epi::AFTER_DRAIN) { E.fused(acc, cur, wr, wc, fr, fq, lds, wid, lane); S.done(cur); }
#undef PG8_SA
#undef PG8_SB
#undef PG8_STAGE
#undef PG8_LDA
#undef PG8_LDB
#undef PG8_MMA
#undef PG8_WAIT_V
#undef PG8_WAIT_L
#undef PG8_BAR
#undef PG8_SCHED
}
}
#define GAS __attribute__((address_space(1)))
#define LAS __attribute__((address_space(3)))
typedef unsigned short bf16;
typedef unsigned v4u __attribute__((ext_vector_type(4)));
typedef float f32x4 __attribute__((ext_vector_type(4)));
typedef short bf16x8 __attribute__((ext_vector_type(8)));
typedef GAS unsigned gu32;
typedef GAS unsigned long long gu64;
#define RLX_AGENT __ATOMIC_RELAXED, __HIP_MEMORY_SCOPE_AGENT
#define LDS_WAIT() asm volatile("s_waitcnt lgkmcnt(0)" ::: "memory")
#define VM_WAIT() asm volatile("s_waitcnt vmcnt(0)" ::: "memory")
__device__ __forceinline__ unsigned long long rt() { return __builtin_amdgcn_s_memrealtime(); }
__device__ __forceinline__ unsigned f2bf(float f) { unsigned u = __builtin_bit_cast(unsigned, f); return (u + 0x7fffu + ((u >> 16) & 1u)) >> 16; }
__device__ __forceinline__ unsigned pk2(float lo, float hi) { return f2bf(lo) | (f2bf(hi) << 16); }
#define XB_TMO      128
#define XB_XCNT(j)  (256  + 64 * (j))
#define XB_XSUB(j)  (1280 + 64 * (j))
#define XB_XGEN(j)  (2304 + 64 * (j))
#define XB_TOP      3328
#define XB_TOPGEN   3392
#define XCD_BAR_WORDS 3456
#define XB_SPIN_CAP (1u << 18)

__device__ __forceinline__ unsigned xb_ld(unsigned* p)              { return __hip_atomic_load(p, __ATOMIC_RELAXED, __HIP_MEMORY_SCOPE_AGENT); }
__device__ __forceinline__ unsigned xb_add(unsigned* p, unsigned v) { return __hip_atomic_fetch_add(p, v, __ATOMIC_RELAXED, __HIP_MEMORY_SCOPE_AGENT); }
__device__ __forceinline__ unsigned xb_xcc_id() { return (unsigned)__builtin_amdgcn_s_getreg((3 << 11) | 20) & 0xFu; }
#define XB_SPIN(cond, bar) do { unsigned _sp = 0; while (cond) { __builtin_amdgcn_s_sleep(1); \
    if ((++_sp & 255u) == 0u) { if (xb_ld(&(bar)[XB_TMO])) break; if (_sp > XB_SPIN_CAP) { atomicAdd(&(bar)[XB_TMO], 1u); break; } } } } while (0)

struct XcdBarrier {
    unsigned* bar; unsigned x;
    volatile LAS unsigned* st;
};

__device__ __forceinline__ XcdBarrier xcd_barrier_post(unsigned* bar, volatile LAS unsigned* st) {
    XcdBarrier b; b.bar = bar; b.x = xb_xcc_id(); b.st = st;
    if (threadIdx.x == 0) (void)xb_add(&bar[XB_XCNT(b.x)], 1u);
    return b;
}
__device__ __forceinline__ void xcd_barrier_complete(unsigned* bar, unsigned x, unsigned& nloc, unsigned& nx) {
    const unsigned G = gridDim.x * gridDim.y * gridDim.z;
    unsigned sum, cnt, mine, sp = 0u;
    for (;;) {
        sum = 0u; cnt = 0u; mine = 0u;
#pragma unroll
        for (unsigned j = 0; j < 16; ++j) { const unsigned c = xb_ld(&bar[XB_XCNT(j)]); sum += c; cnt += (c > 0u) ? 1u : 0u; mine = (j == x) ? c : mine; }
        if (sum == G) break;
        __builtin_amdgcn_s_sleep(1);
        if ((++sp & 255u) == 0u) { if (xb_ld(&bar[XB_TMO])) break; if (sp > XB_SPIN_CAP) { atomicAdd(&bar[XB_TMO], 1u); break; } }
    }
    nloc = mine > 0u ? mine : 1u; nx = cnt > 0u ? cnt : 1u;
}

__device__ __forceinline__ void xcd_barrier(const XcdBarrier& b) {
    asm volatile("s_waitcnt vmcnt(0)" ::: "memory");
    __syncthreads();
    if (threadIdx.x == 0) {
        unsigned* bar = b.bar; asm volatile("" : "+s"(bar));
        __builtin_amdgcn_s_waitcnt(0);
        unsigned nloc = b.st[0], nx = b.st[1];
        if (nloc == 0u) { xcd_barrier_complete(bar, b.x, nloc, nx); b.st[0] = nloc; b.st[1] = nx; }
        const unsigned old = xb_add(&bar[XB_XSUB(b.x)], 1u);
        const unsigned gen = old / nloc;
        if (old + 1u == (gen + 1u) * nloc) {
            __builtin_amdgcn_fence(__ATOMIC_RELEASE, "agent");
            asm volatile("s_waitcnt vmcnt(0)" ::: "memory");
            const unsigned og = xb_add(&bar[XB_TOP], 1u);
            const unsigned tg = og / nx;
            if (og + 1u == (tg + 1u) * nx) xb_add(&bar[XB_TOPGEN], 1u);
            else XB_SPIN(xb_ld(&bar[XB_TOPGEN]) == tg, bar);
            __builtin_amdgcn_fence(__ATOMIC_ACQUIRE, "agent");
            xb_add(&bar[XB_XGEN(b.x)], 1u);
            asm volatile("s_waitcnt vmcnt(0)" ::: "memory");
        } else {
            XB_SPIN(xb_ld(&bar[XB_XGEN(b.x)]) == gen, bar);
            __builtin_amdgcn_fence(__ATOMIC_ACQUIRE, "agent");
            asm volatile("s_waitcnt vmcnt(0)" ::: "memory");
        }
    }
    __syncthreads();
}

constexpr int BATCH = 8, SEQ = 4096, DM = 1024, TOK = BATCH * SEQ, DEPTH = 2;
constexpr int DIN = 5572, NIN = 5632;
constexpr int NH = 8, HD = 64, AW = 512;
constexpr float EPS = 1e-6f;
constexpr float LOG2E = 1.4426950408889634f;
constexpr float C2 = 0.125f * LOG2E;
constexpr int NWAVES = 8;
constexpr int NPHASE = 1 + 5 * DEPTH;

constexpr size_t MiB = 1u << 20;
constexpr size_t WS_CTL = 0, CTL_ZERO_BYTES = 1 * MiB;
constexpr size_t WS_WIN = 1 * MiB;
constexpr size_t WS_WBR = 23 * MiB;
constexpr size_t WS_WOUT = 27 * MiB;
constexpr size_t WS_RSS = 31 * MiB;
constexpr size_t WS_KMP = 33 * MiB;
constexpr size_t WS_WI = 34 * MiB;
constexpr size_t WS_KB = 35 * MiB, WS_VB = 39 * MiB, WS_KI = 43 * MiB;
constexpr size_t WS_QI = 47 * MiB;
constexpr size_t WS_BM = 63 * MiB;
constexpr size_t WS_KMH = 79 * MiB, WS_KML = 79 * MiB + 262144;
constexpr size_t WS_XB = 80 * MiB;
constexpr size_t WS_QA = 144 * MiB, WS_KA = 176 * MiB, WS_VA = 208 * MiB, WS_SGA = 240 * MiB, WS_QB = 272 * MiB, WS_SGB = 304 * MiB;
constexpr size_t WS_TMP = 144 * MiB;
constexpr size_t WS_SMA = 336 * MiB, WS_SMB = 400 * MiB;
constexpr size_t WS_END = 464 * MiB;
constexpr int CW_BAR = 4096;

constexpr int RING_BYTES = 131072;
constexpr int LDSCTL_OFF = RING_BYTES + 28672, MISC_OFF = LDSCTL_OFF + 320;
constexpr int LDS_BYTES = 163840;
static_assert(MISC_OFF + 128 <= LDS_BYTES, "LDS map");

typedef unsigned long long u64;
typedef unsigned u32x4v __attribute__((ext_vector_type(4)));

__device__ __forceinline__ float bf2f(unsigned short v) { return __uint_as_float(((unsigned)v) << 16); }
__device__ __forceinline__ float bflo(unsigned w) { return __uint_as_float(w << 16); }
__device__ __forceinline__ float bfhi(unsigned w) { return __uint_as_float(w & 0xffff0000u); }
__device__ __forceinline__ float sigmoidf_(float v) { return __builtin_amdgcn_rcpf(1.0f + __builtin_amdgcn_exp2f(-v * LOG2E)); }

typedef __attribute__((address_space(4))) const char* kaptr_t;
__device__ __forceinline__ const float* in_ptr(int i) { kaptr_t ka = (kaptr_t)__builtin_amdgcn_kernarg_segment_ptr(); asm volatile("" : "+s"(ka)); return *(const float* const __attribute__((address_space(4)))*)(ka + 8 * i); }
#define PHASE_TID() int tid_o = threadIdx.x; asm volatile("" : "+v"(tid_o)); const int ptid = tid_o, plane = tid_o & 63
struct Frame {
    LAS unsigned char* lds;
    volatile LAS unsigned* MISC;
    gu32* ctl;
    int wave, vcu, G;
    unsigned char* ws;
    float* out;
};

__host__ __device__ __forceinline__ int win_src(int n0, int& nvalid) {
    const int pn = n0 >> 8, c = n0 & 255, bj = c >> 7, wc = (c >> 5) & 3; nvalid = 32;
    if (pn < 2) return 0 + 64 * (4 * pn + wc) + 32 * bj;
    if (pn < 4) return 512 + 64 * (4 * (pn - 2) + wc) + 32 * bj;
    if (pn < 6) return 1024 + 256 * (pn - 4) + c;
    if (pn < 8) return 1536 + 256 * (pn - 6) + c;
    if (pn < 10) return 2048 + 64 * (4 * (pn - 8) + wc) + 32 * bj;
    if (pn == 10) {
        if (wc == 0) return 2560 + 32 * bj;
        if (wc == 1) return 2624 + 32 * bj;
        if (wc == 2) return 3456 + 32 * bj;
        if (bj == 0) { nvalid = 4; return 3520; }
        nvalid = 0; return 0;
    }
    if (pn == 11) return 3200 + c;
    if (pn < 14) return 2688 + 256 * (pn - 12) + c;
    if (pn < 18) return 3524 + 256 * (pn - 14) + c;
    return 4548 + 256 * (pn - 18) + c;
}

__device__ __forceinline__ float wave_sum(float v) {
#pragma unroll
    for (int o = 1; o < 64; o <<= 1) v += __shfl_xor(v, o);
    return v;
}
__device__ __forceinline__ void tr_item(const float* W, int ldw, int src0, int nvalid, const float* gk, bf16* WT, int K, int row0, int k0, LAS float* scr, int lane) {
    const int j4 = 4 * (lane & 7);
#pragma unroll
    for (int i = 0; i < 8; ++i) { const int kk = 8 * i + (lane >> 3);
        f32x4 v = (f32x4){0.f, 0.f, 0.f, 0.f};
        if (j4 < nvalid) { v = *(const f32x4*)(W + (size_t)(k0 + kk) * ldw + src0 + j4); if (gk) v = v * gk[k0 + kk]; }
        scr[kk * 33 + j4] = v[0]; scr[kk * 33 + j4 + 1] = v[1]; scr[kk * 33 + j4 + 2] = v[2]; scr[kk * 33 + j4 + 3] = v[3]; }
    LDS_WAIT(); asm volatile("" ::: "memory");
    const int c = lane & 7;
#pragma unroll
    for (int jj = 0; jj < 4; ++jj) { const int n = (lane >> 3) + 8 * jj; const LAS float* s = scr + (8 * c) * 33 + n;
        v4u o; o.x = pk2(s[0 * 33], s[1 * 33]); o.y = pk2(s[2 * 33], s[3 * 33]); o.z = pk2(s[4 * 33], s[5 * 33]); o.w = pk2(s[6 * 33], s[7 * 33]);
        *(GAS v4u*)(WT + (size_t)(row0 + n) * K + k0 + 8 * c) = o; }
    LDS_WAIT(); asm volatile("" ::: "memory");
}
__device__ __forceinline__ void p0_prologue(Frame& F) {
    PHASE_TID();
    LAS float* scr = (LAS float*)(F.lds + F.wave * 16384);
    const int gw = F.vcu * NWAVES + F.wave, NGW = F.G * NWAVES;
    constexpr int I_IN = (DM / 64) * (NIN / 32), I_BR = (AW / 64) * (DM / 32), I_OUT = (DM / 64) * (DM / 32);
    constexpr int PER_L = I_IN + 2 * I_BR + I_OUT;
    for (int it = gw; it < DEPTH * PER_L; it += NGW) {
        const int l = it / PER_L; int r = it % PER_L;
        if (r < I_IN) { const int kb = r / (NIN / 32), nb = r % (NIN / 32); int nvalid; const int src0 = win_src(32 * nb, nvalid);
            tr_item(in_ptr(2) + (size_t)l * DM * DIN, DIN, src0, nvalid, in_ptr(1) + l * DM, (bf16*)(F.ws + WS_WIN) + (size_t)l * NIN * DM, DM, 32 * nb, 64 * kb, scr, plane); continue; }
        r -= I_IN;
        if (r < 2 * I_BR) { const int which = r / I_BR; r %= I_BR; const int kb = r / (DM / 32), nb = r % (DM / 32);
            tr_item((which ? in_ptr(8) : in_ptr(7)) + (size_t)l * AW * DM, DM, 32 * nb, 32, nullptr, (bf16*)(F.ws + WS_WBR) + (size_t)l * 2048 * AW, AW, which * 1024 + 32 * nb, 64 * kb, scr, plane); continue; }
        r -= 2 * I_BR;
        { const int kb = r / (DM / 32), nb = r % (DM / 32);
            tr_item(in_ptr(9) + (size_t)l * DM * DM, DM, 32 * nb, 32, nullptr, (bf16*)(F.ws + WS_WOUT) + (size_t)l * DM * DM, DM, 32 * nb, 64 * kb, scr, plane); }
    }
    const float* x = in_ptr(0); bf16* XB = (bf16*)(F.ws + WS_XB); float* RSS = (float*)(F.ws + WS_RSS);
    for (int m = gw; m < TOK; m += NGW) {
        const GAS f32x4* xr = (const GAS f32x4*)(x + (size_t)m * DM) + plane;
        f32x4 v[4]; float s = 0.f;
#pragma unroll
        for (int j = 0; j < 4; ++j) { v[j] = xr[64 * j]; s += (v[j].x * v[j].x + v[j].y * v[j].y) + (v[j].z * v[j].z + v[j].w * v[j].w); }
        s = wave_sum(s);
        GAS u64* o8 = (GAS u64*)(XB + (size_t)m * DM) + plane;
#pragma unroll
        for (int j = 0; j < 4; ++j) o8[64 * j] = (u64)pk2(v[j].x, v[j].y) | ((u64)pk2(v[j].z, v[j].w) << 32);
        if (plane < 16) RSS[(size_t)m * 16 + plane] = (plane == 0) ? s : 0.f;
    }
}

namespace pg8 {
__device__ __forceinline__ float row_rs(const float* rss, int row, int fq) {
    const f32x4 a = *(const f32x4*)(rss + (size_t)row * 16 + 4 * fq);
    float s = (a[0] + a[1]) + (a[2] + a[3]);
    s += __shfl_xor(s, 16); s += __shfl_xor(s, 32);
    return __builtin_amdgcn_rsqf(s * (1.0f / DM) + EPS);
}
__device__ __forceinline__ u32x4 pack8(const f32x4 o0, const f32x4 o1) { u32x4 w; w.x = cvt_pk_bf16(o0[0], o0[1]); w.y = cvt_pk_bf16(o0[2], o0[3]); w.z = cvt_pk_bf16(o1[0], o1[1]); w.w = cvt_pk_bf16(o1[2], o1[3]); return w; }
struct EpiIn {
    static constexpr bool PERM = true, AFTER_DRAIN = false, REPEATABLE = true;
    const float* rss; const float *qna, *kna, *qnb, *knb;
    bf16_t *QA, *KA, *VA, *SGA, *QB, *SGB, *KB, *VB, *KI, *QI, *SMA, *SMB; float* WI; float* KMP;
    __device__ __forceinline__ void norm_rows(const f32x4 (&acc)[2][2][4][2], const Unit& u, int wr, int fr, int fq, const float* g, float oscale, bf16_t* dst, int ld, int coloff, float* kmp) const {
        f32x4 gv[2][2];
#pragma unroll
        for (int bj = 0; bj < 2; ++bj)
#pragma unroll
            for (int n = 0; n < 2; ++n) gv[bj][n] = *(const f32x4*)(g + 32 * bj + 8 * fq + 4 * n) * oscale;
        f32x4 cs[2][2];
#pragma unroll
        for (int bj = 0; bj < 2; ++bj)
#pragma unroll
            for (int n = 0; n < 2; ++n) cs[bj][n] = (f32x4){0.f, 0.f, 0.f, 0.f};
#pragma unroll
        for (int ai = 0; ai < 2; ++ai)
#pragma unroll
            for (int m = 0; m < 4; ++m) {
                const int row = u.pm * BM + ai * HALF + wr * 64 + m * 16 + fr; const float rs = row_rs(rss, row, fq);
                float sq = 0.f;
#pragma unroll
                for (int bj = 0; bj < 2; ++bj)
#pragma unroll
                    for (int n = 0; n < 2; ++n) { const f32x4 t = acc[ai][bj][m][n]; sq += (t[0] * t[0] + t[1] * t[1]) + (t[2] * t[2] + t[3] * t[3]); }
                sq += __shfl_xor(sq, 16); sq += __shfl_xor(sq, 32);
                const float sc = rs * __builtin_amdgcn_rsqf(sq * rs * rs * (1.0f / 64.0f) + EPS);
#pragma unroll
                for (int bj = 0; bj < 2; ++bj) {
                    const f32x4 o0 = acc[ai][bj][m][0] * sc * gv[bj][0], o1 = acc[ai][bj][m][1] * sc * gv[bj][1];
                    cs[bj][0] += o0; cs[bj][1] += o1;
                    *(u32x4*)(dst + (size_t)row * ld + coloff + 32 * bj + 8 * fq) = pack8(o0, o1); }
                asm volatile("" ::: "memory");
            }
        if (kmp) {
#pragma unroll
            for (int bj = 0; bj < 2; ++bj)
#pragma unroll
                for (int n = 0; n < 2; ++n) { f32x4 t = cs[bj][n];
#pragma unroll
                    for (int o = 1; o < 16; o <<= 1) { t[0] += __shfl_xor(t[0], o); t[1] += __shfl_xor(t[1], o); t[2] += __shfl_xor(t[2], o); t[3] += __shfl_xor(t[3], o); }
                    if (fr == 0) *(f32x4*)(kmp + 32 * bj + 8 * fq + 4 * n) = t; }
        }
    }
    __device__ __forceinline__ void plain_rows(const f32x4 (&acc)[2][2][4][2], const Unit& u, int wr, int fr, int fq, bf16_t* dst, int ld, int col0, int bjs, float ca, float cb, float cc, float* wi) const {
        const float pa = ca + cc, pb = cb, pc = cb + cc, pd = ca;
        float rsv[2][4];
#pragma unroll
        for (int ai = 0; ai < 2; ++ai)
#pragma unroll
            for (int m = 0; m < 4; ++m) rsv[ai][m] = row_rs(rss, u.pm * BM + ai * HALF + wr * 64 + m * 16 + fr, fq);
#pragma unroll
        for (int ai = 0; ai < 2; ++ai)
#pragma unroll
            for (int m = 0; m < 4; ++m) {
                const int row = u.pm * BM + ai * HALF + wr * 64 + m * 16 + fr; const float rs = rsv[ai][m], rsn = -LOG2E * rs;
                if (wi) { if (fq == 0) *(f32x4*)(wi + (size_t)row * 4) = acc[ai][0][m][0] * rs; }
                else {
#pragma unroll
                for (int bj = 0; bj < 2; ++bj) { f32x4 o[2];
#pragma unroll
                    for (int n = 0; n < 2; ++n) { const f32x4 a = acc[ai][bj][m][n]; const f32x4 v = a * rs, t = a * rsn; f32x4 e;
#pragma unroll
                        for (int i = 0; i < 4; ++i) e[i] = __builtin_amdgcn_exp2f(t[i]);
                        e = e + 1.0f; f32x4 sg;
#pragma unroll
                        for (int i = 0; i < 4; ++i) sg[i] = __builtin_amdgcn_rcpf(e[i]);
                        o[n] = (v * pa + pb) * (sg * pc + pd); }
                    *(u32x4*)(dst + (size_t)row * ld + col0 + bj * bjs) = pack8(o[0], o[1]); }
                }
                asm volatile("" ::: "memory");
            }
    }
    __device__ __forceinline__ void operator()(const f32x4 (&acc)[2][2][4][2], const Unit& u, int wr, int wc, int fr_, int fq_) const {
        int fr = fr_, fq = fq_; asm volatile("" : "+v"(fr), "+v"(fq));
        const int pn = u.pn; const int cid = wc * 32 + 8 * fq;
        bool isnorm = false; bf16_t* dst; int ld = AW, col0, bjs = HALF; const float* g = qna; float osc = 1.0f; float* kmp = nullptr; float ca = 1.f, cb = 0.f, cc = 0.f; float* wi = nullptr;
        if (pn < 2) { isnorm = true; g = qna; osc = C2; dst = QA; col0 = 64 * (4 * pn + wc); }
        else if (pn < 4) { isnorm = true; g = kna; dst = KA; const int h = 4 * (pn - 2) + wc; col0 = 64 * h; kmp = KMP + ((((size_t)(u.pm >> 4) * 16 + (u.pm & 15)) * 8 + h) * 2 + wr) * 64; }
        else if (pn < 6) { dst = VA; col0 = 256 * (pn - 4) + cid; }
        else if (pn < 8) { dst = SGA; col0 = 256 * (pn - 6) + cid; ca = 0.f; cc = 1.f; }
        else if (pn < 10) { isnorm = true; g = qnb; osc = C2; dst = QB; col0 = 64 * (4 * (pn - 8) + wc); }
        else if (pn == 10) { ld = 64; bjs = 32; col0 = 8 * fq; dst = KI;
            if (wc == 0) { isnorm = true; g = knb; dst = KB; col0 = 0; } else if (wc == 1) { dst = VB; } else if (wc == 3) { wi = WI; } }
        else if (pn == 11) { dst = QI; ld = 256; col0 = cid; }
        else if (pn < 14) { dst = SGB; col0 = 256 * (pn - 12) + cid; ca = 0.f; cc = 1.f; }
        else if (pn < 18) { dst = SMA; ld = DM; col0 = 256 * (pn - 14) + cid; ca = 0.f; cb = 1.f; }
        else { dst = SMB; ld = DM; col0 = 256 * (pn - 18) + cid; ca = 0.f; cb = 1.f; }
        if (isnorm) norm_rows(acc, u, wr, fr, fq, g, osc, dst, ld, col0, kmp);
        else plain_rows(acc, u, wr, fr, fq, dst, ld, col0, bjs, ca, cb, cc, wi);
    }
};
struct EpiMerge {
    static constexpr bool PERM = true, AFTER_DRAIN = false, REPEATABLE = false;
    bf16_t* SMA; bf16_t* SMB;
    __device__ __forceinline__ void operator()(const f32x4 (&acc)[2][2][4][2], const Unit& u, int wr, int wc, int fr, int fq) const {
        const bool partb = u.pm >= 128; const int pm = partb ? u.pm - 128 : u.pm, pn = partb ? u.pn - 4 : u.pn;
#pragma unroll
        for (int ai = 0; ai < 2; ++ai)
#pragma unroll
            for (int m = 0; m < 4; ++m) { const int row = pm * BM + ai * HALF + wr * 64 + m * 16 + fr;
#pragma unroll
                for (int bj = 0; bj < 2; ++bj) { const size_t off = (size_t)row * DM + pn * BM + bj * HALF + wc * 32 + 8 * fq;
                    const u32x4 sg = *(const u32x4*)((partb ? SMB : SMA) + off);
                    const f32x4 s0 = (f32x4){__uint_as_float(sg.x << 16), __uint_as_float(sg.x & 0xffff0000u), __uint_as_float(sg.y << 16), __uint_as_float(sg.y & 0xffff0000u)};
                    const f32x4 s1 = (f32x4){__uint_as_float(sg.z << 16), __uint_as_float(sg.z & 0xffff0000u), __uint_as_float(sg.w << 16), __uint_as_float(sg.w & 0xffff0000u)};
                    f32x4 o0 = acc[ai][bj][m][0] * s0, o1 = acc[ai][bj][m][1] * s1;
                    if (partb) { const u32x4 pa = *(const u32x4*)(SMA + off);
                        o0 += (f32x4){__uint_as_float(pa.x << 16), __uint_as_float(pa.x & 0xffff0000u), __uint_as_float(pa.y << 16), __uint_as_float(pa.y & 0xffff0000u)};
                        o1 += (f32x4){__uint_as_float(pa.z << 16), __uint_as_float(pa.z & 0xffff0000u), __uint_as_float(pa.w << 16), __uint_as_float(pa.w & 0xffff0000u)}; }
                    u32x4 w; w.x = cvt_pk_bf16(o0[0], o0[1]); w.y = cvt_pk_bf16(o0[2], o0[3]); w.z = cvt_pk_bf16(o1[0], o1[1]); w.w = cvt_pk_bf16(o1[2], o1[3]);
                    *(u32x4*)((partb ? SMB : SMA) + off) = w; }
            }
    }
};
struct PairOrder {
    StaticOrder base;
    __device__ void init(int G_, int c_) { base.init(TOK, DM, G_, c_); }
    __device__ bool next(int i, Unit& u) const { Unit t; if (!base.next(i >> 1, t)) return false; u.pm = t.pm + (i & 1) * 128; u.pn = t.pn + (i & 1) * 4; return true; }
    __device__ __forceinline__ void a_ready(const Unit&) const {}
    __device__ __forceinline__ void done(const Unit&) const {}
};
template <bool WRITE_NEXT> struct EpiOut {
    static constexpr bool PERM = true, AFTER_DRAIN = false, REPEATABLE = false;
    const float* xin; float* out; bf16_t* XB; float* rss;
    __device__ __forceinline__ void operator()(const f32x4 (&acc)[2][2][4][2], const Unit& u, int wr, int wc, int fr, int fq) const {
#pragma unroll
        for (int ai = 0; ai < 2; ++ai)
#pragma unroll
            for (int m = 0; m < 4; ++m) { const int row = u.pm * BM + ai * HALF + wr * 64 + m * 16 + fr; float ss = 0.f;
#pragma unroll
                for (int bj = 0; bj < 2; ++bj) { const size_t off = (size_t)row * DM + u.pn * BM + bj * HALF + wc * 32 + 8 * fq;
                    const f32x4 o0 = acc[ai][bj][m][0] + *(const f32x4*)(xin + off), o1 = acc[ai][bj][m][1] + *(const f32x4*)(xin + off + 4);
                    *(f32x4*)(out + off) = o0; *(f32x4*)(out + off + 4) = o1;
                    if (WRITE_NEXT) { ss += (o0[0] * o0[0] + o0[1] * o0[1]) + (o0[2] * o0[2] + o0[3] * o0[3]) + (o1[0] * o1[0] + o1[1] * o1[1]) + (o1[2] * o1[2] + o1[3] * o1[3]);
                        u32x4 w; w.x = cvt_pk_bf16(o0[0], o0[1]); w.y = cvt_pk_bf16(o0[2], o0[3]); w.z = cvt_pk_bf16(o1[0], o1[1]); w.w = cvt_pk_bf16(o1[2], o1[3]);
                        *(u32x4*)(XB + off) = w; } }
                if (WRITE_NEXT) { ss += __shfl_xor(ss, 16); ss += __shfl_xor(ss, 32); if (fq == 0) rss[(size_t)row * 16 + 4 * u.pn + wc] = ss; }
            }
    }
};
}

__device__ __forceinline__ int rel_bucket_dev(int n) {
    if (n < 16) return n;
    int large = 16 + (int)(logf((float)n / 16.0f) / logf(8.0f) * 16.0f);
    return large < 31 ? large : 31;
}
__device__ __forceinline__ void build_bias_table(Frame& F, LAS float* tb, const float* gq, const float* gk, int hoff) {
    PHASE_TID(); const float* rb = in_ptr(10);
    float gm = 0.f;
    for (int d = 0; d < 64; ++d) gm = fmaxf(gm, fabsf(gq[d] * gk[d]));
    for (int e = ptid; e < 8 * 128; e += NWAVES * 64) { const int h = e >> 7, d = e & 127;
        float bm = -1e30f; for (int k = 0; k < 32; ++k) bm = fmaxf(bm, rb[k * 16 + hoff + h]);
        const float M0 = 64.0f * C2 * gm + bm * LOG2E;
        tb[e] = rb[rel_bucket_dev(d) * 16 + hoff + h] * LOG2E - M0; }
}

template <int MODE>
__device__ __forceinline__ void naive_attn(Frame& F, int layer) {
    PHASE_TID();
    LAS float* tb = (LAS float*)F.lds;
    const float* gq = in_ptr(MODE == 0 ? 3 : 5) + layer * 64; const float* gk = in_ptr(MODE == 0 ? 4 : 6) + layer * 64;
    build_bias_table(F, tb, gq, gk, MODE * 8);
    __syncthreads();
    const bf16* Q = (const bf16*)(F.ws + (MODE == 0 ? WS_QA : WS_QB));
    const bf16* K = (const bf16*)(F.ws + (MODE == 0 ? WS_KA : WS_KB));
    const bf16* V = (const bf16*)(F.ws + (MODE == 0 ? WS_VA : WS_VB));
    const bf16* SG = (const bf16*)(F.ws + (MODE == 0 ? WS_SGA : WS_SGB));
    bf16* Y = (bf16*)(F.ws + WS_XB) + (size_t)MODE * TOK * AW;
    const float* KMP = (const float*)(F.ws + WS_KMP);
    const u64* BM = (const u64*)(F.ws + WS_BM);
    constexpr int KLD = (MODE == 0) ? AW : 64;
    for (int item = blockIdx.x * (NWAVES * 64) + ptid; item < BATCH * NH * SEQ; item += F.G * NWAVES * 64) {
        const int q = item & (SEQ - 1), h = (item >> 12) & 7, b = item >> 15; const int qblk = q >> 8;
        const size_t tq = (size_t)b * SEQ + q;
        float qv[64];
        { const v4u* qp = (const v4u*)(Q + tq * AW + h * 64);
#pragma unroll
            for (int c = 0; c < 8; ++c) { const v4u w = qp[c]; qv[8 * c + 0] = bflo(w.x); qv[8 * c + 1] = bfhi(w.x); qv[8 * c + 2] = bflo(w.y); qv[8 * c + 3] = bfhi(w.y); qv[8 * c + 4] = bflo(w.z); qv[8 * c + 5] = bfhi(w.z); qv[8 * c + 6] = bflo(w.w); qv[8 * c + 7] = bfhi(w.w); } }
        unsigned selmask = 0;
        if (MODE == 0) {
            float gate[16];
#pragma unroll
            for (int n = 0; n < 16; ++n) { gate[n] = -INFINITY;
                if (n < qblk) { const float* k0 = KMP + ((((size_t)b * 16 + n) * 8 + h) * 2) * 64; float s = 0.f;
#pragma unroll
                    for (int d = 0; d < 64; ++d) s += qv[d] * ((k0[d] + k0[64 + d]) * (1.0f / 256.0f));
                    gate[n] = s; } }
            const int nsel = qblk < 3 ? qblk : 3;
            for (int r = 0; r < nsel; ++r) { float best = -INFINITY; int bi = -1;
#pragma unroll
                for (int n = 0; n < 16; ++n) { const bool ok = (n < qblk) && !((selmask >> n) & 1u) && (bi < 0 || gate[n] > best); if (ok) { best = gate[n]; bi = n; } }
                selmask |= 1u << bi; }
        }
        float acc[64];
#pragma unroll
        for (int d = 0; d < 64; ++d) acc[d] = 0.f;
        float l = 0.f;
        const int kend = (item | 63) & (SEQ - 1);
        const LAS float* tbh = tb + h * 128;
        u64 mw = 0;
        for (int k = 0; k <= kend; ++k) {
            bool allowed;
            if (MODE == 0) { const int n = k >> 8; allowed = (n == qblk) ? (k <= q) : (((selmask >> n) & 1u) != 0u && n < qblk); }
            else { if ((k & 63) == 0) mw = (k <= q) ? BM[tq * 64 + (k >> 6)] : 0ull; allowed = ((mw >> (k & 63)) & 1ull) != 0ull; }
            if (!__any(allowed)) continue;
            const size_t tk = (size_t)b * SEQ + k;
            const v4u* kp = (const v4u*)(K + tk * KLD + (MODE == 0 ? h * 64 : 0));
            float s = 0.f;
#pragma unroll
            for (int c = 0; c < 8; ++c) { const v4u w = kp[c];
                s += qv[8 * c + 0] * bflo(w.x); s += qv[8 * c + 1] * bfhi(w.x); s += qv[8 * c + 2] * bflo(w.y); s += qv[8 * c + 3] * bfhi(w.y);
                s += qv[8 * c + 4] * bflo(w.z); s += qv[8 * c + 5] * bfhi(w.z); s += qv[8 * c + 6] * bflo(w.w); s += qv[8 * c + 7] * bfhi(w.w); }
            int dist = q - k; dist = dist < 0 ? 0 : (dist > 127 ? 127 : dist);
            s += tbh[dist];
            const float p = allowed ? __builtin_amdgcn_exp2f(s) : 0.f;
            l += p;
            const v4u* vp = (const v4u*)(V + tk * KLD + (MODE == 0 ? h * 64 : 0));
#pragma unroll
            for (int c = 0; c < 8; ++c) { const v4u w = vp[c];
                acc[8 * c + 0] += p * bflo(w.x); acc[8 * c + 1] += p * bfhi(w.x); acc[8 * c + 2] += p * bflo(w.y); acc[8 * c + 3] += p * bfhi(w.y);
                acc[8 * c + 4] += p * bflo(w.z); acc[8 * c + 5] += p * bfhi(w.z); acc[8 * c + 6] += p * bflo(w.w); acc[8 * c + 7] += p * bfhi(w.w); }
        }
        const float il = 1.0f / l;
        const v4u* gp = (const v4u*)(SG + tq * AW + h * 64); v4u* yp = (v4u*)(Y + tq * AW + h * 64);
#pragma unroll
        for (int c = 0; c < 8; ++c) { const v4u g = gp[c]; v4u o;
            o.x = pk2(acc[8 * c + 0] * il * bflo(g.x), acc[8 * c + 1] * il * bfhi(g.x)); o.y = pk2(acc[8 * c + 2] * il * bflo(g.y), acc[8 * c + 3] * il * bfhi(g.y));
            o.z = pk2(acc[8 * c + 4] * il * bflo(g.z), acc[8 * c + 5] * il * bfhi(g.z)); o.w = pk2(acc[8 * c + 6] * il * bflo(g.w), acc[8 * c + 7] * il * bfhi(g.w));
            yp[c] = o; }
    }
}

typedef float f32x16 __attribute__((ext_vector_type(16)));
typedef short s16x4 __attribute__((ext_vector_type(4)));
typedef short v4i16_t __attribute__((ext_vector_type(4)));
constexpr int AT_D = 4, AT_R = AT_D + 2;
constexpr int AT_RING = 0, AT_STAGE = 16384, AT_OST = 0  , AT_TB = AT_R * AT_STAGE, AT_WS = AT_TB + 8192, AT_BM = AT_WS + 2048;
static_assert(8 * 8192 <= AT_R * AT_STAGE && AT_BM + 16384 <= LDSCTL_OFF, "attention LDS");
__device__ __forceinline__ void glds16(const void* gsrc, unsigned lds_dst) { unsigned keep;
    asm volatile("s_mov_b32 %0, m0\n\ts_mov_b32 m0, %2\n\ts_nop 0\n\tglobal_load_lds_dwordx4 %1, off\n\ts_mov_b32 m0, %0" : "=&s"(keep) : "v"(gsrc), "s"(lds_dst) : "memory"); }
#define AT_WAIT_BAR() asm volatile("s_waitcnt vmcnt(0) lgkmcnt(0)\n\ts_barrier" ::: "memory")
#define AT_WAIT_BAR_N(N) asm volatile("s_waitcnt vmcnt(%0) lgkmcnt(0)\n\ts_barrier" :: "n"(N) : "memory")
__device__ __forceinline__ int crow(int r, int hi) { return (r & 3) + 8 * (r >> 2) + 4 * hi; }
__device__ __forceinline__ unsigned cvtpk(float lo, float hi) { unsigned r; asm volatile("v_cvt_pk_bf16_f32 %0, %1, %2" : "=v"(r) : "v"(lo), "v"(hi)); return r; }

template <int MODE>
__device__ __forceinline__ void attn_unit(Frame& F, int b, int h_, int blk) {
    int tid_o = threadIdx.x; asm volatile("" : "+v"(tid_o));
    const int lane = tid_o & 63, r32 = lane & 31, hi = lane >> 5, wid = __builtin_amdgcn_readfirstlane(tid_o >> 6);
    constexpr int KLD = (MODE == 0) ? AW : 64;
    const int h = (MODE == 0) ? h_ : wid;
    const int q0 = (MODE == 0) ? 256 * blk + 32 * wid : 32 * blk;
    const int q = q0 + r32; const size_t tq = (size_t)b * SEQ + q;
    const int NT = (MODE == 0) ? 4 * (blk + 1) : (32 * blk + 31) / 64 + 1;
    const bf16* Q = (const bf16*)(F.ws + (MODE == 0 ? WS_QA : WS_QB));
    const bf16* Kg = (const bf16*)(F.ws + (MODE == 0 ? WS_KA : WS_KB)) + (size_t)b * SEQ * KLD + (MODE == 0 ? h * 64 : 0);
    const bf16* Vg = (const bf16*)(F.ws + (MODE == 0 ? WS_VA : WS_VB)) + (size_t)b * SEQ * KLD + (MODE == 0 ? h * 64 : 0);
    const bf16* SG = (const bf16*)(F.ws + (MODE == 0 ? WS_SGA : WS_SGB));
    bf16* Y = (bf16*)(F.ws + WS_XB) + (size_t)MODE * TOK * AW;
    const u64* BM = (const u64*)(F.ws + WS_BM) + tq * 64;
    LAS unsigned char* lds = F.lds;
    const LAS float* tbh = (const LAS float*)(lds + AT_TB) + (MODE * 8 + h) * 128;
    LAS float* wsf = (LAS float*)(lds + AT_WS) + wid * 64;
    LAS float* ost = (LAS float*)(lds + AT_OST) + wid * 2048;
    const int krow_ = 8 * wid + (lane >> 3);
    const bf16* ksrc = Kg + (size_t)krow_ * KLD + 8 * ((lane & 7) ^ ((krow_ ^ (krow_ >> 3)) & 7));
    const bf16* vsrc = Vg + (size_t)(8 * wid + ((lane & 31) >> 2)) * KLD + 32 * (lane >> 5) + 8 * (lane & 3);
    const unsigned lds0 = (unsigned)(uintptr_t)lds;
#define AT_DMA(t, so) do { \
        glds16(ksrc + (size_t)(t) * 64 * KLD, (unsigned)__builtin_amdgcn_readfirstlane((int)(lds0 + AT_RING + (so) + wid * 1024))); \
        glds16(vsrc + (size_t)(t) * 64 * KLD, (unsigned)__builtin_amdgcn_readfirstlane((int)(lds0 + AT_RING + (so) + 8192 + wid * 1024))); } while (0)
#pragma unroll
    for (int i = 0; i < AT_D; ++i) AT_DMA((i < NT ? i : NT - 1), i * AT_STAGE);
    bf16x8 qr[4];
#pragma unroll
    for (int d0 = 0; d0 < 4; ++d0) qr[d0] = *(const bf16x8*)(Q + tq * AW + h * 64 + 16 * d0 + 8 * hi);
    LAS u64* bmL = (LAS u64*)(lds + AT_BM);
    if (MODE == 1) {
        const u64* BMu = (const u64*)(F.ws + WS_BM) + ((size_t)b * SEQ + q0) * 64;
#pragma unroll
        for (int ps = 0; ps < 2; ++ps) { const int it = ps * 512 + (tid_o & 511), row = it >> 5, j2 = (it & 31) * 2;
            const v4u w = *(const v4u*)(BMu + (size_t)row * 64 + j2);
            bmL[j2 * 32 + row] = (u64)w.x | ((u64)w.y << 32); bmL[(j2 + 1) * 32 + row] = (u64)w.z | ((u64)w.w << 32); }
    }
    unsigned selmask = 0;
    if (MODE == 0 && blk > 0) {
        const bf16* kmh = (const bf16*)(F.ws + WS_KMH) + ((size_t)(b * 8 + h) * 32 + r32) * 64 + 8 * hi;
        const bf16* kml = (const bf16*)(F.ws + WS_KML) + ((size_t)(b * 8 + h) * 32 + r32) * 64 + 8 * hi;
        f32x16 gg;
#pragma unroll
        for (int r = 0; r < 16; ++r) gg[r] = 0.f;
#pragma unroll
        for (int d0 = 0; d0 < 4; ++d0) {
            gg = __builtin_amdgcn_mfma_f32_32x32x16_bf16(*(const bf16x8*)(kmh + 16 * d0), qr[d0], gg, 0, 0, 0);
            gg = __builtin_amdgcn_mfma_f32_32x32x16_bf16(*(const bf16x8*)(kml + 16 * d0), qr[d0], gg, 0, 0, 0); }
        float gate[16];
#pragma unroll
        for (int r = 0; r < 8; ++r) { const float o = __shfl_xor(gg[r], 32); const int nb_ = (r & 3) + 8 * (r >> 2); gate[nb_] = hi ? o : gg[r]; gate[nb_ + 4] = hi ? gg[r] : o; }
        const int nsel = blk < 3 ? blk : 3;
        for (int r = 0; r < nsel; ++r) { float best = -INFINITY; int bi = -1;
#pragma unroll
            for (int n = 0; n < 16; ++n) { const bool ok = (n < blk) && !((selmask >> n) & 1u) && (bi < 0 || gate[n] > best); if (ok) { best = gate[n]; bi = n; } }
            selmask |= 1u << bi; }
    }
    const float cfar = tbh[127]; const float NINF = -INFINITY;
#define AT_INIT_NEAR(t, c0, c1, mw) do { \
        const int kv0_ = 64 * (t); \
        bool sel_ = (t) < NT; \
        if (MODE == 0) { const int n_ = (t) >> 2; sel_ = sel_ && ((n_ == blk) || (((selmask >> (n_ & 15)) & 1u) != 0u)); } \
        unsigned mlo_ = 0, mhi_ = 0; if (MODE == 1) { const u64 ms_ = (mw) >> (4 * hi); mlo_ = (unsigned)ms_; mhi_ = (unsigned)(ms_ >> 32); } \
        _Pragma("unroll") for (int r = 0; r < 16; ++r) { const int bp = (r & 3) + 8 * (r >> 2); \
            const int d0_ = q - (kv0_ + bp + 4 * hi), d1_ = d0_ - 32; \
            const float b0_ = tbh[d0_ < 0 ? 0 : (d0_ > 127 ? 127 : d0_)], b1_ = tbh[d1_ < 0 ? 0 : (d1_ > 127 ? 127 : d1_)]; \
            if (MODE == 0) { c0[r] = (sel_ && d0_ >= 0) ? b0_ : NINF; c1[r] = (sel_ && d1_ >= 0) ? b1_ : NINF; } \
            else { c0[r] = (sel_ && ((mlo_ >> bp) & 1u)) ? b0_ : NINF; c1[r] = (sel_ && ((mhi_ >> bp) & 1u)) ? b1_ : NINF; } } } while (0)
#define AT_INIT_FARB(t, c0, c1, mw) do { \
        const u64 ms_ = ((t) < NT) ? ((mw) >> (4 * hi)) : 0ull; const int mlo_ = (int)(unsigned)ms_, mhi_ = (int)(unsigned)(ms_ >> 32); \
        const unsigned cf_ = __float_as_uint(cfar), nf_ = 0xff800000u; \
        _Pragma("unroll") for (int r = 0; r < 16; ++r) { const int bp = (r & 3) + 8 * (r >> 2); \
            const unsigned m0_ = (unsigned)__builtin_amdgcn_sbfe(mlo_, bp, 1), m1_ = (unsigned)__builtin_amdgcn_sbfe(mhi_, bp, 1); \
            c0[r] = __uint_as_float((m0_ & cf_) | (~m0_ & nf_)); c1[r] = __uint_as_float((m1_ & cf_) | (~m1_ & nf_)); } } while (0)
    const int kswz = (r32 ^ (r32 >> 3)) & 7;
#define AT_KF(Kt_, d0, p) (*(const LAS bf16x8*)((Kt_) + (p) * 4096 + (((2 * (d0) + hi) ^ kswz ^ (4 * (p))) << 4)))
#define AT_QK(so, c0, c1, i0, i1) do { const LAS unsigned char* Kt_ = lds + AT_RING + (so) + r32 * 128; \
        c0 = __builtin_amdgcn_mfma_f32_32x32x16_bf16(AT_KF(Kt_, 0, 0), qr[0], i0, 0, 0, 0); \
        c1 = __builtin_amdgcn_mfma_f32_32x32x16_bf16(AT_KF(Kt_, 0, 1), qr[0], i1, 0, 0, 0); \
        _Pragma("unroll") for (int d0 = 1; d0 < 4; ++d0) { \
            c0 = __builtin_amdgcn_mfma_f32_32x32x16_bf16(AT_KF(Kt_, d0, 0), qr[d0], c0, 0, 0, 0); \
            c1 = __builtin_amdgcn_mfma_f32_32x32x16_bf16(AT_KF(Kt_, d0, 1), qr[d0], c1, 0, 0, 0); } } while (0)
#define AT_SCORES(t, kf, c0, c1, mw) do { \
        const bool nearD_ = (q0 - (64 * (t) + 63)) < 113; \
        if (nearD_) { AT_INIT_NEAR(t, c0, c1, mw); AT_QK(kf, c0, c1, c0, c1); } \
        else if (MODE == 0) { AT_QK(kf, c0, c1, ivec, ivec); } \
        else { AT_INIT_FARB(t, c0, c1, mw); AT_QK(kf, c0, c1, c0, c1); } } while (0)
#define AT_IVEC(t) do { if (MODE == 0) { const int n_ = (t) >> 2; const bool s_ = ((t) < NT) && ((n_ == blk) || (((selmask >> (n_ & 15)) & 1u) != 0u)); const float v_ = s_ ? cfar : NINF; \
        _Pragma("unroll") for (int r = 0; r < 16; ++r) ivec[r] = v_; asm volatile("" : "+v"(ivec)); } } while (0)
#ifndef EXP_LDS
#define EXP_LDS 0
#endif
#ifndef EXP_EXP
#define EXP_EXP 0
#endif
#ifndef EXP_MFMA
#define EXP_MFMA 0
#endif
    f32x16 o0, o1, ivec; pg8::f32x4 dm4a = (pg8::f32x4){0.f,0.f,0.f,0.f}, dm4b = (pg8::f32x4){0.f,0.f,0.f,0.f}; f32x16 dmy; if (EXP_MFMA) { _Pragma("unroll") for (int r = 0; r < 16; ++r) dmy[r] = 0.f; }
#pragma unroll
    for (int r = 0; r < 16; ++r) { o0[r] = 0.f; o1[r] = 0.f; ivec[r] = NINF; }
    float lsum = 0.f;
    f32x16 ca0, ca1, cb0, cb1;
    AT_WAIT_BAR_N(2 * (AT_D - 1));
    AT_IVEC(0);
    { u64 mw0 = 0ull; if (MODE == 1) mw0 = bmL[r32];
      AT_SCORES(0, 0, ca0, ca1, mw0); }
    const int vbl = ((lane >> 4) & 1) * 32 + (lane & 3) * 8 + (4 * hi + ((lane & 15) >> 2)) * 64;
    int so_cur = 0, so_nxt = AT_STAGE, so_dma = AT_D * AT_STAGE;
#define AT_STEP(t, C0, C1, N0, N1) do { \
        u64 mw1_ = 0ull; if (MODE == 1) mw1_ = bmL[(((t) + 1) & 63) * 32 + r32]; \
        const LAS unsigned char* Vt_ = lds + AT_RING + so_cur + 8192; \
        asm volatile("" ::: "memory"); \
        if ((((t) + 1) & 3) == 0) AT_IVEC((t) + 1); \
        AT_SCORES((t) + 1, so_nxt, N0, N1, mw1_); \
        float sacc_ = 0.f; \
        if (EXP_EXP) { _Pragma("unroll") for (int r = 0; r < 16; ++r) { float e0_ = __builtin_amdgcn_exp2f(C0[r] + 1.0f), e1_ = __builtin_amdgcn_exp2f(C1[r] + 1.0f); asm volatile("" :: "v"(e0_), "v"(e1_)); } } \
        _Pragma("unroll") for (int r = 0; r < 16; ++r) { C0[r] = __builtin_amdgcn_exp2f(C0[r]); C1[r] = __builtin_amdgcn_exp2f(C1[r]); sacc_ += C0[r] + C1[r]; } \
        lsum += sacc_; \
        u32x4v pw_[4]; \
        _Pragma("unroll") for (int s_ = 0; s_ < 2; ++s_) { \
            pw_[s_] = (u32x4v){cvtpk(C0[8 * s_], C0[8 * s_ + 1]), cvtpk(C0[8 * s_ + 2], C0[8 * s_ + 3]), cvtpk(C0[8 * s_ + 4], C0[8 * s_ + 5]), cvtpk(C0[8 * s_ + 6], C0[8 * s_ + 7])}; \
            pw_[2 + s_] = (u32x4v){cvtpk(C1[8 * s_], C1[8 * s_ + 1]), cvtpk(C1[8 * s_ + 2], C1[8 * s_ + 3]), cvtpk(C1[8 * s_ + 4], C1[8 * s_ + 5]), cvtpk(C1[8 * s_ + 6], C1[8 * s_ + 7])}; } \
        _Pragma("unroll") for (int ks = 0; ks < 4; ++ks) { const bf16x8 pa_ = __builtin_bit_cast(bf16x8, pw_[ks]); \
            _Pragma("unroll") for (int d0 = 0; d0 < 2; ++d0) { const LAS unsigned char* vp_ = Vt_ + (2 * ks) * 1024 + d0 * 512 + vbl; \
                const s16x4 lo_ = __builtin_bit_cast(s16x4, __builtin_amdgcn_ds_read_tr16_b64_v4i16((LAS v4i16_t*)vp_)), hh_ = __builtin_bit_cast(s16x4, __builtin_amdgcn_ds_read_tr16_b64_v4i16((LAS v4i16_t*)(vp_ + 1024))); \
                if (EXP_LDS) { s16x4 l2_ = __builtin_bit_cast(s16x4, __builtin_amdgcn_ds_read_tr16_b64_v4i16((LAS v4i16_t*)(vp_ + 2048))), h2_ = __builtin_bit_cast(s16x4, __builtin_amdgcn_ds_read_tr16_b64_v4i16((LAS v4i16_t*)(vp_ + 3072))); asm volatile("" :: "v"(l2_), "v"(h2_)); } \
                const bf16x8 vf_ = (bf16x8){lo_[0], lo_[1], lo_[2], lo_[3], hh_[0], hh_[1], hh_[2], hh_[3]}; \
                if (d0 == 0) o0 = __builtin_amdgcn_mfma_f32_32x32x16_bf16(pa_, vf_, o0, 0, 0, 0); else o1 = __builtin_amdgcn_mfma_f32_32x32x16_bf16(pa_, vf_, o1, 0, 0, 0); \
                if (EXP_MFMA == 1) { dmy = __builtin_amdgcn_mfma_f32_32x32x16_bf16(pa_, vf_, dmy, 0, 0, 0); } \
                if (EXP_MFMA == 2) { dm4a = __builtin_amdgcn_mfma_f32_16x16x32_bf16(pa_, vf_, dm4a, 0, 0, 0); dm4b = __builtin_amdgcn_mfma_f32_16x16x32_bf16(vf_, pa_, dm4b, 0, 0, 0); } } } \
        so_cur = so_nxt; so_nxt = (so_nxt == (AT_R - 1) * AT_STAGE) ? 0 : so_nxt + AT_STAGE; } while (0)
    for (int t = 0; t < NT; t += 2) {
        AT_WAIT_BAR_N(2 * (AT_D - 3));
        { const int td_ = t + AT_D; AT_DMA((td_ < NT ? td_ : NT - 1), so_dma); so_dma = (so_dma == (AT_R - 1) * AT_STAGE) ? 0 : so_dma + AT_STAGE; }
        { const int td_ = t + AT_D + 1; AT_DMA((td_ < NT ? td_ : NT - 1), so_dma); so_dma = (so_dma == (AT_R - 1) * AT_STAGE) ? 0 : so_dma + AT_STAGE; }
        AT_STEP(t, ca0, ca1, cb0, cb1);
        AT_STEP(t + 1, cb0, cb1, ca0, ca1);
    }
    if (EXP_MFMA == 1) asm volatile("" :: "v"(dmy));
    if (EXP_MFMA == 2) asm volatile("" :: "v"(dm4a), "v"(dm4b));
    AT_WAIT_BAR();
    lsum += __shfl_xor(lsum, 32);
    if (hi == 0) wsf[r32] = lsum;
    LDS_WAIT(); asm volatile("" ::: "memory");
#pragma unroll
    for (int r = 0; r < 16; ++r) { const int orow = crow(r, hi); const float rl = __builtin_amdgcn_rcpf(wsf[orow]);
        ost[orow * 64 + r32] = o0[r] * rl; ost[orow * 64 + 32 + r32] = o1[r] * rl; }
    LDS_WAIT(); asm volatile("" ::: "memory");
#pragma unroll
    for (int i = 0; i < 4; ++i) { const int row = i * 8 + (lane >> 3), ch = lane & 7;
        const f32x4 a = *(const LAS f32x4*)(ost + row * 64 + ch * 8), c = *(const LAS f32x4*)(ost + row * 64 + ch * 8 + 4);
        const size_t off = ((size_t)b * SEQ + q0 + row) * AW + h * 64 + ch * 8;
        const v4u g = *(const v4u*)(SG + off); v4u o;
        o.x = pk2(a[0] * bflo(g.x), a[1] * bfhi(g.x)); o.y = pk2(a[2] * bflo(g.y), a[3] * bfhi(g.y)); o.z = pk2(c[0] * bflo(g.z), c[1] * bfhi(g.z)); o.w = pk2(c[2] * bflo(g.w), c[3] * bfhi(g.w));
        *(v4u*)(Y + off) = o; }
    AT_WAIT_BAR();
#undef AT_DMA
#undef AT_INIT_NEAR
#undef AT_INIT_FARB
#undef AT_QK
#undef AT_KF
#undef AT_SCORES
#undef AT_IVEC
#undef AT_STEP
}
__device__ __forceinline__ void attn_phase_fast(Frame& F, int layer) {
    { LAS float* tb = (LAS float*)(F.lds + AT_TB);
      build_bias_table(F, tb, in_ptr(3) + layer * 64, in_ptr(4) + layer * 64, 0);
      build_bias_table(F, tb + 1024, in_ptr(5) + layer * 64, in_ptr(6) + layer * 64, 8); }
    __syncthreads();
#ifndef REP_ATT_A
#define REP_ATT_A 1
#endif
#ifndef REP_ATT_B
#define REP_ATT_B 1
#endif
    for (int rep = 0; rep < REP_ATT_A; ++rep)
    for (int pr = F.vcu; pr < 512; pr += F.G) {
        const int bh = pr >> 3, s = pr & 7;
        attn_unit<0>(F, bh >> 3, bh & 7, 15 - s); attn_unit<0>(F, bh >> 3, bh & 7, s); }
    for (int rep = 0; rep < REP_ATT_B; ++rep)
    for (int pr = F.vcu; pr < 512; pr += F.G) {
        const int b = pr >> 6, s = pr & 63;
        attn_unit<1>(F, b, 0, 127 - s); attn_unit<1>(F, b, 0, s); }
}

constexpr int IDX_S_OFF = 0, IDX_Q_OFF = RING_BYTES, IDX_W_OFF = RING_BYTES + 8192, IDX_H_OFF = RING_BYTES;
static_assert(IDX_H_OFF + 8 * 3328 <= LDSCTL_OFF, "idx LDS");

#define DPPI_(x, ctrl) __builtin_amdgcn_update_dpp(0, (x), (ctrl), 0xF, 0xF, true)
#define DPPF_(x, ctrl) __builtin_bit_cast(float, DPPI_(__builtin_bit_cast(int, (x)), (ctrl)))
__device__ __forceinline__ float rl_f(float x, int l) { return __builtin_bit_cast(float, __builtin_amdgcn_readlane(__builtin_bit_cast(int, x), l)); }
__device__ __forceinline__ float wave_minf(float x) {
    x = fminf(x, DPPF_(x, 0xB1)); x = fminf(x, DPPF_(x, 0x4E)); x = fminf(x, DPPF_(x, 0x141)); x = fminf(x, DPPF_(x, 0x140));
    return fminf(fminf(rl_f(x, 0), rl_f(x, 16)), fminf(rl_f(x, 32), rl_f(x, 48)));
}
__device__ __forceinline__ float wave_maxf(float x) {
    x = fmaxf(x, DPPF_(x, 0xB1)); x = fmaxf(x, DPPF_(x, 0x4E)); x = fmaxf(x, DPPF_(x, 0x141)); x = fmaxf(x, DPPF_(x, 0x140));
    return fmaxf(fmaxf(rl_f(x, 0), rl_f(x, 16)), fmaxf(rl_f(x, 32), rl_f(x, 48)));
}
#define SEL_OPAQUE() do { _Pragma("unroll") for (int j_ = 0; j_ < 64; ++j_) asm volatile("" : "+v"(v[j_])); } while (0)
__device__ __forceinline__ unsigned bin_of(float x, float lo, float scale) {
    int r; const float t = (x - lo) * scale; asm("v_cvt_i32_f32 %0, %1" : "=v"(r) : "v"(t)); const unsigned u = (unsigned)r; return u < 256u ? u : 256u;
}
template <bool KNOWN>
__device__ __forceinline__ void select_core(LAS float* R, int n, int lane, LAS unsigned* hist, float& T_out, int& needT_out, float lo_in = 0.f, float hi_in = 0.f) {
    const int nch = (n + 63) >> 6;
    if (64 * (nch - 1) + lane >= n) R[64 * (nch - 1) + lane] = -INFINITY;
    LDS_WAIT(); asm volatile("" ::: "memory");
    const LAS float* Rl = R + lane;
    float lo = lo_in, hi = hi_in;
    if (!KNOWN) { lo = INFINITY; hi = -INFINITY;
#pragma unroll 4
        for (int j = 0; j < nch; ++j) { const float x = Rl[64 * j]; lo = fminf(lo, x == -INFINITY ? INFINITY : x); hi = fmaxf(hi, x); }
        lo = wave_minf(lo); hi = wave_maxf(hi); }
    int need = 256; float T = lo; int needT = 256;
    for (int iter = 0; iter < 48; ++iter) {
        T = lo; needT = need;
        if (!(hi > lo)) break;
        hist[lane] = 0u; hist[64 + lane] = 0u; hist[128 + lane] = 0u; hist[192 + lane] = 0u; hist[256 + (lane & 3)] = 0u;
        LDS_WAIT(); asm volatile("" ::: "memory");
        const float scale = 255.99f / (hi - lo);
#pragma unroll 4
        for (int j = 0; j < nch; ++j) __hip_atomic_fetch_add(hist + bin_of(Rl[64 * j], lo, scale), 1u, __ATOMIC_RELAXED, __HIP_MEMORY_SCOPE_WORKGROUP);
        LDS_WAIT(); asm volatile("" ::: "memory");
        const unsigned h0 = hist[4 * lane], h1 = hist[4 * lane + 1], h2 = hist[4 * lane + 2], h3 = hist[4 * lane + 3];
        unsigned suf = h0 + h1 + h2 + h3;
        suf += (unsigned)__builtin_amdgcn_update_dpp(0, (int)suf, 0x101, 0xF, 0xF, true); suf += (unsigned)__builtin_amdgcn_update_dpp(0, (int)suf, 0x102, 0xF, 0xF, true);
        suf += (unsigned)__builtin_amdgcn_update_dpp(0, (int)suf, 0x104, 0xF, 0xF, true); suf += (unsigned)__builtin_amdgcn_update_dpp(0, (int)suf, 0x108, 0xF, 0xF, true);
        { const unsigned r1 = __builtin_amdgcn_readlane(suf, 16), r2 = __builtin_amdgcn_readlane(suf, 32), r3 = __builtin_amdgcn_readlane(suf, 48);
          const int rw = lane >> 4; suf += (rw == 0) ? (r1 + r2 + r3) : (rw == 1) ? (r2 + r3) : (rw == 2) ? r3 : 0u; }
        const u64 bal = __ballot(suf >= (unsigned)need);
        if (bal == 0ull) break;
        const int ls = 63 - __builtin_clzll(bal);
        const unsigned a3 = __builtin_amdgcn_readlane(h3, ls), a2 = __builtin_amdgcn_readlane(h2, ls), a1 = __builtin_amdgcn_readlane(h1, ls), a0 = __builtin_amdgcn_readlane(h0, ls);
        const unsigned above_lane = __builtin_amdgcn_readlane(suf, ls) - (a0 + a1 + a2 + a3);
        unsigned bstar, above, cstar;
        if (above_lane + a3 >= (unsigned)need) { bstar = 4 * ls + 3; above = above_lane; cstar = a3; }
        else if (above_lane + a3 + a2 >= (unsigned)need) { bstar = 4 * ls + 2; above = above_lane + a3; cstar = a2; }
        else if (above_lane + a3 + a2 + a1 >= (unsigned)need) { bstar = 4 * ls + 1; above = above_lane + a3 + a2; cstar = a1; }
        else { bstar = 4 * ls; above = above_lane + a3 + a2 + a1; cstar = a0; }
        need -= (int)above;
        float nlo = INFINITY, nhi = -INFINITY; int cnt = 0;
        LAS float* candx = (LAS float*)hist; LAS unsigned* candi = hist + 64;
#pragma unroll 4
        for (int j = 0; j < nch; ++j) { const float x = Rl[64 * j];
            const bool c = bin_of(x, lo, scale) == bstar;
            const u64 cb = __ballot(c);
            if (cb != 0ull) { nlo = fminf(nlo, c ? x : INFINITY); nhi = fmaxf(nhi, c ? x : -INFINITY);
                const int pos = cnt + (int)__builtin_amdgcn_mbcnt_hi((unsigned)(cb >> 32), __builtin_amdgcn_mbcnt_lo((unsigned)cb, 0u));
                if (c && pos < 64) { candx[pos] = x; candi[pos] = (unsigned)(64 * j + lane); }
                cnt += __builtin_popcountll(cb); } }
        if (cstar <= 64u) {
            LDS_WAIT(); asm volatile("" ::: "memory");
            const bool mine = lane < (int)cstar;
            const float mx = mine ? candx[lane] : -INFINITY; const unsigned mi = candi[lane];
            int rank = 0;
            for (int i = 0; i < (int)cstar; ++i) { const float xi = rl_f(mx, i); const unsigned ii = (unsigned)__builtin_amdgcn_readlane((int)mi, i); rank += (xi > mx || (xi == mx && ii < mi)) ? 1 : 0; }
            const u64 tb_ = __ballot(mine && rank == need - 1);
            if (tb_ == 0ull) break;
            T = rl_f(mx, __builtin_ctzll(tb_));
            needT = need - __builtin_popcountll(__ballot(mine && mx > T));
            LDS_WAIT(); asm volatile("" ::: "memory");
            break;
        }
        nlo = wave_minf(nlo); nhi = wave_maxf(nhi);
        if ((int)cstar == need) { T = nlo; needT = 1 << 20; break; }
        lo = nlo; hi = nhi;
    }
    T_out = T; needT_out = needT;
}

__device__ __forceinline__ u64 bitmap_row(const LAS float* R, int n, int lane, float T, int needT) {
    const int nch = (n + 63) >> 6; const LAS float* Rl = R + lane;
    int run = 0; unsigned wlo = 0u, whi = 0u;
#pragma unroll 4
    for (int j = 0; j < nch; ++j) { const float x = Rl[64 * j];
        u64 w;
        const bool tie = (x == T); const u64 tbal = __ballot(tie);
        if (tbal == 0ull) w = __ballot(x > T);
        else { const int rank = run + (int)__builtin_amdgcn_mbcnt_hi((unsigned)(tbal >> 32), __builtin_amdgcn_mbcnt_lo((unsigned)tbal, 0u)); run += __builtin_popcountll(tbal);
            w = __ballot(x > T || (tie && rank < needT)); }
        if (lane == j) { wlo = (unsigned)w; whi = (unsigned)(w >> 32); }
    }
    return (u64)wlo | ((u64)whi << 32);
}
__device__ __forceinline__ u64 select_row(LAS float* R, int n, int lane, LAS unsigned* hist) {
    const int nch = (n + 63) >> 6;
    if (64 * (nch - 1) + lane >= n) R[64 * (nch - 1) + lane] = -INFINITY;
    LDS_WAIT(); asm volatile("" ::: "memory");
    const LAS float* Rl = R + lane;
    LAS unsigned short* idx16 = (LAS unsigned short*)(hist + 320);
    float T; int needT;
    bool fast = n >= 768;
    float L = 0.f; int cnt = 0;
    if (fast) {
        const float x0 = Rl[0];
        int kth = (64 * 640) / n; kth = kth < 4 ? 4 : (kth > 60 ? 60 : kth);
        int above = 0;
#pragma unroll
        for (int i = 0; i < 16; ++i) { const pg8::f32x4 q = *(const LAS pg8::f32x4*)(R + 4 * i);
            above += (q[0] > x0 ? 1 : 0) + (q[1] > x0 ? 1 : 0) + (q[2] > x0 ? 1 : 0) + (q[3] > x0 ? 1 : 0); }
        L = wave_minf(above <= kth ? x0 : INFINITY);
        int cl = 0;
#pragma unroll 4
        for (int j = 0; j < nch; ++j) cl += (Rl[64 * j] >= L) ? 1 : 0;
        cl += __builtin_amdgcn_update_dpp(0, cl, 0xB1, 0xF, 0xF, true); cl += __builtin_amdgcn_update_dpp(0, cl, 0x4E, 0xF, 0xF, true);
        cl += __builtin_amdgcn_update_dpp(0, cl, 0x141, 0xF, 0xF, true); cl += __builtin_amdgcn_update_dpp(0, cl, 0x140, 0xF, 0xF, true);
        cnt = __builtin_amdgcn_readlane(cl, 0) + __builtin_amdgcn_readlane(cl, 16) + __builtin_amdgcn_readlane(cl, 32) + __builtin_amdgcn_readlane(cl, 48);
        fast = cnt >= 256 && cnt <= 1024;
    }
    if (!fast) { select_core<false>(R, n, lane, hist, T, needT); return bitmap_row(R, n, lane, T, needT); }
    int pos = 0; float xn = Rl[0], hmax = -INFINITY;
    for (int j = 0; j < nch; ++j) { const float x = xn; if (j + 1 < nch) xn = Rl[64 * (j + 1)];
        hmax = fmaxf(hmax, x);
        const bool c = x >= L; const u64 cb = __ballot(c);
        if (cb != 0ull) { const int p = pos + (int)__builtin_amdgcn_mbcnt_hi((unsigned)(cb >> 32), __builtin_amdgcn_mbcnt_lo((unsigned)cb, 0u));
            if (c) { R[p] = x; idx16[p] = (unsigned short)(64 * j + lane); }
            pos += __builtin_popcountll(cb); } }
    LDS_WAIT(); asm volatile("" ::: "memory");
    select_core<true>(R, cnt, lane, hist, T, needT, L, wave_maxf(hmax));
    hist[lane] = 0u; hist[64 + lane] = 0u;
    LDS_WAIT(); asm volatile("" ::: "memory");
    const int ncl = (cnt + 63) >> 6; int run = 0;
    for (int j = 0; j < ncl; ++j) { const float x = Rl[64 * j];
        const bool tie = (x == T); const u64 tbal = __ballot(tie);
        const int rank = run + (int)__builtin_amdgcn_mbcnt_hi((unsigned)(tbal >> 32), __builtin_amdgcn_mbcnt_lo((unsigned)tbal, 0u)); run += __builtin_popcountll(tbal);
        const bool selb = x > T || (tie && rank < needT);
        if (selb) { const unsigned id = idx16[64 * j + lane]; __hip_atomic_fetch_or(hist + (id >> 5), 1u << (id & 31u), __ATOMIC_RELAXED, __HIP_MEMORY_SCOPE_WORKGROUP); } }
    LDS_WAIT(); asm volatile("" ::: "memory");
    const u64 myword = (u64)hist[2 * lane] | ((u64)hist[2 * lane + 1] << 32);
    LDS_WAIT(); asm volatile("" ::: "memory");
    return myword;
}

#ifdef NAIVE_IDX
__device__ __forceinline__ void idx_phase_naive(Frame& F) {
    PHASE_TID();
    LAS float* S = (LAS float*)(F.lds + IDX_S_OFF); LAS float* qs = (LAS float*)(F.lds + IDX_Q_OFF); LAS float* wsm = (LAS float*)(F.lds + IDX_W_OFF);
    LAS unsigned* hist = (LAS unsigned*)(F.lds + IDX_H_OFF) + F.wave * 832;
    const bf16* QI = (const bf16*)(F.ws + WS_QI); const bf16* KI = (const bf16*)(F.ws + WS_KI); const float* WI = (const float*)(F.ws + WS_WI); u64* BM = (u64*)(F.ws + WS_BM);
    for (int un = blockIdx.x; un < TOK / 8; un += F.G) {
        const int b = un >> 9, q0 = (un & 511) * 8; const size_t t0 = (size_t)b * SEQ + q0;
        for (int e = ptid; e < 8 * 256; e += NWAVES * 64) qs[e] = bf2f(QI[t0 * 256 + e]);
        if (ptid < 32) wsm[ptid] = WI[t0 * 4 + ptid];
        __syncthreads();
        const int nk = q0 + 8;
        for (int k = ptid; k < nk; k += NWAVES * 64) {
            float kf[64];
            { const v4u* kp = (const v4u*)(KI + ((size_t)b * SEQ + k) * 64);
#pragma unroll
                for (int c = 0; c < 8; ++c) { const v4u w = kp[c]; kf[8 * c + 0] = bflo(w.x); kf[8 * c + 1] = bfhi(w.x); kf[8 * c + 2] = bflo(w.y); kf[8 * c + 3] = bfhi(w.y); kf[8 * c + 4] = bflo(w.z); kf[8 * c + 5] = bfhi(w.z); kf[8 * c + 6] = bflo(w.w); kf[8 * c + 7] = bfhi(w.w); } }
            for (int i = 0; i < 8; ++i) { float sc = 0.f;
#pragma unroll
                for (int h = 0; h < 4; ++h) { float dot = 0.f; const LAS f32x4* qp = (const LAS f32x4*)(qs + i * 256 + h * 64);
#pragma unroll
                    for (int c = 0; c < 16; ++c) { const f32x4 qq = qp[c]; dot += kf[4 * c] * qq[0]; dot += kf[4 * c + 1] * qq[1]; dot += kf[4 * c + 2] * qq[2]; dot += kf[4 * c + 3] * qq[3]; }
                    sc += wsm[i * 4 + h] * fmaxf(dot, 0.f); }
                S[i * 4096 + k] = sc; }
        }
        __syncthreads();
        { const int i = F.wave, n = q0 + i + 1; u64 word;
            if (n <= 256) { const int full = n >> 6, rem = n & 63; word = (plane < full) ? ~0ull : (plane == full ? ((1ull << rem) - 1ull) : 0ull); }
            else word = select_row(S + i * 4096, n, plane, hist);
            BM[(t0 + i) * 64 + plane] = word; }
        __syncthreads();
    }
}

#endif
__device__ __forceinline__ float dpp_quad_sum(float x) {
    x += __builtin_bit_cast(float, __builtin_amdgcn_mov_dpp(__builtin_bit_cast(int, x), 0xB1, 0xF, 0xF, true));
    x += __builtin_bit_cast(float, __builtin_amdgcn_mov_dpp(__builtin_bit_cast(int, x), 0x4E, 0xF, 0xF, true));
    return x;
}
__device__ __forceinline__ void idx_phase(Frame& F) {
    PHASE_TID();
    LAS float* S = (LAS float*)(F.lds + IDX_S_OFF);
    LAS unsigned* hist = (LAS unsigned*)(F.lds + IDX_H_OFF) + F.wave * 832;
    const bf16* QI = (const bf16*)(F.ws + WS_QI); const bf16* KI = (const bf16*)(F.ws + WS_KI); const float* WI = (const float*)(F.ws + WS_WI); u64* BM = (u64*)(F.ws + WS_BM);
    const int c16 = plane & 15, kg = plane >> 4, qloc = c16 >> 2, hh = c16 & 3;
    {
        const float* KMP = (const float*)(F.ws + WS_KMP); bf16* KMH = (bf16*)(F.ws + WS_KMH); bf16* KML = (bf16*)(F.ws + WS_KML);
        for (int e = blockIdx.x * (NWAVES * 64) + ptid; e < BATCH * NH * 32 * 64; e += F.G * NWAVES * 64) {
            const int d = e & 63, n = (e >> 6) & 31, h = (e >> 11) & 7, b = e >> 14; unsigned vh = 0, vl = 0;
            if (n < 16) { const float* p = KMP + ((((size_t)b * 16 + n) * 8 + h) * 2) * 64 + d; const float v = (p[0] + p[64]) * (1.0f / 256.0f);
                vh = f2bf(v); vl = f2bf(v - __uint_as_float(vh << 16)); }
            KMH[e] = (bf16)vh; KML[e] = (bf16)vl; }
    }
    for (int un = blockIdx.x; un < TOK / 8; un += F.G) {
        const int b = un >> 9, m_ = un & 511, q0 = (m_ < 256 ? m_ : 767 - m_) * 8; const size_t t0 = (size_t)b * SEQ + q0;
        bf16x8 qf[2][2]; float wv[2];
#pragma unroll
        for (int g = 0; g < 2; ++g) { wv[g] = WI[(t0 + 4 * g + qloc) * 4 + hh];
#pragma unroll
            for (int ks = 0; ks < 2; ++ks) qf[g][ks] = *(const bf16x8*)(QI + (t0 + 4 * g + qloc) * 256 + hh * 64 + 32 * ks + 8 * kg); }
        const int nchunk = (q0 + 8 + 15) >> 4;
        const bf16* kbase = KI + (size_t)b * SEQ * 64 + (size_t)c16 * 64 + 8 * kg;
#define IDX_LOAD(KA, c0_) do { _Pragma("unroll") for (int u = 0; u < 4; ++u) { const int c = (c0_) + u * NWAVES; const bf16* kp = kbase + (size_t)(c < nchunk ? c : F.wave) * 16 * 64; \
            KA[u][0] = *(const bf16x8*)kp; KA[u][1] = *(const bf16x8*)(kp + 32); } } while (0)
#define IDX_COMP(KA, c0_) do { _Pragma("unroll") for (int u = 0; u < 4; ++u) { const int c = (c0_) + u * NWAVES; \
            if (c < nchunk) { _Pragma("unroll") for (int g = 0; g < 2; ++g) { \
                pg8::f32x4 acc = (pg8::f32x4){0.f, 0.f, 0.f, 0.f}; \
                acc = __builtin_amdgcn_mfma_f32_16x16x32_bf16(KA[u][0], qf[g][0], acc, 0, 0, 0); \
                acc = __builtin_amdgcn_mfma_f32_16x16x32_bf16(KA[u][1], qf[g][1], acc, 0, 0, 0); \
                pg8::f32x4 sc; \
                _Pragma("unroll") for (int i = 0; i < 4; ++i) sc[i] = dpp_quad_sum(wv[g] * fmaxf(acc[i], 0.f)); \
                if (hh == 0) *(LAS pg8::f32x4*)(S + (4 * g + qloc) * 4096 + 16 * c + 4 * kg) = sc; } } } } while (0)
        { bf16x8 kaA[4][2], kaB[4][2];
          IDX_LOAD(kaA, F.wave);
          for (int c0 = F.wave; c0 < nchunk; c0 += 8 * NWAVES) {
              IDX_LOAD(kaB, c0 + 4 * NWAVES);
              IDX_COMP(kaA, c0);
              IDX_LOAD(kaA, c0 + 8 * NWAVES);
              IDX_COMP(kaB, c0 + 4 * NWAVES);
          } }
#undef IDX_LOAD
#undef IDX_COMP
        __syncthreads();
        { const int i = F.wave, n = q0 + i + 1; u64 word;
            if (n <= 256) { const int full = n >> 6, rem = n & 63; word = (plane < full) ? ~0ull : (plane == full ? ((1ull << rem) - 1ull) : 0ull); }
            else word = select_row(S + i * 4096, n, plane, hist);
            BM[(t0 + i) * 64 + plane] = word; }
        __syncthreads();
    }
}

struct Args { const float* in[11]; float* out; unsigned char* ws; int ph_lo, ph_hi, li, pad; };
__global__ void __launch_bounds__(NWAVES * 64, 2) hyb_fwd(Args args) {
    extern __shared__ __attribute__((aligned(16))) unsigned char lds[];
    Frame F;
    F.lds = (LAS unsigned char*)lds;
    F.MISC = (volatile LAS unsigned*)(F.lds + MISC_OFF);
    F.wave = __builtin_amdgcn_readfirstlane((int)threadIdx.x >> 6);
    F.G = gridDim.x; { const int bx = blockIdx.x; F.vcu = (F.G % 8 == 0) ? (bx % 8) * (F.G / 8) + bx / 8 : bx; }
    F.ws = args.ws; F.ctl = (gu32*)(args.ws + WS_CTL); F.out = args.out;
    for (int u = threadIdx.x; u < (LDS_BYTES - LDSCTL_OFF) / 4; u += NWAVES * 64) ((LAS unsigned*)(F.lds + LDSCTL_OFF))[u] = 0u;
    __syncthreads();
    const bool one_launch = (args.ph_hi - args.ph_lo) > 1;
    XcdBarrier bar; bar.bar = (unsigned*)(F.ctl + CW_BAR); bar.x = 0; bar.st = nullptr;
    if (one_launch) bar = xcd_barrier_post((unsigned*)(F.ctl + CW_BAR), F.MISC + 8);
    const int lo = args.ph_lo, hi = args.ph_hi;
    unsigned char* ws = args.ws;
#ifndef REP_K
#define REP_K -2
#endif
#pragma unroll 1
    for (int ph2 = 2 * lo; ph2 < 2 * hi; ++ph2) {
        const int ph = ph2 >> 1;
        const int l = (ph - 1) / 5, k = (ph == 0) ? -1 : (ph - 1) % 5;
        if ((ph2 & 1) && k != REP_K) continue;
        if (k < 0) {
#ifndef NO_P0
            p0_prologue(F);
#endif
        } else if (k == 0) {
#ifndef NO_P1
            pg8::Gemm g{(const pg8::bf16_t*)(ws + WS_XB), (const pg8::bf16_t*)(ws + WS_WIN) + (size_t)l * NIN * DM, TOK, NIN, DM};
            pg8::StaticOrder S; S.init(TOK, NIN, F.G, (int)blockIdx.x);
            pg8::EpiIn E; E.rss = (const float*)(ws + WS_RSS); E.qna = in_ptr(3) + l * 64; E.kna = in_ptr(4) + l * 64; E.qnb = in_ptr(5) + l * 64; E.knb = in_ptr(6) + l * 64;
            E.QA = (pg8::bf16_t*)(ws + WS_QA); E.KA = (pg8::bf16_t*)(ws + WS_KA); E.VA = (pg8::bf16_t*)(ws + WS_VA); E.SGA = (pg8::bf16_t*)(ws + WS_SGA); E.QB = (pg8::bf16_t*)(ws + WS_QB); E.SGB = (pg8::bf16_t*)(ws + WS_SGB);
            E.KB = (pg8::bf16_t*)(ws + WS_KB); E.VB = (pg8::bf16_t*)(ws + WS_VB); E.KI = (pg8::bf16_t*)(ws + WS_KI); E.QI = (pg8::bf16_t*)(ws + WS_QI); E.SMA = (pg8::bf16_t*)(ws + WS_SMA); E.SMB = (pg8::bf16_t*)(ws + WS_SMB);
            E.WI = (float*)(ws + WS_WI); E.KMP = (float*)(ws + WS_KMP);
            pg8::gemm_phase<pg8::EpiIn, pg8::StaticOrder, true, true>(F.lds, g, S, E);
#endif
        } else if (k == 1) {
#ifndef NO_IDX
#ifdef NAIVE_IDX
            idx_phase_naive(F);
#else
            idx_phase(F);
#endif
#endif
        } else if (k == 2) {
#ifndef NO_ATT
#ifdef NAIVE_ATT
            naive_attn<0>(F, l); __syncthreads(); naive_attn<1>(F, l);
#else
#ifdef CLOCK_PROBE
            if (blockIdx.x == 0 && threadIdx.x == 0 && l == 0) { F.MISC[16] = (unsigned)__builtin_amdgcn_s_memtime(); F.MISC[17] = (unsigned)__builtin_amdgcn_s_memrealtime(); }
#endif
            attn_phase_fast(F, l);
#ifdef CLOCK_PROBE
            if (blockIdx.x == 0 && threadIdx.x == 0 && l == 0) { const unsigned dt = (unsigned)__builtin_amdgcn_s_memtime() - F.MISC[16], dr = (unsigned)__builtin_amdgcn_s_memrealtime() - F.MISC[17]; F.MISC[18] = (unsigned)((unsigned long long)dt * 100ull / (dr ? dr : 1u)); }
#endif
#endif
#endif
        } else if (k == 3) {
#ifndef NO_P4
            pg8::Gemm g{(const pg8::bf16_t*)(ws + WS_XB), (const pg8::bf16_t*)(ws + WS_WBR) + (size_t)l * 2048 * AW, 2 * TOK, 2048, AW};
            pg8::PairOrder S; S.init(F.G, (int)blockIdx.x);
            pg8::EpiMerge E{(pg8::bf16_t*)(ws + WS_SMA), (pg8::bf16_t*)(ws + WS_SMB)};
            pg8::gemm_phase<pg8::EpiMerge, pg8::PairOrder, true, true>(F.lds, g, S, E);
#endif
        } else {
#ifndef NO_P5
            pg8::Gemm g{(const pg8::bf16_t*)(ws + WS_SMB), (const pg8::bf16_t*)(ws + WS_WOUT) + (size_t)l * DM * DM, TOK, DM, DM};
            pg8::StaticOrder S; S.init(TOK, DM, F.G, (int)blockIdx.x);
            if (l == 0) { pg8::EpiOut<true> E{in_ptr(0), F.out, (pg8::bf16_t*)(ws + WS_XB), (float*)(ws + WS_RSS)};
                pg8::gemm_phase<pg8::EpiOut<true>, pg8::StaticOrder, true, true>(F.lds, g, S, E); }
            else { pg8::EpiOut<false> E{F.out, F.out, nullptr, nullptr};
                pg8::gemm_phase<pg8::EpiOut<false>, pg8::StaticOrder, true, true>(F.lds, g, S, E); }
#endif
        }
        if (!((ph == hi - 1) && ((ph2 & 1) || k != REP_K))) xcd_barrier(bar);
    }
#ifdef CLOCK_PROBE
    if (blockIdx.x == 0 && threadIdx.x == 0) {
        const unsigned long long t0 = __builtin_amdgcn_s_memrealtime(); const unsigned long long want = (unsigned long long)F.MISC[18] * 100ull;
        while (__builtin_amdgcn_s_memrealtime() - t0 < want) __builtin_amdgcn_s_sleep(16);
    }
#endif
}

#ifndef N_LAUNCHES
#define N_LAUNCHES 1
#endif
extern "C" void kernel_launch(void* const* d_in, const int* in_sizes, int n_in, void* d_out, int out_size, void* d_ws, size_t ws_size, hipStream_t stream) {
    static int grid = 0;
    if (grid == 0) {
        if (n_in != 11 || in_sizes[0] != TOK * DM || out_size != TOK * DM || ws_size < WS_END) { fprintf(stderr, "kernel_launch: unexpected shapes (n_in %d in0 %d out %d ws %zu)\n", n_in, n_in > 0 ? in_sizes[0] : -1, out_size, ws_size); grid = -1; return; }
        int dev = 0, cus = 0;
        if (hipGetDevice(&dev) != hipSuccess || hipDeviceGetAttribute(&cus, hipDeviceAttributeMultiprocessorCount, dev) != hipSuccess) { grid = -1; return; }
        if (hipFuncSetAttribute((const void*)hyb_fwd, hipFuncAttributeMaxDynamicSharedMemorySize, LDS_BYTES) != hipSuccess) { fprintf(stderr, "kernel_launch: hipFuncSetAttribute failed\n"); grid = -1; return; }
        int per_cu = 0;
        if (hipOccupancyMaxActiveBlocksPerMultiprocessor(&per_cu, (const void*)hyb_fwd, NWAVES * 64, LDS_BYTES) != hipSuccess || per_cu < 1) fprintf(stderr, "kernel_launch: occupancy query says %d\n", per_cu);
        (void)hipGetLastError();
        grid = cus;
    }
    if (grid < 0) return;
    if (hipMemsetAsync((char*)d_ws + WS_CTL, 0, CTL_ZERO_BYTES, stream) != hipSuccess) return;
    Args a{};
    for (int i = 0; i < 11; ++i) a.in[i] = (const float*)d_in[i];
    a.out = (float*)d_out; a.ws = (unsigned char*)d_ws;
    if (N_LAUNCHES == 1) { a.ph_lo = 0; a.ph_hi = NPHASE; a.li = 0; hipLaunchKernelGGL(hyb_fwd, dim3(grid), dim3(NWAVES * 64), LDS_BYTES, stream, a); }
    else for (int li = 0; li < NPHASE; ++li) { a.ph_lo = li; a.ph_hi = li + 1; a.li = li; hipLaunchKernelGGL(hyb_fwd, dim3(grid), dim3(NWAVES * 64), LDS_BYTES, stream, a); }
}
```

```cpp
#include <hip/hip_runtime.h>
#include <cstdio>
#include <cstdint>
#include <cmath>
namespace pg8 {
#define PG8_LAS __attribute__((address_space(3)))
typedef unsigned short bf16_t;
typedef short bf16x8 __attribute__((ext_vector_type(8)));
typedef float f32x4 __attribute__((ext_vector_type(4)));
typedef unsigned u32x4 __attribute__((ext_vector_type(4)));
constexpr int BM = 256, BK = 64, HALF = 128, HTB = HALF * BK * 2  , STAGE_BYTES = 8 * HTB, NXCD = 8, WGM = 8;

__host__ __device__ __forceinline__ int lds_byte(int r, int c) { const int st = (r >> 4) * 2 + (c >> 5), rr = r & 15, cc = c & 31, ob = rr * 64 + cc * 2; return st * 1024 + (ob ^ (((ob >> 9) & 1) << 5)); }
__host__ __device__ __forceinline__ void stage_rc(int b, int& R, int& C) { const int st = b / 1024, sb = b % 1024, swz = sb ^ (((sb >> 9) & 1) << 5); R = (st >> 1) * 16 + swz / 64; C = (st & 1) * 32 + (swz % 64) / 2; }
__host__ __device__ __forceinline__ int perm32(int rho) { const int n = rho >> 4, i = rho & 15; return 8 * (i >> 2) + 4 * n + (i & 3); }

struct Unit { int pm, pn; };
struct Gemm { const bf16_t* A; const bf16_t* Bt; int M, N, K; };

struct StaticOrder {
    int nM, nN, nwg, G, c;
    __host__ __device__ void init(int M, int N, int G_, int c_) { nM = M / BM; nN = N / BM; nwg = nM * nN; G = G_; c = c_; }
    __host__ __device__ bool next(int i, Unit& u) const {
        const long L = (long)i * G + c; if (L >= nwg) return false;
        int wgid = (int)L; { const int q = nwg / NXCD, r = nwg % NXCD, xcd = wgid % NXCD, off = wgid / NXCD; wgid = (xcd < r ? xcd * (q + 1) : r * (q + 1) + (xcd - r) * q) + off; }
        const int nig = WGM * nN, gid = wgid / nig, fm = gid * WGM, gsz = (nM - fm) < WGM ? (nM - fm) : WGM;
        u.pm = fm + ((wgid % nig) % gsz); u.pn = (wgid % nig) / gsz; return true;
    }
    __device__ __forceinline__ void a_ready(const Unit&) const {}
    __device__ __forceinline__ void done(const Unit&) const {}
};

__device__ __forceinline__ unsigned cvt_pk_bf16(float lo, float hi) { unsigned r; asm volatile("v_cvt_pk_bf16_f32 %0, %1, %2" : "=v"(r) : "v"(lo), "v"(hi)); return r; }
template <class Epi, class Sched, bool ALIGN_EPI = false, bool SP2 = false>
__device__ __forceinline__ void gemm_phase(PG8_LAS unsigned char* lds, const Gemm g, const Sched& S, const Epi& E) {
    int tid_ = threadIdx.x; asm volatile("" : "+v"(tid_));
    const int tid = tid_, wid = __builtin_amdgcn_readfirstlane(tid >> 6), lane = tid & 63, wr = wid >> 2, wc = wid & 3, fr = lane & 15, fq = lane >> 4;
    const int K = g.K, nt = K / BK;
    unsigned voffA[2], voffB[2];
#pragma unroll
    for (int i = 0; i < 2; ++i) { int R, C; stage_rc(tid * 16 + i * 8192, R, C); const int Rb = Epi::PERM ? ((R & ~31) + perm32(R & 31)) : R;
        voffA[i] = (unsigned)(R * K + C) * 2u; voffB[i] = (unsigned)(Rb * K + C) * 2u; }
    const size_t kstep = (size_t)(BK * 2);
    const size_t hstep = (size_t)HALF * K * 2;
    const size_t tstep = 2 * hstep;
    const unsigned ldsw = (unsigned)wid * 1024u;
    const int aoff = lds_byte(wr * 64 + fr, fq * 8), boff = lds_byte(wc * 32 + fr, fq * 8);
#define PG8_SA(b, h) (((b) * 2 + (h)) * HTB)
#define PG8_SB(b, h) ((4 + (b) * 2 + (h)) * HTB)
#define PG8_STAGE(bufoff, gbase, voff) do { _Pragma("unroll") for (int _i = 0; _i < 2; ++_i) \
        __builtin_amdgcn_global_load_lds((const unsigned*)((const char*)(gbase) + (voff)[_i]), (PG8_LAS unsigned*)(lds + (bufoff) + ldsw + _i * 8192), 16, 0, 0); } while (0)
#define PG8_LDA(dst, b, h) do { _Pragma("unroll") for (int m = 0; m < 4; ++m) _Pragma("unroll") for (int k = 0; k < 2; ++k) dst[m][k] = *(const PG8_LAS bf16x8*)(lds + PG8_SA(b, h) + aoff + m * 2048 + k * 1024); } while (0)
#define PG8_LDB(dst, b, h) do { _Pragma("unroll") for (int n = 0; n < 2; ++n) _Pragma("unroll") for (int k = 0; k < 2; ++k) dst[n][k] = *(const PG8_LAS bf16x8*)(lds + PG8_SB(b, h) + boff + n * 2048 + k * 1024); } while (0)
#define PG8_MMA(ai, bj, At, Bt) do { __builtin_amdgcn_s_setprio(1); _Pragma("unroll") for (int m = 0; m < 4; ++m) _Pragma("unroll") for (int n = 0; n < 2; ++n) _Pragma("unroll") for (int k = 0; k < 2; ++k) \
        acc[ai][bj][m][n] = __builtin_amdgcn_mfma_f32_16x16x32_bf16(Bt[n][k], At[m][k], acc[ai][bj][m][n], 0, 0, 0); __builtin_amdgcn_s_setprio(0); } while (0)
#define PG8_WAIT_V(n) asm volatile("s_waitcnt vmcnt(" #n ")" ::: "memory")
#define PG8_WAIT_L(n) asm volatile("s_waitcnt lgkmcnt(" #n ")" ::: "memory")
#define PG8_BAR __builtin_amdgcn_s_barrier()
#define PG8_SCHED __builtin_amdgcn_sched_barrier(0)
    Unit cur, nxt; int ui = 0;
    if (!S.next(0, cur)) return;
    f32x4 acc[2][2][4][2];
#pragma unroll
    for (int a = 0; a < 2; ++a)
#pragma unroll
        for (int b = 0; b < 2; ++b)
#pragma unroll
            for (int m = 0; m < 4; ++m)
#pragma unroll
                for (int n = 0; n < 2; ++n) acc[a][b][m][n] = (f32x4){0.f, 0.f, 0.f, 0.f};
    bf16x8 At[4][2], B0[2][2], B1[2][2];
    const char* cA = (const char*)g.A + (size_t)cur.pm * tstep; const char* cB = (const char*)g.Bt + (size_t)cur.pn * tstep;
    S.a_ready(cur);
    if constexpr (SP2) {
        PG8_STAGE(PG8_SB(0, 0), cB, voffB); PG8_STAGE(PG8_SB(0, 1), cB + hstep, voffB); PG8_STAGE(PG8_SA(0, 0), cA, voffA); PG8_STAGE(PG8_SA(0, 1), cA + hstep, voffA);
        if (wr == 1) PG8_BAR;
        PG8_WAIT_V(2); PG8_BAR;
        PG8_STAGE(PG8_SB(1, 0), cB + kstep, voffB); PG8_STAGE(PG8_SA(1, 0), cA + kstep, voffA); PG8_STAGE(PG8_SB(1, 1), cB + hstep + kstep, voffB);
        PG8_WAIT_V(6); PG8_BAR;
    } else {
        PG8_STAGE(PG8_SB(0, 0), cB, voffB); PG8_STAGE(PG8_SA(0, 0), cA, voffA); PG8_STAGE(PG8_SB(0, 1), cB + hstep, voffB); PG8_STAGE(PG8_SA(0, 1), cA + hstep, voffA);
        if (wr == 1) PG8_BAR;
        PG8_WAIT_V(4); PG8_BAR;
        PG8_STAGE(PG8_SB(1, 0), cB + kstep, voffB); PG8_STAGE(PG8_SA(1, 0), cA + kstep, voffA); PG8_STAGE(PG8_SB(1, 1), cB + hstep + kstep, voffB);
        PG8_WAIT_V(6); PG8_BAR;
    }
    for (;;) {
        const bool has_next = S.next(ui + 1, nxt);
        const char* nA = has_next ? (const char*)g.A + (size_t)nxt.pm * tstep : cA; const char* nB = has_next ? (const char*)g.Bt + (size_t)nxt.pn * tstep : cB;
        for (int t = 0; t < nt; t += 2) {
            const bool last = (t == nt - 2);
            const char* a1 = cA + (size_t)(t + 1) * kstep;
            const char* a2 = last ? nA : cA + (size_t)(t + 2) * kstep; const char* b2 = last ? nB : cB + (size_t)(t + 2) * kstep;
            const char* a3 = a2 + kstep; const char* b3 = b2 + kstep;
            if (last && has_next) S.a_ready(nxt);
            if constexpr (SP2) {
            PG8_LDB(B0, 0, 0); PG8_LDB(B1, 0, 1); PG8_SCHED; PG8_LDA(At, 0, 0); PG8_STAGE(PG8_SA(1, 1), a1 + hstep, voffA);
            PG8_WAIT_V(8); PG8_WAIT_L(0); PG8_BAR; PG8_MMA(0, 0, At, B0); PG8_MMA(0, 1, At, B1); PG8_BAR; PG8_SCHED;
            PG8_LDA(At, 0, 1); PG8_STAGE(PG8_SB(0, 0), b2, voffB); PG8_STAGE(PG8_SB(0, 1), b2 + hstep, voffB); PG8_STAGE(PG8_SA(0, 0), a2, voffA);
            PG8_WAIT_V(8); PG8_WAIT_L(0); PG8_BAR; PG8_MMA(1, 0, At, B0); PG8_MMA(1, 1, At, B1); PG8_BAR; PG8_SCHED;
            PG8_LDB(B0, 1, 0); PG8_LDB(B1, 1, 1); PG8_SCHED; PG8_LDA(At, 1, 0); PG8_STAGE(PG8_SA(0, 1), a2 + hstep, voffA);
            PG8_WAIT_V(8); PG8_WAIT_L(0); PG8_BAR; PG8_MMA(0, 0, At, B0); PG8_MMA(0, 1, At, B1); PG8_BAR; PG8_SCHED;
            PG8_LDA(At, 1, 1); PG8_STAGE(PG8_SB(1, 0), b3, voffB); PG8_STAGE(PG8_SB(1, 1), b3 + hstep, voffB); PG8_STAGE(PG8_SA(1, 0), a3, voffA);
            PG8_WAIT_V(8); PG8_WAIT_L(0); PG8_BAR; PG8_MMA(1, 0, At, B0); PG8_MMA(1, 1, At, B1); PG8_BAR; PG8_SCHED;
            } else {
            PG8_LDB(B0, 0, 0); PG8_SCHED; PG8_LDA(At, 0, 0); PG8_STAGE(PG8_SA(1, 1), a1 + hstep, voffA);
            PG8_WAIT_L(8); PG8_BAR; PG8_WAIT_L(0); PG8_MMA(0, 0, At, B0); PG8_BAR; PG8_SCHED;
            PG8_LDB(B1, 0, 1); PG8_STAGE(PG8_SB(0, 0), b2, voffB);
            PG8_BAR; PG8_WAIT_L(0); PG8_MMA(0, 1, At, B1); PG8_BAR;
            PG8_LDA(At, 0, 1); PG8_STAGE(PG8_SA(0, 0), a2, voffA);
            PG8_BAR; PG8_WAIT_L(0); PG8_MMA(1, 0, At, B0); PG8_BAR; PG8_SCHED;
            PG8_STAGE(PG8_SB(0, 1), b2 + hstep, voffB);
            PG8_WAIT_V(6); PG8_BAR; PG8_MMA(1, 1, At, B1); PG8_BAR;
            PG8_LDB(B0, 1, 0); PG8_SCHED; PG8_LDA(At, 1, 0); PG8_STAGE(PG8_SA(0, 1), a2 + hstep, voffA);
            PG8_WAIT_L(8); PG8_BAR; PG8_WAIT_L(0); PG8_MMA(0, 0, At, B0); PG8_BAR; PG8_SCHED;
            PG8_LDB(B1, 1, 1); PG8_STAGE(PG8_SB(1, 0), b3, voffB);
            PG8_BAR; PG8_WAIT_L(0); PG8_MMA(0, 1, At, B1); PG8_BAR;
            PG8_LDA(At, 1, 1); PG8_STAGE(PG8_SA(1, 0), a3, voffA);
            PG8_BAR; PG8_WAIT_L(0); PG8_MMA(1, 0, At, B0); PG8_BAR; PG8_SCHED;
            PG8_STAGE(PG8_SB(1, 1), b3 + hstep, voffB);
            PG8_WAIT_V(6); PG8_BAR; PG8_MMA(1, 1, At, B1); PG8_BAR;
            }
        }
        if constexpr (ALIGN_EPI) { if (wr == 0) PG8_BAR; }
#ifndef EPI_REP
#define EPI_REP 1
#endif
        if constexpr (!Epi::AFTER_DRAIN) { E(acc, cur, wr, wc, fr, fq); if constexpr (Epi::REPEATABLE && EPI_REP == 2) { asm volatile("" ::: "memory"); E(acc, cur, wr, wc, fr, fq); } S.done(cur); }
        if (!has_next) break;
#pragma unroll
        for (int a = 0; a < 2; ++a)
#pragma unroll
            for (int b = 0; b < 2; ++b)
#pragma unroll
                for (int m = 0; m < 4; ++m)
#pragma unroll
                    for (int n = 0; n < 2; ++n) acc[a][b][m][n] = (f32x4){0.f, 0.f, 0.f, 0.f};
        cur = nxt; cA = nA; cB = nB; ++ui;
        if constexpr (ALIGN_EPI) { if (wr == 1) PG8_BAR; }
    }
    PG8_WAIT_V(0);
    if constexpr (!ALIGN_EPI) { if (wr == 0) PG8_BAR; }
    PG8_BAR;
    if constexpr (Epi::AFTER_DRAIN) { E.fused(acc, cur, wr, wc, fr, fq, lds, wid, lane); S.done(cur); }
#undef PG8_SA
#undef PG8_SB
#undef PG8_STAGE
#undef PG8_LDA
#undef PG8_LDB
#undef PG8_MMA
#undef PG8_WAIT_V
#undef PG8_WAIT_L
#undef PG8_BAR
#undef PG8_SCHED
}
}
#define GAS __attribute__((address_space(1)))
#define LAS __attribute__((address_space(3)))
typedef unsigned short bf16;
typedef unsigned v4u __attribute__((ext_vector_type(4)));
typedef float f32x4 __attribute__((ext_vector_type(4)));
typedef short bf16x8 __attribute__((ext_vector_type(8)));
typedef GAS unsigned gu32;
typedef GAS unsigned long long gu64;
#define RLX_AGENT __ATOMIC_RELAXED, __HIP_MEMORY_SCOPE_AGENT
#define LDS_WAIT() asm volatile("s_waitcnt lgkmcnt(0)" ::: "memory")
#define VM_WAIT() asm volatile("s_waitcnt vmcnt(0)" ::: "memory")
__device__ __forceinline__ unsigned long long rt() { return __builtin_amdgcn_s_memrealtime(); }
__device__ __forceinline__ unsigned f2bf(float f) { unsigned u = __builtin_bit_cast(unsigned, f); return (u + 0x7fffu + ((u >> 16) & 1u)) >> 16; }
__device__ __forceinline__ unsigned pk2(float lo, float hi) { return f2bf(lo) | (f2bf(hi) << 16); }
#define XB_TMO      128
#define XB_XCNT(j)  (256  + 64 * (j))
#define XB_XSUB(j)  (1280 + 64 * (j))
#define XB_XGEN(j)  (2304 + 64 * (j))
#define XB_TOP      3328
#define XB_TOPGEN   3392
#define XCD_BAR_WORDS 3456
#define XB_SPIN_CAP (1u << 18)

__device__ __forceinline__ unsigned xb_ld(unsigned* p)              { return __hip_atomic_load(p, __ATOMIC_RELAXED, __HIP_MEMORY_SCOPE_AGENT); }
__device__ __forceinline__ unsigned xb_add(unsigned* p, unsigned v) { return __hip_atomic_fetch_add(p, v, __ATOMIC_RELAXED, __HIP_MEMORY_SCOPE_AGENT); }
__device__ __forceinline__ unsigned xb_xcc_id() { return (unsigned)__builtin_amdgcn_s_getreg((3 << 11) | 20) & 0xFu; }
#define XB_SPIN(cond, bar) do { unsigned _sp = 0; while (cond) { __builtin_amdgcn_s_sleep(1); \
    if ((++_sp & 255u) == 0u) { if (xb_ld(&(bar)[XB_TMO])) break; if (_sp > XB_SPIN_CAP) { atomicAdd(&(bar)[XB_TMO], 1u); break; } } } } while (0)

struct XcdBarrier {
    unsigned* bar; unsigned x;
    volatile LAS unsigned* st;
};

__device__ __forceinline__ XcdBarrier xcd_barrier_post(unsigned* bar, volatile LAS unsigned* st) {
    XcdBarrier b; b.bar = bar; b.x = xb_xcc_id(); b.st = st;
    if (threadIdx.x == 0) (void)xb_add(&bar[XB_XCNT(b.x)], 1u);
    return b;
}
__device__ __forceinline__ void xcd_barrier_complete(unsigned* bar, unsigned x, unsigned& nloc, unsigned& nx) {
    const unsigned G = gridDim.x * gridDim.y * gridDim.z;
    unsigned sum, cnt, mine, sp = 0u;
    for (;;) {
        sum = 0u; cnt = 0u; mine = 0u;
#pragma unroll
        for (unsigned j = 0; j < 16; ++j) { const unsigned c = xb_ld(&bar[XB_XCNT(j)]); sum += c; cnt += (c > 0u) ? 1u : 0u; mine = (j == x) ? c : mine; }
        if (sum == G) break;
        __builtin_amdgcn_s_sleep(1);
        if ((++sp & 255u) == 0u) { if (xb_ld(&bar[XB_TMO])) break; if (sp > XB_SPIN_CAP) { atomicAdd(&bar[XB_TMO], 1u); break; } }
    }
    nloc = mine > 0u ? mine : 1u; nx = cnt > 0u ? cnt : 1u;
}

__device__ __forceinline__ void xcd_barrier(const XcdBarrier& b) {
    asm volatile("s_waitcnt vmcnt(0)" ::: "memory");
    __syncthreads();
    if (threadIdx.x == 0) {
        unsigned* bar = b.bar; asm volatile("" : "+s"(bar));
        __builtin_amdgcn_s_waitcnt(0);
        unsigned nloc = b.st[0], nx = b.st[1];
        if (nloc == 0u) { xcd_barrier_complete(bar, b.x, nloc, nx); b.st[0] = nloc; b.st[1] = nx; }
        const unsigned old = xb_add(&bar[XB_XSUB(b.x)], 1u);
        const unsigned gen = old / nloc;
        if (old + 1u == (gen + 1u) * nloc) {
            __builtin_amdgcn_fence(__ATOMIC_RELEASE, "agent");
            asm volatile("s_waitcnt vmcnt(0)" ::: "memory");
            const unsigned og = xb_add(&bar[XB_TOP], 1u);
            const unsigned tg = og / nx;
            if (og + 1u == (tg + 1u) * nx) xb_add(&bar[XB_TOPGEN], 1u);
            else XB_SPIN(xb_ld(&bar[XB_TOPGEN]) == tg, bar);
            __builtin_amdgcn_fence(__ATOMIC_ACQUIRE, "agent");
            xb_add(&bar[XB_XGEN(b.x)], 1u);
            asm volatile("s_waitcnt vmcnt(0)" ::: "memory");
        } else {
            XB_SPIN(xb_ld(&bar[XB_XGEN(b.x)]) == gen, bar);
            __builtin_amdgcn_fence(__ATOMIC_ACQUIRE, "agent");
            asm volatile("s_waitcnt vmcnt(0)" ::: "memory");
        }
    }
    __syncthreads();
}

constexpr int BATCH = 8, SEQ = 4096, DM = 1024, TOK = BATCH * SEQ, DEPTH = 2;
constexpr int DIN = 5572, NIN = 5632;
constexpr int NH = 8, HD = 64, AW = 512;
constexpr float EPS = 1e-6f;
constexpr float LOG2E = 1.4426950408889634f;
constexpr float C2 = 0.125f * LOG2E;
constexpr int NWAVES = 8;
constexpr int NPHASE = 1 + 5 * DEPTH;

constexpr size_t MiB = 1u << 20;
constexpr size_t WS_CTL = 0, CTL_ZERO_BYTES = 1 * MiB;
constexpr size_t WS_WIN = 1 * MiB;
constexpr size_t WS_WBR = 23 * MiB;
constexpr size_t WS_WOUT = 27 * MiB;
constexpr size_t WS_RSS = 31 * MiB;
constexpr size_t WS_KMP = 33 * MiB;
constexpr size_t WS_WI = 34 * MiB;
constexpr size_t WS_KB = 35 * MiB, WS_VB = 39 * MiB, WS_KI = 43 * MiB;
constexpr size_t WS_QI = 47 * MiB;
constexpr size_t WS_BM = 63 * MiB;
constexpr size_t WS_KMH = 79 * MiB, WS_KML = 79 * MiB + 262144;
constexpr size_t WS_XB = 80 * MiB;
constexpr size_t WS_QA = 144 * MiB, WS_KA = 176 * MiB, WS_VA = 208 * MiB, WS_SGA = 240 * MiB, WS_QB = 272 * MiB, WS_SGB = 304 * MiB;
constexpr size_t WS_TMP = 144 * MiB;
constexpr size_t WS_SMA = 336 * MiB, WS_SMB = 400 * MiB;
constexpr size_t WS_END = 464 * MiB;
constexpr int CW_BAR = 4096;

constexpr int RING_BYTES = 131072;
constexpr int LDSCTL_OFF = RING_BYTES + 28672, MISC_OFF = LDSCTL_OFF + 320;
constexpr int LDS_BYTES = 163840;
static_assert(MISC_OFF + 128 <= LDS_BYTES, "LDS map");

typedef unsigned long long u64;
typedef unsigned u32x4v __attribute__((ext_vector_type(4)));

__device__ __forceinline__ float bf2f(unsigned short v) { return __uint_as_float(((unsigned)v) << 16); }
__device__ __forceinline__ float bflo(unsigned w) { return __uint_as_float(w << 16); }
__device__ __forceinline__ float bfhi(unsigned w) { return __uint_as_float(w & 0xffff0000u); }
__device__ __forceinline__ float sigmoidf_(float v) { return __builtin_amdgcn_rcpf(1.0f + __builtin_amdgcn_exp2f(-v * LOG2E)); }

typedef __attribute__((address_space(4))) const char* kaptr_t;
__device__ __forceinline__ const float* in_ptr(int i) { kaptr_t ka = (kaptr_t)__builtin_amdgcn_kernarg_segment_ptr(); asm volatile("" : "+s"(ka)); return *(const float* const __attribute__((address_space(4)))*)(ka + 8 * i); }
#define PHASE_TID() int tid_o = threadIdx.x; asm volatile("" : "+v"(tid_o)); const int ptid = tid_o, plane = tid_o & 63
struct Frame {
    LAS unsigned char* lds;
    volatile LAS unsigned* MISC;
    gu32* ctl;
    int wave, vcu, G;
    unsigned char* ws;
    float* out;
};

__host__ __device__ __forceinline__ int win_src(int n0, int& nvalid) {
    const int pn = n0 >> 8, c = n0 & 255, bj = c >> 7, wc = (c >> 5) & 3; nvalid = 32;
    if (pn < 2) return 0 + 64 * (4 * pn + wc) + 32 * bj;
    if (pn < 4) return 512 + 64 * (4 * (pn - 2) + wc) + 32 * bj;
    if (pn < 6) return 1024 + 256 * (pn - 4) + c;
    if (pn < 8) return 1536 + 256 * (pn - 6) + c;
    if (pn < 10) return 2048 + 64 * (4 * (pn - 8) + wc) + 32 * bj;
    if (pn == 10) {
        if (wc == 0) return 2560 + 32 * bj;
        if (wc == 1) return 2624 + 32 * bj;
        if (wc == 2) return 3456 + 32 * bj;
        if (bj == 0) { nvalid = 4; return 3520; }
        nvalid = 0; return 0;
    }
    if (pn == 11) return 3200 + c;
    if (pn < 14) return 2688 + 256 * (pn - 12) + c;
    if (pn < 18) return 3524 + 256 * (pn - 14) + c;
    return 4548 + 256 * (pn - 18) + c;
}

__device__ __forceinline__ float wave_sum(float v) {
#pragma unroll
    for (int o = 1; o < 64; o <<= 1) v += __shfl_xor(v, o);
    return v;
}
__device__ __forceinline__ void tr_item(const float* W, int ldw, int src0, int nvalid, const float* gk, bf16* WT, int K, int row0, int k0, LAS float* scr, int lane) {
    const int j4 = 4 * (lane & 7);
#pragma unroll
    for (int i = 0; i < 8; ++i) { const int kk = 8 * i + (lane >> 3);
        f32x4 v = (f32x4){0.f, 0.f, 0.f, 0.f};
        if (j4 < nvalid) { v = *(const f32x4*)(W + (size_t)(k0 + kk) * ldw + src0 + j4); if (gk) v = v * gk[k0 + kk]; }
        scr[kk * 33 + j4] = v[0]; scr[kk * 33 + j4 + 1] = v[1]; scr[kk * 33 + j4 + 2] = v[2]; scr[kk * 33 + j4 + 3] = v[3]; }
    LDS_WAIT(); asm volatile("" ::: "memory");
    const int c = lane & 7;
#pragma unroll
    for (int jj = 0; jj < 4; ++jj) { const int n = (lane >> 3) + 8 * jj; const LAS float* s = scr + (8 * c) * 33 + n;
        v4u o; o.x = pk2(s[0 * 33], s[1 * 33]); o.y = pk2(s[2 * 33], s[3 * 33]); o.z = pk2(s[4 * 33], s[5 * 33]); o.w = pk2(s[6 * 33], s[7 * 33]);
        *(GAS v4u*)(WT + (size_t)(row0 + n) * K + k0 + 8 * c) = o; }
    LDS_WAIT(); asm volatile("" ::: "memory");
}
__device__ __forceinline__ void p0_prologue(Frame& F) {
    PHASE_TID();
    LAS float* scr = (LAS float*)(F.lds + F.wave * 16384);
    const int gw = F.vcu * NWAVES + F.wave, NGW = F.G * NWAVES;
    constexpr int I_IN = (DM / 64) * (NIN / 32), I_BR = (AW / 64) * (DM / 32), I_OUT = (DM / 64) * (DM / 32);
    constexpr int PER_L = I_IN + 2 * I_BR + I_OUT;
    for (int it = gw; it < DEPTH * PER_L; it += NGW) {
        const int l = it / PER_L; int r = it % PER_L;
        if (r < I_IN) { const int kb = r / (NIN / 32), nb = r % (NIN / 32); int nvalid; const int src0 = win_src(32 * nb, nvalid);
            tr_item(in_ptr(2) + (size_t)l * DM * DIN, DIN, src0, nvalid, in_ptr(1) + l * DM, (bf16*)(F.ws + WS_WIN) + (size_t)l * NIN * DM, DM, 32 * nb, 64 * kb, scr, plane); continue; }
        r -= I_IN;
        if (r < 2 * I_BR) { const int which = r / I_BR; r %= I_BR; const int kb = r / (DM / 32), nb = r % (DM / 32);
            tr_item((which ? in_ptr(8) : in_ptr(7)) + (size_t)l * AW * DM, DM, 32 * nb, 32, nullptr, (bf16*)(F.ws + WS_WBR) + (size_t)l * 2048 * AW, AW, which * 1024 + 32 * nb, 64 * kb, scr, plane); continue; }
        r -= 2 * I_BR;
        { const int kb = r / (DM / 32), nb = r % (DM / 32);
            tr_item(in_ptr(9) + (size_t)l * DM * DM, DM, 32 * nb, 32, nullptr, (bf16*)(F.ws + WS_WOUT) + (size_t)l * DM * DM, DM, 32 * nb, 64 * kb, scr, plane); }
    }
    const float* x = in_ptr(0); bf16* XB = (bf16*)(F.ws + WS_XB); float* RSS = (float*)(F.ws + WS_RSS);
    for (int m = gw; m < TOK; m += NGW) {
        const GAS f32x4* xr = (const GAS f32x4*)(x + (size_t)m * DM) + plane;
        f32x4 v[4]; float s = 0.f;
#pragma unroll
        for (int j = 0; j < 4; ++j) { v[j] = xr[64 * j]; s += (v[j].x * v[j].x + v[j].y * v[j].y) + (v[j].z * v[j].z + v[j].w * v[j].w); }
        s = wave_sum(s);
        GAS u64* o8 = (GAS u64*)(XB + (size_t)m * DM) + plane;
#pragma unroll
        for (int j = 0; j < 4; ++j) o8[64 * j] = (u64)pk2(v[j].x, v[j].y) | ((u64)pk2(v[j].z, v[j].w) << 32);
        if (plane < 16) RSS[(size_t)m * 16 + plane] = (plane == 0) ? s : 0.f;
    }
}

namespace pg8 {
__device__ __forceinline__ float row_rs(const float* rss, int row, int fq) {
    const f32x4 a = *(const f32x4*)(rss + (size_t)row * 16 + 4 * fq);
    float s = (a[0] + a[1]) + (a[2] + a[3]);
    s += __shfl_xor(s, 16); s += __shfl_xor(s, 32);
    return __builtin_amdgcn_rsqf(s * (1.0f / DM) + EPS);
}
__device__ __forceinline__ u32x4 pack8(const f32x4 o0, const f32x4 o1) { u32x4 w; w.x = cvt_pk_bf16(o0[0], o0[1]); w.y = cvt_pk_bf16(o0[2], o0[3]); w.z = cvt_pk_bf16(o1[0], o1[1]); w.w = cvt_pk_bf16(o1[2], o1[3]); return w; }
struct EpiIn {
    static constexpr bool PERM = true, AFTER_DRAIN = false, REPEATABLE = true;
    const float* rss; const float *qna, *kna, *qnb, *knb;
    bf16_t *QA, *KA, *VA, *SGA, *QB, *SGB, *KB, *VB, *KI, *QI, *SMA, *SMB; float* WI; float* KMP;
    __device__ __forceinline__ void norm_rows(const f32x4 (&acc)[2][2][4][2], const Unit& u, int wr, int fr, int fq, const float* g, float oscale, bf16_t* dst, int ld, int coloff, float* kmp) const {
        f32x4 gv[2][2];
#pragma unroll
        for (int bj = 0; bj < 2; ++bj)
#pragma unroll
            for (int n = 0; n < 2; ++n) gv[bj][n] = *(const f32x4*)(g + 32 * bj + 8 * fq + 4 * n) * oscale;
        f32x4 cs[2][2];
#pragma unroll
        for (int bj = 0; bj < 2; ++bj)
#pragma unroll
            for (int n = 0; n < 2; ++n) cs[bj][n] = (f32x4){0.f, 0.f, 0.f, 0.f};
#pragma unroll
        for (int ai = 0; ai < 2; ++ai)
#pragma unroll
            for (int m = 0; m < 4; ++m) {
                const int row = u.pm * BM + ai * HALF + wr * 64 + m * 16 + fr; const float rs = row_rs(rss, row, fq);
                float sq = 0.f;
#pragma unroll
                for (int bj = 0; bj < 2; ++bj)
#pragma unroll
                    for (int n = 0; n < 2; ++n) { const f32x4 t = acc[ai][bj][m][n]; sq += (t[0] * t[0] + t[1] * t[1]) + (t[2] * t[2] + t[3] * t[3]); }
                sq += __shfl_xor(sq, 16); sq += __shfl_xor(sq, 32);
                const float sc = rs * __builtin_amdgcn_rsqf(sq * rs * rs * (1.0f / 64.0f) + EPS);
#pragma unroll
                for (int bj = 0; bj < 2; ++bj) {
                    const f32x4 o0 = acc[ai][bj][m][0] * sc * gv[bj][0], o1 = acc[ai][bj][m][1] * sc * gv[bj][1];
                    cs[bj][0] += o0; cs[bj][1] += o1;
                    *(u32x4*)(dst + (size_t)row * ld + coloff + 32 * bj + 8 * fq) = pack8(o0, o1); }
                asm volatile("" ::: "memory");
            }
        if (kmp) {
#pragma unroll
            for (int bj = 0; bj < 2; ++bj)
#pragma unroll
                for (int n = 0; n < 2; ++n) { f32x4 t = cs[bj][n];
#pragma unroll
                    for (int o = 1; o < 16; o <<= 1) { t[0] += __shfl_xor(t[0], o); t[1] += __shfl_xor(t[1], o); t[2] += __shfl_xor(t[2], o); t[3] += __shfl_xor(t[3], o); }
                    if (fr == 0) *(f32x4*)(kmp + 32 * bj + 8 * fq + 4 * n) = t; }
        }
    }
    __device__ __forceinline__ void plain_rows(const f32x4 (&acc)[2][2][4][2], const Unit& u, int wr, int fr, int fq, bf16_t* dst, int ld, int col0, int bjs, float ca, float cb, float cc, float* wi) const {
        const float pa = ca + cc, pb = cb, pc = cb + cc, pd = ca;
        float rsv[2][4];
#pragma unroll
        for (int ai = 0; ai < 2; ++ai)
#pragma unroll
            for (int m = 0; m < 4; ++m) rsv[ai][m] = row_rs(rss, u.pm * BM + ai * HALF + wr * 64 + m * 16 + fr, fq);
#pragma unroll
        for (int ai = 0; ai < 2; ++ai)
#pragma unroll
            for (int m = 0; m < 4; ++m) {
                const int row = u.pm * BM + ai * HALF + wr * 64 + m * 16 + fr; const float rs = rsv[ai][m], rsn = -LOG2E * rs;
                if (wi) { if (fq == 0) *(f32x4*)(wi + (size_t)row * 4) = acc[ai][0][m][0] * rs; }
                else {
#pragma unroll
                for (int bj = 0; bj < 2; ++bj) { f32x4 o[2];
#pragma unroll
                    for (int n = 0; n < 2; ++n) { const f32x4 a = acc[ai][bj][m][n]; const f32x4 v = a * rs, t = a * rsn; f32x4 e;
#pragma unroll
                        for (int i = 0; i < 4; ++i) e[i] = __builtin_amdgcn_exp2f(t[i]);
                        e = e + 1.0f; f32x4 sg;
#pragma unroll
                        for (int i = 0; i < 4; ++i) sg[i] = __builtin_amdgcn_rcpf(e[i]);
                        o[n] = (v * pa + pb) * (sg * pc + pd); }
                    *(u32x4*)(dst + (size_t)row * ld + col0 + bj * bjs) = pack8(o[0], o[1]); }
                }
                asm volatile("" ::: "memory");
            }
    }
    __device__ __forceinline__ void operator()(const f32x4 (&acc)[2][2][4][2], const Unit& u, int wr, int wc, int fr_, int fq_) const {
        int fr = fr_, fq = fq_; asm volatile("" : "+v"(fr), "+v"(fq));
        const int pn = u.pn; const int cid = wc * 32 + 8 * fq;
        bool isnorm = false; bf16_t* dst; int ld = AW, col0, bjs = HALF; const float* g = qna; float osc = 1.0f; float* kmp = nullptr; float ca = 1.f, cb = 0.f, cc = 0.f; float* wi = nullptr;
        if (pn < 2) { isnorm = true; g = qna; osc = C2; dst = QA; col0 = 64 * (4 * pn + wc); }
        else if (pn < 4) { isnorm = true; g = kna; dst = KA; const int h = 4 * (pn - 2) + wc; col0 = 64 * h; kmp = KMP + ((((size_t)(u.pm >> 4) * 16 + (u.pm & 15)) * 8 + h) * 2 + wr) * 64; }
        else if (pn < 6) { dst = VA; col0 = 256 * (pn - 4) + cid; }
        else if (pn < 8) { dst = SGA; col0 = 256 * (pn - 6) + cid; ca = 0.f; cc = 1.f; }
        else if (pn < 10) { isnorm = true; g = qnb; osc = C2; dst = QB; col0 = 64 * (4 * (pn - 8) + wc); }
        else if (pn == 10) { ld = 64; bjs = 32; col0 = 8 * fq; dst = KI;
            if (wc == 0) { isnorm = true; g = knb; dst = KB; col0 = 0; } else if (wc == 1) { dst = VB; } else if (wc == 3) { wi = WI; } }
        else if (pn == 11) { dst = QI; ld = 256; col0 = cid; }
        else if (pn < 14) { dst = SGB; col0 = 256 * (pn - 12) + cid; ca = 0.f; cc = 1.f; }
        else if (pn < 18) { dst = SMA; ld = DM; col0 = 256 * (pn - 14) + cid; ca = 0.f; cb = 1.f; }
        else { dst = SMB; ld = DM; col0 = 256 * (pn - 18) + cid; ca = 0.f; cb = 1.f; }
        if (isnorm) norm_rows(acc, u, wr, fr, fq, g, osc, dst, ld, col0, kmp);
        else plain_rows(acc, u, wr, fr, fq, dst, ld, col0, bjs, ca, cb, cc, wi);
    }
};
struct EpiMerge {
    static constexpr bool PERM = true, AFTER_DRAIN = false, REPEATABLE = false;
    bf16_t* SMA; bf16_t* SMB;
    __device__ __forceinline__ void operator()(const f32x4 (&acc)[2][2][4][2], const Unit& u, int wr, int wc, int fr, int fq) const {
        const bool partb = u.pm >= 128; const int pm = partb ? u.pm - 128 : u.pm, pn = partb ? u.pn - 4 : u.pn;
#pragma unroll
        for (int ai = 0; ai < 2; ++ai)
#pragma unroll
            for (int m = 0; m < 4; ++m) { const int row = pm * BM + ai * HALF + wr * 64 + m * 16 + fr;
#pragma unroll
                for (int bj = 0; bj < 2; ++bj) { const size_t off = (size_t)row * DM + pn * BM + bj * HALF + wc * 32 + 8 * fq;
                    const u32x4 sg = *(const u32x4*)((partb ? SMB : SMA) + off);
                    const f32x4 s0 = (f32x4){__uint_as_float(sg.x << 16), __uint_as_float(sg.x & 0xffff0000u), __uint_as_float(sg.y << 16), __uint_as_float(sg.y & 0xffff0000u)};
                    const f32x4 s1 = (f32x4){__uint_as_float(sg.z << 16), __uint_as_float(sg.z & 0xffff0000u), __uint_as_float(sg.w << 16), __uint_as_float(sg.w & 0xffff0000u)};
                    f32x4 o0 = acc[ai][bj][m][0] * s0, o1 = acc[ai][bj][m][1] * s1;
                    if (partb) { const u32x4 pa = *(const u32x4*)(SMA + off);
                        o0 += (f32x4){__uint_as_float(pa.x << 16), __uint_as_float(pa.x & 0xffff0000u), __uint_as_float(pa.y << 16), __uint_as_float(pa.y & 0xffff0000u)};
                        o1 += (f32x4){__uint_as_float(pa.z << 16), __uint_as_float(pa.z & 0xffff0000u), __uint_as_float(pa.w << 16), __uint_as_float(pa.w & 0xffff0000u)}; }
                    u32x4 w; w.x = cvt_pk_bf16(o0[0], o0[1]); w.y = cvt_pk_bf16(o0[2], o0[3]); w.z = cvt_pk_bf16(o1[0], o1[1]); w.w = cvt_pk_bf16(o1[2], o1[3]);
                    *(u32x4*)((partb ? SMB : SMA) + off) = w; }
            }
    }
};
struct PairOrder {
    StaticOrder base;
    __device__ void init(int G_, int c_) { base.init(TOK, DM, G_, c_); }
    __device__ bool next(int i, Unit& u) const { Unit t; if (!base.next(i >> 1, t)) return false; u.pm = t.pm + (i & 1) * 128; u.pn = t.pn + (i & 1) * 4; return true; }
    __device__ __forceinline__ void a_ready(const Unit&) const {}
    __device__ __forceinline__ void done(const Unit&) const {}
};
template <bool WRITE_NEXT> struct EpiOut {
    static constexpr bool PERM = true, AFTER_DRAIN = false, REPEATABLE = false;
    const float* xin; float* out; bf16_t* XB; float* rss;
    __device__ __forceinline__ void operator()(const f32x4 (&acc)[2][2][4][2], const Unit& u, int wr, int wc, int fr, int fq) const {
#pragma unroll
        for (int ai = 0; ai < 2; ++ai)
#pragma unroll
            for (int m = 0; m < 4; ++m) { const int row = u.pm * BM + ai * HALF + wr * 64 + m * 16 + fr; float ss = 0.f;
#pragma unroll
                for (int bj = 0; bj < 2; ++bj) { const size_t off = (size_t)row * DM + u.pn * BM + bj * HALF + wc * 32 + 8 * fq;
                    const f32x4 o0 = acc[ai][bj][m][0] + *(const f32x4*)(xin + off), o1 = acc[ai][bj][m][1] + *(const f32x4*)(xin + off + 4);
                    *(f32x4*)(out + off) = o0; *(f32x4*)(out + off + 4) = o1;
                    if (WRITE_NEXT) { ss += (o0[0] * o0[0] + o0[1] * o0[1]) + (o0[2] * o0[2] + o0[3] * o0[3]) + (o1[0] * o1[0] + o1[1] * o1[1]) + (o1[2] * o1[2] + o1[3] * o1[3]);
                        u32x4 w; w.x = cvt_pk_bf16(o0[0], o0[1]); w.y = cvt_pk_bf16(o0[2], o0[3]); w.z = cvt_pk_bf16(o1[0], o1[1]); w.w = cvt_pk_bf16(o1[2], o1[3]);
                        *(u32x4*)(XB + off) = w; } }
                if (WRITE_NEXT) { ss += __shfl_xor(ss, 16); ss += __shfl_xor(ss, 32); if (fq == 0) rss[(size_t)row * 16 + 4 * u.pn + wc] = ss; }
            }
    }
};
}

__device__ __forceinline__ int rel_bucket_dev(int n) {
    if (n < 16) return n;
    int large = 16 + (int)(logf((float)n / 16.0f) / logf(8.0f) * 16.0f);
    return large < 31 ? large : 31;
}
__device__ __forceinline__ void build_bias_table(Frame& F, LAS float* tb, const float* gq, const float* gk, int hoff) {
    PHASE_TID(); const float* rb = in_ptr(10);
    float gm = 0.f;
    for (int d = 0; d < 64; ++d) gm = fmaxf(gm, fabsf(gq[d] * gk[d]));
    for (int e = ptid; e < 8 * 128; e += NWAVES * 64) { const int h = e >> 7, d = e & 127;
        float bm = -1e30f; for (int k = 0; k < 32; ++k) bm = fmaxf(bm, rb[k * 16 + hoff + h]);
        const float M0 = 64.0f * C2 * gm + bm * LOG2E;
        tb[e] = rb[rel_bucket_dev(d) * 16 + hoff + h] * LOG2E - M0; }
}

template <int MODE>
__device__ __forceinline__ void naive_attn(Frame& F, int layer) {
    PHASE_TID();
    LAS float* tb = (LAS float*)F.lds;
    const float* gq = in_ptr(MODE == 0 ? 3 : 5) + layer * 64; const float* gk = in_ptr(MODE == 0 ? 4 : 6) + layer * 64;
    build_bias_table(F, tb, gq, gk, MODE * 8);
    __syncthreads();
    const bf16* Q = (const bf16*)(F.ws + (MODE == 0 ? WS_QA : WS_QB));
    const bf16* K = (const bf16*)(F.ws + (MODE == 0 ? WS_KA : WS_KB));
    const bf16* V = (const bf16*)(F.ws + (MODE == 0 ? WS_VA : WS_VB));
    const bf16* SG = (const bf16*)(F.ws + (MODE == 0 ? WS_SGA : WS_SGB));
    bf16* Y = (bf16*)(F.ws + WS_XB) + (size_t)MODE * TOK * AW;
    const float* KMP = (const float*)(F.ws + WS_KMP);
    const u64* BM = (const u64*)(F.ws + WS_BM);
    constexpr int KLD = (MODE == 0) ? AW : 64;
    for (int item = blockIdx.x * (NWAVES * 64) + ptid; item < BATCH * NH * SEQ; item += F.G * NWAVES * 64) {
        const int q = item & (SEQ - 1), h = (item >> 12) & 7, b = item >> 15; const int qblk = q >> 8;
        const size_t tq = (size_t)b * SEQ + q;
        float qv[64];
        { const v4u* qp = (const v4u*)(Q + tq * AW + h * 64);
#pragma unroll
            for (int c = 0; c < 8; ++c) { const v4u w = qp[c]; qv[8 * c + 0] = bflo(w.x); qv[8 * c + 1] = bfhi(w.x); qv[8 * c + 2] = bflo(w.y); qv[8 * c + 3] = bfhi(w.y); qv[8 * c + 4] = bflo(w.z); qv[8 * c + 5] = bfhi(w.z); qv[8 * c + 6] = bflo(w.w); qv[8 * c + 7] = bfhi(w.w); } }
        unsigned selmask = 0;
        if (MODE == 0) {
            float gate[16];
#pragma unroll
            for (int n = 0; n < 16; ++n) { gate[n] = -INFINITY;
                if (n < qblk) { const float* k0 = KMP + ((((size_t)b * 16 + n) * 8 + h) * 2) * 64; float s = 0.f;
#pragma unroll
                    for (int d = 0; d < 64; ++d) s += qv[d] * ((k0[d] + k0[64 + d]) * (1.0f / 256.0f));
                    gate[n] = s; } }
            const int nsel = qblk < 3 ? qblk : 3;
            for (int r = 0; r < nsel; ++r) { float best = -INFINITY; int bi = -1;
#pragma unroll
                for (int n = 0; n < 16; ++n) { const bool ok = (n < qblk) && !((selmask >> n) & 1u) && (bi < 0 || gate[n] > best); if (ok) { best = gate[n]; bi = n; } }
                selmask |= 1u << bi; }
        }
        float acc[64];
#pragma unroll
        for (int d = 0; d < 64; ++d) acc[d] = 0.f;
        float l = 0.f;
        const int kend = (item | 63) & (SEQ - 1);
        const LAS float* tbh = tb + h * 128;
        u64 mw = 0;
        for (int k = 0; k <= kend; ++k) {
            bool allowed;
            if (MODE == 0) { const int n = k >> 8; allowed = (n == qblk) ? (k <= q) : (((selmask >> n) & 1u) != 0u && n < qblk); }
            else { if ((k & 63) == 0) mw = (k <= q) ? BM[tq * 64 + (k >> 6)] : 0ull; allowed = ((mw >> (k & 63)) & 1ull) != 0ull; }
            if (!__any(allowed)) continue;
            const size_t tk = (size_t)b * SEQ + k;
            const v4u* kp = (const v4u*)(K + tk * KLD + (MODE == 0 ? h * 64 : 0));
            float s = 0.f;
#pragma unroll
            for (int c = 0; c < 8; ++c) { const v4u w = kp[c];
                s += qv[8 * c + 0] * bflo(w.x); s += qv[8 * c + 1] * bfhi(w.x); s += qv[8 * c + 2] * bflo(w.y); s += qv[8 * c + 3] * bfhi(w.y);
                s += qv[8 * c + 4] * bflo(w.z); s += qv[8 * c + 5] * bfhi(w.z); s += qv[8 * c + 6] * bflo(w.w); s += qv[8 * c + 7] * bfhi(w.w); }
            int dist = q - k; dist = dist < 0 ? 0 : (dist > 127 ? 127 : dist);
            s += tbh[dist];
            const float p = allowed ? __builtin_amdgcn_exp2f(s) : 0.f;
            l += p;
            const v4u* vp = (const v4u*)(V + tk * KLD + (MODE == 0 ? h * 64 : 0));
#pragma unroll
            for (int c = 0; c < 8; ++c) { const v4u w = vp[c];
                acc[8 * c + 0] += p * bflo(w.x); acc[8 * c + 1] += p * bfhi(w.x); acc[8 * c + 2] += p * bflo(w.y); acc[8 * c + 3] += p * bfhi(w.y);
                acc[8 * c + 4] += p * bflo(w.z); acc[8 * c + 5] += p * bfhi(w.z); acc[8 * c + 6] += p * bflo(w.w); acc[8 * c + 7] += p * bfhi(w.w); }
        }
        const float il = 1.0f / l;
        const v4u* gp = (const v4u*)(SG + tq * AW + h * 64); v4u* yp = (v4u*)(Y + tq * AW + h * 64);
#pragma unroll
        for (int c = 0; c < 8; ++c) { const v4u g = gp[c]; v4u o;
            o.x = pk2(acc[8 * c + 0] * il * bflo(g.x), acc[8 * c + 1] * il * bfhi(g.x)); o.y = pk2(acc[8 * c + 2] * il * bflo(g.y), acc[8 * c + 3] * il * bfhi(g.y));
            o.z = pk2(acc[8 * c + 4] * il * bflo(g.z), acc[8 * c + 5] * il * bfhi(g.z)); o.w = pk2(acc[8 * c + 6] * il * bflo(g.w), acc[8 * c + 7] * il * bfhi(g.w));
            yp[c] = o; }
    }
}

typedef float f32x16 __attribute__((ext_vector_type(16)));
typedef short s16x4 __attribute__((ext_vector_type(4)));
typedef short v4i16_t __attribute__((ext_vector_type(4)));
constexpr int AT_D = 4, AT_R = AT_D + 2;
constexpr int AT_RING = 0, AT_STAGE = 16384, AT_OST = 0  , AT_TB = AT_R * AT_STAGE, AT_WS = AT_TB + 8192, AT_BM = AT_WS + 2048;
static_assert(8 * 8192 <= AT_R * AT_STAGE && AT_BM + 16384 <= LDSCTL_OFF, "attention LDS");
__device__ __forceinline__ void glds16(const void* gsrc, unsigned lds_dst) { unsigned keep;
    asm volatile("s_mov_b32 %0, m0\n\ts_mov_b32 m0, %2\n\ts_nop 0\n\tglobal_load_lds_dwordx4 %1, off\n\ts_mov_b32 m0, %0" : "=&s"(keep) : "v"(gsrc), "s"(lds_dst) : "memory"); }
#define AT_WAIT_BAR() asm volatile("s_waitcnt vmcnt(0) lgkmcnt(0)\n\ts_barrier" ::: "memory")
#define AT_WAIT_BAR_N(N) asm volatile("s_waitcnt vmcnt(%0) lgkmcnt(0)\n\ts_barrier" :: "n"(N) : "memory")
__device__ __forceinline__ int crow(int r, int hi) { return (r & 3) + 8 * (r >> 2) + 4 * hi; }
__device__ __forceinline__ unsigned cvtpk(float lo, float hi) { unsigned r; asm volatile("v_cvt_pk_bf16_f32 %0, %1, %2" : "=v"(r) : "v"(lo), "v"(hi)); return r; }

template <int MODE>
__device__ __forceinline__ void attn_unit(Frame& F, int b, int h_, int blk) {
    int tid_o = threadIdx.x; asm volatile("" : "+v"(tid_o));
    const int lane = tid_o & 63, r32 = lane & 31, hi = lane >> 5, wid = __builtin_amdgcn_readfirstlane(tid_o >> 6);
    constexpr int KLD = (MODE == 0) ? AW : 64;
    const int h = (MODE == 0) ? h_ : wid;
    const int q0 = (MODE == 0) ? 256 * blk + 32 * wid : 32 * blk;
    const int q = q0 + r32; const size_t tq = (size_t)b * SEQ + q;
    const int NT = (MODE == 0) ? 4 * (blk + 1) : (32 * blk + 31) / 64 + 1;
    const bf16* Q = (const bf16*)(F.ws + (MODE == 0 ? WS_QA : WS_QB));
    const bf16* Kg = (const bf16*)(F.ws + (MODE == 0 ? WS_KA : WS_KB)) + (size_t)b * SEQ * KLD + (MODE == 0 ? h * 64 : 0);
    const bf16* Vg = (const bf16*)(F.ws + (MODE == 0 ? WS_VA : WS_VB)) + (size_t)b * SEQ * KLD + (MODE == 0 ? h * 64 : 0);
    const bf16* SG = (const bf16*)(F.ws + (MODE == 0 ? WS_SGA : WS_SGB));
    bf16* Y = (bf16*)(F.ws + WS_XB) + (size_t)MODE * TOK * AW;
    const u64* BM = (const u64*)(F.ws + WS_BM) + tq * 64;
    LAS unsigned char* lds = F.lds;
    const LAS float* tbh = (const LAS float*)(lds + AT_TB) + (MODE * 8 + h) * 128;
    LAS float* wsf = (LAS float*)(lds + AT_WS) + wid * 64;
    LAS float* ost = (LAS float*)(lds + AT_OST) + wid * 2048;
    const int krow_ = 8 * wid + (lane >> 3);
    const bf16* ksrc = Kg + (size_t)krow_ * KLD + 8 * ((lane & 7) ^ ((krow_ ^ (krow_ >> 3)) & 7));
    const bf16* vsrc = Vg + (size_t)(8 * wid + ((lane & 31) >> 2)) * KLD + 32 * (lane >> 5) + 8 * (lane & 3);
    const unsigned lds0 = (unsigned)(uintptr_t)lds;
#define AT_DMA(t, so) do { \
        glds16(ksrc + (size_t)(t) * 64 * KLD, (unsigned)__builtin_amdgcn_readfirstlane((int)(lds0 + AT_RING + (so) + wid * 1024))); \
        glds16(vsrc + (size_t)(t) * 64 * KLD, (unsigned)__builtin_amdgcn_readfirstlane((int)(lds0 + AT_RING + (so) + 8192 + wid * 1024))); } while (0)
#pragma unroll
    for (int i = 0; i < AT_D; ++i) AT_DMA((i < NT ? i : NT - 1), i * AT_STAGE);
    bf16x8 qr[4];
#pragma unroll
    for (int d0 = 0; d0 < 4; ++d0) qr[d0] = *(const bf16x8*)(Q + tq * AW + h * 64 + 16 * d0 + 8 * hi);
    LAS u64* bmL = (LAS u64*)(lds + AT_BM);
    if (MODE == 1) {
        const u64* BMu = (const u64*)(F.ws + WS_BM) + ((size_t)b * SEQ + q0) * 64;
#pragma unroll
        for (int ps = 0; ps < 2; ++ps) { const int it = ps * 512 + (tid_o & 511), row = it >> 5, j2 = (it & 31) * 2;
            const v4u w = *(const v4u*)(BMu + (size_t)row * 64 + j2);
            bmL[j2 * 32 + row] = (u64)w.x | ((u64)w.y << 32); bmL[(j2 + 1) * 32 + row] = (u64)w.z | ((u64)w.w << 32); }
    }
    unsigned selmask = 0;
    if (MODE == 0 && blk > 0) {
        const bf16* kmh = (const bf16*)(F.ws + WS_KMH) + ((size_t)(b * 8 + h) * 32 + r32) * 64 + 8 * hi;
        const bf16* kml = (const bf16*)(F.ws + WS_KML) + ((size_t)(b * 8 + h) * 32 + r32) * 64 + 8 * hi;
        f32x16 gg;
#pragma unroll
        for (int r = 0; r < 16; ++r) gg[r] = 0.f;
#pragma unroll
        for (int d0 = 0; d0 < 4; ++d0) {
            gg = __builtin_amdgcn_mfma_f32_32x32x16_bf16(*(const bf16x8*)(kmh + 16 * d0), qr[d0], gg, 0, 0, 0);
            gg = __builtin_amdgcn_mfma_f32_32x32x16_bf16(*(const bf16x8*)(kml + 16 * d0), qr[d0], gg, 0, 0, 0); }
        float gate[16];
#pragma unroll
        for (int r = 0; r < 8; ++r) { const float o = __shfl_xor(gg[r], 32); const int nb_ = (r & 3) + 8 * (r >> 2); gate[nb_] = hi ? o : gg[r]; gate[nb_ + 4] = hi ? gg[r] : o; }
        const int nsel = blk < 3 ? blk : 3;
        for (int r = 0; r < nsel; ++r) { float best = -INFINITY; int bi = -1;
#pragma unroll
            for (int n = 0; n < 16; ++n) { const bool ok = (n < blk) && !((selmask >> n) & 1u) && (bi < 0 || gate[n] > best); if (ok) { best = gate[n]; bi = n; } }
            selmask |= 1u << bi; }
    }
    const float cfar = tbh[127]; const float NINF = -INFINITY;
#define AT_INIT_NEAR(t, c0, c1, mw) do { \
        const int kv0_ = 64 * (t); \
        bool sel_ = (t) < NT; \
        if (MODE == 0) { const int n_ = (t) >> 2; sel_ = sel_ && ((n_ == blk) || (((selmask >> (n_ & 15)) & 1u) != 0u)); } \
        unsigned mlo_ = 0, mhi_ = 0; if (MODE == 1) { const u64 ms_ = (mw) >> (4 * hi); mlo_ = (unsigned)ms_; mhi_ = (unsigned)(ms_ >> 32); } \
        _Pragma("unroll") for (int r = 0; r < 16; ++r) { const int bp = (r & 3) + 8 * (r >> 2); \
            const int d0_ = q - (kv0_ + bp + 4 * hi), d1_ = d0_ - 32; \
            const float b0_ = tbh[d0_ < 0 ? 0 : (d0_ > 127 ? 127 : d0_)], b1_ = tbh[d1_ < 0 ? 0 : (d1_ > 127 ? 127 : d1_)]; \
            if (MODE == 0) { c0[r] = (sel_ && d0_ >= 0) ? b0_ : NINF; c1[r] = (sel_ && d1_ >= 0) ? b1_ : NINF; } \
            else { c0[r] = (sel_ && ((mlo_ >> bp) & 1u)) ? b0_ : NINF; c1[r] = (sel_ && ((mhi_ >> bp) & 1u)) ? b1_ : NINF; } } } while (0)
#define AT_INIT_FARB(t, c0, c1, mw) do { \
        const u64 ms_ = ((t) < NT) ? ((mw) >> (4 * hi)) : 0ull; const int mlo_ = (int)(unsigned)ms_, mhi_ = (int)(unsigned)(ms_ >> 32); \
        const unsigned cf_ = __float_as_uint(cfar), nf_ = 0xff800000u; \
        _Pragma("unroll") for (int r = 0; r < 16; ++r) { const int bp = (r & 3) + 8 * (r >> 2); \
            const unsigned m0_ = (unsigned)__builtin_amdgcn_sbfe(mlo_, bp, 1), m1_ = (unsigned)__builtin_amdgcn_sbfe(mhi_, bp, 1); \
            c0[r] = __uint_as_float((m0_ & cf_) | (~m0_ & nf_)); c1[r] = __uint_as_float((m1_ & cf_) | (~m1_ & nf_)); } } while (0)
    const int kswz = (r32 ^ (r32 >> 3)) & 7;
#define AT_KF(Kt_, d0, p) (*(const LAS bf16x8*)((Kt_) + (p) * 4096 + (((2 * (d0) + hi) ^ kswz ^ (4 * (p))) << 4)))
#define AT_QK(so, c0, c1, i0, i1) do { const LAS unsigned char* Kt_ = lds + AT_RING + (so) + r32 * 128; \
        c0 = __builtin_amdgcn_mfma_f32_32x32x16_bf16(AT_KF(Kt_, 0, 0), qr[0], i0, 0, 0, 0); \
        c1 = __builtin_amdgcn_mfma_f32_32x32x16_bf16(AT_KF(Kt_, 0, 1), qr[0], i1, 0, 0, 0); \
        _Pragma("unroll") for (int d0 = 1; d0 < 4; ++d0) { \
            c0 = __builtin_amdgcn_mfma_f32_32x32x16_bf16(AT_KF(Kt_, d0, 0), qr[d0], c0, 0, 0, 0); \
            c1 = __builtin_amdgcn_mfma_f32_32x32x16_bf16(AT_KF(Kt_, d0, 1), qr[d0], c1, 0, 0, 0); } } while (0)
#define AT_SCORES(t, kf, c0, c1, mw) do { \
        const bool nearD_ = (q0 - (64 * (t) + 63)) < 113; \
        if (nearD_) { AT_INIT_NEAR(t, c0, c1, mw); AT_QK(kf, c0, c1, c0, c1); } \
        else if (MODE == 0) { AT_QK(kf, c0, c1, ivec, ivec); } \
        else { AT_INIT_FARB(t, c0, c1, mw); AT_QK(kf, c0, c1, c0, c1); } } while (0)
#define AT_IVEC(t) do { if (MODE == 0) { const int n_ = (t) >> 2; const bool s_ = ((t) < NT) && ((n_ == blk) || (((selmask >> (n_ & 15)) & 1u) != 0u)); const float v_ = s_ ? cfar : NINF; \
        _Pragma("unroll") for (int r = 0; r < 16; ++r) ivec[r] = v_; asm volatile("" : "+v"(ivec)); } } while (0)
#ifndef EXP_LDS
#define EXP_LDS 0
#endif
#ifndef EXP_EXP
#define EXP_EXP 0
#endif
#ifndef EXP_MFMA
#define EXP_MFMA 0
#endif
    f32x16 o0, o1, ivec; pg8::f32x4 dm4a = (pg8::f32x4){0.f,0.f,0.f,0.f}, dm4b = (pg8::f32x4){0.f,0.f,0.f,0.f}; f32x16 dmy; if (EXP_MFMA) { _Pragma("unroll") for (int r = 0; r < 16; ++r) dmy[r] = 0.f; }
#pragma unroll
    for (int r = 0; r < 16; ++r) { o0[r] = 0.f; o1[r] = 0.f; ivec[r] = NINF; }
    float lsum = 0.f;
    f32x16 ca0, ca1, cb0, cb1;
    AT_WAIT_BAR_N(2 * (AT_D - 1));
    AT_IVEC(0);
    { u64 mw0 = 0ull; if (MODE == 1) mw0 = bmL[r32];
      AT_SCORES(0, 0, ca0, ca1, mw0); }
    const int vbl = ((lane >> 4) & 1) * 32 + (lane & 3) * 8 + (4 * hi + ((lane & 15) >> 2)) * 64;
    int so_cur = 0, so_nxt = AT_STAGE, so_dma = AT_D * AT_STAGE;
#define AT_STEP(t, C0, C1, N0, N1) do { \
        u64 mw1_ = 0ull; if (MODE == 1) mw1_ = bmL[(((t) + 1) & 63) * 32 + r32]; \
        const LAS unsigned char* Vt_ = lds + AT_RING + so_cur + 8192; \
        asm volatile("" ::: "memory"); \
        if ((((t) + 1) & 3) == 0) AT_IVEC((t) + 1); \
        AT_SCORES((t) + 1, so_nxt, N0, N1, mw1_); \
        float sacc_ = 0.f; \
        if (EXP_EXP) { _Pragma("unroll") for (int r = 0; r < 16; ++r) { float e0_ = __builtin_amdgcn_exp2f(C0[r] + 1.0f), e1_ = __builtin_amdgcn_exp2f(C1[r] + 1.0f); asm volatile("" :: "v"(e0_), "v"(e1_)); } } \
        _Pragma("unroll") for (int r = 0; r < 16; ++r) { C0[r] = __builtin_amdgcn_exp2f(C0[r]); C1[r] = __builtin_amdgcn_exp2f(C1[r]); sacc_ += C0[r] + C1[r]; } \
        lsum += sacc_; \
        u32x4v pw_[4]; \
        _Pragma("unroll") for (int s_ = 0; s_ < 2; ++s_) { \
            pw_[s_] = (u32x4v){cvtpk(C0[8 * s_], C0[8 * s_ + 1]), cvtpk(C0[8 * s_ + 2], C0[8 * s_ + 3]), cvtpk(C0[8 * s_ + 4], C0[8 * s_ + 5]), cvtpk(C0[8 * s_ + 6], C0[8 * s_ + 7])}; \
            pw_[2 + s_] = (u32x4v){cvtpk(C1[8 * s_], C1[8 * s_ + 1]), cvtpk(C1[8 * s_ + 2], C1[8 * s_ + 3]), cvtpk(C1[8 * s_ + 4], C1[8 * s_ + 5]), cvtpk(C1[8 * s_ + 6], C1[8 * s_ + 7])}; } \
        _Pragma("unroll") for (int ks = 0; ks < 4; ++ks) { const bf16x8 pa_ = __builtin_bit_cast(bf16x8, pw_[ks]); \
            _Pragma("unroll") for (int d0 = 0; d0 < 2; ++d0) { const LAS unsigned char* vp_ = Vt_ + (2 * ks) * 1024 + d0 * 512 + vbl; \
                const s16x4 lo_ = __builtin_bit_cast(s16x4, __builtin_amdgcn_ds_read_tr16_b64_v4i16((LAS v4i16_t*)vp_)), hh_ = __builtin_bit_cast(s16x4, __builtin_amdgcn_ds_read_tr16_b64_v4i16((LAS v4i16_t*)(vp_ + 1024))); \
                if (EXP_LDS) { s16x4 l2_ = __builtin_bit_cast(s16x4, __builtin_amdgcn_ds_read_tr16_b64_v4i16((LAS v4i16_t*)(vp_ + 2048))), h2_ = __builtin_bit_cast(s16x4, __builtin_amdgcn_ds_read_tr16_b64_v4i16((LAS v4i16_t*)(vp_ + 3072))); asm volatile("" :: "v"(l2_), "v"(h2_)); } \
                const bf16x8 vf_ = (bf16x8){lo_[0], lo_[1], lo_[2], lo_[3], hh_[0], hh_[1], hh_[2], hh_[3]}; \
                if (d0 == 0) o0 = __builtin_amdgcn_mfma_f32_32x32x16_bf16(pa_, vf_, o0, 0, 0, 0); else o1 = __builtin_amdgcn_mfma_f32_32x32x16_bf16(pa_, vf_, o1, 0, 0, 0); \
                if (EXP_MFMA == 1) { dmy = __builtin_amdgcn_mfma_f32_32x32x16_bf16(pa_, vf_, dmy, 0, 0, 0); } \
                if (EXP_MFMA == 2) { dm4a = __builtin_amdgcn_mfma_f32_16x16x32_bf16(pa_, vf_, dm4a, 0, 0, 0); dm4b = __builtin_amdgcn_mfma_f32_16x16x32_bf16(vf_, pa_, dm4b, 0, 0, 0); } } } \
        so_cur = so_nxt; so_nxt = (so_nxt == (AT_R - 1) * AT_STAGE) ? 0 : so_nxt + AT_STAGE; } while (0)
    for (int t = 0; t < NT; t += 2) {
        AT_WAIT_BAR_N(2 * (AT_D - 3));
        { const int td_ = t + AT_D; AT_DMA((td_ < NT ? td_ : NT - 1), so_dma); so_dma = (so_dma == (AT_R - 1) * AT_STAGE) ? 0 : so_dma + AT_STAGE; }
        { const int td_ = t + AT_D + 1; AT_DMA((td_ < NT ? td_ : NT - 1), so_dma); so_dma = (so_dma == (AT_R - 1) * AT_STAGE) ? 0 : so_dma + AT_STAGE; }
        AT_STEP(t, ca0, ca1, cb0, cb1);
        AT_STEP(t + 1, cb0, cb1, ca0, ca1);
    }
    if (EXP_MFMA == 1) asm volatile("" :: "v"(dmy));
    if (EXP_MFMA == 2) asm volatile("" :: "v"(dm4a), "v"(dm4b));
    AT_WAIT_BAR();
    lsum += __shfl_xor(lsum, 32);
    if (hi == 0) wsf[r32] = lsum;
    LDS_WAIT(); asm volatile("" ::: "memory");
#pragma unroll
    for (int r = 0; r < 16; ++r) { const int orow = crow(r, hi); const float rl = __builtin_amdgcn_rcpf(wsf[orow]);
        ost[orow * 64 + r32] = o0[r] * rl; ost[orow * 64 + 32 + r32] = o1[r] * rl; }
    LDS_WAIT(); asm volatile("" ::: "memory");
#pragma unroll
    for (int i = 0; i < 4; ++i) { const int row = i * 8 + (lane >> 3), ch = lane & 7;
        const f32x4 a = *(const LAS f32x4*)(ost + row * 64 + ch * 8), c = *(const LAS f32x4*)(ost + row * 64 + ch * 8 + 4);
        const size_t off = ((size_t)b * SEQ + q0 + row) * AW + h * 64 + ch * 8;
        const v4u g = *(const v4u*)(SG + off); v4u o;
        o.x = pk2(a[0] * bflo(g.x), a[1] * bfhi(g.x)); o.y = pk2(a[2] * bflo(g.y), a[3] * bfhi(g.y)); o.z = pk2(c[0] * bflo(g.z), c[1] * bfhi(g.z)); o.w = pk2(c[2] * bflo(g.w), c[3] * bfhi(g.w));
        *(v4u*)(Y + off) = o; }
    AT_WAIT_BAR();
#undef AT_DMA
#undef AT_INIT_NEAR
#undef AT_INIT_FARB
#undef AT_QK
#undef AT_KF
#undef AT_SCORES
#undef AT_IVEC
#undef AT_STEP
}
__device__ __forceinline__ void attn_phase_fast(Frame& F, int layer) {
    { LAS float* tb = (LAS float*)(F.lds + AT_TB);
      build_bias_table(F, tb, in_ptr(3) + layer * 64, in_ptr(4) + layer * 64, 0);
      build_bias_table(F, tb + 1024, in_ptr(5) + layer * 64, in_ptr(6) + layer * 64, 8); }
    __syncthreads();
#ifndef REP_ATT_A
#define REP_ATT_A 1
#endif
#ifndef REP_ATT_B
#define REP_ATT_B 1
#endif
    for (int rep = 0; rep < REP_ATT_A; ++rep)
    for (int pr = F.vcu; pr < 512; pr += F.G) {
        const int bh = pr >> 3, s = pr & 7;
        attn_unit<0>(F, bh >> 3, bh & 7, 15 - s); attn_unit<0>(F, bh >> 3, bh & 7, s); }
    for (int rep = 0; rep < REP_ATT_B; ++rep)
    for (int pr = F.vcu; pr < 512; pr += F.G) {
        const int b = pr >> 6, s = pr & 63;
        attn_unit<1>(F, b, 0, 127 - s); attn_unit<1>(F, b, 0, s); }
}

constexpr int IDX_S_OFF = 0, IDX_Q_OFF = RING_BYTES, IDX_W_OFF = RING_BYTES + 8192, IDX_H_OFF = RING_BYTES;
static_assert(IDX_H_OFF + 8 * 3328 <= LDSCTL_OFF, "idx LDS");

#define DPPI_(x, ctrl) __builtin_amdgcn_update_dpp(0, (x), (ctrl), 0xF, 0xF, true)
#define DPPF_(x, ctrl) __builtin_bit_cast(float, DPPI_(__builtin_bit_cast(int, (x)), (ctrl)))
__device__ __forceinline__ float rl_f(float x, int l) { return __builtin_bit_cast(float, __builtin_amdgcn_readlane(__builtin_bit_cast(int, x), l)); }
__device__ __forceinline__ float wave_minf(float x) {
    x = fminf(x, DPPF_(x, 0xB1)); x = fminf(x, DPPF_(x, 0x4E)); x = fminf(x, DPPF_(x, 0x141)); x = fminf(x, DPPF_(x, 0x140));
    return fminf(fminf(rl_f(x, 0), rl_f(x, 16)), fminf(rl_f(x, 32), rl_f(x, 48)));
}
__device__ __forceinline__ float wave_maxf(float x) {
    x = fmaxf(x, DPPF_(x, 0xB1)); x = fmaxf(x, DPPF_(x, 0x4E)); x = fmaxf(x, DPPF_(x, 0x141)); x = fmaxf(x, DPPF_(x, 0x140));
    return fmaxf(fmaxf(rl_f(x, 0), rl_f(x, 16)), fmaxf(rl_f(x, 32), rl_f(x, 48)));
}
#define SEL_OPAQUE() do { _Pragma("unroll") for (int j_ = 0; j_ < 64; ++j_) asm volatile("" : "+v"(v[j_])); } while (0)
typedef unsigned u32x2v __attribute__((ext_vector_type(2)));
__device__ __forceinline__ unsigned pkrtz_f16(float a, float b) { unsigned r; asm("v_cvt_pkrtz_f16_f32 %0, %1, %2" : "=v"(r) : "v"(a), "v"(b)); return r; }
typedef _Float16 sel_t;
typedef _Float16 sel8_t __attribute__((ext_vector_type(8)));
__device__ __forceinline__ unsigned bin_of(float x, float lo, float scale) {
    int r; const float t = (x - lo) * scale; asm("v_cvt_i32_f32 %0, %1" : "=v"(r) : "v"(t)); const unsigned u = (unsigned)r; return u < 256u ? u : 256u;
}
template <bool KNOWN>
__device__ __forceinline__ void select_core(LAS sel_t* R, int n, int lane, LAS unsigned* hist, float& T_out, int& needT_out, float lo_in = 0.f, float hi_in = 0.f) {
    const int nch = (n + 63) >> 6;
    if (64 * (nch - 1) + lane >= n) R[64 * (nch - 1) + lane] = (sel_t)(-INFINITY);
    LDS_WAIT(); asm volatile("" ::: "memory");
    const LAS sel_t* Rl = R + lane;
    float lo = lo_in, hi = hi_in;
    if (!KNOWN) { lo = INFINITY; hi = -INFINITY;
#pragma unroll 4
        for (int j = 0; j < nch; ++j) { const float x = Rl[64 * j]; lo = fminf(lo, x == -INFINITY ? INFINITY : x); hi = fmaxf(hi, x); }
        lo = wave_minf(lo); hi = wave_maxf(hi); }
    int need = 256; float T = lo; int needT = 256;
    for (int iter = 0; iter < 48; ++iter) {
        T = lo; needT = need;
        if (!(hi > lo)) break;
        hist[lane] = 0u; hist[64 + lane] = 0u; hist[128 + lane] = 0u; hist[192 + lane] = 0u; hist[256 + (lane & 3)] = 0u;
        LDS_WAIT(); asm volatile("" ::: "memory");
        const float scale = 255.99f / (hi - lo);
#pragma unroll 4
        for (int j = 0; j < nch; ++j) __hip_atomic_fetch_add(hist + bin_of(Rl[64 * j], lo, scale), 1u, __ATOMIC_RELAXED, __HIP_MEMORY_SCOPE_WORKGROUP);
        LDS_WAIT(); asm volatile("" ::: "memory");
        const unsigned h0 = hist[4 * lane], h1 = hist[4 * lane + 1], h2 = hist[4 * lane + 2], h3 = hist[4 * lane + 3];
        unsigned suf = h0 + h1 + h2 + h3;
        suf += (unsigned)__builtin_amdgcn_update_dpp(0, (int)suf, 0x101, 0xF, 0xF, true); suf += (unsigned)__builtin_amdgcn_update_dpp(0, (int)suf, 0x102, 0xF, 0xF, true);
        suf += (unsigned)__builtin_amdgcn_update_dpp(0, (int)suf, 0x104, 0xF, 0xF, true); suf += (unsigned)__builtin_amdgcn_update_dpp(0, (int)suf, 0x108, 0xF, 0xF, true);
        { const unsigned r1 = __builtin_amdgcn_readlane(suf, 16), r2 = __builtin_amdgcn_readlane(suf, 32), r3 = __builtin_amdgcn_readlane(suf, 48);
          const int rw = lane >> 4; suf += (rw == 0) ? (r1 + r2 + r3) : (rw == 1) ? (r2 + r3) : (rw == 2) ? r3 : 0u; }
        const u64 bal = __ballot(suf >= (unsigned)need);
        if (bal == 0ull) break;
        const int ls = 63 - __builtin_clzll(bal);
        const unsigned a3 = __builtin_amdgcn_readlane(h3, ls), a2 = __builtin_amdgcn_readlane(h2, ls), a1 = __builtin_amdgcn_readlane(h1, ls), a0 = __builtin_amdgcn_readlane(h0, ls);
        const unsigned above_lane = __builtin_amdgcn_readlane(suf, ls) - (a0 + a1 + a2 + a3);
        unsigned bstar, above, cstar;
        if (above_lane + a3 >= (unsigned)need) { bstar = 4 * ls + 3; above = above_lane; cstar = a3; }
        else if (above_lane + a3 + a2 >= (unsigned)need) { bstar = 4 * ls + 2; above = above_lane + a3; cstar = a2; }
        else if (above_lane + a3 + a2 + a1 >= (unsigned)need) { bstar = 4 * ls + 1; above = above_lane + a3 + a2; cstar = a1; }
        else { bstar = 4 * ls; above = above_lane + a3 + a2 + a1; cstar = a0; }
        need -= (int)above;
        float nlo = INFINITY, nhi = -INFINITY; int cnt = 0;
        LAS float* candx = (LAS float*)hist; LAS unsigned* candi = hist + 64;
#pragma unroll 4
        for (int j = 0; j < nch; ++j) { const float x = Rl[64 * j];
            const bool c = bin_of(x, lo, scale) == bstar;
            const u64 cb = __ballot(c);
            if (cb != 0ull) { nlo = fminf(nlo, c ? x : INFINITY); nhi = fmaxf(nhi, c ? x : -INFINITY);
                const int pos = cnt + (int)__builtin_amdgcn_mbcnt_hi((unsigned)(cb >> 32), __builtin_amdgcn_mbcnt_lo((unsigned)cb, 0u));
                if (c && pos < 64) { candx[pos] = x; candi[pos] = (unsigned)(64 * j + lane); }
                cnt += __builtin_popcountll(cb); } }
        if (cstar <= 64u) {
            LDS_WAIT(); asm volatile("" ::: "memory");
            const bool mine = lane < (int)cstar;
            const float mx = mine ? candx[lane] : -INFINITY; const unsigned mi = candi[lane];
            int rank = 0;
            for (int i = 0; i < (int)cstar; ++i) { const float xi = rl_f(mx, i); const unsigned ii = (unsigned)__builtin_amdgcn_readlane((int)mi, i); rank += (xi > mx || (xi == mx && ii < mi)) ? 1 : 0; }
            const u64 tb_ = __ballot(mine && rank == need - 1);
            if (tb_ == 0ull) break;
            T = rl_f(mx, __builtin_ctzll(tb_));
            needT = need - __builtin_popcountll(__ballot(mine && mx > T));
            LDS_WAIT(); asm volatile("" ::: "memory");
            break;
        }
        nlo = wave_minf(nlo); nhi = wave_maxf(nhi);
        if ((int)cstar == need) { T = nlo; needT = 1 << 20; break; }
        lo = nlo; hi = nhi;
    }
    T_out = T; needT_out = needT;
}

__device__ __forceinline__ u64 bitmap_row(const LAS sel_t* R, int n, int lane, float T, int needT) {
    const int nch = (n + 63) >> 6; const LAS sel_t* Rl = R + lane;
    int run = 0; unsigned wlo = 0u, whi = 0u;
#pragma unroll 4
    for (int j = 0; j < nch; ++j) { const float x = Rl[64 * j];
        u64 w;
        const bool tie = (x == T); const u64 tbal = __ballot(tie);
        if (tbal == 0ull) w = __ballot(x > T);
        else { const int rank = run + (int)__builtin_amdgcn_mbcnt_hi((unsigned)(tbal >> 32), __builtin_amdgcn_mbcnt_lo((unsigned)tbal, 0u)); run += __builtin_popcountll(tbal);
            w = __ballot(x > T || (tie && rank < needT)); }
        if (lane == j) { wlo = (unsigned)w; whi = (unsigned)(w >> 32); }
    }
    return (u64)wlo | ((u64)whi << 32);
}
__device__ __forceinline__ u64 select_row(LAS sel_t* R, int n, int lane, LAS unsigned* hist) {
    const int nch = (n + 63) >> 6;
    if (64 * (nch - 1) + lane >= n) R[64 * (nch - 1) + lane] = (sel_t)(-INFINITY);
    LDS_WAIT(); asm volatile("" ::: "memory");
    const LAS sel_t* Rl = R + lane;
    LAS unsigned short* idx16 = (LAS unsigned short*)(hist + 320);
    float T; int needT;
    bool fast = n >= 768;
    float L = 0.f; int cnt = 0;
    if (fast) {
        const float x0 = Rl[0];
        int kth = (64 * 640) / n; kth = kth < 4 ? 4 : (kth > 60 ? 60 : kth);
        int above = 0;
#pragma unroll
        for (int i = 0; i < 8; ++i) { const sel8_t q = *(const LAS sel8_t*)(R + 8 * i);
#pragma unroll
            for (int k = 0; k < 8; ++k) above += ((float)q[k] > x0) ? 1 : 0; }
        L = wave_minf(above <= kth ? x0 : INFINITY);
        int cl = 0;
#pragma unroll 4
        for (int j = 0; j < nch; ++j) cl += (Rl[64 * j] >= L) ? 1 : 0;
        cl += __builtin_amdgcn_update_dpp(0, cl, 0xB1, 0xF, 0xF, true); cl += __builtin_amdgcn_update_dpp(0, cl, 0x4E, 0xF, 0xF, true);
        cl += __builtin_amdgcn_update_dpp(0, cl, 0x141, 0xF, 0xF, true); cl += __builtin_amdgcn_update_dpp(0, cl, 0x140, 0xF, 0xF, true);
        cnt = __builtin_amdgcn_readlane(cl, 0) + __builtin_amdgcn_readlane(cl, 16) + __builtin_amdgcn_readlane(cl, 32) + __builtin_amdgcn_readlane(cl, 48);
        fast = cnt >= 256 && cnt <= 1024;
    }
    if (!fast) { select_core<false>(R, n, lane, hist, T, needT); return bitmap_row(R, n, lane, T, needT); }
    int pos = 0; float xn = Rl[0], hmax = -INFINITY;
    for (int j = 0; j < nch; ++j) { const float x = xn; if (j + 1 < nch) xn = Rl[64 * (j + 1)];
        hmax = fmaxf(hmax, x);
        const bool c = x >= L; const u64 cb = __ballot(c);
        if (cb != 0ull) { const int p = pos + (int)__builtin_amdgcn_mbcnt_hi((unsigned)(cb >> 32), __builtin_amdgcn_mbcnt_lo((unsigned)cb, 0u));
            if (c) { R[p] = (sel_t)x; idx16[p] = (unsigned short)(64 * j + lane); }
            pos += __builtin_popcountll(cb); } }
    LDS_WAIT(); asm volatile("" ::: "memory");
    select_core<true>(R, cnt, lane, hist, T, needT, L, wave_maxf(hmax));
    hist[lane] = 0u; hist[64 + lane] = 0u;
    LDS_WAIT(); asm volatile("" ::: "memory");
    const int ncl = (cnt + 63) >> 6; int run = 0;
    for (int j = 0; j < ncl; ++j) { const float x = Rl[64 * j];
        const bool tie = (x == T); const u64 tbal = __ballot(tie);
        const int rank = run + (int)__builtin_amdgcn_mbcnt_hi((unsigned)(tbal >> 32), __builtin_amdgcn_mbcnt_lo((unsigned)tbal, 0u)); run += __builtin_popcountll(tbal);
        const bool selb = x > T || (tie && rank < needT);
        if (selb) { const unsigned id = idx16[64 * j + lane]; __hip_atomic_fetch_or(hist + (id >> 5), 1u << (id & 31u), __ATOMIC_RELAXED, __HIP_MEMORY_SCOPE_WORKGROUP); } }
    LDS_WAIT(); asm volatile("" ::: "memory");
    const u64 myword = (u64)hist[2 * lane] | ((u64)hist[2 * lane + 1] << 32);
    LDS_WAIT(); asm volatile("" ::: "memory");
    return myword;
}

#ifdef NAIVE_IDX
__device__ __forceinline__ void idx_phase_naive(Frame& F) {
    PHASE_TID();
    LAS float* S = (LAS float*)(F.lds + IDX_S_OFF); LAS float* qs = (LAS float*)(F.lds + IDX_Q_OFF); LAS float* wsm = (LAS float*)(F.lds + IDX_W_OFF);
    LAS unsigned* hist = (LAS unsigned*)(F.lds + IDX_H_OFF) + F.wave * 832;
    const bf16* QI = (const bf16*)(F.ws + WS_QI); const bf16* KI = (const bf16*)(F.ws + WS_KI); const float* WI = (const float*)(F.ws + WS_WI); u64* BM = (u64*)(F.ws + WS_BM);
    for (int un = blockIdx.x; un < TOK / 8; un += F.G) {
        const int b = un >> 9, q0 = (un & 511) * 8; const size_t t0 = (size_t)b * SEQ + q0;
        for (int e = ptid; e < 8 * 256; e += NWAVES * 64) qs[e] = bf2f(QI[t0 * 256 + e]);
        if (ptid < 32) wsm[ptid] = WI[t0 * 4 + ptid];
        __syncthreads();
        const int nk = q0 + 8;
        for (int k = ptid; k < nk; k += NWAVES * 64) {
            float kf[64];
            { const v4u* kp = (const v4u*)(KI + ((size_t)b * SEQ + k) * 64);
#pragma unroll
                for (int c = 0; c < 8; ++c) { const v4u w = kp[c]; kf[8 * c + 0] = bflo(w.x); kf[8 * c + 1] = bfhi(w.x); kf[8 * c + 2] = bflo(w.y); kf[8 * c + 3] = bfhi(w.y); kf[8 * c + 4] = bflo(w.z); kf[8 * c + 5] = bfhi(w.z); kf[8 * c + 6] = bflo(w.w); kf[8 * c + 7] = bfhi(w.w); } }
            for (int i = 0; i < 8; ++i) { float sc = 0.f;
#pragma unroll
                for (int h = 0; h < 4; ++h) { float dot = 0.f; const LAS f32x4* qp = (const LAS f32x4*)(qs + i * 256 + h * 64);
#pragma unroll
                    for (int c = 0; c < 16; ++c) { const f32x4 qq = qp[c]; dot += kf[4 * c] * qq[0]; dot += kf[4 * c + 1] * qq[1]; dot += kf[4 * c + 2] * qq[2]; dot += kf[4 * c + 3] * qq[3]; }
                    sc += wsm[i * 4 + h] * fmaxf(dot, 0.f); }
                S[i * 4096 + k] = sc; }
        }
        __syncthreads();
        { const int i = F.wave, n = q0 + i + 1; u64 word;
            if (n <= 256) { const int full = n >> 6, rem = n & 63; word = (plane < full) ? ~0ull : (plane == full ? ((1ull << rem) - 1ull) : 0ull); }
            else word = select_row(S + i * 4096, n, plane, hist);
            BM[(t0 + i) * 64 + plane] = word; }
        __syncthreads();
    }
}

#endif
__device__ __forceinline__ float dpp_quad_sum(float x) {
    x += __builtin_bit_cast(float, __builtin_amdgcn_mov_dpp(__builtin_bit_cast(int, x), 0xB1, 0xF, 0xF, true));
    x += __builtin_bit_cast(float, __builtin_amdgcn_mov_dpp(__builtin_bit_cast(int, x), 0x4E, 0xF, 0xF, true));
    return x;
}
__device__ __forceinline__ void idx_phase(Frame& F) {
    PHASE_TID();
    LAS sel_t* S = (LAS sel_t*)(F.lds + IDX_S_OFF);
    LAS unsigned* hist = (LAS unsigned*)(F.lds + IDX_H_OFF) + F.wave * 832;
    const bf16* QI = (const bf16*)(F.ws + WS_QI); const bf16* KI = (const bf16*)(F.ws + WS_KI); const float* WI = (const float*)(F.ws + WS_WI); u64* BM = (u64*)(F.ws + WS_BM);
    const int c16 = plane & 15, kg = plane >> 4, qloc = c16 >> 2, hh = c16 & 3;
    {
        const float* KMP = (const float*)(F.ws + WS_KMP); bf16* KMH = (bf16*)(F.ws + WS_KMH); bf16* KML = (bf16*)(F.ws + WS_KML);
        for (int e = blockIdx.x * (NWAVES * 64) + ptid; e < BATCH * NH * 32 * 64; e += F.G * NWAVES * 64) {
            const int d = e & 63, n = (e >> 6) & 31, h = (e >> 11) & 7, b = e >> 14; unsigned vh = 0, vl = 0;
            if (n < 16) { const float* p = KMP + ((((size_t)b * 16 + n) * 8 + h) * 2) * 64 + d; const float v = (p[0] + p[64]) * (1.0f / 256.0f);
                vh = f2bf(v); vl = f2bf(v - __uint_as_float(vh << 16)); }
            KMH[e] = (bf16)vh; KML[e] = (bf16)vl; }
    }
    for (int un = blockIdx.x; un < TOK / 16; un += F.G) {
        const int b = un & 7, m_ = un >> 3, q0 = (m_ < 128 ? m_ : 383 - m_) * 16; const size_t t0 = (size_t)b * SEQ + q0;
        bf16x8 qf[4][2]; float wv[4];
#pragma unroll
        for (int g = 0; g < 4; ++g) { wv[g] = WI[(t0 + 4 * g + qloc) * 4 + hh];
#pragma unroll
            for (int ks = 0; ks < 2; ++ks) qf[g][ks] = *(const bf16x8*)(QI + (t0 + 4 * g + qloc) * 256 + hh * 64 + 32 * ks + 8 * kg); }
        const int nchunk = (q0 + 16 + 15) >> 4;
        const bf16* kbase = KI + (size_t)b * SEQ * 64 + (size_t)c16 * 64 + 8 * kg;
#define IDX_LOAD(KA, c0_) do { _Pragma("unroll") for (int u = 0; u < 4; ++u) { const int c = (c0_) + u * NWAVES; const bf16* kp = kbase + (size_t)(c < nchunk ? c : F.wave) * 16 * 64; \
            KA[u][0] = *(const bf16x8*)kp; KA[u][1] = *(const bf16x8*)(kp + 32); } } while (0)
#define IDX_COMP(KA, c0_) do { _Pragma("unroll") for (int u = 0; u < 4; ++u) { const int c = (c0_) + u * NWAVES; \
            if (c < nchunk) { _Pragma("unroll") for (int g = 0; g < 4; ++g) { \
                pg8::f32x4 acc = (pg8::f32x4){0.f, 0.f, 0.f, 0.f}; \
                acc = __builtin_amdgcn_mfma_f32_16x16x32_bf16(KA[u][0], qf[g][0], acc, 0, 0, 0); \
                acc = __builtin_amdgcn_mfma_f32_16x16x32_bf16(KA[u][1], qf[g][1], acc, 0, 0, 0); \
                float sc[4]; \
                _Pragma("unroll") for (int i = 0; i < 4; ++i) sc[i] = dpp_quad_sum(wv[g] * fmaxf(acc[i], 0.f)); \
                if (hh == 0) { u32x2v w_; w_.x = pkrtz_f16(sc[0], sc[1]); w_.y = pkrtz_f16(sc[2], sc[3]); \
                    *(LAS u32x2v*)(S + (4 * g + qloc) * 4096 + 16 * c + 4 * kg) = w_; } } } } } while (0)
        { bf16x8 kaA[4][2], kaB[4][2];
          IDX_LOAD(kaA, F.wave);
          for (int c0 = F.wave; c0 < nchunk; c0 += 8 * NWAVES) {
              IDX_LOAD(kaB, c0 + 4 * NWAVES);
              IDX_COMP(kaA, c0);
              IDX_LOAD(kaA, c0 + 8 * NWAVES);
              IDX_COMP(kaB, c0 + 4 * NWAVES);
          } }
#undef IDX_LOAD
#undef IDX_COMP
        __syncthreads();
#pragma unroll 1
        for (int r2 = 0; r2 < 2; ++r2) { const int i = F.wave + 8 * r2, n = q0 + i + 1; u64 word;
            if (n <= 256) { const int full = n >> 6, rem = n & 63; word = (plane < full) ? ~0ull : (plane == full ? ((1ull << rem) - 1ull) : 0ull); }
            else word = select_row(S + i * 4096, n, plane, hist);
            BM[(t0 + i) * 64 + plane] = word; }
        __syncthreads();
    }
}

struct Args { const float* in[11]; float* out; unsigned char* ws; int ph_lo, ph_hi, li, pad; };
__global__ void __launch_bounds__(NWAVES * 64, 2) hyb_fwd(Args args) {
    extern __shared__ __attribute__((aligned(16))) unsigned char lds[];
    Frame F;
    F.lds = (LAS unsigned char*)lds;
    F.MISC = (volatile LAS unsigned*)(F.lds + MISC_OFF);
    F.wave = __builtin_amdgcn_readfirstlane((int)threadIdx.x >> 6);
    F.G = gridDim.x; { const int bx = blockIdx.x; F.vcu = (F.G % 8 == 0) ? (bx % 8) * (F.G / 8) + bx / 8 : bx; }
    F.ws = args.ws; F.ctl = (gu32*)(args.ws + WS_CTL); F.out = args.out;
    for (int u = threadIdx.x; u < (LDS_BYTES - LDSCTL_OFF) / 4; u += NWAVES * 64) ((LAS unsigned*)(F.lds + LDSCTL_OFF))[u] = 0u;
    __syncthreads();
    const bool one_launch = (args.ph_hi - args.ph_lo) > 1;
    XcdBarrier bar; bar.bar = (unsigned*)(F.ctl + CW_BAR); bar.x = 0; bar.st = nullptr;
    if (one_launch) bar = xcd_barrier_post((unsigned*)(F.ctl + CW_BAR), F.MISC + 8);
    const int lo = args.ph_lo, hi = args.ph_hi;
    unsigned char* ws = args.ws;
#ifndef REP_K
#define REP_K -2
#endif
#pragma unroll 1
    for (int ph2 = 2 * lo; ph2 < 2 * hi; ++ph2) {
        const int ph = ph2 >> 1;
        const int l = (ph - 1) / 5, k = (ph == 0) ? -1 : (ph - 1) % 5;
        if ((ph2 & 1) && k != REP_K) continue;
        if (k < 0) {
#ifndef NO_P0
            p0_prologue(F);
#endif
        } else if (k == 0) {
#ifndef NO_P1
            pg8::Gemm g{(const pg8::bf16_t*)(ws + WS_XB), (const pg8::bf16_t*)(ws + WS_WIN) + (size_t)l * NIN * DM, TOK, NIN, DM};
            pg8::StaticOrder S; S.init(TOK, NIN, F.G, (int)blockIdx.x);
            pg8::EpiIn E; E.rss = (const float*)(ws + WS_RSS); E.qna = in_ptr(3) + l * 64; E.kna = in_ptr(4) + l * 64; E.qnb = in_ptr(5) + l * 64; E.knb = in_ptr(6) + l * 64;
            E.QA = (pg8::bf16_t*)(ws + WS_QA); E.KA = (pg8::bf16_t*)(ws + WS_KA); E.VA = (pg8::bf16_t*)(ws + WS_VA); E.SGA = (pg8::bf16_t*)(ws + WS_SGA); E.QB = (pg8::bf16_t*)(ws + WS_QB); E.SGB = (pg8::bf16_t*)(ws + WS_SGB);
            E.KB = (pg8::bf16_t*)(ws + WS_KB); E.VB = (pg8::bf16_t*)(ws + WS_VB); E.KI = (pg8::bf16_t*)(ws + WS_KI); E.QI = (pg8::bf16_t*)(ws + WS_QI); E.SMA = (pg8::bf16_t*)(ws + WS_SMA); E.SMB = (pg8::bf16_t*)(ws + WS_SMB);
            E.WI = (float*)(ws + WS_WI); E.KMP = (float*)(ws + WS_KMP);
            pg8::gemm_phase<pg8::EpiIn, pg8::StaticOrder, true, true>(F.lds, g, S, E);
#endif
        } else if (k == 1) {
#ifndef NO_IDX
#ifdef NAIVE_IDX
            idx_phase_naive(F);
#else
            idx_phase(F);
#endif
#endif
        } else if (k == 2) {
#ifndef NO_ATT
#ifdef NAIVE_ATT
            naive_attn<0>(F, l); __syncthreads(); naive_attn<1>(F, l);
#else
#ifdef CLOCK_PROBE
            if (blockIdx.x == 0 && threadIdx.x == 0 && l == 0) { F.MISC[16] = (unsigned)__builtin_amdgcn_s_memtime(); F.MISC[17] = (unsigned)__builtin_amdgcn_s_memrealtime(); }
#endif
            attn_phase_fast(F, l);
#ifdef CLOCK_PROBE
            if (blockIdx.x == 0 && threadIdx.x == 0 && l == 0) { const unsigned dt = (unsigned)__builtin_amdgcn_s_memtime() - F.MISC[16], dr = (unsigned)__builtin_amdgcn_s_memrealtime() - F.MISC[17]; F.MISC[18] = (unsigned)((unsigned long long)dt * 100ull / (dr ? dr : 1u)); }
#endif
#endif
#endif
        } else if (k == 3) {
#ifndef NO_P4
            pg8::Gemm g{(const pg8::bf16_t*)(ws + WS_XB), (const pg8::bf16_t*)(ws + WS_WBR) + (size_t)l * 2048 * AW, 2 * TOK, 2048, AW};
            pg8::PairOrder S; S.init(F.G, (int)blockIdx.x);
            pg8::EpiMerge E{(pg8::bf16_t*)(ws + WS_SMA), (pg8::bf16_t*)(ws + WS_SMB)};
            pg8::gemm_phase<pg8::EpiMerge, pg8::PairOrder, true, true>(F.lds, g, S, E);
#endif
        } else {
#ifndef NO_P5
            pg8::Gemm g{(const pg8::bf16_t*)(ws + WS_SMB), (const pg8::bf16_t*)(ws + WS_WOUT) + (size_t)l * DM * DM, TOK, DM, DM};
            pg8::StaticOrder S; S.init(TOK, DM, F.G, (int)blockIdx.x);
            if (l == 0) { pg8::EpiOut<true> E{in_ptr(0), F.out, (pg8::bf16_t*)(ws + WS_XB), (float*)(ws + WS_RSS)};
                pg8::gemm_phase<pg8::EpiOut<true>, pg8::StaticOrder, true, true>(F.lds, g, S, E); }
            else { pg8::EpiOut<false> E{F.out, F.out, nullptr, nullptr};
                pg8::gemm_phase<pg8::EpiOut<false>, pg8::StaticOrder, true, true>(F.lds, g, S, E); }
#endif
        }
        if (!((ph == hi - 1) && ((ph2 & 1) || k != REP_K))) xcd_barrier(bar);
    }
#ifdef CLOCK_PROBE
    if (blockIdx.x == 0 && threadIdx.x == 0) {
        const unsigned long long t0 = __builtin_amdgcn_s_memrealtime(); const unsigned long long want = (unsigned long long)F.MISC[18] * 100ull;
        while (__builtin_amdgcn_s_memrealtime() - t0 < want) __builtin_amdgcn_s_sleep(16);
    }
#endif
}

#ifndef N_LAUNCHES
#define N_LAUNCHES 1
#endif
extern "C" void kernel_launch(void* const* d_in, const int* in_sizes, int n_in, void* d_out, int out_size, void* d_ws, size_t ws_size, hipStream_t stream) {
    static int grid = 0;
    if (grid == 0) {
        if (n_in != 11 || in_sizes[0] != TOK * DM || out_size != TOK * DM || ws_size < WS_END) { fprintf(stderr, "kernel_launch: unexpected shapes (n_in %d in0 %d out %d ws %zu)\n", n_in, n_in > 0 ? in_sizes[0] : -1, out_size, ws_size); grid = -1; return; }
        int dev = 0, cus = 0;
        if (hipGetDevice(&dev) != hipSuccess || hipDeviceGetAttribute(&cus, hipDeviceAttributeMultiprocessorCount, dev) != hipSuccess) { grid = -1; return; }
        if (hipFuncSetAttribute((const void*)hyb_fwd, hipFuncAttributeMaxDynamicSharedMemorySize, LDS_BYTES) != hipSuccess) { fprintf(stderr, "kernel_launch: hipFuncSetAttribute failed\n"); grid = -1; return; }
        int per_cu = 0;
        if (hipOccupancyMaxActiveBlocksPerMultiprocessor(&per_cu, (const void*)hyb_fwd, NWAVES * 64, LDS_BYTES) != hipSuccess || per_cu < 1) fprintf(stderr, "kernel_launch: occupancy query says %d\n", per_cu);
        (void)hipGetLastError();
        grid = cus;
    }
    if (grid < 0) return;
    if (hipMemsetAsync((char*)d_ws + WS_CTL, 0, CTL_ZERO_BYTES, stream) != hipSuccess) return;
    Args a{};
    for (int i = 0; i < 11; ++i) a.in[i] = (const float*)d_in[i];
    a.out = (float*)d_out; a.ws = (unsigned char*)d_ws;
    if (N_LAUNCHES == 1) { a.ph_lo = 0; a.ph_hi = NPHASE; a.li = 0; hipLaunchKernelGGL(hyb_fwd, dim3(grid), dim3(NWAVES * 64), LDS_BYTES, stream, a); }
    else for (int li = 0; li < NPHASE; ++li) { a.ph_lo = li; a.ph_hi = li + 1; a.li = li; hipLaunchKernelGGL(hyb_fwd, dim3(grid), dim3(NWAVES * 64), LDS_BYTES, stream, a); }
}
```

```cpp
#include <hip/hip_runtime.h>
#include <cstdio>
#include <cstdint>
#include <cmath>
namespace pg8 {
#define PG8_LAS __attribute__((address_space(3)))
typedef unsigned short bf16_t;
typedef short bf16x8 __attribute__((ext_vector_type(8)));
typedef float f32x4 __attribute__((ext_vector_type(4)));
typedef unsigned u32x4 __attribute__((ext_vector_type(4)));
constexpr int BM = 256, BK = 64, HALF = 128, HTB = HALF * BK * 2  , STAGE_BYTES = 8 * HTB, NXCD = 8, WGM = 8;

__host__ __device__ __forceinline__ int lds_byte(int r, int c) { const int st = (r >> 4) * 2 + (c >> 5), rr = r & 15, cc = c & 31, ob = rr * 64 + cc * 2; return st * 1024 + (ob ^ (((ob >> 9) & 1) << 5)); }
__host__ __device__ __forceinline__ void stage_rc(int b, int& R, int& C) { const int st = b / 1024, sb = b % 1024, swz = sb ^ (((sb >> 9) & 1) << 5); R = (st >> 1) * 16 + swz / 64; C = (st & 1) * 32 + (swz % 64) / 2; }
__host__ __device__ __forceinline__ int perm32(int rho) { const int n = rho >> 4, i = rho & 15; return 8 * (i >> 2) + 4 * n + (i & 3); }

struct Unit { int pm, pn; };
struct Gemm { const bf16_t* A; const bf16_t* Bt; int M, N, K; };

struct StaticOrder {
    int nM, nN, nwg, G, c;
    __host__ __device__ void init(int M, int N, int G_, int c_) { nM = M / BM; nN = N / BM; nwg = nM * nN; G = G_; c = c_; }
    __host__ __device__ bool next(int i, Unit& u) const {
        const long L = (long)i * G + c; if (L >= nwg) return false;
        int wgid = (int)L; { const int q = nwg / NXCD, r = nwg % NXCD, xcd = wgid % NXCD, off = wgid / NXCD; wgid = (xcd < r ? xcd * (q + 1) : r * (q + 1) + (xcd - r) * q) + off; }
        const int nig = WGM * nN, gid = wgid / nig, fm = gid * WGM, gsz = (nM - fm) < WGM ? (nM - fm) : WGM;
        u.pm = fm + ((wgid % nig) % gsz); u.pn = (wgid % nig) / gsz; return true;
    }
    __device__ __forceinline__ void a_ready(const Unit&) const {}
    __device__ __forceinline__ void done(const Unit&) const {}
};

__device__ __forceinline__ unsigned cvt_pk_bf16(float lo, float hi) { unsigned r; asm volatile("v_cvt_pk_bf16_f32 %0, %1, %2" : "=v"(r) : "v"(lo), "v"(hi)); return r; }
template <class Epi, class Sched, bool ALIGN_EPI = false, bool SP2 = false>
__device__ __forceinline__ void gemm_phase(PG8_LAS unsigned char* lds, const Gemm g, const Sched& S, const Epi& E) {
    int tid_ = threadIdx.x; asm volatile("" : "+v"(tid_));
    const int tid = tid_, wid = __builtin_amdgcn_readfirstlane(tid >> 6), lane = tid & 63, wr = wid >> 2, wc = wid & 3, fr = lane & 15, fq = lane >> 4;
    const int K = g.K, nt = K / BK;
    unsigned voffA[2], voffB[2];
#pragma unroll
    for (int i = 0; i < 2; ++i) { int R, C; stage_rc(tid * 16 + i * 8192, R, C); const int Rb = Epi::PERM ? ((R & ~31) + perm32(R & 31)) : R;
        voffA[i] = (unsigned)(R * K + C) * 2u; voffB[i] = (unsigned)(Rb * K + C) * 2u; }
    const size_t kstep = (size_t)(BK * 2);
    const size_t hstep = (size_t)HALF * K * 2;
    const size_t tstep = 2 * hstep;
    const unsigned ldsw = (unsigned)wid * 1024u;
    const int aoff = lds_byte(wr * 64 + fr, fq * 8), boff = lds_byte(wc * 32 + fr, fq * 8);
#define PG8_SA(b, h) (((b) * 2 + (h)) * HTB)
#define PG8_SB(b, h) ((4 + (b) * 2 + (h)) * HTB)
#define PG8_STAGE(bufoff, gbase, voff) do { _Pragma("unroll") for (int _i = 0; _i < 2; ++_i) \
        __builtin_amdgcn_global_load_lds((const unsigned*)((const char*)(gbase) + (voff)[_i]), (PG8_LAS unsigned*)(lds + (bufoff) + ldsw + _i * 8192), 16, 0, 0); } while (0)
#define PG8_LDA(dst, b, h) do { _Pragma("unroll") for (int m = 0; m < 4; ++m) _Pragma("unroll") for (int k = 0; k < 2; ++k) dst[m][k] = *(const PG8_LAS bf16x8*)(lds + PG8_SA(b, h) + aoff + m * 2048 + k * 1024); } while (0)
#define PG8_LDB(dst, b, h) do { _Pragma("unroll") for (int n = 0; n < 2; ++n) _Pragma("unroll") for (int k = 0; k < 2; ++k) dst[n][k] = *(const PG8_LAS bf16x8*)(lds + PG8_SB(b, h) + boff + n * 2048 + k * 1024); } while (0)
#define PG8_MMA(ai, bj, At, Bt) do { __builtin_amdgcn_s_setprio(1); _Pragma("unroll") for (int m = 0; m < 4; ++m) _Pragma("unroll") for (int n = 0; n < 2; ++n) _Pragma("unroll") for (int k = 0; k < 2; ++k) \
        acc[ai][bj][m][n] = __builtin_amdgcn_mfma_f32_16x16x32_bf16(Bt[n][k], At[m][k], acc[ai][bj][m][n], 0, 0, 0); __builtin_amdgcn_s_setprio(0); } while (0)
#define PG8_WAIT_V(n) asm volatile("s_waitcnt vmcnt(" #n ")" ::: "memory")
#define PG8_WAIT_L(n) asm volatile("s_waitcnt lgkmcnt(" #n ")" ::: "memory")
#define PG8_BAR __builtin_amdgcn_s_barrier()
#define PG8_SCHED __builtin_amdgcn_sched_barrier(0)
    Unit cur, nxt; int ui = 0;
    if (!S.next(0, cur)) return;
    f32x4 acc[2][2][4][2];
#pragma unroll
    for (int a = 0; a < 2; ++a)
#pragma unroll
        for (int b = 0; b < 2; ++b)
#pragma unroll
            for (int m = 0; m < 4; ++m)
#pragma unroll
                for (int n = 0; n < 2; ++n) acc[a][b][m][n] = (f32x4){0.f, 0.f, 0.f, 0.f};
    bf16x8 At[4][2], B0[2][2], B1[2][2];
    const char* cA = (const char*)g.A + (size_t)cur.pm * tstep; const char* cB = (const char*)g.Bt + (size_t)cur.pn * tstep;
    S.a_ready(cur);
    if constexpr (SP2) {
        PG8_STAGE(PG8_SB(0, 0), cB, voffB); PG8_STAGE(PG8_SB(0, 1), cB + hstep, voffB); PG8_STAGE(PG8_SA(0, 0), cA, voffA); PG8_STAGE(PG8_SA(0, 1), cA + hstep, voffA);
        if (wr == 1) PG8_BAR;
        PG8_WAIT_V(2); PG8_BAR;
        PG8_STAGE(PG8_SB(1, 0), cB + kstep, voffB); PG8_STAGE(PG8_SA(1, 0), cA + kstep, voffA); PG8_STAGE(PG8_SB(1, 1), cB + hstep + kstep, voffB);
        PG8_WAIT_V(6); PG8_BAR;
    } else {
        PG8_STAGE(PG8_SB(0, 0), cB, voffB); PG8_STAGE(PG8_SA(0, 0), cA, voffA); PG8_STAGE(PG8_SB(0, 1), cB + hstep, voffB); PG8_STAGE(PG8_SA(0, 1), cA + hstep, voffA);
        if (wr == 1) PG8_BAR;
        PG8_WAIT_V(4); PG8_BAR;
        PG8_STAGE(PG8_SB(1, 0), cB + kstep, voffB); PG8_STAGE(PG8_SA(1, 0), cA + kstep, voffA); PG8_STAGE(PG8_SB(1, 1), cB + hstep + kstep, voffB);
        PG8_WAIT_V(6); PG8_BAR;
    }
    for (;;) {
        const bool has_next = S.next(ui + 1, nxt);
        const char* nA = has_next ? (const char*)g.A + (size_t)nxt.pm * tstep : cA; const char* nB = has_next ? (const char*)g.Bt + (size_t)nxt.pn * tstep : cB;
        for (int t = 0; t < nt; t += 2) {
            const bool last = (t == nt - 2);
            const char* a1 = cA + (size_t)(t + 1) * kstep;
            const char* a2 = last ? nA : cA + (size_t)(t + 2) * kstep; const char* b2 = last ? nB : cB + (size_t)(t + 2) * kstep;
            const char* a3 = a2 + kstep; const char* b3 = b2 + kstep;
            if (last && has_next) S.a_ready(nxt);
            if constexpr (SP2) {
            PG8_LDB(B0, 0, 0); PG8_LDB(B1, 0, 1); PG8_SCHED; PG8_LDA(At, 0, 0); PG8_STAGE(PG8_SA(1, 1), a1 + hstep, voffA);
            PG8_WAIT_V(8); PG8_WAIT_L(0); PG8_BAR; PG8_MMA(0, 0, At, B0); PG8_MMA(0, 1, At, B1); PG8_BAR; PG8_SCHED;
            PG8_LDA(At, 0, 1); PG8_STAGE(PG8_SB(0, 0), b2, voffB); PG8_STAGE(PG8_SB(0, 1), b2 + hstep, voffB); PG8_STAGE(PG8_SA(0, 0), a2, voffA);
            PG8_WAIT_V(8); PG8_WAIT_L(0); PG8_BAR; PG8_MMA(1, 0, At, B0); PG8_MMA(1, 1, At, B1); PG8_BAR; PG8_SCHED;
            PG8_LDB(B0, 1, 0); PG8_LDB(B1, 1, 1); PG8_SCHED; PG8_LDA(At, 1, 0); PG8_STAGE(PG8_SA(0, 1), a2 + hstep, voffA);
            PG8_WAIT_V(8); PG8_WAIT_L(0); PG8_BAR; PG8_MMA(0, 0, At, B0); PG8_MMA(0, 1, At, B1); PG8_BAR; PG8_SCHED;
            PG8_LDA(At, 1, 1); PG8_STAGE(PG8_SB(1, 0), b3, voffB); PG8_STAGE(PG8_SB(1, 1), b3 + hstep, voffB); PG8_STAGE(PG8_SA(1, 0), a3, voffA);
            PG8_WAIT_V(8); PG8_WAIT_L(0); PG8_BAR; PG8_MMA(1, 0, At, B0); PG8_MMA(1, 1, At, B1); PG8_BAR; PG8_SCHED;
            } else {
            PG8_LDB(B0, 0, 0); PG8_SCHED; PG8_LDA(At, 0, 0); PG8_STAGE(PG8_SA(1, 1), a1 + hstep, voffA);
            PG8_WAIT_L(8); PG8_BAR; PG8_WAIT_L(0); PG8_MMA(0, 0, At, B0); PG8_BAR; PG8_SCHED;
            PG8_LDB(B1, 0, 1); PG8_STAGE(PG8_SB(0, 0), b2, voffB);
            PG8_BAR; PG8_WAIT_L(0); PG8_MMA(0, 1, At, B1); PG8_BAR;
            PG8_LDA(At, 0, 1); PG8_STAGE(PG8_SA(0, 0), a2, voffA);
            PG8_BAR; PG8_WAIT_L(0); PG8_MMA(1, 0, At, B0); PG8_BAR; PG8_SCHED;
            PG8_STAGE(PG8_SB(0, 1), b2 + hstep, voffB);
            PG8_WAIT_V(6); PG8_BAR; PG8_MMA(1, 1, At, B1); PG8_BAR;
            PG8_LDB(B0, 1, 0); PG8_SCHED; PG8_LDA(At, 1, 0); PG8_STAGE(PG8_SA(0, 1), a2 + hstep, voffA);
            PG8_WAIT_L(8); PG8_BAR; PG8_WAIT_L(0); PG8_MMA(0, 0, At, B0); PG8_BAR; PG8_SCHED;
            PG8_LDB(B1, 1, 1); PG8_STAGE(PG8_SB(1, 0), b3, voffB);
            PG8_BAR; PG8_WAIT_L(0); PG8_MMA(0, 1, At, B1); PG8_BAR;
            PG8_LDA(At, 1, 1); PG8_STAGE(PG8_SA(1, 0), a3, voffA);
            PG8_BAR; PG8_WAIT_L(0); PG8_MMA(1, 0, At, B0); PG8_BAR; PG8_SCHED;
            PG8_STAGE(PG8_SB(1, 1), b3 + hstep, voffB);
            PG8_WAIT_V(6); PG8_BAR; PG8_MMA(1, 1, At, B1); PG8_BAR;
            }
        }
        if constexpr (ALIGN_EPI) { if (wr == 0) PG8_BAR; }
#ifndef EPI_REP
#define EPI_REP 1
#endif
        if constexpr (!Epi::AFTER_DRAIN) { E(acc, cur, wr, wc, fr, fq); if constexpr (Epi::REPEATABLE && EPI_REP == 2) { asm volatile("" ::: "memory"); E(acc, cur, wr, wc, fr, fq); } S.done(cur); }
        if (!has_next) break;
#pragma unroll
        for (int a = 0; a < 2; ++a)
#pragma unroll
            for (int b = 0; b < 2; ++b)
#pragma unroll
                for (int m = 0; m < 4; ++m)
#pragma unroll
                    for (int n = 0; n < 2; ++n) acc[a][b][m][n] = (f32x4){0.f, 0.f, 0.f, 0.f};
        cur = nxt; cA = nA; cB = nB; ++ui;
        if constexpr (ALIGN_EPI) { if (wr == 1) PG8_BAR; }
    }
    PG8_WAIT_V(0);
    if constexpr (!ALIGN_EPI) { if (wr == 0) PG8_BAR; }
    PG8_BAR;
    if constexpr (Epi::AFTER_DRAIN) { E.fused(acc, cur, wr, wc, fr, fq, lds, wid, lane); S.done(cur); }
#undef PG8_SA
#undef PG8_SB
#undef PG8_STAGE
#undef PG8_LDA
#undef PG8_LDB
#undef PG8_MMA
#undef PG8_WAIT_V
#undef PG8_WAIT_L
#undef PG8_BAR
#undef PG8_SCHED
}
}
#define GAS __attribute__((address_space(1)))
#define LAS __attribute__((address_space(3)))
typedef unsigned short bf16;
typedef unsigned v4u __attribute__((ext_vector_type(4)));
typedef float f32x4 __attribute__((ext_vector_type(4)));
typedef short bf16x8 __attribute__((ext_vector_type(8)));
typedef GAS unsigned gu32;
typedef GAS unsigned long long gu64;
#define RLX_AGENT __ATOMIC_RELAXED, __HIP_MEMORY_SCOPE_AGENT
#define LDS_WAIT() asm volatile("s_waitcnt lgkmcnt(0)" ::: "memory")
#define VM_WAIT() asm volatile("s_waitcnt vmcnt(0)" ::: "memory")
__device__ __forceinline__ unsigned long long rt() { return __builtin_amdgcn_s_memrealtime(); }
__device__ __forceinline__ unsigned f2bf(float f) { unsigned u = __builtin_bit_cast(unsigned, f); return (u + 0x7fffu + ((u >> 16) & 1u)) >> 16; }
__device__ __forceinline__ unsigned pk2(float lo, float hi) { return f2bf(lo) | (f2bf(hi) << 16); }
#define XB_TMO      128
#define XB_XCNT(j)  (256  + 64 * (j))
#define XB_XSUB(j)  (1280 + 64 * (j))
#define XB_XGEN(j)  (2304 + 64 * (j))
#define XB_TOP      3328
#define XB_TOPGEN   3392
#define XCD_BAR_WORDS 3456
#define XB_SPIN_CAP (1u << 18)

__device__ __forceinline__ unsigned xb_ld(unsigned* p)              { return __hip_atomic_load(p, __ATOMIC_RELAXED, __HIP_MEMORY_SCOPE_AGENT); }
__device__ __forceinline__ unsigned xb_add(unsigned* p, unsigned v) { return __hip_atomic_fetch_add(p, v, __ATOMIC_RELAXED, __HIP_MEMORY_SCOPE_AGENT); }
__device__ __forceinline__ unsigned xb_xcc_id() { return (unsigned)__builtin_amdgcn_s_getreg((3 << 11) | 20) & 0xFu; }
#define XB_SPIN(cond, bar) do { unsigned _sp = 0; while (cond) { __builtin_amdgcn_s_sleep(1); \
    if ((++_sp & 255u) == 0u) { if (xb_ld(&(bar)[XB_TMO])) break; if (_sp > XB_SPIN_CAP) { atomicAdd(&(bar)[XB_TMO], 1u); break; } } } } while (0)

struct XcdBarrier {
    unsigned* bar; unsigned x;
    volatile LAS unsigned* st;
};

__device__ __forceinline__ XcdBarrier xcd_barrier_post(unsigned* bar, volatile LAS unsigned* st) {
    XcdBarrier b; b.bar = bar; b.x = xb_xcc_id(); b.st = st;
    if (threadIdx.x == 0) (void)xb_add(&bar[XB_XCNT(b.x)], 1u);
    return b;
}
__device__ __forceinline__ void xcd_barrier_complete(unsigned* bar, unsigned x, unsigned& nloc, unsigned& nx) {
    const unsigned G = gridDim.x * gridDim.y * gridDim.z;
    unsigned sum, cnt, mine, sp = 0u;
    for (;;) {
        sum = 0u; cnt = 0u; mine = 0u;
#pragma unroll
        for (unsigned j = 0; j < 16; ++j) { const unsigned c = xb_ld(&bar[XB_XCNT(j)]); sum += c; cnt += (c > 0u) ? 1u : 0u; mine = (j == x) ? c : mine; }
        if (sum == G) break;
        __builtin_amdgcn_s_sleep(1);
        if ((++sp & 255u) == 0u) { if (xb_ld(&bar[XB_TMO])) break; if (sp > XB_SPIN_CAP) { atomicAdd(&bar[XB_TMO], 1u); break; } }
    }
    nloc = mine > 0u ? mine : 1u; nx = cnt > 0u ? cnt : 1u;
}

__device__ __forceinline__ void xcd_barrier(const XcdBarrier& b) {
    asm volatile("s_waitcnt vmcnt(0)" ::: "memory");
    __syncthreads();
    if (threadIdx.x == 0) {
        unsigned* bar = b.bar; asm volatile("" : "+s"(bar));
        __builtin_amdgcn_s_waitcnt(0);
        unsigned nloc = b.st[0], nx = b.st[1];
        if (nloc == 0u) { xcd_barrier_complete(bar, b.x, nloc, nx); b.st[0] = nloc; b.st[1] = nx; }
        const unsigned old = xb_add(&bar[XB_XSUB(b.x)], 1u);
        const unsigned gen = old / nloc;
        if (old + 1u == (gen + 1u) * nloc) {
            __builtin_amdgcn_fence(__ATOMIC_RELEASE, "agent");
            asm volatile("s_waitcnt vmcnt(0)" ::: "memory");
            const unsigned og = xb_add(&bar[XB_TOP], 1u);
            const unsigned tg = og / nx;
            if (og + 1u == (tg + 1u) * nx) xb_add(&bar[XB_TOPGEN], 1u);
            else XB_SPIN(xb_ld(&bar[XB_TOPGEN]) == tg, bar);
            __builtin_amdgcn_fence(__ATOMIC_ACQUIRE, "agent");
            xb_add(&bar[XB_XGEN(b.x)], 1u);
            asm volatile("s_waitcnt vmcnt(0)" ::: "memory");
        } else {
            XB_SPIN(xb_ld(&bar[XB_XGEN(b.x)]) == gen, bar);
            __builtin_amdgcn_fence(__ATOMIC_ACQUIRE, "agent");
            asm volatile("s_waitcnt vmcnt(0)" ::: "memory");
        }
    }
    __syncthreads();
}

constexpr int BATCH = 8, SEQ = 4096, DM = 1024, TOK = BATCH * SEQ, DEPTH = 2;
constexpr int DIN = 5572, NIN = 5632;
constexpr int NH = 8, HD = 64, AW = 512;
constexpr float EPS = 1e-6f;
constexpr float LOG2E = 1.4426950408889634f;
constexpr float C2 = 0.125f * LOG2E;
constexpr int NWAVES = 8;
constexpr int NPHASE = 1 + 5 * DEPTH;

constexpr size_t MiB = 1u << 20;
constexpr size_t WS_CTL = 0, CTL_ZERO_BYTES = 1 * MiB;
constexpr size_t WS_WIN = 1 * MiB;
constexpr size_t WS_WBR = 23 * MiB;
constexpr size_t WS_WOUT = 27 * MiB;
constexpr size_t WS_RSS = 31 * MiB;
constexpr size_t WS_KMP = 33 * MiB;
constexpr size_t WS_WI = 34 * MiB;
constexpr size_t WS_KB = 35 * MiB, WS_VB = 39 * MiB, WS_KI = 43 * MiB;
constexpr size_t WS_QI = 47 * MiB;
constexpr size_t WS_BM = 63 * MiB;
constexpr size_t WS_KMH = 79 * MiB, WS_KML = 79 * MiB + 262144;
constexpr size_t WS_XB = 80 * MiB;
constexpr size_t WS_QA = 144 * MiB, WS_KA = 176 * MiB, WS_VA = 208 * MiB, WS_SGA = 240 * MiB, WS_QB = 272 * MiB, WS_SGB = 304 * MiB;
constexpr size_t WS_TMP = 144 * MiB;
constexpr size_t WS_SMA = 336 * MiB, WS_SMB = 400 * MiB;
constexpr size_t WS_END = 464 * MiB;
constexpr int CW_BAR = 4096;

constexpr int RING_BYTES = 131072;
constexpr int LDSCTL_OFF = RING_BYTES + 28672, MISC_OFF = LDSCTL_OFF + 320;
constexpr int LDS_BYTES = 163840;
static_assert(MISC_OFF + 128 <= LDS_BYTES, "LDS map");

typedef unsigned long long u64;
typedef unsigned u32x4v __attribute__((ext_vector_type(4)));

__device__ __forceinline__ float bf2f(unsigned short v) { return __uint_as_float(((unsigned)v) << 16); }
__device__ __forceinline__ float bflo(unsigned w) { return __uint_as_float(w << 16); }
__device__ __forceinline__ float bfhi(unsigned w) { return __uint_as_float(w & 0xffff0000u); }
__device__ __forceinline__ float sigmoidf_(float v) { return __builtin_amdgcn_rcpf(1.0f + __builtin_amdgcn_exp2f(-v * LOG2E)); }

typedef __attribute__((address_space(4))) const char* kaptr_t;
__device__ __forceinline__ const float* in_ptr(int i) { kaptr_t ka = (kaptr_t)__builtin_amdgcn_kernarg_segment_ptr(); asm volatile("" : "+s"(ka)); return *(const float* const __attribute__((address_space(4)))*)(ka + 8 * i); }
#define PHASE_TID() int tid_o = threadIdx.x; asm volatile("" : "+v"(tid_o)); const int ptid = tid_o, plane = tid_o & 63
struct Frame {
    LAS unsigned char* lds;
    volatile LAS unsigned* MISC;
    gu32* ctl;
    int wave, vcu, G;
    unsigned char* ws;
    float* out;
};

__host__ __device__ __forceinline__ int win_src(int n0, int& nvalid) {
    const int pn = n0 >> 8, c = n0 & 255, bj = c >> 7, wc = (c >> 5) & 3; nvalid = 32;
    if (pn < 2) return 0 + 64 * (4 * pn + wc) + 32 * bj;
    if (pn < 4) return 512 + 64 * (4 * (pn - 2) + wc) + 32 * bj;
    if (pn < 6) return 1024 + 256 * (pn - 4) + c;
    if (pn < 8) return 1536 + 256 * (pn - 6) + c;
    if (pn < 10) return 2048 + 64 * (4 * (pn - 8) + wc) + 32 * bj;
    if (pn == 10) {
        if (wc == 0) return 2560 + 32 * bj;
        if (wc == 1) return 2624 + 32 * bj;
        if (wc == 2) return 3456 + 32 * bj;
        if (bj == 0) { nvalid = 4; return 3520; }
        nvalid = 0; return 0;
    }
    if (pn == 11) return 3200 + c;
    if (pn < 14) return 2688 + 256 * (pn - 12) + c;
    if (pn < 18) return 3524 + 256 * (pn - 14) + c;
    return 4548 + 256 * (pn - 18) + c;
}

__device__ __forceinline__ float wave_sum(float v) {
#pragma unroll
    for (int o = 1; o < 64; o <<= 1) v += __shfl_xor(v, o);
    return v;
}
__device__ __forceinline__ void tr_item(const float* W, int ldw, int src0, int nvalid, const float* gk, bf16* WT, int K, int row0, int k0, LAS float* scr, int lane) {
    const int j4 = 4 * (lane & 7);
#pragma unroll
    for (int i = 0; i < 8; ++i) { const int kk = 8 * i + (lane >> 3);
        f32x4 v = (f32x4){0.f, 0.f, 0.f, 0.f};
        if (j4 < nvalid) { v = *(const f32x4*)(W + (size_t)(k0 + kk) * ldw + src0 + j4); if (gk) v = v * gk[k0 + kk]; }
        scr[kk * 33 + j4] = v[0]; scr[kk * 33 + j4 + 1] = v[1]; scr[kk * 33 + j4 + 2] = v[2]; scr[kk * 33 + j4 + 3] = v[3]; }
    LDS_WAIT(); asm volatile("" ::: "memory");
    const int c = lane & 7;
#pragma unroll
    for (int jj = 0; jj < 4; ++jj) { const int n = (lane >> 3) + 8 * jj; const LAS float* s = scr + (8 * c) * 33 + n;
        v4u o; o.x = pk2(s[0 * 33], s[1 * 33]); o.y = pk2(s[2 * 33], s[3 * 33]); o.z = pk2(s[4 * 33], s[5 * 33]); o.w = pk2(s[6 * 33], s[7 * 33]);
        *(GAS v4u*)(WT + (size_t)(row0 + n) * K + k0 + 8 * c) = o; }
    LDS_WAIT(); asm volatile("" ::: "memory");
}
__device__ __forceinline__ void p0_prologue(Frame& F) {
    PHASE_TID();
    LAS float* scr = (LAS float*)(F.lds + F.wave * 16384);
    const int gw = F.vcu * NWAVES + F.wave, NGW = F.G * NWAVES;
    constexpr int I_IN = (DM / 64) * (NIN / 32), I_BR = (AW / 64) * (DM / 32), I_OUT = (DM / 64) * (DM / 32);
    constexpr int PER_L = I_IN + 2 * I_BR + I_OUT;
    for (int it = gw; it < DEPTH * PER_L; it += NGW) {
        const int l = it / PER_L; int r = it % PER_L;
        if (r < I_IN) { const int kb = r / (NIN / 32), nb = r % (NIN / 32); int nvalid; const int src0 = win_src(32 * nb, nvalid);
            tr_item(in_ptr(2) + (size_t)l * DM * DIN, DIN, src0, nvalid, in_ptr(1) + l * DM, (bf16*)(F.ws + WS_WIN) + (size_t)l * NIN * DM, DM, 32 * nb, 64 * kb, scr, plane); continue; }
        r -= I_IN;
        if (r < 2 * I_BR) { const int which = r / I_BR; r %= I_BR; const int kb = r / (DM / 32), nb = r % (DM / 32);
            tr_item((which ? in_ptr(8) : in_ptr(7)) + (size_t)l * AW * DM, DM, 32 * nb, 32, nullptr, (bf16*)(F.ws + WS_WBR) + (size_t)l * 2048 * AW, AW, which * 1024 + 32 * nb, 64 * kb, scr, plane); continue; }
        r -= 2 * I_BR;
        { const int kb = r / (DM / 32), nb = r % (DM / 32);
            tr_item(in_ptr(9) + (size_t)l * DM * DM, DM, 32 * nb, 32, nullptr, (bf16*)(F.ws + WS_WOUT) + (size_t)l * DM * DM, DM, 32 * nb, 64 * kb, scr, plane); }
    }
    const float* x = in_ptr(0); bf16* XB = (bf16*)(F.ws + WS_XB); float* RSS = (float*)(F.ws + WS_RSS);
    for (int m = gw; m < TOK; m += NGW) {
        const GAS f32x4* xr = (const GAS f32x4*)(x + (size_t)m * DM) + plane;
        f32x4 v[4]; float s = 0.f;
#pragma unroll
        for (int j = 0; j < 4; ++j) { v[j] = xr[64 * j]; s += (v[j].x * v[j].x + v[j].y * v[j].y) + (v[j].z * v[j].z + v[j].w * v[j].w); }
        s = wave_sum(s);
        GAS u64* o8 = (GAS u64*)(XB + (size_t)m * DM) + plane;
#pragma unroll
        for (int j = 0; j < 4; ++j) o8[64 * j] = (u64)pk2(v[j].x, v[j].y) | ((u64)pk2(v[j].z, v[j].w) << 32);
        if (plane < 16) RSS[(size_t)m * 16 + plane] = (plane == 0) ? s : 0.f;
    }
}

namespace pg8 {
__device__ __forceinline__ float row_rs(const float* rss, int row, int fq) {
    const f32x4 a = *(const f32x4*)(rss + (size_t)row * 16 + 4 * fq);
    float s = (a[0] + a[1]) + (a[2] + a[3]);
    s += __shfl_xor(s, 16); s += __shfl_xor(s, 32);
    return __builtin_amdgcn_rsqf(s * (1.0f / DM) + EPS);
}
__device__ __forceinline__ u32x4 pack8(const f32x4 o0, const f32x4 o1) { u32x4 w; w.x = cvt_pk_bf16(o0[0], o0[1]); w.y = cvt_pk_bf16(o0[2], o0[3]); w.z = cvt_pk_bf16(o1[0], o1[1]); w.w = cvt_pk_bf16(o1[2], o1[3]); return w; }
struct EpiIn {
    static constexpr bool PERM = true, AFTER_DRAIN = false, REPEATABLE = true;
    const float* rss; const float *qna, *kna, *qnb, *knb;
    bf16_t *QA, *KA, *VA, *SGA, *QB, *SGB, *KB, *VB, *KI, *QI, *SMA, *SMB; float* WI; float* KMP;
    __device__ __forceinline__ void norm_rows(const f32x4 (&acc)[2][2][4][2], const Unit& u, int wr, int fr, int fq, const float* g, float oscale, bf16_t* dst, int ld, int coloff, float* kmp) const {
        f32x4 gv[2][2];
#pragma unroll
        for (int bj = 0; bj < 2; ++bj)
#pragma unroll
            for (int n = 0; n < 2; ++n) gv[bj][n] = *(const f32x4*)(g + 32 * bj + 8 * fq + 4 * n) * oscale;
        f32x4 cs[2][2];
#pragma unroll
        for (int bj = 0; bj < 2; ++bj)
#pragma unroll
            for (int n = 0; n < 2; ++n) cs[bj][n] = (f32x4){0.f, 0.f, 0.f, 0.f};
#pragma unroll
        for (int ai = 0; ai < 2; ++ai)
#pragma unroll
            for (int m = 0; m < 4; ++m) {
                const int row = u.pm * BM + ai * HALF + wr * 64 + m * 16 + fr; const float rs = row_rs(rss, row, fq);
                float sq = 0.f;
#pragma unroll
                for (int bj = 0; bj < 2; ++bj)
#pragma unroll
                    for (int n = 0; n < 2; ++n) { const f32x4 t = acc[ai][bj][m][n]; sq += (t[0] * t[0] + t[1] * t[1]) + (t[2] * t[2] + t[3] * t[3]); }
                sq += __shfl_xor(sq, 16); sq += __shfl_xor(sq, 32);
                const float sc = rs * __builtin_amdgcn_rsqf(sq * rs * rs * (1.0f / 64.0f) + EPS);
#pragma unroll
                for (int bj = 0; bj < 2; ++bj) {
                    const f32x4 o0 = acc[ai][bj][m][0] * sc * gv[bj][0], o1 = acc[ai][bj][m][1] * sc * gv[bj][1];
                    cs[bj][0] += o0; cs[bj][1] += o1;
                    *(u32x4*)(dst + (size_t)row * ld + coloff + 32 * bj + 8 * fq) = pack8(o0, o1); }
                asm volatile("" ::: "memory");
            }
        if (kmp) {
#pragma unroll
            for (int bj = 0; bj < 2; ++bj)
#pragma unroll
                for (int n = 0; n < 2; ++n) { f32x4 t = cs[bj][n];
#pragma unroll
                    for (int o = 1; o < 16; o <<= 1) { t[0] += __shfl_xor(t[0], o); t[1] += __shfl_xor(t[1], o); t[2] += __shfl_xor(t[2], o); t[3] += __shfl_xor(t[3], o); }
                    if (fr == 0) *(f32x4*)(kmp + 32 * bj + 8 * fq + 4 * n) = t; }
        }
    }
    __device__ __forceinline__ void plain_rows(const f32x4 (&acc)[2][2][4][2], const Unit& u, int wr, int fr, int fq, bf16_t* dst, int ld, int col0, int bjs, float ca, float cb, float cc, float* wi) const {
        const float pa = ca + cc, pb = cb, pc = cb + cc, pd = ca;
        float rsv[2][4];
#pragma unroll
        for (int ai = 0; ai < 2; ++ai)
#pragma unroll
            for (int m = 0; m < 4; ++m) rsv[ai][m] = row_rs(rss, u.pm * BM + ai * HALF + wr * 64 + m * 16 + fr, fq);
#pragma unroll
        for (int ai = 0; ai < 2; ++ai)
#pragma unroll
            for (int m = 0; m < 4; ++m) {
                const int row = u.pm * BM + ai * HALF + wr * 64 + m * 16 + fr; const float rs = rsv[ai][m], rsn = -LOG2E * rs;
                if (wi) { if (fq == 0) *(f32x4*)(wi + (size_t)row * 4) = acc[ai][0][m][0] * rs; }
                else {
#pragma unroll
                for (int bj = 0; bj < 2; ++bj) { f32x4 o[2];
#pragma unroll
                    for (int n = 0; n < 2; ++n) { const f32x4 a = acc[ai][bj][m][n]; const f32x4 v = a * rs, t = a * rsn; f32x4 e;
#pragma unroll
                        for (int i = 0; i < 4; ++i) e[i] = __builtin_amdgcn_exp2f(t[i]);
                        e = e + 1.0f; f32x4 sg;
#pragma unroll
                        for (int i = 0; i < 4; ++i) sg[i] = __builtin_amdgcn_rcpf(e[i]);
                        o[n] = (v * pa + pb) * (sg * pc + pd); }
                    *(u32x4*)(dst + (size_t)row * ld + col0 + bj * bjs) = pack8(o[0], o[1]); }
                }
                asm volatile("" ::: "memory");
            }
    }
    __device__ __forceinline__ void operator()(const f32x4 (&acc)[2][2][4][2], const Unit& u, int wr, int wc, int fr_, int fq_) const {
        int fr = fr_, fq = fq_; asm volatile("" : "+v"(fr), "+v"(fq));
        const int pn = u.pn; const int cid = wc * 32 + 8 * fq;
        bool isnorm = false; bf16_t* dst; int ld = AW, col0, bjs = HALF; const float* g = qna; float osc = 1.0f; float* kmp = nullptr; float ca = 1.f, cb = 0.f, cc = 0.f; float* wi = nullptr;
        if (pn < 2) { isnorm = true; g = qna; osc = C2; dst = QA; col0 = 64 * (4 * pn + wc); }
        else if (pn < 4) { isnorm = true; g = kna; dst = KA; const int h = 4 * (pn - 2) + wc; col0 = 64 * h; kmp = KMP + ((((size_t)(u.pm >> 4) * 16 + (u.pm & 15)) * 8 + h) * 2 + wr) * 64; }
        else if (pn < 6) { dst = VA; col0 = 256 * (pn - 4) + cid; }
        else if (pn < 8) { dst = SGA; col0 = 256 * (pn - 6) + cid; ca = 0.f; cc = 1.f; }
        else if (pn < 10) { isnorm = true; g = qnb; osc = C2; dst = QB; col0 = 64 * (4 * (pn - 8) + wc); }
        else if (pn == 10) { ld = 64; bjs = 32; col0 = 8 * fq; dst = KI;
            if (wc == 0) { isnorm = true; g = knb; dst = KB; col0 = 0; } else if (wc == 1) { dst = VB; } else if (wc == 3) { wi = WI; } }
        else if (pn == 11) { dst = QI; ld = 256; col0 = cid; }
        else if (pn < 14) { dst = SGB; col0 = 256 * (pn - 12) + cid; ca = 0.f; cc = 1.f; }
        else if (pn < 18) { dst = SMA; ld = DM; col0 = 256 * (pn - 14) + cid; ca = 0.f; cb = 1.f; }
        else { dst = SMB; ld = DM; col0 = 256 * (pn - 18) + cid; ca = 0.f; cb = 1.f; }
        if (isnorm) norm_rows(acc, u, wr, fr, fq, g, osc, dst, ld, col0, kmp);
        else plain_rows(acc, u, wr, fr, fq, dst, ld, col0, bjs, ca, cb, cc, wi);
    }
};
struct EpiMerge {
    static constexpr bool PERM = true, AFTER_DRAIN = false, REPEATABLE = false;
    bf16_t* SMA; bf16_t* SMB;
    __device__ __forceinline__ void operator()(const f32x4 (&acc)[2][2][4][2], const Unit& u, int wr, int wc, int fr, int fq) const {
        const bool partb = u.pm >= 128; const int pm = partb ? u.pm - 128 : u.pm, pn = partb ? u.pn - 4 : u.pn;
#pragma unroll
        for (int ai = 0; ai < 2; ++ai)
#pragma unroll
            for (int m = 0; m < 4; ++m) { const int row = pm * BM + ai * HALF + wr * 64 + m * 16 + fr;
#pragma unroll
                for (int bj = 0; bj < 2; ++bj) { const size_t off = (size_t)row * DM + pn * BM + bj * HALF + wc * 32 + 8 * fq;
                    const u32x4 sg = *(const u32x4*)((partb ? SMB : SMA) + off);
                    const f32x4 s0 = (f32x4){__uint_as_float(sg.x << 16), __uint_as_float(sg.x & 0xffff0000u), __uint_as_float(sg.y << 16), __uint_as_float(sg.y & 0xffff0000u)};
                    const f32x4 s1 = (f32x4){__uint_as_float(sg.z << 16), __uint_as_float(sg.z & 0xffff0000u), __uint_as_float(sg.w << 16), __uint_as_float(sg.w & 0xffff0000u)};
                    f32x4 o0 = acc[ai][bj][m][0] * s0, o1 = acc[ai][bj][m][1] * s1;
                    if (partb) { const u32x4 pa = *(const u32x4*)(SMA + off);
                        o0 += (f32x4){__uint_as_float(pa.x << 16), __uint_as_float(pa.x & 0xffff0000u), __uint_as_float(pa.y << 16), __uint_as_float(pa.y & 0xffff0000u)};
                        o1 += (f32x4){__uint_as_float(pa.z << 16), __uint_as_float(pa.z & 0xffff0000u), __uint_as_float(pa.w << 16), __uint_as_float(pa.w & 0xffff0000u)}; }
                    u32x4 w; w.x = cvt_pk_bf16(o0[0], o0[1]); w.y = cvt_pk_bf16(o0[2], o0[3]); w.z = cvt_pk_bf16(o1[0], o1[1]); w.w = cvt_pk_bf16(o1[2], o1[3]);
                    *(u32x4*)((partb ? SMB : SMA) + off) = w; }
            }
    }
};
struct PairOrder {
    StaticOrder base;
    __device__ void init(int G_, int c_) { base.init(TOK, DM, G_, c_); }
    __device__ bool next(int i, Unit& u) const { Unit t; if (!base.next(i >> 1, t)) return false; u.pm = t.pm + (i & 1) * 128; u.pn = t.pn + (i & 1) * 4; return true; }
    __device__ __forceinline__ void a_ready(const Unit&) const {}
    __device__ __forceinline__ void done(const Unit&) const {}
};
template <bool WRITE_NEXT> struct EpiOut {
    static constexpr bool PERM = true, AFTER_DRAIN = false, REPEATABLE = false;
    const float* xin; float* out; bf16_t* XB; float* rss;
    __device__ __forceinline__ void operator()(const f32x4 (&acc)[2][2][4][2], const Unit& u, int wr, int wc, int fr, int fq) const {
#pragma unroll
        for (int ai = 0; ai < 2; ++ai)
#pragma unroll
            for (int m = 0; m < 4; ++m) { const int row = u.pm * BM + ai * HALF + wr * 64 + m * 16 + fr; float ss = 0.f;
#pragma unroll
                for (int bj = 0; bj < 2; ++bj) { const size_t off = (size_t)row * DM + u.pn * BM + bj * HALF + wc * 32 + 8 * fq;
                    const f32x4 o0 = acc[ai][bj][m][0] + *(const f32x4*)(xin + off), o1 = acc[ai][bj][m][1] + *(const f32x4*)(xin + off + 4);
                    *(f32x4*)(out + off) = o0; *(f32x4*)(out + off + 4) = o1;
                    if (WRITE_NEXT) { ss += (o0[0] * o0[0] + o0[1] * o0[1]) + (o0[2] * o0[2] + o0[3] * o0[3]) + (o1[0] * o1[0] + o1[1] * o1[1]) + (o1[2] * o1[2] + o1[3] * o1[3]);
                        u32x4 w; w.x = cvt_pk_bf16(o0[0], o0[1]); w.y = cvt_pk_bf16(o0[2], o0[3]); w.z = cvt_pk_bf16(o1[0], o1[1]); w.w = cvt_pk_bf16(o1[2], o1[3]);
                        *(u32x4*)(XB + off) = w; } }
                if (WRITE_NEXT) { ss += __shfl_xor(ss, 16); ss += __shfl_xor(ss, 32); if (fq == 0) rss[(size_t)row * 16 + 4 * u.pn + wc] = ss; }
            }
    }
};
}

__device__ __forceinline__ int rel_bucket_dev(int n) {
    if (n < 16) return n;
    int large = 16 + (int)(logf((float)n / 16.0f) / logf(8.0f) * 16.0f);
    return large < 31 ? large : 31;
}
__device__ __forceinline__ void build_bias_table(Frame& F, LAS float* tb, const float* gq, const float* gk, int hoff) {
    PHASE_TID(); const float* rb = in_ptr(10);
    float gm = 0.f;
    for (int d = 0; d < 64; ++d) gm = fmaxf(gm, fabsf(gq[d] * gk[d]));
    for (int e = ptid; e < 8 * 128; e += NWAVES * 64) { const int h = e >> 7, d = e & 127;
        float bm = -1e30f; for (int k = 0; k < 32; ++k) bm = fmaxf(bm, rb[k * 16 + hoff + h]);
        const float M0 = 64.0f * C2 * gm + bm * LOG2E;
        tb[e] = rb[rel_bucket_dev(d) * 16 + hoff + h] * LOG2E - M0; }
}

template <int MODE>
__device__ __forceinline__ void naive_attn(Frame& F, int layer) {
    PHASE_TID();
    LAS float* tb = (LAS float*)F.lds;
    const float* gq = in_ptr(MODE == 0 ? 3 : 5) + layer * 64; const float* gk = in_ptr(MODE == 0 ? 4 : 6) + layer * 64;
    build_bias_table(F, tb, gq, gk, MODE * 8);
    __syncthreads();
    const bf16* Q = (const bf16*)(F.ws + (MODE == 0 ? WS_QA : WS_QB));
    const bf16* K = (const bf16*)(F.ws + (MODE == 0 ? WS_KA : WS_KB));
    const bf16* V = (const bf16*)(F.ws + (MODE == 0 ? WS_VA : WS_VB));
    const bf16* SG = (const bf16*)(F.ws + (MODE == 0 ? WS_SGA : WS_SGB));
    bf16* Y = (bf16*)(F.ws + WS_XB) + (size_t)MODE * TOK * AW;
    const float* KMP = (const float*)(F.ws + WS_KMP);
    const u64* BM = (const u64*)(F.ws + WS_BM);
    constexpr int KLD = (MODE == 0) ? AW : 64;
    for (int item = blockIdx.x * (NWAVES * 64) + ptid; item < BATCH * NH * SEQ; item += F.G * NWAVES * 64) {
        const int q = item & (SEQ - 1), h = (item >> 12) & 7, b = item >> 15; const int qblk = q >> 8;
        const size_t tq = (size_t)b * SEQ + q;
        float qv[64];
        { const v4u* qp = (const v4u*)(Q + tq * AW + h * 64);
#pragma unroll
            for (int c = 0; c < 8; ++c) { const v4u w = qp[c]; qv[8 * c + 0] = bflo(w.x); qv[8 * c + 1] = bfhi(w.x); qv[8 * c + 2] = bflo(w.y); qv[8 * c + 3] = bfhi(w.y); qv[8 * c + 4] = bflo(w.z); qv[8 * c + 5] = bfhi(w.z); qv[8 * c + 6] = bflo(w.w); qv[8 * c + 7] = bfhi(w.w); } }
        unsigned selmask = 0;
        if (MODE == 0) {
            float gate[16];
#pragma unroll
            for (int n = 0; n < 16; ++n) { gate[n] = -INFINITY;
                if (n < qblk) { const float* k0 = KMP + ((((size_t)b * 16 + n) * 8 + h) * 2) * 64; float s = 0.f;
#pragma unroll
                    for (int d = 0; d < 64; ++d) s += qv[d] * ((k0[d] + k0[64 + d]) * (1.0f / 256.0f));
                    gate[n] = s; } }
            const int nsel = qblk < 3 ? qblk : 3;
            for (int r = 0; r < nsel; ++r) { float best = -INFINITY; int bi = -1;
#pragma unroll
                for (int n = 0; n < 16; ++n) { const bool ok = (n < qblk) && !((selmask >> n) & 1u) && (bi < 0 || gate[n] > best); if (ok) { best = gate[n]; bi = n; } }
                selmask |= 1u << bi; }
        }
        float acc[64];
#pragma unroll
        for (int d = 0; d < 64; ++d) acc[d] = 0.f;
        float l = 0.f;
        const int kend = (item | 63) & (SEQ - 1);
        const LAS float* tbh = tb + h * 128;
        u64 mw = 0;
        for (int k = 0; k <= kend; ++k) {
            bool allowed;
            if (MODE == 0) { const int n = k >> 8; allowed = (n == qblk) ? (k <= q) : (((selmask >> n) & 1u) != 0u && n < qblk); }
            else { if ((k & 63) == 0) mw = (k <= q) ? BM[tq * 64 + (k >> 6)] : 0ull; allowed = ((mw >> (k & 63)) & 1ull) != 0ull; }
            if (!__any(allowed)) continue;
            const size_t tk = (size_t)b * SEQ + k;
            const v4u* kp = (const v4u*)(K + tk * KLD + (MODE == 0 ? h * 64 : 0));
            float s = 0.f;
#pragma unroll
            for (int c = 0; c < 8; ++c) { const v4u w = kp[c];
                s += qv[8 * c + 0] * bflo(w.x); s += qv[8 * c + 1] * bfhi(w.x); s += qv[8 * c + 2] * bflo(w.y); s += qv[8 * c + 3] * bfhi(w.y);
                s += qv[8 * c + 4] * bflo(w.z); s += qv[8 * c + 5] * bfhi(w.z); s += qv[8 * c + 6] * bflo(w.w); s += qv[8 * c + 7] * bfhi(w.w); }
            int dist = q - k; dist = dist < 0 ? 0 : (dist > 127 ? 127 : dist);
            s += tbh[dist];
            const float p = allowed ? __builtin_amdgcn_exp2f(s) : 0.f;
            l += p;
            const v4u* vp = (const v4u*)(V + tk * KLD + (MODE == 0 ? h * 64 : 0));
#pragma unroll
            for (int c = 0; c < 8; ++c) { const v4u w = vp[c];
                acc[8 * c + 0] += p * bflo(w.x); acc[8 * c + 1] += p * bfhi(w.x); acc[8 * c + 2] += p * bflo(w.y); acc[8 * c + 3] += p * bfhi(w.y);
                acc[8 * c + 4] += p * bflo(w.z); acc[8 * c + 5] += p * bfhi(w.z); acc[8 * c + 6] += p * bflo(w.w); acc[8 * c + 7] += p * bfhi(w.w); }
        }
        const float il = 1.0f / l;
        const v4u* gp = (const v4u*)(SG + tq * AW + h * 64); v4u* yp = (v4u*)(Y + tq * AW + h * 64);
#pragma unroll
        for (int c = 0; c < 8; ++c) { const v4u g = gp[c]; v4u o;
            o.x = pk2(acc[8 * c + 0] * il * bflo(g.x), acc[8 * c + 1] * il * bfhi(g.x)); o.y = pk2(acc[8 * c + 2] * il * bflo(g.y), acc[8 * c + 3] * il * bfhi(g.y));
            o.z = pk2(acc[8 * c + 4] * il * bflo(g.z), acc[8 * c + 5] * il * bfhi(g.z)); o.w = pk2(acc[8 * c + 6] * il * bflo(g.w), acc[8 * c + 7] * il * bfhi(g.w));
            yp[c] = o; }
    }
}

typedef float f32x16 __attribute__((ext_vector_type(16)));
typedef short s16x4 __attribute__((ext_vector_type(4)));
typedef short v4i16_t __attribute__((ext_vector_type(4)));
constexpr int AT_D = 4, AT_R = AT_D + 2;
constexpr int AT_RING = 0, AT_STAGE = 16384, AT_OST = 0  , AT_TB = AT_R * AT_STAGE, AT_WS = AT_TB + 8192, AT_BM = AT_WS + 2048;
static_assert(8 * 8192 <= AT_R * AT_STAGE && AT_BM + 16384 <= LDSCTL_OFF, "attention LDS");
__device__ __forceinline__ void glds16(const void* gsrc, unsigned lds_dst) { unsigned keep;
    asm volatile("s_mov_b32 %0, m0\n\ts_mov_b32 m0, %2\n\ts_nop 0\n\tglobal_load_lds_dwordx4 %1, off\n\ts_mov_b32 m0, %0" : "=&s"(keep) : "v"(gsrc), "s"(lds_dst) : "memory"); }
#define AT_WAIT_BAR() asm volatile("s_waitcnt vmcnt(0) lgkmcnt(0)\n\ts_barrier" ::: "memory")
#define AT_WAIT_BAR_N(N) asm volatile("s_waitcnt vmcnt(%0) lgkmcnt(0)\n\ts_barrier" :: "n"(N) : "memory")
__device__ __forceinline__ int crow(int r, int hi) { return (r & 3) + 8 * (r >> 2) + 4 * hi; }
__device__ __forceinline__ unsigned cvtpk(float lo, float hi) { unsigned r; asm volatile("v_cvt_pk_bf16_f32 %0, %1, %2" : "=v"(r) : "v"(lo), "v"(hi)); return r; }

template <int MODE>
__device__ __forceinline__ void attn_unit(Frame& F, int b, int h_, int blk) {
    int tid_o = threadIdx.x; asm volatile("" : "+v"(tid_o));
    const int lane = tid_o & 63, r32 = lane & 31, hi = lane >> 5, wid = __builtin_amdgcn_readfirstlane(tid_o >> 6);
    constexpr int KLD = (MODE == 0) ? AW : 64;
    const int h = (MODE == 0) ? h_ : wid;
    const int q0 = (MODE == 0) ? 256 * blk + 32 * wid : 32 * blk;
    const int q = q0 + r32; const size_t tq = (size_t)b * SEQ + q;
    const int NT = (MODE == 0) ? 4 * (blk + 1) : (32 * blk + 31) / 64 + 1;
    const bf16* Q = (const bf16*)(F.ws + (MODE == 0 ? WS_QA : WS_QB));
    const bf16* Kg = (const bf16*)(F.ws + (MODE == 0 ? WS_KA : WS_KB)) + (size_t)b * SEQ * KLD + (MODE == 0 ? h * 64 : 0);
    const bf16* Vg = (const bf16*)(F.ws + (MODE == 0 ? WS_VA : WS_VB)) + (size_t)b * SEQ * KLD + (MODE == 0 ? h * 64 : 0);
    const bf16* SG = (const bf16*)(F.ws + (MODE == 0 ? WS_SGA : WS_SGB));
    bf16* Y = (bf16*)(F.ws + WS_XB) + (size_t)MODE * TOK * AW;
    const u64* BM = (const u64*)(F.ws + WS_BM) + tq * 64;
    LAS unsigned char* lds = F.lds;
    const LAS float* tbh = (const LAS float*)(lds + AT_TB) + (MODE * 8 + h) * 128;
    LAS float* wsf = (LAS float*)(lds + AT_WS) + wid * 64;
    LAS float* ost = (LAS float*)(lds + AT_OST) + wid * 2048;
    const int krow_ = 8 * wid + (lane >> 3);
    const bf16* ksrc = Kg + (size_t)krow_ * KLD + 8 * ((lane & 7) ^ ((krow_ ^ (krow_ >> 3)) & 7));
    const bf16* vsrc = Vg + (size_t)(8 * wid + ((lane & 31) >> 2)) * KLD + 32 * (lane >> 5) + 8 * (lane & 3);
    const unsigned lds0 = (unsigned)(uintptr_t)lds;
#define AT_DMA(t, so) do { \
        glds16(ksrc + (size_t)(t) * 64 * KLD, (unsigned)__builtin_amdgcn_readfirstlane((int)(lds0 + AT_RING + (so) + wid * 1024))); \
        glds16(vsrc + (size_t)(t) * 64 * KLD, (unsigned)__builtin_amdgcn_readfirstlane((int)(lds0 + AT_RING + (so) + 8192 + wid * 1024))); } while (0)
#pragma unroll
    for (int i = 0; i < AT_D; ++i) AT_DMA((i < NT ? i : NT - 1), i * AT_STAGE);
    bf16x8 qr[4];
#pragma unroll
    for (int d0 = 0; d0 < 4; ++d0) qr[d0] = *(const bf16x8*)(Q + tq * AW + h * 64 + 16 * d0 + 8 * hi);
    LAS u64* bmL = (LAS u64*)(lds + AT_BM);
    if (MODE == 1) {
        const u64* BMu = (const u64*)(F.ws + WS_BM) + ((size_t)b * SEQ + q0) * 64;
#pragma unroll
        for (int ps = 0; ps < 2; ++ps) { const int it = ps * 512 + (tid_o & 511), row = it >> 5, j2 = (it & 31) * 2;
            const v4u w = *(const v4u*)(BMu + (size_t)row * 64 + j2);
            bmL[j2 * 32 + row] = (u64)w.x | ((u64)w.y << 32); bmL[(j2 + 1) * 32 + row] = (u64)w.z | ((u64)w.w << 32); }
    }
    unsigned selmask = 0;
    if (MODE == 0 && blk > 0) {
        const bf16* kmh = (const bf16*)(F.ws + WS_KMH) + ((size_t)(b * 8 + h) * 32 + r32) * 64 + 8 * hi;
        const bf16* kml = (const bf16*)(F.ws + WS_KML) + ((size_t)(b * 8 + h) * 32 + r32) * 64 + 8 * hi;
        f32x16 gg;
#pragma unroll
        for (int r = 0; r < 16; ++r) gg[r] = 0.f;
#pragma unroll
        for (int d0 = 0; d0 < 4; ++d0) {
            gg = __builtin_amdgcn_mfma_f32_32x32x16_bf16(*(const bf16x8*)(kmh + 16 * d0), qr[d0], gg, 0, 0, 0);
            gg = __builtin_amdgcn_mfma_f32_32x32x16_bf16(*(const bf16x8*)(kml + 16 * d0), qr[d0], gg, 0, 0, 0); }
        float gate[16];
#pragma unroll
        for (int r = 0; r < 8; ++r) { const float o = __shfl_xor(gg[r], 32); const int nb_ = (r & 3) + 8 * (r >> 2); gate[nb_] = hi ? o : gg[r]; gate[nb_ + 4] = hi ? gg[r] : o; }
        const int nsel = blk < 3 ? blk : 3;
        for (int r = 0; r < nsel; ++r) { float best = -INFINITY; int bi = -1;
#pragma unroll
            for (int n = 0; n < 16; ++n) { const bool ok = (n < blk) && !((selmask >> n) & 1u) && (bi < 0 || gate[n] > best); if (ok) { best = gate[n]; bi = n; } }
            selmask |= 1u << bi; }
    }
    const float cfar = tbh[127]; const float NINF = -INFINITY;
#define AT_INIT_NEAR(t, c0, c1, mw) do { \
        const int kv0_ = 64 * (t); \
        bool sel_ = (t) < NT; \
        if (MODE == 0) { const int n_ = (t) >> 2; sel_ = sel_ && ((n_ == blk) || (((selmask >> (n_ & 15)) & 1u) != 0u)); } \
        unsigned mlo_ = 0, mhi_ = 0; if (MODE == 1) { const u64 ms_ = (mw) >> (4 * hi); mlo_ = (unsigned)ms_; mhi_ = (unsigned)(ms_ >> 32); } \
        _Pragma("unroll") for (int r = 0; r < 16; ++r) { const int bp = (r & 3) + 8 * (r >> 2); \
            const int d0_ = q - (kv0_ + bp + 4 * hi), d1_ = d0_ - 32; \
            const float b0_ = tbh[d0_ < 0 ? 0 : (d0_ > 127 ? 127 : d0_)], b1_ = tbh[d1_ < 0 ? 0 : (d1_ > 127 ? 127 : d1_)]; \
            if (MODE == 0) { c0[r] = (sel_ && d0_ >= 0) ? b0_ : NINF; c1[r] = (sel_ && d1_ >= 0) ? b1_ : NINF; } \
            else { c0[r] = (sel_ && ((mlo_ >> bp) & 1u)) ? b0_ : NINF; c1[r] = (sel_ && ((mhi_ >> bp) & 1u)) ? b1_ : NINF; } } } while (0)
#define AT_INIT_FARB(t, c0, c1, mw) do { \
        const u64 ms_ = ((t) < NT) ? ((mw) >> (4 * hi)) : 0ull; const int mlo_ = (int)(unsigned)ms_, mhi_ = (int)(unsigned)(ms_ >> 32); \
        const unsigned cf_ = __float_as_uint(cfar), nf_ = 0xff800000u; \
        _Pragma("unroll") for (int r = 0; r < 16; ++r) { const int bp = (r & 3) + 8 * (r >> 2); \
            const unsigned m0_ = (unsigned)__builtin_amdgcn_sbfe(mlo_, bp, 1), m1_ = (unsigned)__builtin_amdgcn_sbfe(mhi_, bp, 1); \
            c0[r] = __uint_as_float((m0_ & cf_) | (~m0_ & nf_)); c1[r] = __uint_as_float((m1_ & cf_) | (~m1_ & nf_)); } } while (0)
    const int kswz = (r32 ^ (r32 >> 3)) & 7;
#define AT_KF(Kt_, d0, p) (*(const LAS bf16x8*)((Kt_) + (p) * 4096 + (((2 * (d0) + hi) ^ kswz ^ (4 * (p))) << 4)))
#define AT_QK(so, c0, c1, i0, i1) do { const LAS unsigned char* Kt_ = lds + AT_RING + (so) + r32 * 128; \
        c0 = __builtin_amdgcn_mfma_f32_32x32x16_bf16(AT_KF(Kt_, 0, 0), qr[0], i0, 0, 0, 0); \
        c1 = __builtin_amdgcn_mfma_f32_32x32x16_bf16(AT_KF(Kt_, 0, 1), qr[0], i1, 0, 0, 0); \
        _Pragma("unroll") for (int d0 = 1; d0 < 4; ++d0) { \
            c0 = __builtin_amdgcn_mfma_f32_32x32x16_bf16(AT_KF(Kt_, d0, 0), qr[d0], c0, 0, 0, 0); \
            c1 = __builtin_amdgcn_mfma_f32_32x32x16_bf16(AT_KF(Kt_, d0, 1), qr[d0], c1, 0, 0, 0); } } while (0)
#define AT_SCORES(t, kf, c0, c1, mw) do { \
        const bool nearD_ = (q0 - (64 * (t) + 63)) < 113; \
        if (nearD_) { AT_INIT_NEAR(t, c0, c1, mw); AT_QK(kf, c0, c1, c0, c1); } \
        else if (MODE == 0) { AT_QK(kf, c0, c1, ivec, ivec); } \
        else { AT_INIT_FARB(t, c0, c1, mw); AT_QK(kf, c0, c1, c0, c1); } } while (0)
#define AT_IVEC(t) do { if (MODE == 0) { const int n_ = (t) >> 2; const bool s_ = ((t) < NT) && ((n_ == blk) || (((selmask >> (n_ & 15)) & 1u) != 0u)); const float v_ = s_ ? cfar : NINF; \
        _Pragma("unroll") for (int r = 0; r < 16; ++r) ivec[r] = v_; asm volatile("" : "+v"(ivec)); } } while (0)
#ifndef EXP_LDS
#define EXP_LDS 0
#endif
#ifndef EXP_EXP
#define EXP_EXP 0
#endif
#ifndef EXP_MFMA
#define EXP_MFMA 0
#endif
    f32x16 o0, o1, ivec; pg8::f32x4 dm4a = (pg8::f32x4){0.f,0.f,0.f,0.f}, dm4b = (pg8::f32x4){0.f,0.f,0.f,0.f}; f32x16 dmy; if (EXP_MFMA) { _Pragma("unroll") for (int r = 0; r < 16; ++r) dmy[r] = 0.f; }
#pragma unroll
    for (int r = 0; r < 16; ++r) { o0[r] = 0.f; o1[r] = 0.f; ivec[r] = NINF; }
    float lsum = 0.f;
    f32x16 ca0, ca1, cb0, cb1;
    AT_WAIT_BAR_N(2 * (AT_D - 1));
    AT_IVEC(0);
    { u64 mw0 = 0ull; if (MODE == 1) mw0 = bmL[r32];
      AT_SCORES(0, 0, ca0, ca1, mw0); }
    const int vbl = ((lane >> 4) & 1) * 32 + (lane & 3) * 8 + (4 * hi + ((lane & 15) >> 2)) * 64;
    int so_cur = 0, so_nxt = AT_STAGE, so_dma = AT_D * AT_STAGE;
#define AT_STEP(t, C0, C1, N0, N1) do { \
        u64 mw1_ = 0ull; if (MODE == 1) mw1_ = bmL[(((t) + 1) & 63) * 32 + r32]; \
        const LAS unsigned char* Vt_ = lds + AT_RING + so_cur + 8192; \
        asm volatile("" ::: "memory"); \
        if ((((t) + 1) & 3) == 0) AT_IVEC((t) + 1); \
        AT_SCORES((t) + 1, so_nxt, N0, N1, mw1_); \
        float sacc_ = 0.f; \
        if (EXP_EXP) { _Pragma("unroll") for (int r = 0; r < 16; ++r) { float e0_ = __builtin_amdgcn_exp2f(C0[r] + 1.0f), e1_ = __builtin_amdgcn_exp2f(C1[r] + 1.0f); asm volatile("" :: "v"(e0_), "v"(e1_)); } } \
        _Pragma("unroll") for (int r = 0; r < 16; ++r) { C0[r] = __builtin_amdgcn_exp2f(C0[r]); C1[r] = __builtin_amdgcn_exp2f(C1[r]); sacc_ += C0[r] + C1[r]; } \
        lsum += sacc_; \
        u32x4v pw_[4]; \
        _Pragma("unroll") for (int s_ = 0; s_ < 2; ++s_) { \
            pw_[s_] = (u32x4v){cvtpk(C0[8 * s_], C0[8 * s_ + 1]), cvtpk(C0[8 * s_ + 2], C0[8 * s_ + 3]), cvtpk(C0[8 * s_ + 4], C0[8 * s_ + 5]), cvtpk(C0[8 * s_ + 6], C0[8 * s_ + 7])}; \
            pw_[2 + s_] = (u32x4v){cvtpk(C1[8 * s_], C1[8 * s_ + 1]), cvtpk(C1[8 * s_ + 2], C1[8 * s_ + 3]), cvtpk(C1[8 * s_ + 4], C1[8 * s_ + 5]), cvtpk(C1[8 * s_ + 6], C1[8 * s_ + 7])}; } \
        _Pragma("unroll") for (int ks = 0; ks < 4; ++ks) { const bf16x8 pa_ = __builtin_bit_cast(bf16x8, pw_[ks]); \
            _Pragma("unroll") for (int d0 = 0; d0 < 2; ++d0) { const LAS unsigned char* vp_ = Vt_ + (2 * ks) * 1024 + d0 * 512 + vbl; \
                const s16x4 lo_ = __builtin_bit_cast(s16x4, __builtin_amdgcn_ds_read_tr16_b64_v4i16((LAS v4i16_t*)vp_)), hh_ = __builtin_bit_cast(s16x4, __builtin_amdgcn_ds_read_tr16_b64_v4i16((LAS v4i16_t*)(vp_ + 1024))); \
                if (EXP_LDS) { s16x4 l2_ = __builtin_bit_cast(s16x4, __builtin_amdgcn_ds_read_tr16_b64_v4i16((LAS v4i16_t*)(vp_ + 2048))), h2_ = __builtin_bit_cast(s16x4, __builtin_amdgcn_ds_read_tr16_b64_v4i16((LAS v4i16_t*)(vp_ + 3072))); asm volatile("" :: "v"(l2_), "v"(h2_)); } \
                const bf16x8 vf_ = (bf16x8){lo_[0], lo_[1], lo_[2], lo_[3], hh_[0], hh_[1], hh_[2], hh_[3]}; \
                if (d0 == 0) o0 = __builtin_amdgcn_mfma_f32_32x32x16_bf16(pa_, vf_, o0, 0, 0, 0); else o1 = __builtin_amdgcn_mfma_f32_32x32x16_bf16(pa_, vf_, o1, 0, 0, 0); \
                if (EXP_MFMA == 1) { dmy = __builtin_amdgcn_mfma_f32_32x32x16_bf16(pa_, vf_, dmy, 0, 0, 0); } \
                if (EXP_MFMA == 2) { dm4a = __builtin_amdgcn_mfma_f32_16x16x32_bf16(pa_, vf_, dm4a, 0, 0, 0); dm4b = __builtin_amdgcn_mfma_f32_16x16x32_bf16(vf_, pa_, dm4b, 0, 0, 0); } } } \
        so_cur = so_nxt; so_nxt = (so_nxt == (AT_R - 1) * AT_STAGE) ? 0 : so_nxt + AT_STAGE; } while (0)
    for (int t = 0; t < NT; t += 2) {
        AT_WAIT_BAR_N(2 * (AT_D - 3));
        { const int td_ = t + AT_D; AT_DMA((td_ < NT ? td_ : NT - 1), so_dma); so_dma = (so_dma == (AT_R - 1) * AT_STAGE) ? 0 : so_dma + AT_STAGE; }
        { const int td_ = t + AT_D + 1; AT_DMA((td_ < NT ? td_ : NT - 1), so_dma); so_dma = (so_dma == (AT_R - 1) * AT_STAGE) ? 0 : so_dma + AT_STAGE; }
        AT_STEP(t, ca0, ca1, cb0, cb1);
        AT_STEP(t + 1, cb0, cb1, ca0, ca1);
    }
    if (EXP_MFMA == 1) asm volatile("" :: "v"(dmy));
    if (EXP_MFMA == 2) asm volatile("" :: "v"(dm4a), "v"(dm4b));
    v4u sgv[4];
#pragma unroll
    for (int i = 0; i < 4; ++i) sgv[i] = *(const v4u*)(SG + ((size_t)b * SEQ + q0 + i * 8 + (lane >> 3)) * AW + h * 64 + (lane & 7) * 8);
    asm volatile("s_waitcnt vmcnt(4) lgkmcnt(0)\n\ts_barrier" ::: "memory");
    lsum += __shfl_xor(lsum, 32);
    if (hi == 0) wsf[r32] = lsum;
    LDS_WAIT(); asm volatile("" ::: "memory");
#pragma unroll
    for (int r = 0; r < 16; ++r) { const int orow = crow(r, hi); const float rl = __builtin_amdgcn_rcpf(wsf[orow]);
        ost[orow * 64 + r32] = o0[r] * rl; ost[orow * 64 + 32 + r32] = o1[r] * rl; }
    LDS_WAIT(); asm volatile("" ::: "memory");
#pragma unroll
    for (int i = 0; i < 4; ++i) { const int row = i * 8 + (lane >> 3), ch = lane & 7;
        const f32x4 a = *(const LAS f32x4*)(ost + row * 64 + ch * 8), c = *(const LAS f32x4*)(ost + row * 64 + ch * 8 + 4);
        const size_t off = ((size_t)b * SEQ + q0 + row) * AW + h * 64 + ch * 8;
        const v4u g = sgv[i]; v4u o;
        o.x = pk2(a[0] * bflo(g.x), a[1] * bfhi(g.x)); o.y = pk2(a[2] * bflo(g.y), a[3] * bfhi(g.y)); o.z = pk2(c[0] * bflo(g.z), c[1] * bfhi(g.z)); o.w = pk2(c[2] * bflo(g.w), c[3] * bfhi(g.w));
        *(v4u*)(Y + off) = o; }
    AT_WAIT_BAR();
#undef AT_DMA
#undef AT_INIT_NEAR
#undef AT_INIT_FARB
#undef AT_QK
#undef AT_KF
#undef AT_SCORES
#undef AT_IVEC
#undef AT_STEP
}
__device__ __forceinline__ void attn_phase_fast(Frame& F, int layer) {
    { LAS float* tb = (LAS float*)(F.lds + AT_TB);
      build_bias_table(F, tb, in_ptr(3) + layer * 64, in_ptr(4) + layer * 64, 0);
      build_bias_table(F, tb + 1024, in_ptr(5) + layer * 64, in_ptr(6) + layer * 64, 8); }
    __syncthreads();
#ifndef REP_ATT_A
#define REP_ATT_A 1
#endif
#ifndef REP_ATT_B
#define REP_ATT_B 1
#endif
    for (int rep = 0; rep < REP_ATT_A; ++rep)
    for (int pr = F.vcu; pr < 512; pr += F.G) {
        const int bh = pr >> 3, s = pr & 7;
        attn_unit<0>(F, bh >> 3, bh & 7, 15 - s); attn_unit<0>(F, bh >> 3, bh & 7, s); }
    for (int rep = 0; rep < REP_ATT_B; ++rep)
    for (int pr = F.vcu; pr < 512; pr += F.G) {
        const int b = pr >> 6, s = pr & 63;
        attn_unit<1>(F, b, 0, 127 - s); attn_unit<1>(F, b, 0, s); }
}

constexpr int IDX_S_OFF = 0, IDX_Q_OFF = RING_BYTES, IDX_W_OFF = RING_BYTES + 8192, IDX_H_OFF = RING_BYTES;
static_assert(IDX_H_OFF + 8 * 3328 <= LDSCTL_OFF, "idx LDS");

#define DPPI_(x, ctrl) __builtin_amdgcn_update_dpp(0, (x), (ctrl), 0xF, 0xF, true)
#define DPPF_(x, ctrl) __builtin_bit_cast(float, DPPI_(__builtin_bit_cast(int, (x)), (ctrl)))
__device__ __forceinline__ float rl_f(float x, int l) { return __builtin_bit_cast(float, __builtin_amdgcn_readlane(__builtin_bit_cast(int, x), l)); }
__device__ __forceinline__ float wave_minf(float x) {
    x = fminf(x, DPPF_(x, 0xB1)); x = fminf(x, DPPF_(x, 0x4E)); x = fminf(x, DPPF_(x, 0x141)); x = fminf(x, DPPF_(x, 0x140));
    return fminf(fminf(rl_f(x, 0), rl_f(x, 16)), fminf(rl_f(x, 32), rl_f(x, 48)));
}
__device__ __forceinline__ float wave_maxf(float x) {
    x = fmaxf(x, DPPF_(x, 0xB1)); x = fmaxf(x, DPPF_(x, 0x4E)); x = fmaxf(x, DPPF_(x, 0x141)); x = fmaxf(x, DPPF_(x, 0x140));
    return fmaxf(fmaxf(rl_f(x, 0), rl_f(x, 16)), fmaxf(rl_f(x, 32), rl_f(x, 48)));
}
#define SEL_OPAQUE() do { _Pragma("unroll") for (int j_ = 0; j_ < 64; ++j_) asm volatile("" : "+v"(v[j_])); } while (0)
typedef unsigned u32x2v __attribute__((ext_vector_type(2)));
__device__ __forceinline__ unsigned pkrtz_f16(float a, float b) { unsigned r; asm("v_cvt_pkrtz_f16_f32 %0, %1, %2" : "=v"(r) : "v"(a), "v"(b)); return r; }
typedef _Float16 sel_t;
typedef _Float16 sel8_t __attribute__((ext_vector_type(8)));
__device__ __forceinline__ unsigned bin_of(float x, float lo, float scale) {
    int r; const float t = (x - lo) * scale; asm("v_cvt_i32_f32 %0, %1" : "=v"(r) : "v"(t)); const unsigned u = (unsigned)r; return u < 256u ? u : 256u;
}
template <bool KNOWN>
__device__ __forceinline__ void select_core(LAS sel_t* R, int n, int lane, LAS unsigned* hist, float& T_out, int& needT_out, float lo_in = 0.f, float hi_in = 0.f) {
    const int nch = (n + 63) >> 6;
    if (64 * (nch - 1) + lane >= n) R[64 * (nch - 1) + lane] = (sel_t)(-INFINITY);
    LDS_WAIT(); asm volatile("" ::: "memory");
    const LAS sel_t* Rl = R + lane;
    float lo = lo_in, hi = hi_in;
    if (!KNOWN) { lo = INFINITY; hi = -INFINITY;
#pragma unroll 4
        for (int j = 0; j < nch; ++j) { const float x = Rl[64 * j]; lo = fminf(lo, x == -INFINITY ? INFINITY : x); hi = fmaxf(hi, x); }
        lo = wave_minf(lo); hi = wave_maxf(hi); }
    int need = 256; float T = lo; int needT = 256;
    for (int iter = 0; iter < 48; ++iter) {
        T = lo; needT = need;
        if (!(hi > lo)) break;
        hist[lane] = 0u; hist[64 + lane] = 0u; hist[128 + lane] = 0u; hist[192 + lane] = 0u; hist[256 + (lane & 3)] = 0u;
        LDS_WAIT(); asm volatile("" ::: "memory");
        const float scale = 255.99f / (hi - lo);
#pragma unroll 4
        for (int j = 0; j < nch; ++j) __hip_atomic_fetch_add(hist + bin_of(Rl[64 * j], lo, scale), 1u, __ATOMIC_RELAXED, __HIP_MEMORY_SCOPE_WORKGROUP);
        LDS_WAIT(); asm volatile("" ::: "memory");
        const unsigned h0 = hist[4 * lane], h1 = hist[4 * lane + 1], h2 = hist[4 * lane + 2], h3 = hist[4 * lane + 3];
        unsigned suf = h0 + h1 + h2 + h3;
        suf += (unsigned)__builtin_amdgcn_update_dpp(0, (int)suf, 0x101, 0xF, 0xF, true); suf += (unsigned)__builtin_amdgcn_update_dpp(0, (int)suf, 0x102, 0xF, 0xF, true);
        suf += (unsigned)__builtin_amdgcn_update_dpp(0, (int)suf, 0x104, 0xF, 0xF, true); suf += (unsigned)__builtin_amdgcn_update_dpp(0, (int)suf, 0x108, 0xF, 0xF, true);
        { const unsigned r1 = __builtin_amdgcn_readlane(suf, 16), r2 = __builtin_amdgcn_readlane(suf, 32), r3 = __builtin_amdgcn_readlane(suf, 48);
          const int rw = lane >> 4; suf += (rw == 0) ? (r1 + r2 + r3) : (rw == 1) ? (r2 + r3) : (rw == 2) ? r3 : 0u; }
        const u64 bal = __ballot(suf >= (unsigned)need);
        if (bal == 0ull) break;
        const int ls = 63 - __builtin_clzll(bal);
        const unsigned a3 = __builtin_amdgcn_readlane(h3, ls), a2 = __builtin_amdgcn_readlane(h2, ls), a1 = __builtin_amdgcn_readlane(h1, ls), a0 = __builtin_amdgcn_readlane(h0, ls);
        const unsigned above_lane = __builtin_amdgcn_readlane(suf, ls) - (a0 + a1 + a2 + a3);
        unsigned bstar, above, cstar;
        if (above_lane + a3 >= (unsigned)need) { bstar = 4 * ls + 3; above = above_lane; cstar = a3; }
        else if (above_lane + a3 + a2 >= (unsigned)need) { bstar = 4 * ls + 2; above = above_lane + a3; cstar = a2; }
        else if (above_lane + a3 + a2 + a1 >= (unsigned)need) { bstar = 4 * ls + 1; above = above_lane + a3 + a2; cstar = a1; }
        else { bstar = 4 * ls; above = above_lane + a3 + a2 + a1; cstar = a0; }
        need -= (int)above;
        float nlo = INFINITY, nhi = -INFINITY; int cnt = 0;
        LAS float* candx = (LAS float*)hist; LAS unsigned* candi = hist + 64;
#pragma unroll 4
        for (int j = 0; j < nch; ++j) { const float x = Rl[64 * j];
            const bool c = bin_of(x, lo, scale) == bstar;
            const u64 cb = __ballot(c);
            if (cb != 0ull) { nlo = fminf(nlo, c ? x : INFINITY); nhi = fmaxf(nhi, c ? x : -INFINITY);
                const int pos = cnt + (int)__builtin_amdgcn_mbcnt_hi((unsigned)(cb >> 32), __builtin_amdgcn_mbcnt_lo((unsigned)cb, 0u));
                if (c && pos < 64) { candx[pos] = x; candi[pos] = (unsigned)(64 * j + lane); }
                cnt += __builtin_popcountll(cb); } }
        if (cstar <= 64u) {
            LDS_WAIT(); asm volatile("" ::: "memory");
            const bool mine = lane < (int)cstar;
            const float mx = mine ? candx[lane] : -INFINITY; const unsigned mi = candi[lane];
            int rank = 0;
            for (int i = 0; i < (int)cstar; ++i) { const float xi = rl_f(mx, i); const unsigned ii = (unsigned)__builtin_amdgcn_readlane((int)mi, i); rank += (xi > mx || (xi == mx && ii < mi)) ? 1 : 0; }
            const u64 tb_ = __ballot(mine && rank == need - 1);
            if (tb_ == 0ull) break;
            T = rl_f(mx, __builtin_ctzll(tb_));
            needT = need - __builtin_popcountll(__ballot(mine && mx > T));
            LDS_WAIT(); asm volatile("" ::: "memory");
            break;
        }
        nlo = wave_minf(nlo); nhi = wave_maxf(nhi);
        if ((int)cstar == need) { T = nlo; needT = 1 << 20; break; }
        lo = nlo; hi = nhi;
    }
    T_out = T; needT_out = needT;
}

__device__ __forceinline__ u64 bitmap_row(const LAS sel_t* R, int n, int lane, float T, int needT) {
    const int nch = (n + 63) >> 6; const LAS sel_t* Rl = R + lane;
    int run = 0; unsigned wlo = 0u, whi = 0u;
#pragma unroll 4
    for (int j = 0; j < nch; ++j) { const float x = Rl[64 * j];
        u64 w;
        const bool tie = (x == T); const u64 tbal = __ballot(tie);
        if (tbal == 0ull) w = __ballot(x > T);
        else { const int rank = run + (int)__builtin_amdgcn_mbcnt_hi((unsigned)(tbal >> 32), __builtin_amdgcn_mbcnt_lo((unsigned)tbal, 0u)); run += __builtin_popcountll(tbal);
            w = __ballot(x > T || (tie && rank < needT)); }
        if (lane == j) { wlo = (unsigned)w; whi = (unsigned)(w >> 32); }
    }
    return (u64)wlo | ((u64)whi << 32);
}
__device__ __forceinline__ u64 select_row(LAS sel_t* R, int n, int lane, LAS unsigned* hist) {
    const int nch = (n + 63) >> 6;
    if (64 * (nch - 1) + lane >= n) R[64 * (nch - 1) + lane] = (sel_t)(-INFINITY);
    LDS_WAIT(); asm volatile("" ::: "memory");
    const LAS sel_t* Rl = R + lane;
    LAS unsigned short* idx16 = (LAS unsigned short*)(hist + 320);
    float T; int needT;
    bool fast = n >= 768;
    float L = 0.f; int cnt = 0;
    if (fast) {
        const float x0 = Rl[0];
        int kth = (64 * 640) / n; kth = kth < 4 ? 4 : (kth > 60 ? 60 : kth);
        int above = 0;
#pragma unroll
        for (int i = 0; i < 8; ++i) { const sel8_t q = *(const LAS sel8_t*)(R + 8 * i);
#pragma unroll
            for (int k = 0; k < 8; ++k) above += ((float)q[k] > x0) ? 1 : 0; }
        fast = false;
        for (int attempt = 0; attempt < 3 && !fast; ++attempt) {
            L = wave_minf(above <= kth ? x0 : INFINITY);
            int cl = 0;
#pragma unroll 4
            for (int j = 0; j < nch; ++j) cl += (Rl[64 * j] >= L) ? 1 : 0;
            cl += __builtin_amdgcn_update_dpp(0, cl, 0xB1, 0xF, 0xF, true); cl += __builtin_amdgcn_update_dpp(0, cl, 0x4E, 0xF, 0xF, true);
            cl += __builtin_amdgcn_update_dpp(0, cl, 0x141, 0xF, 0xF, true); cl += __builtin_amdgcn_update_dpp(0, cl, 0x140, 0xF, 0xF, true);
            cnt = __builtin_amdgcn_readlane(cl, 0) + __builtin_amdgcn_readlane(cl, 16) + __builtin_amdgcn_readlane(cl, 32) + __builtin_amdgcn_readlane(cl, 48);
            fast = cnt >= 256 && cnt <= 1024;
            if (cnt > 1024) kth = (kth > 1) ? (kth >> 1) : 0; else kth = (2 * kth + 2 > 63) ? 63 : 2 * kth + 2;
        }
    }
    if (!fast) { select_core<false>(R, n, lane, hist, T, needT); return bitmap_row(R, n, lane, T, needT); }
    int pos = 0; float xn = Rl[0], hmax = -INFINITY;
    for (int j = 0; j < nch; ++j) { const float x = xn; if (j + 1 < nch) xn = Rl[64 * (j + 1)];
        hmax = fmaxf(hmax, x);
        const bool c = x >= L; const u64 cb = __ballot(c);
        if (cb != 0ull) { const int p = pos + (int)__builtin_amdgcn_mbcnt_hi((unsigned)(cb >> 32), __builtin_amdgcn_mbcnt_lo((unsigned)cb, 0u));
            if (c) { R[p] = (sel_t)x; idx16[p] = (unsigned short)(64 * j + lane); }
            pos += __builtin_popcountll(cb); } }
    LDS_WAIT(); asm volatile("" ::: "memory");
    select_core<true>(R, cnt, lane, hist, T, needT, L, wave_maxf(hmax));
    hist[lane] = 0u; hist[64 + lane] = 0u;
    LDS_WAIT(); asm volatile("" ::: "memory");
    const int ncl = (cnt + 63) >> 6; int run = 0;
    for (int j = 0; j < ncl; ++j) { const float x = Rl[64 * j];
        const bool tie = (x == T); const u64 tbal = __ballot(tie);
        const int rank = run + (int)__builtin_amdgcn_mbcnt_hi((unsigned)(tbal >> 32), __builtin_amdgcn_mbcnt_lo((unsigned)tbal, 0u)); run += __builtin_popcountll(tbal);
        const bool selb = x > T || (tie && rank < needT);
        if (selb) { const unsigned id = idx16[64 * j + lane]; __hip_atomic_fetch_or(hist + (id >> 5), 1u << (id & 31u), __ATOMIC_RELAXED, __HIP_MEMORY_SCOPE_WORKGROUP); } }
    LDS_WAIT(); asm volatile("" ::: "memory");
    const u64 myword = (u64)hist[2 * lane] | ((u64)hist[2 * lane + 1] << 32);
    LDS_WAIT(); asm volatile("" ::: "memory");
    return myword;
}

#ifdef NAIVE_IDX
__device__ __forceinline__ void idx_phase_naive(Frame& F) {
    PHASE_TID();
    LAS float* S = (LAS float*)(F.lds + IDX_S_OFF); LAS float* qs = (LAS float*)(F.lds + IDX_Q_OFF); LAS float* wsm = (LAS float*)(F.lds + IDX_W_OFF);
    LAS unsigned* hist = (LAS unsigned*)(F.lds + IDX_H_OFF) + F.wave * 832;
    const bf16* QI = (const bf16*)(F.ws + WS_QI); const bf16* KI = (const bf16*)(F.ws + WS_KI); const float* WI = (const float*)(F.ws + WS_WI); u64* BM = (u64*)(F.ws + WS_BM);
    for (int un = blockIdx.x; un < TOK / 8; un += F.G) {
        const int b = un >> 9, q0 = (un & 511) * 8; const size_t t0 = (size_t)b * SEQ + q0;
        for (int e = ptid; e < 8 * 256; e += NWAVES * 64) qs[e] = bf2f(QI[t0 * 256 + e]);
        if (ptid < 32) wsm[ptid] = WI[t0 * 4 + ptid];
        __syncthreads();
        const int nk = q0 + 8;
        for (int k = ptid; k < nk; k += NWAVES * 64) {
            float kf[64];
            { const v4u* kp = (const v4u*)(KI + ((size_t)b * SEQ + k) * 64);
#pragma unroll
                for (int c = 0; c < 8; ++c) { const v4u w = kp[c]; kf[8 * c + 0] = bflo(w.x); kf[8 * c + 1] = bfhi(w.x); kf[8 * c + 2] = bflo(w.y); kf[8 * c + 3] = bfhi(w.y); kf[8 * c + 4] = bflo(w.z); kf[8 * c + 5] = bfhi(w.z); kf[8 * c + 6] = bflo(w.w); kf[8 * c + 7] = bfhi(w.w); } }
            for (int i = 0; i < 8; ++i) { float sc = 0.f;
#pragma unroll
                for (int h = 0; h < 4; ++h) { float dot = 0.f; const LAS f32x4* qp = (const LAS f32x4*)(qs + i * 256 + h * 64);
#pragma unroll
                    for (int c = 0; c < 16; ++c) { const f32x4 qq = qp[c]; dot += kf[4 * c] * qq[0]; dot += kf[4 * c + 1] * qq[1]; dot += kf[4 * c + 2] * qq[2]; dot += kf[4 * c + 3] * qq[3]; }
                    sc += wsm[i * 4 + h] * fmaxf(dot, 0.f); }
                S[i * 4096 + k] = sc; }
        }
        __syncthreads();
        { const int i = F.wave, n = q0 + i + 1; u64 word;
            if (n <= 256) { const int full = n >> 6, rem = n & 63; word = (plane < full) ? ~0ull : (plane == full ? ((1ull << rem) - 1ull) : 0ull); }
            else word = select_row(S + i * 4096, n, plane, hist);
            BM[(t0 + i) * 64 + plane] = word; }
        __syncthreads();
    }
}

#endif
__device__ __forceinline__ float dpp_quad_sum(float x) {
    x += __builtin_bit_cast(float, __builtin_amdgcn_mov_dpp(__builtin_bit_cast(int, x), 0xB1, 0xF, 0xF, true));
    x += __builtin_bit_cast(float, __builtin_amdgcn_mov_dpp(__builtin_bit_cast(int, x), 0x4E, 0xF, 0xF, true));
    return x;
}
__device__ __forceinline__ void idx_phase(Frame& F) {
    PHASE_TID();
    LAS sel_t* S = (LAS sel_t*)(F.lds + IDX_S_OFF);
    LAS unsigned* hist = (LAS unsigned*)(F.lds + IDX_H_OFF) + F.wave * 832;
    const bf16* QI = (const bf16*)(F.ws + WS_QI); const bf16* KI = (const bf16*)(F.ws + WS_KI); const float* WI = (const float*)(F.ws + WS_WI); u64* BM = (u64*)(F.ws + WS_BM);
    const int c16 = plane & 15, kg = plane >> 4, qloc = c16 >> 2, hh = c16 & 3;
    {
        const float* KMP = (const float*)(F.ws + WS_KMP); bf16* KMH = (bf16*)(F.ws + WS_KMH); bf16* KML = (bf16*)(F.ws + WS_KML);
        for (int e = blockIdx.x * (NWAVES * 64) + ptid; e < BATCH * NH * 32 * 64; e += F.G * NWAVES * 64) {
            const int d = e & 63, n = (e >> 6) & 31, h = (e >> 11) & 7, b = e >> 14; unsigned vh = 0, vl = 0;
            if (n < 16) { const float* p = KMP + ((((size_t)b * 16 + n) * 8 + h) * 2) * 64 + d; const float v = (p[0] + p[64]) * (1.0f / 256.0f);
                vh = f2bf(v); vl = f2bf(v - __uint_as_float(vh << 16)); }
            KMH[e] = (bf16)vh; KML[e] = (bf16)vl; }
    }
    for (int un = blockIdx.x; un < TOK / 16; un += F.G) {
        const int b = un & 7, m_ = un >> 3, q0 = (m_ < 128 ? m_ : 383 - m_) * 16; const size_t t0 = (size_t)b * SEQ + q0;
        bf16x8 qf[4][2]; float wv[4];
#pragma unroll
        for (int g = 0; g < 4; ++g) { wv[g] = WI[(t0 + 4 * g + qloc) * 4 + hh];
#pragma unroll
            for (int ks = 0; ks < 2; ++ks) qf[g][ks] = *(const bf16x8*)(QI + (t0 + 4 * g + qloc) * 256 + hh * 64 + 32 * ks + 8 * kg); }
        const int nchunk = (q0 + 16 + 15) >> 4;
        const bf16* kbase = KI + (size_t)b * SEQ * 64 + (size_t)c16 * 64 + 8 * kg;
#define IDX_LOAD(KA, c0_) do { _Pragma("unroll") for (int u = 0; u < 4; ++u) { const int c = (c0_) + u * NWAVES; const bf16* kp = kbase + (size_t)(c < nchunk ? c : F.wave) * 16 * 64; \
            KA[u][0] = *(const bf16x8*)kp; KA[u][1] = *(const bf16x8*)(kp + 32); } } while (0)
#define IDX_COMP(KA, c0_) do { _Pragma("unroll") for (int u = 0; u < 4; ++u) { const int c = (c0_) + u * NWAVES; \
            if (c < nchunk) { _Pragma("unroll") for (int g = 0; g < 4; ++g) { \
                pg8::f32x4 acc = (pg8::f32x4){0.f, 0.f, 0.f, 0.f}; \
                acc = __builtin_amdgcn_mfma_f32_16x16x32_bf16(KA[u][0], qf[g][0], acc, 0, 0, 0); \
                acc = __builtin_amdgcn_mfma_f32_16x16x32_bf16(KA[u][1], qf[g][1], acc, 0, 0, 0); \
                float sc[4]; \
                _Pragma("unroll") for (int i = 0; i < 4; ++i) sc[i] = dpp_quad_sum(wv[g] * fmaxf(acc[i], 0.f)); \
                if (hh == 0) { u32x2v w_; w_.x = pkrtz_f16(sc[0], sc[1]); w_.y = pkrtz_f16(sc[2], sc[3]); \
                    *(LAS u32x2v*)(S + (4 * g + qloc) * 4096 + 16 * c + 4 * kg) = w_; } } } } } while (0)
        { bf16x8 kaA[4][2], kaB[4][2];
          IDX_LOAD(kaA, F.wave);
          for (int c0 = F.wave; c0 < nchunk; c0 += 8 * NWAVES) {
              IDX_LOAD(kaB, c0 + 4 * NWAVES);
              IDX_COMP(kaA, c0);
              IDX_LOAD(kaA, c0 + 8 * NWAVES);
              IDX_COMP(kaB, c0 + 4 * NWAVES);
          } }
#undef IDX_LOAD
#undef IDX_COMP
        __syncthreads();
#pragma unroll 1
        for (int r2 = 0; r2 < 2; ++r2) { const int i = F.wave + 8 * r2, n = q0 + i + 1; u64 word;
            if (n <= 256) { const int full = n >> 6, rem = n & 63; word = (plane < full) ? ~0ull : (plane == full ? ((1ull << rem) - 1ull) : 0ull); }
            else word = select_row(S + i * 4096, n, plane, hist);
            BM[(t0 + i) * 64 + plane] = word; }
        __syncthreads();
    }
}

struct Args { const float* in[11]; float* out; unsigned char* ws; int ph_lo, ph_hi, li, pad; };
__global__ void __launch_bounds__(NWAVES * 64, 2) hyb_fwd(Args args) {
    extern __shared__ __attribute__((aligned(16))) unsigned char lds[];
    Frame F;
    F.lds = (LAS unsigned char*)lds;
    F.MISC = (volatile LAS unsigned*)(F.lds + MISC_OFF);
    F.wave = __builtin_amdgcn_readfirstlane((int)threadIdx.x >> 6);
    F.G = gridDim.x; { const int bx = blockIdx.x; F.vcu = (F.G % 8 == 0) ? (bx % 8) * (F.G / 8) + bx / 8 : bx; }
    F.ws = args.ws; F.ctl = (gu32*)(args.ws + WS_CTL); F.out = args.out;
    for (int u = threadIdx.x; u < (LDS_BYTES - LDSCTL_OFF) / 4; u += NWAVES * 64) ((LAS unsigned*)(F.lds + LDSCTL_OFF))[u] = 0u;
    __syncthreads();
    const bool one_launch = (args.ph_hi - args.ph_lo) > 1;
    XcdBarrier bar; bar.bar = (unsigned*)(F.ctl + CW_BAR); bar.x = 0; bar.st = nullptr;
    if (one_launch) bar = xcd_barrier_post((unsigned*)(F.ctl + CW_BAR), F.MISC + 8);
    const int lo = args.ph_lo, hi = args.ph_hi;
    unsigned char* ws = args.ws;
#ifndef REP_K
#define REP_K -2
#endif
#pragma unroll 1
    for (int ph2 = 2 * lo; ph2 < 2 * hi; ++ph2) {
        const int ph = ph2 >> 1;
        const int l = (ph - 1) / 5, k = (ph == 0) ? -1 : (ph - 1) % 5;
        if ((ph2 & 1) && k != REP_K) continue;
        if (k < 0) {
#ifndef NO_P0
            p0_prologue(F);
#endif
        } else if (k == 0) {
#ifndef NO_P1
            pg8::Gemm g{(const pg8::bf16_t*)(ws + WS_XB), (const pg8::bf16_t*)(ws + WS_WIN) + (size_t)l * NIN * DM, TOK, NIN, DM};
            pg8::StaticOrder S; S.init(TOK, NIN, F.G, (int)blockIdx.x);
            pg8::EpiIn E; E.rss = (const float*)(ws + WS_RSS); E.qna = in_ptr(3) + l * 64; E.kna = in_ptr(4) + l * 64; E.qnb = in_ptr(5) + l * 64; E.knb = in_ptr(6) + l * 64;
            E.QA = (pg8::bf16_t*)(ws + WS_QA); E.KA = (pg8::bf16_t*)(ws + WS_KA); E.VA = (pg8::bf16_t*)(ws + WS_VA); E.SGA = (pg8::bf16_t*)(ws + WS_SGA); E.QB = (pg8::bf16_t*)(ws + WS_QB); E.SGB = (pg8::bf16_t*)(ws + WS_SGB);
            E.KB = (pg8::bf16_t*)(ws + WS_KB); E.VB = (pg8::bf16_t*)(ws + WS_VB); E.KI = (pg8::bf16_t*)(ws + WS_KI); E.QI = (pg8::bf16_t*)(ws + WS_QI); E.SMA = (pg8::bf16_t*)(ws + WS_SMA); E.SMB = (pg8::bf16_t*)(ws + WS_SMB);
            E.WI = (float*)(ws + WS_WI); E.KMP = (float*)(ws + WS_KMP);
            pg8::gemm_phase<pg8::EpiIn, pg8::StaticOrder, true, true>(F.lds, g, S, E);
#endif
        } else if (k == 1) {
#ifndef NO_IDX
#ifdef NAIVE_IDX
            idx_phase_naive(F);
#else
            idx_phase(F);
#endif
#endif
        } else if (k == 2) {
#ifndef NO_ATT
#ifdef NAIVE_ATT
            naive_attn<0>(F, l); __syncthreads(); naive_attn<1>(F, l);
#else
#ifdef CLOCK_PROBE
            if (blockIdx.x == 0 && threadIdx.x == 0 && l == 0) { F.MISC[16] = (unsigned)__builtin_amdgcn_s_memtime(); F.MISC[17] = (unsigned)__builtin_amdgcn_s_memrealtime(); }
#endif
            attn_phase_fast(F, l);
#ifdef CLOCK_PROBE
            if (blockIdx.x == 0 && threadIdx.x == 0 && l == 0) { const unsigned dt = (unsigned)__builtin_amdgcn_s_memtime() - F.MISC[16], dr = (unsigned)__builtin_amdgcn_s_memrealtime() - F.MISC[17]; F.MISC[18] = (unsigned)((unsigned long long)dt * 100ull / (dr ? dr : 1u)); }
#endif
#endif
#endif
        } else if (k == 3) {
#ifndef NO_P4
            pg8::Gemm g{(const pg8::bf16_t*)(ws + WS_XB), (const pg8::bf16_t*)(ws + WS_WBR) + (size_t)l * 2048 * AW, 2 * TOK, 2048, AW};
            pg8::PairOrder S; S.init(F.G, (int)blockIdx.x);
            pg8::EpiMerge E{(pg8::bf16_t*)(ws + WS_SMA), (pg8::bf16_t*)(ws + WS_SMB)};
            pg8::gemm_phase<pg8::EpiMerge, pg8::PairOrder, true, true>(F.lds, g, S, E);
#endif
        } else {
#ifndef NO_P5
            pg8::Gemm g{(const pg8::bf16_t*)(ws + WS_SMB), (const pg8::bf16_t*)(ws + WS_WOUT) + (size_t)l * DM * DM, TOK, DM, DM};
            pg8::StaticOrder S; S.init(TOK, DM, F.G, (int)blockIdx.x);
            if (l == 0) { pg8::EpiOut<true> E{in_ptr(0), F.out, (pg8::bf16_t*)(ws + WS_XB), (float*)(ws + WS_RSS)};
                pg8::gemm_phase<pg8::EpiOut<true>, pg8::StaticOrder, true, true>(F.lds, g, S, E); }
            else { pg8::EpiOut<false> E{F.out, F.out, nullptr, nullptr};
                pg8::gemm_phase<pg8::EpiOut<false>, pg8::StaticOrder, true, true>(F.lds, g, S, E); }
#endif
        }
        if (!((ph == hi - 1) && ((ph2 & 1) || k != REP_K))) xcd_barrier(bar);
    }
#ifdef CLOCK_PROBE
    if (blockIdx.x == 0 && threadIdx.x == 0) {
        const unsigned long long t0 = __builtin_amdgcn_s_memrealtime(); const unsigned long long want = (unsigned long long)F.MISC[18] * 100ull;
        while (__builtin_amdgcn_s_memrealtime() - t0 < want) __builtin_amdgcn_s_sleep(16);
    }
#endif
}

#ifndef N_LAUNCHES
#define N_LAUNCHES 1
#endif
extern "C" void kernel_launch(void* const* d_in, const int* in_sizes, int n_in, void* d_out, int out_size, void* d_ws, size_t ws_size, hipStream_t stream) {
    static int grid = 0;
    if (grid == 0) {
        if (n_in != 11 || in_sizes[0] != TOK * DM || out_size != TOK * DM || ws_size < WS_END) { fprintf(stderr, "kernel_launch: unexpected shapes (n_in %d in0 %d out %d ws %zu)\n", n_in, n_in > 0 ? in_sizes[0] : -1, out_size, ws_size); grid = -1; return; }
        int dev = 0, cus = 0;
        if (hipGetDevice(&dev) != hipSuccess || hipDeviceGetAttribute(&cus, hipDeviceAttributeMultiprocessorCount, dev) != hipSuccess) { grid = -1; return; }
        if (hipFuncSetAttribute((const void*)hyb_fwd, hipFuncAttributeMaxDynamicSharedMemorySize, LDS_BYTES) != hipSuccess) { fprintf(stderr, "kernel_launch: hipFuncSetAttribute failed\n"); grid = -1; return; }
        int per_cu = 0;
        if (hipOccupancyMaxActiveBlocksPerMultiprocessor(&per_cu, (const void*)hyb_fwd, NWAVES * 64, LDS_BYTES) != hipSuccess || per_cu < 1) fprintf(stderr, "kernel_launch: occupancy query says %d\n", per_cu);
        (void)hipGetLastError();
        grid = cus;
    }
    if (grid < 0) return;
    if (hipMemsetAsync((char*)d_ws + WS_CTL, 0, CTL_ZERO_BYTES, stream) != hipSuccess) return;
    Args a{};
    for (int i = 0; i < 11; ++i) a.in[i] = (const float*)d_in[i];
    a.out = (float*)d_out; a.ws = (unsigned char*)d_ws;
    if (N_LAUNCHES == 1) { a.ph_lo = 0; a.ph_hi = NPHASE; a.li = 0; hipLaunchKernelGGL(hyb_fwd, dim3(grid), dim3(NWAVES * 64), LDS_BYTES, stream, a); }
    else for (int li = 0; li < NPHASE; ++li) { a.ph_lo = li; a.ph_hi = li + 1; a.li = li; hipLaunchKernelGGL(hyb_fwd, dim3(grid), dim3(NWAVES * 64), LDS_BYTES, stream, a); }
}
```

```cpp
#include <hip/hip_runtime.h>
#include <cstdio>
#include <cstdint>
#include <cmath>
namespace pg8 {
#define PG8_LAS __attribute__((address_space(3)))
typedef unsigned short bf16_t;
typedef short bf16x8 __attribute__((ext_vector_type(8)));
typedef float f32x4 __attribute__((ext_vector_type(4)));
typedef unsigned u32x4 __attribute__((ext_vector_type(4)));
constexpr int BM = 256, BK = 64, HALF = 128, HTB = HALF * BK * 2  , STAGE_BYTES = 8 * HTB, NXCD = 8, WGM = 8;

__host__ __device__ __forceinline__ int lds_byte(int r, int c) { const int st = (r >> 4) * 2 + (c >> 5), rr = r & 15, cc = c & 31, ob = rr * 64 + cc * 2; return st * 1024 + (ob ^ (((ob >> 9) & 1) << 5)); }
__host__ __device__ __forceinline__ void stage_rc(int b, int& R, int& C) { const int st = b / 1024, sb = b % 1024, swz = sb ^ (((sb >> 9) & 1) << 5); R = (st >> 1) * 16 + swz / 64; C = (st & 1) * 32 + (swz % 64) / 2; }
__host__ __device__ __forceinline__ int perm32(int rho) { const int n = rho >> 4, i = rho & 15; return 8 * (i >> 2) + 4 * n + (i & 3); }

struct Unit { int pm, pn; };
struct Gemm { const bf16_t* A; const bf16_t* Bt; int M, N, K; };

struct StaticOrder {
    int nM, nN, nwg, G, c;
    __host__ __device__ void init(int M, int N, int G_, int c_) { nM = M / BM; nN = N / BM; nwg = nM * nN; G = G_; c = c_; }
    __host__ __device__ bool next(int i, Unit& u) const {
        const long L = (long)i * G + c; if (L >= nwg) return false;
        int wgid = (int)L; { const int q = nwg / NXCD, r = nwg % NXCD, xcd = wgid % NXCD, off = wgid / NXCD; wgid = (xcd < r ? xcd * (q + 1) : r * (q + 1) + (xcd - r) * q) + off; }
        const int nig = WGM * nN, gid = wgid / nig, fm = gid * WGM, gsz = (nM - fm) < WGM ? (nM - fm) : WGM;
        u.pm = fm + ((wgid % nig) % gsz); u.pn = (wgid % nig) / gsz; return true;
    }
    __device__ __forceinline__ void a_ready(const Unit&) const {}
    __device__ __forceinline__ void done(const Unit&) const {}
};

typedef __bf16 bf2_t __attribute__((ext_vector_type(2)));
typedef float f2_t __attribute__((ext_vector_type(2)));
__device__ __forceinline__ unsigned cvt_pk_bf16(float lo, float hi) { const f2_t v = {lo, hi}; return __builtin_bit_cast(unsigned, __builtin_convertvector(v, bf2_t)); }
template <class Epi, class Sched, bool ALIGN_EPI = false, bool SP2 = false>
__device__ __forceinline__ void gemm_phase(PG8_LAS unsigned char* lds, const Gemm g, const Sched& S, const Epi& E) {
    int tid_ = threadIdx.x; asm volatile("" : "+v"(tid_));
    const int tid = tid_, wid = __builtin_amdgcn_readfirstlane(tid >> 6), lane = tid & 63, wr = wid >> 2, wc = wid & 3, fr = lane & 15, fq = lane >> 4;
    const int K = g.K, nt = K / BK;
    unsigned voffA[2], voffB[2];
#pragma unroll
    for (int i = 0; i < 2; ++i) { int R, C; stage_rc(tid * 16 + i * 8192, R, C); const int Rb = Epi::PERM ? ((R & ~31) + perm32(R & 31)) : R;
        voffA[i] = (unsigned)(R * K + C) * 2u; voffB[i] = (unsigned)(Rb * K + C) * 2u; }
    const size_t kstep = (size_t)(BK * 2);
    const size_t hstep = (size_t)HALF * K * 2;
    const size_t tstep = 2 * hstep;
    const unsigned ldsw = (unsigned)wid * 1024u;
    const int aoff = lds_byte(wr * 64 + fr, fq * 8), boff = lds_byte(wc * 32 + fr, fq * 8);
#define PG8_SA(b, h) (((b) * 2 + (h)) * HTB)
#define PG8_SB(b, h) ((4 + (b) * 2 + (h)) * HTB)
#define PG8_STAGE(bufoff, gbase, voff) do { _Pragma("unroll") for (int _i = 0; _i < 2; ++_i) \
        __builtin_amdgcn_global_load_lds((const unsigned*)((const char*)(gbase) + (voff)[_i]), (PG8_LAS unsigned*)(lds + (bufoff) + ldsw + _i * 8192), 16, 0, 0); } while (0)
#define PG8_LDA(dst, b, h) do { _Pragma("unroll") for (int m = 0; m < 4; ++m) _Pragma("unroll") for (int k = 0; k < 2; ++k) dst[m][k] = *(const PG8_LAS bf16x8*)(lds + PG8_SA(b, h) + aoff + m * 2048 + k * 1024); } while (0)
#define PG8_LDB(dst, b, h) do { _Pragma("unroll") for (int n = 0; n < 2; ++n) _Pragma("unroll") for (int k = 0; k < 2; ++k) dst[n][k] = *(const PG8_LAS bf16x8*)(lds + PG8_SB(b, h) + boff + n * 2048 + k * 1024); } while (0)
#define PG8_MMA(ai, bj, At, Bt) do { __builtin_amdgcn_s_setprio(1); _Pragma("unroll") for (int m = 0; m < 4; ++m) _Pragma("unroll") for (int n = 0; n < 2; ++n) _Pragma("unroll") for (int k = 0; k < 2; ++k) \
        acc[ai][bj][m][n] = __builtin_amdgcn_mfma_f32_16x16x32_bf16(Bt[n][k], At[m][k], acc[ai][bj][m][n], 0, 0, 0); __builtin_amdgcn_s_setprio(0); } while (0)
#define PG8_WAIT_V(n) asm volatile("s_waitcnt vmcnt(" #n ")" ::: "memory")
#define PG8_WAIT_L(n) asm volatile("s_waitcnt lgkmcnt(" #n ")" ::: "memory")
#define PG8_BAR __builtin_amdgcn_s_barrier()
#define PG8_SCHED __builtin_amdgcn_sched_barrier(0)
    Unit cur, nxt; int ui = 0;
    if (!S.next(0, cur)) return;
    f32x4 acc[2][2][4][2];
#pragma unroll
    for (int a = 0; a < 2; ++a)
#pragma unroll
        for (int b = 0; b < 2; ++b)
#pragma unroll
            for (int m = 0; m < 4; ++m)
#pragma unroll
                for (int n = 0; n < 2; ++n) acc[a][b][m][n] = (f32x4){0.f, 0.f, 0.f, 0.f};
    bf16x8 At[4][2], B0[2][2], B1[2][2];
    const char* cA = (const char*)g.A + (size_t)cur.pm * tstep; const char* cB = (const char*)g.Bt + (size_t)cur.pn * tstep;
    S.a_ready(cur);
    if constexpr (SP2) {
        PG8_STAGE(PG8_SB(0, 0), cB, voffB); PG8_STAGE(PG8_SB(0, 1), cB + hstep, voffB); PG8_STAGE(PG8_SA(0, 0), cA, voffA); PG8_STAGE(PG8_SA(0, 1), cA + hstep, voffA);
        if (wr == 1) PG8_BAR;
        PG8_WAIT_V(2); PG8_BAR;
        PG8_STAGE(PG8_SB(1, 0), cB + kstep, voffB); PG8_STAGE(PG8_SA(1, 0), cA + kstep, voffA); PG8_STAGE(PG8_SB(1, 1), cB + hstep + kstep, voffB);
        PG8_WAIT_V(6); PG8_BAR;
    } else {
        PG8_STAGE(PG8_SB(0, 0), cB, voffB); PG8_STAGE(PG8_SA(0, 0), cA, voffA); PG8_STAGE(PG8_SB(0, 1), cB + hstep, voffB); PG8_STAGE(PG8_SA(0, 1), cA + hstep, voffA);
        if (wr == 1) PG8_BAR;
        PG8_WAIT_V(4); PG8_BAR;
        PG8_STAGE(PG8_SB(1, 0), cB + kstep, voffB); PG8_STAGE(PG8_SA(1, 0), cA + kstep, voffA); PG8_STAGE(PG8_SB(1, 1), cB + hstep + kstep, voffB);
        PG8_WAIT_V(6); PG8_BAR;
    }
    for (;;) {
        const bool has_next = S.next(ui + 1, nxt);
        const char* nA = has_next ? (const char*)g.A + (size_t)nxt.pm * tstep : cA; const char* nB = has_next ? (const char*)g.Bt + (size_t)nxt.pn * tstep : cB;
        for (int t = 0; t < nt; t += 2) {
            const bool last = (t == nt - 2);
            const char* a1 = cA + (size_t)(t + 1) * kstep;
            const char* a2 = last ? nA : cA + (size_t)(t + 2) * kstep; const char* b2 = last ? nB : cB + (size_t)(t + 2) * kstep;
            const char* a3 = a2 + kstep; const char* b3 = b2 + kstep;
            if (last && has_next) S.a_ready(nxt);
            if constexpr (SP2) {
            PG8_LDB(B0, 0, 0); PG8_LDB(B1, 0, 1); PG8_SCHED; PG8_LDA(At, 0, 0); PG8_STAGE(PG8_SA(1, 1), a1 + hstep, voffA);
            PG8_WAIT_V(8); PG8_WAIT_L(0); PG8_BAR; PG8_MMA(0, 0, At, B0); PG8_MMA(0, 1, At, B1); PG8_BAR; PG8_SCHED;
            PG8_LDA(At, 0, 1); PG8_STAGE(PG8_SB(0, 0), b2, voffB); PG8_STAGE(PG8_SB(0, 1), b2 + hstep, voffB); PG8_STAGE(PG8_SA(0, 0), a2, voffA);
            PG8_WAIT_V(8); PG8_WAIT_L(0); PG8_BAR; PG8_MMA(1, 0, At, B0); PG8_MMA(1, 1, At, B1); PG8_BAR; PG8_SCHED;
            PG8_LDB(B0, 1, 0); PG8_LDB(B1, 1, 1); PG8_SCHED; PG8_LDA(At, 1, 0); PG8_STAGE(PG8_SA(0, 1), a2 + hstep, voffA);
            PG8_WAIT_V(8); PG8_WAIT_L(0); PG8_BAR; PG8_MMA(0, 0, At, B0); PG8_MMA(0, 1, At, B1); PG8_BAR; PG8_SCHED;
            PG8_LDA(At, 1, 1); PG8_STAGE(PG8_SB(1, 0), b3, voffB); PG8_STAGE(PG8_SB(1, 1), b3 + hstep, voffB); PG8_STAGE(PG8_SA(1, 0), a3, voffA);
            PG8_WAIT_V(8); PG8_WAIT_L(0); PG8_BAR; PG8_MMA(1, 0, At, B0); PG8_MMA(1, 1, At, B1); PG8_BAR; PG8_SCHED;
            } else {
            PG8_LDB(B0, 0, 0); PG8_SCHED; PG8_LDA(At, 0, 0); PG8_STAGE(PG8_SA(1, 1), a1 + hstep, voffA);
            PG8_WAIT_L(8); PG8_BAR; PG8_WAIT_L(0); PG8_MMA(0, 0, At, B0); PG8_BAR; PG8_SCHED;
            PG8_LDB(B1, 0, 1); PG8_STAGE(PG8_SB(0, 0), b2, voffB);
            PG8_BAR; PG8_WAIT_L(0); PG8_MMA(0, 1, At, B1); PG8_BAR;
            PG8_LDA(At, 0, 1); PG8_STAGE(PG8_SA(0, 0), a2, voffA);
            PG8_BAR; PG8_WAIT_L(0); PG8_MMA(1, 0, At, B0); PG8_BAR; PG8_SCHED;
            PG8_STAGE(PG8_SB(0, 1), b2 + hstep, voffB);
            PG8_WAIT_V(6); PG8_BAR; PG8_MMA(1, 1, At, B1); PG8_BAR;
            PG8_LDB(B0, 1, 0); PG8_SCHED; PG8_LDA(At, 1, 0); PG8_STAGE(PG8_SA(0, 1), a2 + hstep, voffA);
            PG8_WAIT_L(8); PG8_BAR; PG8_WAIT_L(0); PG8_MMA(0, 0, At, B0); PG8_BAR; PG8_SCHED;
            PG8_LDB(B1, 1, 1); PG8_STAGE(PG8_SB(1, 0), b3, voffB);
            PG8_BAR; PG8_WAIT_L(0); PG8_MMA(0, 1, At, B1); PG8_BAR;
            PG8_LDA(At, 1, 1); PG8_STAGE(PG8_SA(1, 0), a3, voffA);
            PG8_BAR; PG8_WAIT_L(0); PG8_MMA(1, 0, At, B0); PG8_BAR; PG8_SCHED;
            PG8_STAGE(PG8_SB(1, 1), b3 + hstep, voffB);
            PG8_WAIT_V(6); PG8_BAR; PG8_MMA(1, 1, At, B1); PG8_BAR;
            }
        }
        if constexpr (ALIGN_EPI) { if (wr == 0) PG8_BAR; }
#ifndef EPI_REP
#define EPI_REP 1
#endif
        if constexpr (!Epi::AFTER_DRAIN) { E(acc, cur, wr, wc, fr, fq); if constexpr (Epi::REPEATABLE && EPI_REP == 2) { asm volatile("" ::: "memory"); E(acc, cur, wr, wc, fr, fq); } S.done(cur); }
        if (!has_next) break;
        if (!E.keep_acc(cur)) {
#pragma unroll
        for (int a = 0; a < 2; ++a)
#pragma unroll
            for (int b = 0; b < 2; ++b)
#pragma unroll
                for (int m = 0; m < 4; ++m)
#pragma unroll
                    for (int n = 0; n < 2; ++n) acc[a][b][m][n] = (f32x4){0.f, 0.f, 0.f, 0.f};
        }
        cur = nxt; cA = nA; cB = nB; ++ui;
        if constexpr (ALIGN_EPI) { if (wr == 1) PG8_BAR; }
    }
    PG8_WAIT_V(0);
    if constexpr (!ALIGN_EPI) { if (wr == 0) PG8_BAR; }
    PG8_BAR;
    if constexpr (Epi::AFTER_DRAIN) { E.fused(acc, cur, wr, wc, fr, fq, lds, wid, lane); S.done(cur); }
#undef PG8_SA
#undef PG8_SB
#undef PG8_STAGE
#undef PG8_LDA
#undef PG8_LDB
#undef PG8_MMA
#undef PG8_WAIT_V
#undef PG8_WAIT_L
#undef PG8_BAR
#undef PG8_SCHED
}
}
#define GAS __attribute__((address_space(1)))
#define LAS __attribute__((address_space(3)))
typedef unsigned short bf16;
typedef unsigned v4u __attribute__((ext_vector_type(4)));
typedef float f32x4 __attribute__((ext_vector_type(4)));
typedef short bf16x8 __attribute__((ext_vector_type(8)));
typedef GAS unsigned gu32;
typedef GAS unsigned long long gu64;
#define RLX_AGENT __ATOMIC_RELAXED, __HIP_MEMORY_SCOPE_AGENT
#define LDS_WAIT() asm volatile("s_waitcnt lgkmcnt(0)" ::: "memory")
#define VM_WAIT() asm volatile("s_waitcnt vmcnt(0)" ::: "memory")
__device__ __forceinline__ unsigned long long rt() { return __builtin_amdgcn_s_memrealtime(); }
__device__ __forceinline__ unsigned f2bf(float f) { unsigned u = __builtin_bit_cast(unsigned, f); return (u + 0x7fffu + ((u >> 16) & 1u)) >> 16; }
__device__ __forceinline__ unsigned pk2(float lo, float hi) { return f2bf(lo) | (f2bf(hi) << 16); }
#define XB_TMO      128
#define XB_XCNT(j)  (256  + 64 * (j))
#define XB_XSUB(j)  (1280 + 64 * (j))
#define XB_XGEN(j)  (2304 + 64 * (j))
#define XB_TOP      3328
#define XB_TOPGEN   3392
#define XCD_BAR_WORDS 3456
#define XB_SPIN_CAP (1u << 18)

__device__ __forceinline__ unsigned xb_ld(unsigned* p)              { return __hip_atomic_load(p, __ATOMIC_RELAXED, __HIP_MEMORY_SCOPE_AGENT); }
__device__ __forceinline__ unsigned xb_add(unsigned* p, unsigned v) { return __hip_atomic_fetch_add(p, v, __ATOMIC_RELAXED, __HIP_MEMORY_SCOPE_AGENT); }
__device__ __forceinline__ unsigned xb_xcc_id() { return (unsigned)__builtin_amdgcn_s_getreg((3 << 11) | 20) & 0xFu; }
#define XB_SPIN(cond, bar) do { unsigned _sp = 0; while (cond) { __builtin_amdgcn_s_sleep(1); \
    if ((++_sp & 255u) == 0u) { if (xb_ld(&(bar)[XB_TMO])) break; if (_sp > XB_SPIN_CAP) { atomicAdd(&(bar)[XB_TMO], 1u); break; } } } } while (0)

struct XcdBarrier {
    unsigned* bar; unsigned x;
    volatile LAS unsigned* st;
};

__device__ __forceinline__ XcdBarrier xcd_barrier_post(unsigned* bar, volatile LAS unsigned* st) {
    XcdBarrier b; b.bar = bar; b.x = xb_xcc_id(); b.st = st;
    if (threadIdx.x == 0) (void)xb_add(&bar[XB_XCNT(b.x)], 1u);
    return b;
}
__device__ __forceinline__ void xcd_barrier_complete(unsigned* bar, unsigned x, unsigned& nloc, unsigned& nx) {
    const unsigned G = gridDim.x * gridDim.y * gridDim.z;
    unsigned sum, cnt, mine, sp = 0u;
    for (;;) {
        sum = 0u; cnt = 0u; mine = 0u;
#pragma unroll
        for (unsigned j = 0; j < 16; ++j) { const unsigned c = xb_ld(&bar[XB_XCNT(j)]); sum += c; cnt += (c > 0u) ? 1u : 0u; mine = (j == x) ? c : mine; }
        if (sum == G) break;
        __builtin_amdgcn_s_sleep(1);
        if ((++sp & 255u) == 0u) { if (xb_ld(&bar[XB_TMO])) break; if (sp > XB_SPIN_CAP) { atomicAdd(&bar[XB_TMO], 1u); break; } }
    }
    nloc = mine > 0u ? mine : 1u; nx = cnt > 0u ? cnt : 1u;
}

__device__ __forceinline__ void xcd_barrier(const XcdBarrier& b) {
    asm volatile("s_waitcnt vmcnt(0)" ::: "memory");
    __syncthreads();
    if (threadIdx.x == 0) {
        unsigned* bar = b.bar; asm volatile("" : "+s"(bar));
        __builtin_amdgcn_s_waitcnt(0);
        unsigned nloc = b.st[0], nx = b.st[1];
        if (nloc == 0u) { xcd_barrier_complete(bar, b.x, nloc, nx); b.st[0] = nloc; b.st[1] = nx; }
        const unsigned old = xb_add(&bar[XB_XSUB(b.x)], 1u);
        const unsigned gen = old / nloc;
        if (old + 1u == (gen + 1u) * nloc) {
            __builtin_amdgcn_fence(__ATOMIC_RELEASE, "agent");
            asm volatile("s_waitcnt vmcnt(0)" ::: "memory");
            const unsigned og = xb_add(&bar[XB_TOP], 1u);
            const unsigned tg = og / nx;
            if (og + 1u == (tg + 1u) * nx) xb_add(&bar[XB_TOPGEN], 1u);
            else XB_SPIN(xb_ld(&bar[XB_TOPGEN]) == tg, bar);
            __builtin_amdgcn_fence(__ATOMIC_ACQUIRE, "agent");
            xb_add(&bar[XB_XGEN(b.x)], 1u);
            asm volatile("s_waitcnt vmcnt(0)" ::: "memory");
        } else {
            XB_SPIN(xb_ld(&bar[XB_XGEN(b.x)]) == gen, bar);
            __builtin_amdgcn_fence(__ATOMIC_ACQUIRE, "agent");
            asm volatile("s_waitcnt vmcnt(0)" ::: "memory");
        }
    }
    __syncthreads();
}

constexpr int BATCH = 8, SEQ = 4096, DM = 1024, TOK = BATCH * SEQ, DEPTH = 2;
constexpr int DIN = 5572, NIN = 5632;
constexpr int NH = 8, HD = 64, AW = 512;
constexpr float EPS = 1e-6f;
constexpr float LOG2E = 1.4426950408889634f;
constexpr float C2 = 0.125f * LOG2E;
constexpr int NWAVES = 8;
constexpr int NPHASE = 1 + 5 * DEPTH;

constexpr size_t MiB = 1u << 20;
constexpr size_t WS_CTL = 0, CTL_ZERO_BYTES = 1 * MiB;
constexpr size_t WS_WIN = 1 * MiB;
constexpr size_t WS_WBR = 23 * MiB;
constexpr size_t WS_WOUT = 27 * MiB;
constexpr size_t WS_RSS = 31 * MiB;
constexpr size_t WS_KMP = 33 * MiB;
constexpr size_t WS_WI = 34 * MiB;
constexpr size_t WS_KB = 35 * MiB, WS_VB = 39 * MiB, WS_KI = 43 * MiB;
constexpr size_t WS_QI = 47 * MiB;
constexpr size_t WS_BM = 63 * MiB;
constexpr size_t WS_KMH = 79 * MiB, WS_KML = 79 * MiB + 262144;
constexpr size_t WS_XB = 80 * MiB;
constexpr size_t WS_QA = 144 * MiB, WS_KA = 176 * MiB, WS_VA = 208 * MiB, WS_SGA = 240 * MiB, WS_QB = 272 * MiB, WS_SGB = 304 * MiB;
constexpr size_t WS_TMP = 144 * MiB;
constexpr size_t WS_SMA = 336 * MiB, WS_SMB = 400 * MiB;
constexpr size_t WS_SL0 = 464 * MiB, WS_SL1A = 496 * MiB;
constexpr size_t WS_LST = WS_RSS;
constexpr size_t WS_LS = WS_KI;
constexpr size_t WS_END = 512 * MiB;
constexpr int CW_MCNT = 16384, CW_MTKT = 20480;
__host__ __device__ __forceinline__ int lst_off(int n) { return 256 * (15 * n - (n * (n - 1)) / 2); }
constexpr int CW_BAR = 4096;

constexpr int RING_BYTES = 131072;
constexpr int LDSCTL_OFF = RING_BYTES + 28672, MISC_OFF = LDSCTL_OFF + 320;
constexpr int LDS_BYTES = 163840;
static_assert(MISC_OFF + 128 <= LDS_BYTES, "LDS map");

typedef unsigned long long u64;
typedef unsigned u32x4v __attribute__((ext_vector_type(4)));
typedef unsigned u32x2v __attribute__((ext_vector_type(2)));

__device__ __forceinline__ float bf2f(unsigned short v) { return __uint_as_float(((unsigned)v) << 16); }
__device__ __forceinline__ float bflo(unsigned w) { return __uint_as_float(w << 16); }
__device__ __forceinline__ float bfhi(unsigned w) { return __uint_as_float(w & 0xffff0000u); }
__device__ __forceinline__ float sigmoidf_(float v) { return __builtin_amdgcn_rcpf(1.0f + __builtin_amdgcn_exp2f(-v * LOG2E)); }

typedef __attribute__((address_space(4))) const char* kaptr_t;
__device__ __forceinline__ const float* in_ptr(int i) { kaptr_t ka = (kaptr_t)__builtin_amdgcn_kernarg_segment_ptr(); asm volatile("" : "+s"(ka)); return *(const float* const __attribute__((address_space(4)))*)(ka + 8 * i); }
#define PHASE_TID() int tid_o = threadIdx.x; asm volatile("" : "+v"(tid_o)); const int ptid = tid_o, plane = tid_o & 63
struct Frame {
    LAS unsigned char* lds;
    volatile LAS unsigned* MISC;
    gu32* ctl;
    int wave, vcu, G;
    unsigned char* ws;
    float* out;
};

__host__ __device__ __forceinline__ int win_src(int n0, int& nvalid) {
    const int pn = n0 >> 8, c = n0 & 255, bj = c >> 7, wc = (c >> 5) & 3; nvalid = 32;
    if (pn < 2) return 0 + 64 * (4 * pn + wc) + 32 * bj;
    if (pn < 4) return 512 + 64 * (4 * (pn - 2) + wc) + 32 * bj;
    if (pn < 6) return 1024 + 256 * (pn - 4) + c;
    if (pn < 8) return 1536 + 256 * (pn - 6) + c;
    if (pn < 10) return 2048 + 64 * (4 * (pn - 8) + wc) + 32 * bj;
    if (pn == 10) {
        if (wc == 0) return 2560 + 32 * bj;
        if (wc == 1) return 2624 + 32 * bj;
        if (wc == 2) return 3456 + 32 * bj;
        if (bj == 0) { nvalid = 4; return 3520; }
        nvalid = 0; return 0;
    }
    if (pn == 11) return 3200 + c;
    if (pn < 14) return 2688 + 256 * (pn - 12) + c;
    if (pn < 18) return 3524 + 256 * (pn - 14) + c;
    return 4548 + 256 * (pn - 18) + c;
}

__device__ __forceinline__ float wave_sum(float v) {
#pragma unroll
    for (int o = 1; o < 64; o <<= 1) v += __shfl_xor(v, o);
    return v;
}
__device__ __forceinline__ void tr_item(const float* W, int ldw, int src0, int nvalid, const float* gk, bf16* WT, int K, int row0, int k0, LAS float* scr, int lane) {
    const int j4 = 4 * (lane & 7);
    f32x4 vv[8]; float gs[8];
#pragma unroll
    for (int i = 0; i < 8; ++i) { const int kk = 8 * i + (lane >> 3); vv[i] = *(const f32x4*)(W + (size_t)(k0 + kk) * ldw + src0 + j4); gs[i] = gk ? gk[k0 + kk] : 1.0f; }
    __builtin_amdgcn_sched_barrier(0);
    const bool ok = j4 < nvalid;
#pragma unroll
    for (int i = 0; i < 8; ++i) { const int kk = 8 * i + (lane >> 3); const float gm = ok ? gs[i] : 0.f; const f32x4 v = vv[i] * gm;
        scr[kk * 33 + j4] = v[0]; scr[kk * 33 + j4 + 1] = v[1]; scr[kk * 33 + j4 + 2] = v[2]; scr[kk * 33 + j4 + 3] = v[3]; }
    LDS_WAIT(); asm volatile("" ::: "memory");
    const int c = lane & 7;
#pragma unroll
    for (int jj = 0; jj < 4; ++jj) { const int n = (lane >> 3) + 8 * jj; const LAS float* s = scr + (8 * c) * 33 + n;
        v4u o; o.x = pk2(s[0 * 33], s[1 * 33]); o.y = pk2(s[2 * 33], s[3 * 33]); o.z = pk2(s[4 * 33], s[5 * 33]); o.w = pk2(s[6 * 33], s[7 * 33]);
        *(GAS v4u*)(WT + (size_t)(row0 + n) * K + k0 + 8 * c) = o; }
    LDS_WAIT(); asm volatile("" ::: "memory");
}
__device__ __forceinline__ void p0_prologue(Frame& F) {
    PHASE_TID();
    LAS float* scr = (LAS float*)(F.lds + F.wave * 16384);
    const int gw = F.vcu * NWAVES + F.wave, NGW = F.G * NWAVES;
    constexpr int I_IN = (DM / 64) * (NIN / 32), I_BR = (AW / 64) * (DM / 32), I_OUT = (DM / 64) * (DM / 32);
    constexpr int PER_L = I_IN + 2 * I_BR + I_OUT;
    for (int it = gw; it < DEPTH * PER_L; it += NGW) {
        const int l = it / PER_L; int r = it % PER_L;
        if (r < I_IN) { const int kb = r / (NIN / 32), nb = r % (NIN / 32); int nvalid; const int src0 = win_src(32 * nb, nvalid);
            tr_item(in_ptr(2) + (size_t)l * DM * DIN, DIN, src0, nvalid, in_ptr(1) + l * DM, (bf16*)(F.ws + WS_WIN) + (size_t)l * NIN * DM, DM, 32 * nb, 64 * kb, scr, plane); continue; }
        r -= I_IN;
        if (r < 2 * I_BR) { const int which = r / I_BR; r %= I_BR; const int kb = r / (DM / 32), nb = r % (DM / 32);
            tr_item((which ? in_ptr(8) : in_ptr(7)) + (size_t)l * AW * DM, DM, 32 * nb, 32, nullptr, (bf16*)(F.ws + WS_WBR) + (size_t)l * 2048 * AW, AW, which * 1024 + 32 * nb, 64 * kb, scr, plane); continue; }
        r -= 2 * I_BR;
        { const int kb = r / (DM / 32), nb = r % (DM / 32);
            tr_item(in_ptr(9) + (size_t)l * DM * DM, DM, 32 * nb, 32, nullptr, (bf16*)(F.ws + WS_WOUT) + (size_t)l * DM * DM, DM, 32 * nb, 64 * kb, scr, plane); }
    }
    const float* x = in_ptr(0); bf16* XB = (bf16*)(F.ws + WS_XB); float* RSS = (float*)(F.ws + WS_RSS);
    for (int m0 = gw; m0 < TOK; m0 += 2 * NGW) {
        const int m1 = (m0 + NGW < TOK) ? m0 + NGW : m0;
        f32x4 v[2][4];
#pragma unroll
        for (int r = 0; r < 2; ++r) { const GAS f32x4* xr = (const GAS f32x4*)(x + (size_t)(r ? m1 : m0) * DM) + plane;
#pragma unroll
            for (int j = 0; j < 4; ++j) v[r][j] = xr[64 * j]; }
        __builtin_amdgcn_sched_barrier(0);
#pragma unroll
        for (int r = 0; r < 2; ++r) { const int m = r ? m1 : m0; float s = 0.f;
#pragma unroll
            for (int j = 0; j < 4; ++j) s += (v[r][j].x * v[r][j].x + v[r][j].y * v[r][j].y) + (v[r][j].z * v[r][j].z + v[r][j].w * v[r][j].w);
            s = wave_sum(s);
            GAS u64* o8 = (GAS u64*)(XB + (size_t)m * DM) + plane;
#pragma unroll
            for (int j = 0; j < 4; ++j) o8[64 * j] = (u64)pk2(v[r][j].x, v[r][j].y) | ((u64)pk2(v[r][j].z, v[r][j].w) << 32);
            if (plane < 16) RSS[(size_t)m * 16 + plane] = (plane == 0) ? s : 0.f; }
    }
}

namespace pg8 {
__device__ __forceinline__ void row_rs8(const float* rss, int row0, int fq, float (&rsv)[2][4]) {
    f32x4 a[2][4];
#pragma unroll
    for (int ai = 0; ai < 2; ++ai)
#pragma unroll
        for (int m = 0; m < 4; ++m) a[ai][m] = *(const f32x4*)(rss + (size_t)(row0 + ai * HALF + m * 16) * 16 + 4 * fq);
    __builtin_amdgcn_sched_barrier(0);
#pragma unroll
    for (int ai = 0; ai < 2; ++ai)
#pragma unroll
        for (int m = 0; m < 4; ++m) { float s = (a[ai][m][0] + a[ai][m][1]) + (a[ai][m][2] + a[ai][m][3]);
            s += __shfl_xor(s, 16); s += __shfl_xor(s, 32); rsv[ai][m] = __builtin_amdgcn_rsqf(s * (1.0f / DM) + EPS); }
}
__device__ __forceinline__ float row_rs(const float* rss, int row, int fq) {
    const f32x4 a = *(const f32x4*)(rss + (size_t)row * 16 + 4 * fq);
    float s = (a[0] + a[1]) + (a[2] + a[3]);
    s += __shfl_xor(s, 16); s += __shfl_xor(s, 32);
    return __builtin_amdgcn_rsqf(s * (1.0f / DM) + EPS);
}
__device__ __forceinline__ u32x4 pack8(const f32x4 o0, const f32x4 o1) { u32x4 w; w.x = cvt_pk_bf16(o0[0], o0[1]); w.y = cvt_pk_bf16(o0[2], o0[3]); w.z = cvt_pk_bf16(o1[0], o1[1]); w.w = cvt_pk_bf16(o1[2], o1[3]); return w; }
struct EpiIn {
    static constexpr bool PERM = true, AFTER_DRAIN = false, REPEATABLE = true;
    __device__ __forceinline__ bool keep_acc(const Unit&) const { return false; }
    const float* rss; const float *qna, *kna, *qnb, *knb;
    bf16_t *QA, *KA, *VA, *SGA, *QB, *SGB, *KB, *VB, *KI, *QI, *SMA, *SMB; float* WI; float* KMP;
    __device__ __forceinline__ void norm_rows(const f32x4 (&acc)[2][2][4][2], const Unit& u, int wr, int fr, int fq, const float* g, float oscale, bf16_t* dst, int ld, int coloff, float* kmp) const {
        f32x4 gv[2][2];
#pragma unroll
        for (int bj = 0; bj < 2; ++bj)
#pragma unroll
            for (int n = 0; n < 2; ++n) gv[bj][n] = *(const f32x4*)(g + 32 * bj + 8 * fq + 4 * n) * oscale;
        f32x4 cs[2][2];
#pragma unroll
        for (int bj = 0; bj < 2; ++bj)
#pragma unroll
            for (int n = 0; n < 2; ++n) cs[bj][n] = (f32x4){0.f, 0.f, 0.f, 0.f};
        float rsv[2][4]; row_rs8(rss, u.pm * BM + wr * 64 + fr, fq, rsv);
#pragma unroll
        for (int ai = 0; ai < 2; ++ai)
#pragma unroll
            for (int m = 0; m < 4; ++m) {
                const int row = u.pm * BM + ai * HALF + wr * 64 + m * 16 + fr; const float rs = rsv[ai][m];
                float sq = 0.f;
#pragma unroll
                for (int bj = 0; bj < 2; ++bj)
#pragma unroll
                    for (int n = 0; n < 2; ++n) { const f32x4 t = acc[ai][bj][m][n]; sq += (t[0] * t[0] + t[1] * t[1]) + (t[2] * t[2] + t[3] * t[3]); }
                sq += __shfl_xor(sq, 16); sq += __shfl_xor(sq, 32);
                const float sc = rs * __builtin_amdgcn_rsqf(sq * rs * rs * (1.0f / 64.0f) + EPS);
#pragma unroll
                for (int bj = 0; bj < 2; ++bj) {
                    const f32x4 o0 = acc[ai][bj][m][0] * sc * gv[bj][0], o1 = acc[ai][bj][m][1] * sc * gv[bj][1];
                    cs[bj][0] += o0; cs[bj][1] += o1;
                    *(u32x4*)(dst + (size_t)row * ld + coloff + 32 * bj + 8 * fq) = pack8(o0, o1); }
                asm volatile("" ::: "memory");
            }
        if (kmp) {
#pragma unroll
            for (int bj = 0; bj < 2; ++bj)
#pragma unroll
                for (int n = 0; n < 2; ++n) { f32x4 t = cs[bj][n];
#pragma unroll
                    for (int o = 1; o < 16; o <<= 1) { t[0] += __shfl_xor(t[0], o); t[1] += __shfl_xor(t[1], o); t[2] += __shfl_xor(t[2], o); t[3] += __shfl_xor(t[3], o); }
                    if (fr == 0) *(f32x4*)(kmp + 32 * bj + 8 * fq + 4 * n) = t; }
        }
    }
    template <int KIND> __device__ __forceinline__ void plain_rows_k(const f32x4 (&acc)[2][2][4][2], const Unit& u, int wr, int fr, int fq, bf16_t* dst, int ld, int col0, int bjs, float* wi) const {
        float rsv[2][4]; row_rs8(rss, u.pm * BM + wr * 64 + fr, fq, rsv);
#pragma unroll
        for (int ai = 0; ai < 2; ++ai)
#pragma unroll
            for (int m = 0; m < 4; ++m) {
                const int row = u.pm * BM + ai * HALF + wr * 64 + m * 16 + fr; const float rs = rsv[ai][m], rsn = -LOG2E * rs;
                if (KIND == 0 && wi) { if (fq == 0) *(f32x4*)(wi + (size_t)row * 4) = acc[ai][0][m][0] * rs; }
                else {
#pragma unroll
                for (int bj = 0; bj < 2; ++bj) { f32x4 o[2];
#pragma unroll
                    for (int n = 0; n < 2; ++n) { const f32x4 a = acc[ai][bj][m][n];
                        if (KIND == 0) o[n] = a * rs;
                        else { const f32x4 t = a * rsn; f32x4 e;
#pragma unroll
                            for (int i = 0; i < 4; ++i) e[i] = __builtin_amdgcn_exp2f(t[i]);
                            e = e + 1.0f; f32x4 sg;
#pragma unroll
                            for (int i = 0; i < 4; ++i) sg[i] = __builtin_amdgcn_rcpf(e[i]);
                            if (KIND == 1) o[n] = sg; else o[n] = (a * rs) * sg; } }
                    *(u32x4*)(dst + (size_t)row * ld + col0 + bj * bjs) = pack8(o[0], o[1]); }
                }
                asm volatile("" ::: "memory");
            }
    }
    __device__ __forceinline__ void plain_rows(const f32x4 (&acc)[2][2][4][2], const Unit& u, int wr, int fr, int fq, bf16_t* dst, int ld, int col0, int bjs, int kind, float* wi) const {
        if (kind == 1) plain_rows_k<1>(acc, u, wr, fr, fq, dst, ld, col0, bjs, nullptr);
        else if (kind == 2) plain_rows_k<2>(acc, u, wr, fr, fq, dst, ld, col0, bjs, nullptr);
        else plain_rows_k<0>(acc, u, wr, fr, fq, dst, ld, col0, bjs, wi);
    }
    __device__ __forceinline__ void operator()(const f32x4 (&acc)[2][2][4][2], const Unit& u, int wr, int wc, int fr_, int fq_) const {
        int fr = fr_, fq = fq_; asm volatile("" : "+v"(fr), "+v"(fq));
        const int pn = u.pn; const int cid = wc * 32 + 8 * fq;
        bool isnorm = false; bf16_t* dst; int ld = AW, col0, bjs = HALF; const float* g = qna; float osc = 1.0f; float* kmp = nullptr; int kind = 0; float* wi = nullptr;
        if (pn < 2) { isnorm = true; g = qna; osc = C2; dst = QA; col0 = 64 * (4 * pn + wc); }
        else if (pn < 4) { isnorm = true; g = kna; dst = KA; const int h = 4 * (pn - 2) + wc; col0 = 64 * h; kmp = KMP + ((((size_t)(u.pm >> 4) * 16 + (u.pm & 15)) * 8 + h) * 2 + wr) * 64; }
        else if (pn < 6) { dst = VA; col0 = 256 * (pn - 4) + cid; }
        else if (pn < 8) { dst = SGA; col0 = 256 * (pn - 6) + cid; kind = 2; }
        else if (pn < 10) { isnorm = true; g = qnb; osc = C2; dst = QB; col0 = 64 * (4 * (pn - 8) + wc); }
        else if (pn == 10) { ld = 64; bjs = 32; col0 = 8 * fq; dst = KI;
            if (wc == 0) { isnorm = true; g = knb; dst = KB; col0 = 0; } else if (wc == 1) { dst = VB; } else if (wc == 3) { wi = WI; } }
        else if (pn == 11) { dst = QI; ld = 256; col0 = cid; }
        else if (pn < 14) { dst = SGB; col0 = 256 * (pn - 12) + cid; kind = 2; }
        else if (pn < 18) { dst = SMA; ld = DM; col0 = 256 * (pn - 14) + cid; kind = 1; }
        else { dst = SMB; ld = DM; col0 = 256 * (pn - 18) + cid; kind = 1; }
        if (isnorm) norm_rows(acc, u, wr, fr, fq, g, osc, dst, ld, col0, kmp);
        else plain_rows(acc, u, wr, fr, fq, dst, ld, col0, bjs, kind, wi);
    }
};
#ifndef EPO_MB
#define EPO_MB 4
#endif
#ifndef EPM_MB
#define EPM_MB 4
#endif
struct EpiMerge {
    static constexpr bool PERM = true, AFTER_DRAIN = false, REPEATABLE = false;
    const bf16_t* SMA; bf16_t* SMB;
    __device__ __forceinline__ bool keep_acc(const Unit& u) const { return u.pm < 128; }
    __device__ __forceinline__ void operator()(f32x4 (&acc)[2][2][4][2], const Unit& u, int wr, int wc, int fr, int fq) const {
        const bool partb = u.pm >= 128; const int pm = partb ? u.pm - 128 : u.pm, pn = partb ? u.pn - 4 : u.pn;
        const bf16_t* PA = partb ? (const bf16_t*)SMB : SMA;
#define PG8_BF8_TO_F(sg, s0, s1) const f32x4 s0 = (f32x4){__uint_as_float(sg.x << 16), __uint_as_float(sg.x & 0xffff0000u), __uint_as_float(sg.y << 16), __uint_as_float(sg.y & 0xffff0000u)}, \
                                              s1 = (f32x4){__uint_as_float(sg.z << 16), __uint_as_float(sg.z & 0xffff0000u), __uint_as_float(sg.w << 16), __uint_as_float(sg.w & 0xffff0000u)}
#pragma unroll
        for (int aim = 0; aim < 8; aim += EPM_MB) { u32x4 gb[EPM_MB][2], ga[EPM_MB][2];
#pragma unroll
            for (int mm = 0; mm < EPM_MB; ++mm)
#pragma unroll
                for (int bj = 0; bj < 2; ++bj) { const int ai = (aim + mm) >> 2, m = (aim + mm) & 3; const size_t off = (size_t)(pm * BM + ai * HALF + wr * 64 + m * 16 + fr) * DM + pn * BM + bj * HALF + wc * 32 + 8 * fq;
                    gb[mm][bj] = *(const u32x4*)(SMB + off); ga[mm][bj] = *(const u32x4*)(PA + off); }
            asm volatile("" ::: "memory");
#pragma unroll
            for (int mm = 0; mm < EPM_MB; ++mm)
#pragma unroll
                for (int bj = 0; bj < 2; ++bj) { const int ai = (aim + mm) >> 2, m = (aim + mm) & 3; const size_t off = (size_t)(pm * BM + ai * HALF + wr * 64 + m * 16 + fr) * DM + pn * BM + bj * HALF + wc * 32 + 8 * fq;
                    const u32x4 sg = gb[mm][bj], sa = ga[mm][bj];
                    PG8_BF8_TO_F(sg, b0, b1); PG8_BF8_TO_F(sa, a0, a1); f32x4 t0, t1;
#pragma unroll
                    for (int i = 0; i < 4; ++i) { const float r0 = a0[i] * __builtin_amdgcn_rcpf(fmaxf(b0[i], 7.9e-31f)), r1 = a1[i] * __builtin_amdgcn_rcpf(fmaxf(b1[i], 7.9e-31f)); t0[i] = partb ? b0[i] : r0; t1[i] = partb ? b1[i] : r1; }
                    acc[ai][bj][m][0] *= t0; acc[ai][bj][m][1] *= t1;
                    if (partb) { const f32x4 o0 = acc[ai][bj][m][0], o1 = acc[ai][bj][m][1];
                        u32x4 w; w.x = cvt_pk_bf16(o0[0], o0[1]); w.y = cvt_pk_bf16(o0[2], o0[3]); w.z = cvt_pk_bf16(o1[0], o1[1]); w.w = cvt_pk_bf16(o1[2], o1[3]);
                        *(u32x4*)(SMB + off) = w; } }
            asm volatile("" ::: "memory");
        }
#undef PG8_BF8_TO_F
    }
};
struct PairOrder {
    StaticOrder base;
    __device__ void init(int G_, int c_) { base.init(TOK, DM, G_, c_); }
    __device__ bool next(int i, Unit& u) const { Unit t; if (!base.next(i >> 1, t)) return false; u.pm = t.pm + (i & 1) * 128; u.pn = t.pn + (i & 1) * 4; return true; }
    __device__ __forceinline__ void a_ready(const Unit&) const {}
    __device__ __forceinline__ void done(const Unit&) const {}
};
template <bool WRITE_NEXT> struct EpiOut {
    static constexpr bool PERM = true, AFTER_DRAIN = false, REPEATABLE = false;
    __device__ __forceinline__ bool keep_acc(const Unit&) const { return false; }
    const float* xin; float* out; bf16_t* XB; float* rss;
    __device__ __forceinline__ void operator()(const f32x4 (&acc)[2][2][4][2], const Unit& u, int wr, int wc, int fr_, int fq_) const {
        int fr = fr_, fq = fq_; asm volatile("" : "+v"(fr), "+v"(fq));
#pragma unroll
        for (int aim = 0; aim < 8; aim += EPO_MB) {
            f32x4 xv[EPO_MB][2][2];
#pragma unroll
            for (int mm = 0; mm < EPO_MB; ++mm)
#pragma unroll
                for (int bj = 0; bj < 2; ++bj) { const int ai = (aim + mm) >> 2, m = (aim + mm) & 3; const size_t off = (size_t)(u.pm * BM + ai * HALF + wr * 64 + m * 16 + fr) * DM + u.pn * BM + bj * HALF + wc * 32 + 8 * fq;
                    xv[mm][bj][0] = *(const f32x4*)(xin + off); xv[mm][bj][1] = *(const f32x4*)(xin + off + 4); }
            asm volatile("" ::: "memory");
#pragma unroll
            for (int mm = 0; mm < EPO_MB; ++mm) { const int ai = (aim + mm) >> 2, m = (aim + mm) & 3; const int row = u.pm * BM + ai * HALF + wr * 64 + m * 16 + fr; float ss = 0.f;
#pragma unroll
                for (int bj = 0; bj < 2; ++bj) { const size_t off = (size_t)row * DM + u.pn * BM + bj * HALF + wc * 32 + 8 * fq;
                    const f32x4 o0 = acc[ai][bj][m][0] + xv[mm][bj][0], o1 = acc[ai][bj][m][1] + xv[mm][bj][1];
                    *(f32x4*)(out + off) = o0; *(f32x4*)(out + off + 4) = o1;
                    if (WRITE_NEXT) { ss += (o0[0] * o0[0] + o0[1] * o0[1]) + (o0[2] * o0[2] + o0[3] * o0[3]) + (o1[0] * o1[0] + o1[1] * o1[1]) + (o1[2] * o1[2] + o1[3] * o1[3]);
                        u32x4 w; w.x = cvt_pk_bf16(o0[0], o0[1]); w.y = cvt_pk_bf16(o0[2], o0[3]); w.z = cvt_pk_bf16(o1[0], o1[1]); w.w = cvt_pk_bf16(o1[2], o1[3]);
                        *(u32x4*)(XB + off) = w; } }
                if (WRITE_NEXT) { ss += __shfl_xor(ss, 16); ss += __shfl_xor(ss, 32); if (fq == 0) rss[(size_t)row * 16 + 4 * u.pn + wc] = ss; }
            }
            asm volatile("" ::: "memory");
        }
    }
};
}

__device__ __forceinline__ int rel_bucket_dev(int n) {
    if (n < 16) return n;
    int large = 16 + (int)(logf((float)n / 16.0f) / logf(8.0f) * 16.0f);
    return large < 31 ? large : 31;
}
constexpr int CW_BTM = 32768;
__device__ __forceinline__ void bias_maxima(Frame& F) {
    PHASE_TID(); const float* rb = in_ptr(10); float* BT = (float*)(F.ctl + CW_BTM);
    const int w = ptid >> 6;
    if (w < 4) { const int l = w >> 1, br = w & 1; const float* gq = in_ptr(br ? 5 : 3) + l * 64; const float* gk = in_ptr(br ? 6 : 4) + l * 64;
        float v = fabsf(gq[plane] * gk[plane]);
#pragma unroll
        for (int o = 32; o >= 1; o >>= 1) v = fmaxf(v, __shfl_xor(v, o));
        if (plane == 0) BT[w] = v; }
    else if (w == 4) {
        for (int cc = 0; cc < 8; ++cc) { float v = rb[(plane & 31) * 16 + 2 * cc + (plane >> 5)];
#pragma unroll
            for (int o = 16; o >= 1; o >>= 1) v = fmaxf(v, __shfl_xor(v, o));
            if ((plane & 31) == 0) BT[8 + 2 * cc + (plane >> 5)] = v; } }
}
__device__ __forceinline__ void build_bias_table(Frame& F, LAS float* tb, int layer, int hoff) {
    PHASE_TID(); const float* rb = in_ptr(10); const float* BT = (const float*)(F.ctl + CW_BTM);
    const float gm = BT[layer * 2 + (hoff >> 3)];
    for (int e = ptid; e < 8 * 128; e += NWAVES * 64) { const int h = e >> 7, d = e & 127;
        const float bm = BT[8 + hoff + h];
        const float M0 = 64.0f * C2 * gm + bm * LOG2E;
        tb[e] = rb[rel_bucket_dev(d) * 16 + hoff + h] * LOG2E - M0; }
}

template <int MODE>
__device__ __forceinline__ void naive_attn(Frame& F, int layer) {
    PHASE_TID();
    LAS float* tb = (LAS float*)F.lds;
    const float* gq = in_ptr(MODE == 0 ? 3 : 5) + layer * 64; const float* gk = in_ptr(MODE == 0 ? 4 : 6) + layer * 64;
    build_bias_table(F, tb, layer, MODE * 8);
    __syncthreads();
    const bf16* Q = (const bf16*)(F.ws + (MODE == 0 ? WS_QA : WS_QB));
    const bf16* K = (const bf16*)(F.ws + (MODE == 0 ? WS_KA : WS_KB));
    const bf16* V = (const bf16*)(F.ws + (MODE == 0 ? WS_VA : WS_VB));
    const bf16* SG = (const bf16*)(F.ws + (MODE == 0 ? WS_SGA : WS_SGB));
    bf16* Y = (bf16*)(F.ws + WS_XB) + (size_t)MODE * TOK * AW;
    const float* KMP = (const float*)(F.ws + WS_KMP);
    const u64* BM = (const u64*)(F.ws + WS_BM);
    constexpr int KLD = (MODE == 0) ? AW : 64;
    for (int item = blockIdx.x * (NWAVES * 64) + ptid; item < BATCH * NH * SEQ; item += F.G * NWAVES * 64) {
        const int q = item & (SEQ - 1), h = (item >> 12) & 7, b = item >> 15; const int qblk = q >> 8;
        const size_t tq = (size_t)b * SEQ + q;
        float qv[64];
        { const v4u* qp = (const v4u*)(Q + tq * AW + h * 64);
#pragma unroll
            for (int c = 0; c < 8; ++c) { const v4u w = qp[c]; qv[8 * c + 0] = bflo(w.x); qv[8 * c + 1] = bfhi(w.x); qv[8 * c + 2] = bflo(w.y); qv[8 * c + 3] = bfhi(w.y); qv[8 * c + 4] = bflo(w.z); qv[8 * c + 5] = bfhi(w.z); qv[8 * c + 6] = bflo(w.w); qv[8 * c + 7] = bfhi(w.w); } }
        unsigned selmask = 0;
        if (MODE == 0) {
            float gate[16];
#pragma unroll
            for (int n = 0; n < 16; ++n) { gate[n] = -INFINITY;
                if (n < qblk) { const float* k0 = KMP + ((((size_t)b * 16 + n) * 8 + h) * 2) * 64; float s = 0.f;
#pragma unroll
                    for (int d = 0; d < 64; ++d) s += qv[d] * ((k0[d] + k0[64 + d]) * (1.0f / 256.0f));
                    gate[n] = s; } }
            const int nsel = qblk < 3 ? qblk : 3;
            for (int r = 0; r < nsel; ++r) { float best = -INFINITY; int bi = -1;
#pragma unroll
                for (int n = 0; n < 16; ++n) { const bool ok = (n < qblk) && !((selmask >> n) & 1u) && (bi < 0 || gate[n] > best); if (ok) { best = gate[n]; bi = n; } }
                selmask |= 1u << bi; }
        }
        float acc[64];
#pragma unroll
        for (int d = 0; d < 64; ++d) acc[d] = 0.f;
        float l = 0.f;
        const int kend = (item | 63) & (SEQ - 1);
        const LAS float* tbh = tb + h * 128;
        u64 mw = 0;
        for (int k = 0; k <= kend; ++k) {
            bool allowed;
            if (MODE == 0) { const int n = k >> 8; allowed = (n == qblk) ? (k <= q) : (((selmask >> n) & 1u) != 0u && n < qblk); }
            else { if ((k & 63) == 0) mw = (k <= q) ? BM[tq * 64 + (k >> 6)] : 0ull; allowed = ((mw >> (k & 63)) & 1ull) != 0ull; }
            if (!__any(allowed)) continue;
            const size_t tk = (size_t)b * SEQ + k;
            const v4u* kp = (const v4u*)(K + tk * KLD + (MODE == 0 ? h * 64 : 0));
            float s = 0.f;
#pragma unroll
            for (int c = 0; c < 8; ++c) { const v4u w = kp[c];
                s += qv[8 * c + 0] * bflo(w.x); s += qv[8 * c + 1] * bfhi(w.x); s += qv[8 * c + 2] * bflo(w.y); s += qv[8 * c + 3] * bfhi(w.y);
                s += qv[8 * c + 4] * bflo(w.z); s += qv[8 * c + 5] * bfhi(w.z); s += qv[8 * c + 6] * bflo(w.w); s += qv[8 * c + 7] * bfhi(w.w); }
            int dist = q - k; dist = dist < 0 ? 0 : (dist > 127 ? 127 : dist);
            s += tbh[dist];
            const float p = allowed ? __builtin_amdgcn_exp2f(s) : 0.f;
            l += p;
            const v4u* vp = (const v4u*)(V + tk * KLD + (MODE == 0 ? h * 64 : 0));
#pragma unroll
            for (int c = 0; c < 8; ++c) { const v4u w = vp[c];
                acc[8 * c + 0] += p * bflo(w.x); acc[8 * c + 1] += p * bfhi(w.x); acc[8 * c + 2] += p * bflo(w.y); acc[8 * c + 3] += p * bfhi(w.y);
                acc[8 * c + 4] += p * bflo(w.z); acc[8 * c + 5] += p * bfhi(w.z); acc[8 * c + 6] += p * bflo(w.w); acc[8 * c + 7] += p * bfhi(w.w); }
        }
        const float il = 1.0f / l;
        const v4u* gp = (const v4u*)(SG + tq * AW + h * 64); v4u* yp = (v4u*)(Y + tq * AW + h * 64);
#pragma unroll
        for (int c = 0; c < 8; ++c) { const v4u g = gp[c]; v4u o;
            o.x = pk2(acc[8 * c + 0] * il * bflo(g.x), acc[8 * c + 1] * il * bfhi(g.x)); o.y = pk2(acc[8 * c + 2] * il * bflo(g.y), acc[8 * c + 3] * il * bfhi(g.y));
            o.z = pk2(acc[8 * c + 4] * il * bflo(g.z), acc[8 * c + 5] * il * bfhi(g.z)); o.w = pk2(acc[8 * c + 6] * il * bflo(g.w), acc[8 * c + 7] * il * bfhi(g.w));
            yp[c] = o; }
    }
}

typedef float f32x16 __attribute__((ext_vector_type(16)));
typedef short s16x4 __attribute__((ext_vector_type(4)));
typedef short v4i16_t __attribute__((ext_vector_type(4)));
constexpr int AT_D = 4, AT_R = AT_D + 2;
constexpr int AT_RING = 0, AT_STAGE = 16384, AT_OST = 0  , AT_TB = AT_R * AT_STAGE, AT_WS = AT_TB + 8192, AT_BM = AT_WS + 2048;
static_assert(8 * 8192 <= AT_R * AT_STAGE && AT_BM + 16384 <= LDSCTL_OFF, "attention LDS");
__device__ __forceinline__ void glds16(const void* gsrc, unsigned lds_dst) { unsigned keep;
    asm volatile("s_mov_b32 %0, m0\n\ts_mov_b32 m0, %2\n\ts_nop 0\n\tglobal_load_lds_dwordx4 %1, off\n\ts_mov_b32 m0, %0" : "=&s"(keep) : "v"(gsrc), "s"(lds_dst) : "memory"); }
#define AT_WAIT_BAR() asm volatile("s_waitcnt vmcnt(0) lgkmcnt(0)\n\ts_barrier" ::: "memory")
#define AT_WAIT_BAR_N(N) asm volatile("s_waitcnt vmcnt(%0) lgkmcnt(0)\n\ts_barrier" :: "n"(N) : "memory")
__device__ __forceinline__ int crow(int r, int hi) { return (r & 3) + 8 * (r >> 2) + 4 * hi; }
__device__ __forceinline__ unsigned cvtpk(float lo, float hi) { return pg8::cvt_pk_bf16(lo, hi); }

template <int MODE>
__device__ __forceinline__ void attn_unit(Frame& F, int b, int h_, int blk) {
    int tid_o = threadIdx.x; asm volatile("" : "+v"(tid_o));
    const int lane = tid_o & 63, r32 = lane & 31, hi = lane >> 5, wid = __builtin_amdgcn_readfirstlane(tid_o >> 6);
    constexpr int KLD = (MODE == 0) ? AW : 64;
    const int h = (MODE == 0) ? h_ : wid;
    const int q0 = (MODE == 0) ? 256 * blk + 32 * wid : 32 * blk;
    const int q = q0 + r32; const size_t tq = (size_t)b * SEQ + q;
    const int TB = (MODE == 0 && blk > 0) ? 4 * blk - 2 : 0;
    const int NT = (MODE == 0) ? (blk > 0 ? 6 : 4) : (32 * blk + 31) / 64 + 1;
    const bf16* Q = (const bf16*)(F.ws + (MODE == 0 ? WS_QA : WS_QB));
    const bf16* Kg = (const bf16*)(F.ws + (MODE == 0 ? WS_KA : WS_KB)) + (size_t)b * SEQ * KLD + (MODE == 0 ? h * 64 : 0);
    const bf16* Vg = (const bf16*)(F.ws + (MODE == 0 ? WS_VA : WS_VB)) + (size_t)b * SEQ * KLD + (MODE == 0 ? h * 64 : 0);
    const bf16* SG = (const bf16*)(F.ws + (MODE == 0 ? WS_SGA : WS_SGB));
    bf16* Y = (bf16*)(F.ws + WS_XB) + (size_t)MODE * TOK * AW;
    const u64* BM = (const u64*)(F.ws + WS_BM) + tq * 64;
    LAS unsigned char* lds = F.lds;
    const LAS float* tbh = (const LAS float*)(lds + AT_TB) + (MODE * 8 + h) * 128;
    LAS float* wsf = (LAS float*)(lds + AT_WS) + wid * 64;
    LAS float* ost = (LAS float*)(lds + AT_OST) + wid * 2048;
    const int krow_ = 8 * wid + (lane >> 3);
    const bf16* ksrc = Kg + (size_t)krow_ * KLD + 8 * ((lane & 7) ^ ((krow_ ^ (krow_ >> 3)) & 7));
    const bf16* vsrc = Vg + (size_t)(8 * wid + ((lane & 31) >> 2)) * KLD + 32 * (lane >> 5) + 8 * (lane & 3);
    const unsigned lds0 = (unsigned)(uintptr_t)lds;
#define AT_DMA(t, so) do { \
        glds16(ksrc + (size_t)((t) + TB) * 64 * KLD, (unsigned)__builtin_amdgcn_readfirstlane((int)(lds0 + AT_RING + (so) + wid * 1024))); \
        glds16(vsrc + (size_t)((t) + TB) * 64 * KLD, (unsigned)__builtin_amdgcn_readfirstlane((int)(lds0 + AT_RING + (so) + 8192 + wid * 1024))); } while (0)
#pragma unroll
    for (int i = 0; i < AT_D; ++i) AT_DMA((i < NT ? i : NT - 1), i * AT_STAGE);
    bf16x8 qr[4];
#pragma unroll
    for (int d0 = 0; d0 < 4; ++d0) qr[d0] = *(const bf16x8*)(Q + tq * AW + h * 64 + 16 * d0 + 8 * hi);
    LAS u64* bmL = (LAS u64*)(lds + AT_BM);
    if (MODE == 1) {
        const u64* BMu = (const u64*)(F.ws + WS_BM) + ((size_t)b * SEQ + q0) * 64;
#pragma unroll
        for (int ps = 0; ps < 2; ++ps) { const int it = ps * 512 + (tid_o & 511), row = it >> 5, j2 = (it & 31) * 2;
            const v4u w = *(const v4u*)(BMu + (size_t)row * 64 + j2);
            bmL[j2 * 32 + row] = (u64)w.x | ((u64)w.y << 32); bmL[(j2 + 1) * 32 + row] = (u64)w.z | ((u64)w.w << 32); }
    }
    unsigned selmask = 0;
    if (MODE == 0 && blk > 0) {
        const bf16* kmh = (const bf16*)(F.ws + WS_KMH) + ((size_t)(b * 8 + h) * 32 + r32) * 64 + 8 * hi;
        const bf16* kml = (const bf16*)(F.ws + WS_KML) + ((size_t)(b * 8 + h) * 32 + r32) * 64 + 8 * hi;
        f32x16 gg;
#pragma unroll
        for (int r = 0; r < 16; ++r) gg[r] = 0.f;
#pragma unroll
        for (int d0 = 0; d0 < 4; ++d0) {
            gg = __builtin_amdgcn_mfma_f32_32x32x16_bf16(*(const bf16x8*)(kmh + 16 * d0), qr[d0], gg, 0, 0, 0);
            gg = __builtin_amdgcn_mfma_f32_32x32x16_bf16(*(const bf16x8*)(kml + 16 * d0), qr[d0], gg, 0, 0, 0); }
        float gate[16];
#pragma unroll
        for (int r = 0; r < 8; ++r) { const float o = __shfl_xor(gg[r], 32); const int nb_ = (r & 3) + 8 * (r >> 2); gate[nb_] = hi ? o : gg[r]; gate[nb_ + 4] = hi ? gg[r] : o; }
        const int nsel = blk < 3 ? blk : 3;
        for (int r = 0; r < nsel; ++r) { float best = -INFINITY; int bi = -1;
#pragma unroll
            for (int n = 0; n < 16; ++n) { const bool ok = (n < blk) && !((selmask >> n) & 1u) && (bi < 0 || gate[n] > best); if (ok) { best = gate[n]; bi = n; } }
            selmask |= 1u << bi; }
    }
    const float cfar = tbh[127]; const float NINF = -INFINITY;
#define AT_INIT_NEAR(t, c0, c1, mw) do { \
        const int kv0_ = 64 * ((t) + TB); \
        bool sel_ = (t) < NT; \
        if (MODE == 0) { const int n_ = ((t) + TB) >> 2; sel_ = sel_ && ((n_ == blk) || (((selmask >> (n_ & 15)) & 1u) != 0u)); } \
        unsigned mlo_ = 0, mhi_ = 0; if (MODE == 1) { const u64 ms_ = (mw) >> (4 * hi); mlo_ = (unsigned)ms_; mhi_ = (unsigned)(ms_ >> 32); } \
        _Pragma("unroll") for (int r = 0; r < 16; ++r) { const int bp = (r & 3) + 8 * (r >> 2); \
            const int d0_ = q - (kv0_ + bp + 4 * hi), d1_ = d0_ - 32; \
            const float b0_ = tbh[d0_ < 0 ? 0 : (d0_ > 127 ? 127 : d0_)], b1_ = tbh[d1_ < 0 ? 0 : (d1_ > 127 ? 127 : d1_)]; \
            if (MODE == 0) { c0[r] = (sel_ && d0_ >= 0) ? b0_ : NINF; c1[r] = (sel_ && d1_ >= 0) ? b1_ : NINF; } \
            else { c0[r] = (sel_ && ((mlo_ >> bp) & 1u)) ? b0_ : NINF; c1[r] = (sel_ && ((mhi_ >> bp) & 1u)) ? b1_ : NINF; } } } while (0)
#define AT_INIT_FARB(t, c0, c1, mw) do { \
        const u64 ms_ = ((t) < NT) ? ((mw) >> (4 * hi)) : 0ull; const int mlo_ = (int)(unsigned)ms_, mhi_ = (int)(unsigned)(ms_ >> 32); \
        const unsigned cf_ = __float_as_uint(cfar), nf_ = 0xff800000u; \
        _Pragma("unroll") for (int r = 0; r < 16; ++r) { const int bp = (r & 3) + 8 * (r >> 2); \
            const unsigned m0_ = (unsigned)__builtin_amdgcn_sbfe(mlo_, bp, 1), m1_ = (unsigned)__builtin_amdgcn_sbfe(mhi_, bp, 1); \
            c0[r] = __uint_as_float((m0_ & cf_) | (~m0_ & nf_)); c1[r] = __uint_as_float((m1_ & cf_) | (~m1_ & nf_)); } } while (0)
    const int kswz = (r32 ^ (r32 >> 3)) & 7;
#define AT_KF(Kt_, d0, p) (*(const LAS bf16x8*)((Kt_) + (p) * 4096 + (((2 * (d0) + hi) ^ kswz ^ (4 * (p))) << 4)))
#define AT_QK(so, c0, c1, i0, i1) do { const LAS unsigned char* Kt_ = lds + AT_RING + (so) + r32 * 128; \
        c0 = __builtin_amdgcn_mfma_f32_32x32x16_bf16(AT_KF(Kt_, 0, 0), qr[0], i0, 0, 0, 0); \
        c1 = __builtin_amdgcn_mfma_f32_32x32x16_bf16(AT_KF(Kt_, 0, 1), qr[0], i1, 0, 0, 0); \
        _Pragma("unroll") for (int d0 = 1; d0 < 4; ++d0) { \
            c0 = __builtin_amdgcn_mfma_f32_32x32x16_bf16(AT_KF(Kt_, d0, 0), qr[d0], c0, 0, 0, 0); \
            c1 = __builtin_amdgcn_mfma_f32_32x32x16_bf16(AT_KF(Kt_, d0, 1), qr[d0], c1, 0, 0, 0); } } while (0)
#define AT_SCORES(t, kf, c0, c1, mw) do { \
        const bool nearD_ = (q0 - (64 * ((t) + TB) + 63)) < 113; \
        if (nearD_) { AT_INIT_NEAR(t, c0, c1, mw); AT_QK(kf, c0, c1, c0, c1); } \
        else if (MODE == 0) { AT_QK(kf, c0, c1, ivec, ivec); } \
        else { AT_INIT_FARB(t, c0, c1, mw); AT_QK(kf, c0, c1, c0, c1); } } while (0)
#define AT_IVEC(t) do { if (MODE == 0) { const int n_ = ((t) + TB) >> 2; const bool s_ = ((t) < NT) && ((n_ == blk) || (((selmask >> (n_ & 15)) & 1u) != 0u)); const float v_ = s_ ? cfar : NINF; \
        _Pragma("unroll") for (int r = 0; r < 16; ++r) ivec[r] = v_; asm volatile("" : "+v"(ivec)); } } while (0)
#ifndef EXP_LDS
#define EXP_LDS 0
#endif
#ifndef EXP_EXP
#define EXP_EXP 0
#endif
#ifndef EXP_MFMA
#define EXP_MFMA 0
#endif
    f32x16 o0, o1, ivec; pg8::f32x4 dm4a = (pg8::f32x4){0.f,0.f,0.f,0.f}, dm4b = (pg8::f32x4){0.f,0.f,0.f,0.f}; f32x16 dmy; if (EXP_MFMA) { _Pragma("unroll") for (int r = 0; r < 16; ++r) dmy[r] = 0.f; }
#pragma unroll
    for (int r = 0; r < 16; ++r) { o0[r] = 0.f; o1[r] = 0.f; ivec[r] = NINF; }
    float lsum = 0.f;
    f32x16 ca0, ca1, cb0, cb1;
    AT_WAIT_BAR_N(2 * (AT_D - 1));
    AT_IVEC(0);
    { u64 mw0 = 0ull; if (MODE == 1) mw0 = bmL[r32];
      AT_SCORES(0, 0, ca0, ca1, mw0); }
    const int vbl = ((lane >> 4) & 1) * 32 + (lane & 3) * 8 + (4 * hi + ((lane & 15) >> 2)) * 64;
    int so_cur = 0, so_nxt = AT_STAGE, so_dma = AT_D * AT_STAGE;
#define AT_STEP(t, C0, C1, N0, N1) do { \
        u64 mw1_ = 0ull; if (MODE == 1) mw1_ = bmL[(((t) + 1) & 63) * 32 + r32]; \
        const LAS unsigned char* Vt_ = lds + AT_RING + so_cur + 8192; \
        asm volatile("" ::: "memory"); \
        if ((((t) + 1 + TB) & 3) == 0) AT_IVEC((t) + 1); \
        AT_SCORES((t) + 1, so_nxt, N0, N1, mw1_); \
        float sacc_ = 0.f; \
        if (EXP_EXP) { _Pragma("unroll") for (int r = 0; r < 16; ++r) { float e0_ = __builtin_amdgcn_exp2f(C0[r] + 1.0f), e1_ = __builtin_amdgcn_exp2f(C1[r] + 1.0f); asm volatile("" :: "v"(e0_), "v"(e1_)); } } \
        _Pragma("unroll") for (int r = 0; r < 16; ++r) { C0[r] = __builtin_amdgcn_exp2f(C0[r]); C1[r] = __builtin_amdgcn_exp2f(C1[r]); sacc_ += C0[r] + C1[r]; } \
        lsum += sacc_; \
        u32x4v pw_[4]; \
        _Pragma("unroll") for (int s_ = 0; s_ < 2; ++s_) { \
            pw_[s_] = (u32x4v){cvtpk(C0[8 * s_], C0[8 * s_ + 1]), cvtpk(C0[8 * s_ + 2], C0[8 * s_ + 3]), cvtpk(C0[8 * s_ + 4], C0[8 * s_ + 5]), cvtpk(C0[8 * s_ + 6], C0[8 * s_ + 7])}; \
            pw_[2 + s_] = (u32x4v){cvtpk(C1[8 * s_], C1[8 * s_ + 1]), cvtpk(C1[8 * s_ + 2], C1[8 * s_ + 3]), cvtpk(C1[8 * s_ + 4], C1[8 * s_ + 5]), cvtpk(C1[8 * s_ + 6], C1[8 * s_ + 7])}; } \
        _Pragma("unroll") for (int ks = 0; ks < 4; ++ks) { const bf16x8 pa_ = __builtin_bit_cast(bf16x8, pw_[ks]); \
            _Pragma("unroll") for (int d0 = 0; d0 < 2; ++d0) { const LAS unsigned char* vp_ = Vt_ + (2 * ks) * 1024 + d0 * 512 + vbl; \
                const s16x4 lo_ = __builtin_bit_cast(s16x4, __builtin_amdgcn_ds_read_tr16_b64_v4i16((LAS v4i16_t*)vp_)), hh_ = __builtin_bit_cast(s16x4, __builtin_amdgcn_ds_read_tr16_b64_v4i16((LAS v4i16_t*)(vp_ + 1024))); \
                if (EXP_LDS) { s16x4 l2_ = __builtin_bit_cast(s16x4, __builtin_amdgcn_ds_read_tr16_b64_v4i16((LAS v4i16_t*)(vp_ + 2048))), h2_ = __builtin_bit_cast(s16x4, __builtin_amdgcn_ds_read_tr16_b64_v4i16((LAS v4i16_t*)(vp_ + 3072))); asm volatile("" :: "v"(l2_), "v"(h2_)); } \
                const bf16x8 vf_ = (bf16x8){lo_[0], lo_[1], lo_[2], lo_[3], hh_[0], hh_[1], hh_[2], hh_[3]}; \
                if (d0 == 0) o0 = __builtin_amdgcn_mfma_f32_32x32x16_bf16(pa_, vf_, o0, 0, 0, 0); else o1 = __builtin_amdgcn_mfma_f32_32x32x16_bf16(pa_, vf_, o1, 0, 0, 0); \
                if (EXP_MFMA == 1) { dmy = __builtin_amdgcn_mfma_f32_32x32x16_bf16(pa_, vf_, dmy, 0, 0, 0); } \
                if (EXP_MFMA == 2) { dm4a = __builtin_amdgcn_mfma_f32_16x16x32_bf16(pa_, vf_, dm4a, 0, 0, 0); dm4b = __builtin_amdgcn_mfma_f32_16x16x32_bf16(vf_, pa_, dm4b, 0, 0, 0); } } } \
        so_cur = so_nxt; so_nxt = (so_nxt == (AT_R - 1) * AT_STAGE) ? 0 : so_nxt + AT_STAGE; } while (0)
    for (int t = 0; t < NT; t += 2) {
        AT_WAIT_BAR_N(2 * (AT_D - 3));
        { const int td_ = t + AT_D; AT_DMA((td_ < NT ? td_ : NT - 1), so_dma); so_dma = (so_dma == (AT_R - 1) * AT_STAGE) ? 0 : so_dma + AT_STAGE; }
        { const int td_ = t + AT_D + 1; AT_DMA((td_ < NT ? td_ : NT - 1), so_dma); so_dma = (so_dma == (AT_R - 1) * AT_STAGE) ? 0 : so_dma + AT_STAGE; }
        AT_STEP(t, ca0, ca1, cb0, cb1);
        AT_STEP(t + 1, cb0, cb1, ca0, ca1);
    }
    if (EXP_MFMA == 1) asm volatile("" :: "v"(dmy));
    if (EXP_MFMA == 2) asm volatile("" :: "v"(dm4a), "v"(dm4b));
    v4u sgv[4];
#pragma unroll
    for (int i = 0; i < 4; ++i) sgv[i] = *(const v4u*)(SG + ((size_t)b * SEQ + q0 + i * 8 + (lane >> 3)) * AW + h * 64 + (lane & 7) * 8);
    v4u slw[3][4]; float sll[3][4];
#pragma unroll
    for (int sl = 0; sl < 3; ++sl)
#pragma unroll
        for (int i = 0; i < 4; ++i) { const size_t trow = (size_t)b * SEQ + q0 + i * 8 + (lane >> 3);
            const unsigned char* sp = (sl == 0) ? F.ws + WS_SL0 + trow * 1024 : (sl == 1) ? ((trow < 4 * SEQ) ? F.ws + WS_SL1A + trow * 1024 : F.ws + WS_QI + (trow - 4 * SEQ) * 1024) : F.ws + WS_XB + trow * 1024;
            slw[sl][i] = *(const v4u*)(sp + (h * 64 + (lane & 7) * 8) * 2); sll[sl][i] = ((const float*)(F.ws + WS_LS))[(trow * 8 + h) * 4 + sl]; }
    asm volatile("s_waitcnt vmcnt(28) lgkmcnt(0)\n\ts_barrier" ::: "memory");
    lsum += __shfl_xor(lsum, 32);
    if (hi == 0) wsf[r32] = lsum;
    LDS_WAIT(); asm volatile("" ::: "memory");
#pragma unroll
    for (int r = 0; r < 16; ++r) { const int orow = crow(r, hi); ost[orow * 64 + r32] = o0[r]; ost[orow * 64 + 32 + r32] = o1[r]; }
    LDS_WAIT(); asm volatile("" ::: "memory");
    const int nsl = (MODE == 0) ? (blk < 3 ? blk : 3) : 0;
#pragma unroll
    for (int i = 0; i < 4; ++i) { const int row = i * 8 + (lane >> 3), ch = lane & 7;
        f32x4 a = *(const LAS f32x4*)(ost + row * 64 + ch * 8), c = *(const LAS f32x4*)(ost + row * 64 + ch * 8 + 4);
        const size_t trow = (size_t)b * SEQ + q0 + row; const size_t off = trow * AW + h * 64 + ch * 8;
        float lt = wsf[row];
#pragma unroll
        for (int sl = 0; sl < 3; ++sl) if (sl < nsl) { const v4u w = slw[sl][i];
            a[0] += bflo(w.x); a[1] += bfhi(w.x); a[2] += bflo(w.y); a[3] += bfhi(w.y); c[0] += bflo(w.z); c[1] += bfhi(w.z); c[2] += bflo(w.w); c[3] += bfhi(w.w);
            lt += sll[sl][i]; }
        const float rl = __builtin_amdgcn_rcpf(lt);
        const v4u g = sgv[i]; v4u o;
        o.x = pk2(a[0] * rl * bflo(g.x), a[1] * rl * bfhi(g.x)); o.y = pk2(a[2] * rl * bflo(g.y), a[3] * rl * bfhi(g.y)); o.z = pk2(c[0] * rl * bflo(g.z), c[1] * rl * bfhi(g.z)); o.w = pk2(c[2] * rl * bflo(g.w), c[3] * rl * bfhi(g.w));
        *(v4u*)(Y + off) = o; }
    AT_WAIT_BAR();
#undef AT_DMA
#undef AT_INIT_NEAR
#undef AT_INIT_FARB
#undef AT_QK
#undef AT_KF
#undef AT_SCORES
#undef AT_IVEC
#undef AT_STEP
}
#ifndef DSA_SPARSE
#define DSA_SPARSE 1
#endif
typedef unsigned u32x2va __attribute__((ext_vector_type(2), may_alias));
constexpr int DS_KV = 0, DS_LIST = 131072, DS_TB = DS_LIST + 8192;
static_assert(DS_TB + 4096 <= LDSCTL_OFF, "sparse DSA LDS");
__device__ __forceinline__ u32x4v dsld16(unsigned off, const void* base) { u32x4v r; asm volatile("global_load_dwordx4 %0, %1, %2" : "=&v"(r) : "v"(off), "s"(base) : "memory"); return r; }
__device__ __forceinline__ u32x4v dsld16o(unsigned off, const void* base) { u32x4v r; asm volatile("global_load_dwordx4 %0, %1, %2 offset:64" : "=&v"(r) : "v"(off), "s"(base) : "memory"); return r; }
template <int IMM> __device__ __forceinline__ u32x2v dsld8(unsigned off, const void* base) { u32x2v r; asm volatile("global_load_dwordx2 %0, %1, %2 offset:%3" : "=&v"(r) : "v"(off), "s"(base), "n"(IMM) : "memory"); return r; }
__device__ __forceinline__ void dsdma_chunk(unsigned ka, unsigned kb, unsigned kc, unsigned kd, unsigned va, unsigned vb, unsigned vc, unsigned vd, const void* kbase, const void* vbase, unsigned lds_dst) { unsigned keep;
    asm volatile("s_mov_b32 %0, m0\n\ts_mov_b32 m0, %11\n\ts_nop 0\n\tglobal_load_lds_dwordx4 %1, %9\n\ts_add_u32 m0, m0, 0x400\n\ts_nop 0\n\tglobal_load_lds_dwordx4 %2, %9\n\ts_add_u32 m0, m0, 0x400\n\ts_nop 0\n\tglobal_load_lds_dwordx4 %3, %9\n\ts_add_u32 m0, m0, 0x400\n\ts_nop 0\n\tglobal_load_lds_dwordx4 %4, %9\n\t"
                 "s_add_u32 m0, m0, 0x400\n\ts_nop 0\n\tglobal_load_lds_dwordx4 %5, %10\n\ts_add_u32 m0, m0, 0x400\n\ts_nop 0\n\tglobal_load_lds_dwordx4 %6, %10\n\ts_add_u32 m0, m0, 0x400\n\ts_nop 0\n\tglobal_load_lds_dwordx4 %7, %10\n\ts_add_u32 m0, m0, 0x400\n\ts_nop 0\n\tglobal_load_lds_dwordx4 %8, %10\n\ts_mov_b32 m0, %0"
                 : "=&s"(keep) : "v"(ka), "v"(kb), "v"(kc), "v"(kd), "v"(va), "v"(vb), "v"(vc), "v"(vd), "s"(kbase), "s"(vbase), "s"(lds_dst) : "memory", "scc"); }
__device__ __forceinline__ void ds_expand(const u32x2v lw, LAS unsigned short* lst, int lane, int t, int& total, int& nfar) {
    const int tot = t < 255 ? t + 1 : 256, p = 4 * lane, lim = t - 127;
    unsigned k0 = lw.x & 0xffffu, k1 = lw.x >> 16, k2 = lw.y & 0xffffu, k3 = lw.y >> 16;
    k0 = (p < tot) ? k0 : (unsigned)t; k1 = (p + 1 < tot) ? k1 : (unsigned)t; k2 = (p + 2 < tot) ? k2 : (unsigned)t; k3 = (p + 3 < tot) ? k3 : (unsigned)t;
    u32x2v w_; w_.x = k0 | (k1 << 16); w_.y = k2 | (k3 << 16);
    *(LAS u32x2va*)(lst + p) = w_;
    int c = (((int)k0 <= lim) ? 1 : 0) + (((int)k1 <= lim) ? 1 : 0) + (((int)k2 <= lim) ? 1 : 0) + (((int)k3 <= lim) ? 1 : 0);
    c += __builtin_amdgcn_update_dpp(0, c, 0xB1, 0xF, 0xF, true); c += __builtin_amdgcn_update_dpp(0, c, 0x4E, 0xF, 0xF, true);
    c += __builtin_amdgcn_update_dpp(0, c, 0x141, 0xF, 0xF, true); c += __builtin_amdgcn_update_dpp(0, c, 0x140, 0xF, 0xF, true);
    int nf = __builtin_amdgcn_readlane(c, 0) + __builtin_amdgcn_readlane(c, 16) + __builtin_amdgcn_readlane(c, 32) + __builtin_amdgcn_readlane(c, 48);
    nf = nf > tot ? tot : nf;
    total = tot; nfar = nf;
    asm volatile("" ::: "memory");
}
__device__ __forceinline__ void dsa_sparse_phase(Frame& F, int layer) {
    int tid_o = threadIdx.x; asm volatile("" : "+v"(tid_o));
    const int lane = tid_o & 63, wid = __builtin_amdgcn_readfirstlane(tid_o >> 6);
    const int c16 = lane & 15, g = lane >> 4, h = c16 & 7, j8 = lane >> 3;
    LAS unsigned char* lds = F.lds;
    LAS float* tb = (LAS float*)(lds + DS_TB);
    __syncthreads();
    build_bias_table(F, tb, layer, 8);
    __syncthreads();
    const LAS float* tbh = tb + h * 128;
    const float cfar = tbh[127]; const float NINF = -INFINITY; f32x4 cfar4 = (f32x4){cfar, cfar, cfar, cfar}; asm volatile("" : "+v"(cfar4));
    LAS unsigned short* lstb = (LAS unsigned short*)(lds + DS_LIST + wid * 1024);
    LAS unsigned char* kvp = lds + DS_KV + wid * 16384;
    const unsigned kv0 = (unsigned)(uintptr_t)kvp;
    const unsigned char* QBp = F.ws + WS_QB; const unsigned char* KBp = F.ws + WS_KB; const unsigned char* VBp = F.ws + WS_VB; const unsigned char* SGp = F.ws + WS_SGB; const unsigned char* BMp = F.ws + WS_BM;
    bf16* Y = (bf16*)(F.ws + WS_XB) + (size_t)TOK * AW;
    const int nW = F.G * NWAVES, gw = F.vcu * NWAVES + wid;
    const bool loc = (nW == 2048);
    const int nq = loc ? 16 : (TOK - gw + nW - 1) / nW;
#define DS_QMAP(i, bb, tt) do { if (loc) { bb = gw >> 8; tt = (gw & 255) + 256 * (i); } else { const int u_ = gw + nW * (i); bb = u_ >> 12; tt = u_ & (SEQ - 1); } } while (0)
    if (nq <= 0) return;
    const unsigned kswA = 16u * (unsigned)((lane & 7) ^ (j8 >> 1)), kswB = kswA ^ 64u;
    const unsigned vsw = 16u * (unsigned)((lane & 7) ^ (2 * (j8 >> 1)));
    const unsigned kr0 = (unsigned)(c16 * 128 + 16 * (g ^ (c16 >> 1))), kr1 = kr0 ^ 64u;
    const unsigned qoff = (unsigned)(h * 128 + 16 * g), goff = (unsigned)(h * 128 + 8 * g), boff = (unsigned)(lane * 8);
    unsigned va[4];
    { const int q_ = c16 >> 2, pp = c16 & 3, s_ = (2 * g + (q_ >> 1)) & 3;
#pragma unroll
      for (int dt = 0; dt < 4; ++dt) va[dt] = (unsigned)((4 * g + q_) * 128 + (((2 * dt + (pp >> 1)) ^ (2 * s_)) * 16) + 8 * (pp & 1)); }
    const int pnear = 16 * (g & 1) + (g >> 1);
    u32x4v qfu[2]; u32x2v gt[4], bmw;
    int b, t; DS_QMAP(0, b, t);
    int total, nfar;
    const unsigned char* KBb = KBp + (size_t)b * SEQ * 128; const unsigned char* VBb = VBp + (size_t)b * SEQ * 128;
#define DS_ISSUE(lstc, c, buf) do { const u32x2v kk_ = *(const LAS u32x2va*)((lstc) + 32 * (c) + 4 * j8); \
        const unsigned k0_ = (kk_.x & 0xffffu) * 128u, k1_ = (kk_.x >> 16) * 128u, k2_ = (kk_.y & 0xffffu) * 128u, k3_ = (kk_.y >> 16) * 128u; \
        dsdma_chunk(k0_ + kswA, k1_ + kswB, k2_ + kswA, k3_ + kswB, k0_ + vsw, k1_ + vsw, k2_ + vsw, k3_ + vsw, KBb, VBb, (buf)); } while (0)
#define DS_COMPUTE(lstc, c, bo, HOOK) do { \
        const bf16x8 kf0_ = *(const LAS bf16x8*)(kvp + (bo) + kr0), kf1_ = *(const LAS bf16x8*)(kvp + (bo) + kr1), kf2_ = *(const LAS bf16x8*)(kvp + (bo) + 2048 + kr0), kf3_ = *(const LAS bf16x8*)(kvp + (bo) + 2048 + kr1); \
        s16x4 vl_[4], vh_[4]; \
        _Pragma("unroll") for (int dt = 0; dt < 4; ++dt) { const LAS unsigned char* vp_ = kvp + (bo) + 4096 + va[dt]; \
            vl_[dt] = __builtin_bit_cast(s16x4, __builtin_amdgcn_ds_read_tr16_b64_v4i16((LAS v4i16_t*)vp_)); vh_[dt] = __builtin_bit_cast(s16x4, __builtin_amdgcn_ds_read_tr16_b64_v4i16((LAS v4i16_t*)(vp_ + 2048))); } \
        f32x4 s0_, s1_; \
        if (32 * ((c) + 1) <= nfar) { \
            s0_ = __builtin_amdgcn_mfma_f32_16x16x32_bf16(kf0_, __builtin_bit_cast(bf16x8, qfu[0]), cfar4, 0, 0, 0); \
            s1_ = __builtin_amdgcn_mfma_f32_16x16x32_bf16(kf2_, __builtin_bit_cast(bf16x8, qfu[0]), cfar4, 0, 0, 0); } \
        else { f32x4 ci0_, ci1_; \
            _Pragma("unroll") for (int u = 0; u < 2; ++u) { f32x4 ci; const int p0 = 32 * (c) + pnear + 2 * u; \
                int d0_ = t - (int)(lstc)[p0], d1_ = t - (int)(lstc)[p0 + 4], d2_ = t - (int)(lstc)[p0 + 8], d3_ = t - (int)(lstc)[p0 + 12]; \
                d0_ = d0_ < 0 ? 0 : (d0_ > 127 ? 127 : d0_); d1_ = d1_ < 0 ? 0 : (d1_ > 127 ? 127 : d1_); d2_ = d2_ < 0 ? 0 : (d2_ > 127 ? 127 : d2_); d3_ = d3_ < 0 ? 0 : (d3_ > 127 ? 127 : d3_); \
                const float b0_ = tbh[d0_], b1_ = tbh[d1_], b2_ = tbh[d2_], b3_ = tbh[d3_];     \
                ci[0] = (p0 < total) ? b0_ : NINF; ci[1] = (p0 + 4 < total) ? b1_ : NINF; ci[2] = (p0 + 8 < total) ? b2_ : NINF; ci[3] = (p0 + 12 < total) ? b3_ : NINF; \
                if (u == 0) ci0_ = ci; else ci1_ = ci; } \
            s0_ = __builtin_amdgcn_mfma_f32_16x16x32_bf16(kf0_, __builtin_bit_cast(bf16x8, qfu[0]), ci0_, 0, 0, 0); \
            s1_ = __builtin_amdgcn_mfma_f32_16x16x32_bf16(kf2_, __builtin_bit_cast(bf16x8, qfu[0]), ci1_, 0, 0, 0); } \
        s0_ = __builtin_amdgcn_mfma_f32_16x16x32_bf16(kf1_, __builtin_bit_cast(bf16x8, qfu[1]), s0_, 0, 0, 0); \
        s1_ = __builtin_amdgcn_mfma_f32_16x16x32_bf16(kf3_, __builtin_bit_cast(bf16x8, qfu[1]), s1_, 0, 0, 0); \
        HOOK; \
        float e_[8]; \
        _Pragma("unroll") for (int r = 0; r < 4; ++r) { e_[r] = __builtin_amdgcn_exp2f(s0_[r]); e_[4 + r] = __builtin_amdgcn_exp2f(s1_[r]); } \
        lsum += ((e_[0] + e_[1]) + (e_[2] + e_[3])) + ((e_[4] + e_[5]) + (e_[6] + e_[7])); \
        const bf16x8 pb_ = __builtin_bit_cast(bf16x8, ((u32x4v){cvtpk(e_[0], e_[1]), cvtpk(e_[2], e_[3]), cvtpk(e_[4], e_[5]), cvtpk(e_[6], e_[7])})); \
        _Pragma("unroll") for (int dt = 0; dt < 4; ++dt) { \
            const bf16x8 vf_ = (bf16x8){vl_[dt][0], vl_[dt][1], vl_[dt][2], vl_[dt][3], vh_[dt][0], vh_[dt][1], vh_[dt][2], vh_[dt][3]}; \
            o[dt] = __builtin_amdgcn_mfma_f32_16x16x32_bf16(vf_, pb_, o[dt], 0, 0, 0); } } while (0)
#define DS_NOHOOK ((void)0)
#define DS_QRELOAD do { asm volatile("" : "+v"(s0_), "+v"(s1_), "+v"(qfu[0]), "+v"(qfu[1]) :: "memory"); qfu[0] = dsld16(qoff, QBp + tq2 * 1024); qfu[1] = dsld16o(qoff, QBp + tq2 * 1024); } while (0)
#define DS_WAIT8() asm volatile("s_waitcnt vmcnt(8)" ::: "memory")
    { const size_t tq = (size_t)b * SEQ + t;
      bmw = dsld8<0>(boff, BMp + tq * 512);
      asm volatile("s_waitcnt vmcnt(0)" : "+v"(bmw) :: "memory");
      ds_expand(bmw, lstb, lane, t, total, nfar);
      DS_ISSUE(lstb, 0, kv0);
      qfu[0] = dsld16(qoff, QBp + tq * 1024); qfu[1] = dsld16o(qoff, QBp + tq * 1024); }
    for (int i = 0; i < nq; ++i) {
        LAS unsigned short* lc = lstb + (i & 1) * 256; LAS unsigned short* ln = lstb + ((i + 1) & 1) * 256;
        const size_t tq = (size_t)b * SEQ + t;
        const bool more = (i + 1 < nq);
        int b2 = b, t2 = t; if (more) DS_QMAP(i + 1, b2, t2);
        const size_t tq2 = (size_t)b2 * SEQ + t2;
        int total2, nfar2;
        pg8::f32x4 o[4];
#pragma unroll
        for (int dt = 0; dt < 4; ++dt) o[dt] = (pg8::f32x4){0.f, 0.f, 0.f, 0.f};
        float lsum = 0.f;
        bmw = dsld8<0>(boff, BMp + tq2 * 512);
        gt[0] = dsld8<0>(goff, SGp + tq * 1024); gt[1] = dsld8<32>(goff, SGp + tq * 1024); gt[2] = dsld8<64>(goff, SGp + tq * 1024); gt[3] = dsld8<96>(goff, SGp + tq * 1024);
        DS_ISSUE(lc, 1, kv0 + 8192);
        asm volatile("s_waitcnt vmcnt(13)" : "+v"(qfu[0]), "+v"(qfu[1]) :: "memory");
        DS_COMPUTE(lc, 0, 0, DS_NOHOOK);
        DS_ISSUE(lc, 2, kv0);
        asm volatile("s_waitcnt vmcnt(8)" : "+v"(bmw), "+v"(gt[0]), "+v"(gt[1]), "+v"(gt[2]), "+v"(gt[3]) :: "memory");
        DS_COMPUTE(lc, 1, 8192, DS_NOHOOK);
        ds_expand(bmw, ln, lane, t2, total2, nfar2);
        DS_ISSUE(lc, 3, kv0 + 8192); DS_WAIT8(); DS_COMPUTE(lc, 2, 0, DS_NOHOOK);
        DS_ISSUE(lc, 4, kv0); DS_WAIT8(); DS_COMPUTE(lc, 3, 8192, DS_NOHOOK);
        DS_ISSUE(lc, 5, kv0 + 8192); DS_WAIT8(); DS_COMPUTE(lc, 4, 0, DS_NOHOOK);
        DS_ISSUE(lc, 6, kv0); DS_WAIT8(); DS_COMPUTE(lc, 5, 8192, DS_NOHOOK);
        DS_ISSUE(lc, 7, kv0 + 8192); DS_WAIT8(); DS_COMPUTE(lc, 6, 0, DS_NOHOOK);
        KBb = KBp + (size_t)b2 * SEQ * 128; VBb = VBp + (size_t)b2 * SEQ * 128;
        DS_ISSUE(ln, 0, kv0); DS_WAIT8();
        DS_COMPUTE(lc, 7, 8192, DS_QRELOAD);
        lsum += __shfl_xor(lsum, 16); lsum += __shfl_xor(lsum, 32);
        const float rl = __builtin_amdgcn_rcpf(lsum);
        if (c16 < 8) {
#pragma unroll
            for (int dt = 0; dt < 4; ++dt) { const u32x2v gg = gt[dt]; u32x2v yo;
                yo.x = pk2(o[dt][0] * rl * bflo(gg.x), o[dt][1] * rl * bfhi(gg.x)); yo.y = pk2(o[dt][2] * rl * bflo(gg.y), o[dt][3] * rl * bfhi(gg.y));
                *(u32x2v*)(Y + tq * AW + h * 64 + 16 * dt + 4 * g) = yo; } }
        b = b2; t = t2; total = total2; nfar = nfar2;
    }
    asm volatile("s_waitcnt vmcnt(0)" : "+v"(qfu[0]), "+v"(qfu[1]) :: "memory");
#undef DS_QMAP
#undef DS_ISSUE
#undef DS_COMPUTE
#undef DS_NOHOOK
#undef DS_QRELOAD
#undef DS_WAIT8
}
__device__ __forceinline__ void moba_mask_pass(Frame& F, int layer) {
    int tid_o = threadIdx.x; asm volatile("" : "+v"(tid_o));
    const int lane = tid_o & 63, r32 = lane & 31, hi = lane >> 5, wid = __builtin_amdgcn_readfirstlane(tid_o >> 6);
    const bf16* Q = (const bf16*)(F.ws + WS_QA);
    unsigned short* LST = (unsigned short*)(F.ws + WS_LST);
    unsigned* CNT = (unsigned*)(F.ctl + CW_MCNT + layer * 1024);
#define MK_LOAD(X) \
        const int bh##X = j##X / 15, blk##X = 1 + j##X % 15, b##X = bh##X >> 3, h##X = bh##X & 7, q##X = 256 * blk##X + 32 * wid + r32; const size_t tq##X = (size_t)b##X * SEQ + q##X; \
        bf16x8 qr##X[4], kh##X[4], kl##X[4]; \
        { const bf16* kmh = (const bf16*)(F.ws + WS_KMH) + ((size_t)(b##X * 8 + h##X) * 32 + r32) * 64 + 8 * hi; const bf16* kml = (const bf16*)(F.ws + WS_KML) + ((size_t)(b##X * 8 + h##X) * 32 + r32) * 64 + 8 * hi; \
          _Pragma("unroll") for (int d0 = 0; d0 < 4; ++d0) { qr##X[d0] = *(const bf16x8*)(Q + tq##X * AW + h##X * 64 + 16 * d0 + 8 * hi); kh##X[d0] = *(const bf16x8*)(kmh + 16 * d0); kl##X[d0] = *(const bf16x8*)(kml + 16 * d0); } }
#define MK_GATE(X) \
        unsigned selmask##X = 0; \
        { f32x16 gg; \
          _Pragma("unroll") for (int r = 0; r < 16; ++r) gg[r] = 0.f; \
          _Pragma("unroll") for (int d0 = 0; d0 < 4; ++d0) { \
              gg = __builtin_amdgcn_mfma_f32_32x32x16_bf16(kh##X[d0], qr##X[d0], gg, 0, 0, 0); \
              gg = __builtin_amdgcn_mfma_f32_32x32x16_bf16(kl##X[d0], qr##X[d0], gg, 0, 0, 0); } \
          float gate[16]; \
          _Pragma("unroll") for (int r = 0; r < 8; ++r) { const float o = __shfl_xor(gg[r], 32); const int nb_ = (r & 3) + 8 * (r >> 2); gate[nb_] = hi ? o : gg[r]; gate[nb_ + 4] = hi ? gg[r] : o; } \
          const int nsel = blk##X < 3 ? blk##X : 3; \
          for (int r = 0; r < nsel; ++r) { float best = -INFINITY; int bi = -1; \
              _Pragma("unroll") for (int n = 0; n < 16; ++n) { const bool ok = (n < blk##X) && !((selmask##X >> n) & 1u) && (bi < 0 || gate[n] > best); if (ok) { best = gate[n]; bi = n; } } \
              selmask##X |= 1u << bi; } } \
        if (hi == 0) ((unsigned*)(F.ws + WS_LS))[(tq##X * 8 + h##X) * 4 + 3] = (selmask##X >> (blk##X - 1)) & 1u;     \
        unsigned mycnt##X = 0;     \
        for (int n = 0; n < 15; ++n) { const bool c = (hi == 0) && (((selmask##X >> n) & 1u) != 0u); const u64 bl = __ballot(c); const unsigned cn = (unsigned)__builtin_popcountll(bl); if (lane == n) mycnt##X = cn; } \
        unsigned base##X = 0; if (lane < 15 && mycnt##X > 0) base##X = __hip_atomic_fetch_add(CNT + bh##X * 16 + lane, mycnt##X, __ATOMIC_RELAXED, __HIP_MEMORY_SCOPE_AGENT);
#define MK_WRITE(X) \
        for (int n = 0; n < blk##X; ++n) { const bool c = (hi == 0) && (((selmask##X >> n) & 1u) != 0u); const u64 bl = __ballot(c); if (bl == 0ull) continue; \
            const unsigned bs = (unsigned)__builtin_amdgcn_readlane((int)base##X, n); \
            const int pos = (int)bs + (int)__builtin_amdgcn_mbcnt_hi((unsigned)(bl >> 32), __builtin_amdgcn_mbcnt_lo((unsigned)bl, 0u)); \
            const unsigned slot = (unsigned)__builtin_popcount(selmask##X & ((1u << n) - 1u)); \
            if (c) LST[(size_t)bh##X * 30720 + lst_off(n) + pos] = (unsigned short)((unsigned)q##X | (slot << 12)); }
    for (int j0 = F.vcu; j0 < 960; j0 += 2 * F.G) {
        const int jA = j0, jB = j0 + F.G;
        if (jB < 960) { MK_LOAD(A) MK_LOAD(B) MK_GATE(A) MK_GATE(B) MK_WRITE(A) MK_WRITE(B) }
        else { MK_LOAD(A) MK_GATE(A) MK_WRITE(A) }
    }
#undef MK_LOAD
#undef MK_GATE
#undef MK_WRITE
}
__device__ __forceinline__ void moba_far_phase(Frame& F, int layer) {
    int tid_o = threadIdx.x; asm volatile("" : "+v"(tid_o));
    const int lane = tid_o & 63, r32 = lane & 31, hi = lane >> 5, wid = __builtin_amdgcn_readfirstlane(tid_o >> 6);
    LAS unsigned char* lds = F.lds;
    __syncthreads();
    { LAS float* tb = (LAS float*)(lds + AT_TB); build_bias_table(F, tb, layer, 0); }
    __syncthreads();
    const bf16* Q = (const bf16*)(F.ws + WS_QA);
    const unsigned short* LST = (const unsigned short*)(F.ws + WS_LST);
    unsigned* CNT = (unsigned*)(F.ctl + CW_MCNT + layer * 1024); unsigned* TKT = (unsigned*)(F.ctl + CW_MTKT + layer);
    float* LS = (float*)(F.ws + WS_LS);
    volatile LAS unsigned* tkl = (volatile LAS unsigned*)(lds + AT_WS);
    const unsigned lds0 = (unsigned)(uintptr_t)lds;
    const int kswz = (r32 ^ (r32 >> 3)) & 7;
    const int vbl = ((lane >> 4) & 1) * 32 + (lane & 3) * 8 + (4 * hi + ((lane & 15) >> 2)) * 64;
    LAS unsigned short* ost16 = (LAS unsigned short*)(lds + 4 * AT_STAGE) + wid * 2048;
#define FR_KF(Kt_, d0, p) (*(const LAS bf16x8*)((Kt_) + (p) * 4096 + (((2 * (d0) + hi) ^ kswz ^ (4 * (p))) << 4)))
    for (;;) {
        if (tid_o == 0) *tkl = __hip_atomic_fetch_add(TKT, 1u, __ATOMIC_RELAXED, __HIP_MEMORY_SCOPE_AGENT);
        __syncthreads();
        const unsigned tk = (unsigned)__builtin_amdgcn_readfirstlane((int)*tkl);
        __syncthreads();
        if (tk >= 960u) break;
        const int n = (int)(tk >> 6), bh = (int)(tk & 63u), b = bh >> 3, h = bh & 7;
        const int cnt = __builtin_amdgcn_readfirstlane((int)__hip_atomic_load(CNT + bh * 16 + n, __ATOMIC_RELAXED, __HIP_MEMORY_SCOPE_AGENT));
        const int ngr = (cnt + 31) >> 5;
        if (ngr == 0) continue;
        const unsigned short* lst = LST + (size_t)bh * 30720 + lst_off(n);
        unsigned e_c = lst[(32 * wid + r32 < cnt) ? 32 * wid + r32 : 0];
        unsigned e_n = lst[(32 * (wid + NWAVES) + r32 < cnt) ? 32 * (wid + NWAVES) + r32 : 0];
        {
          const bf16* Kg = (const bf16*)(F.ws + WS_KA) + (size_t)b * SEQ * AW + h * 64; const bf16* Vg = (const bf16*)(F.ws + WS_VA) + (size_t)b * SEQ * AW + h * 64;
          const int krow_ = 8 * wid + (lane >> 3);
          const bf16* ksrc = Kg + (size_t)krow_ * AW + 8 * ((lane & 7) ^ ((krow_ ^ (krow_ >> 3)) & 7));
          const bf16* vsrc = Vg + (size_t)(8 * wid + ((lane & 31) >> 2)) * AW + 32 * (lane >> 5) + 8 * (lane & 3);
#pragma unroll
          for (int t = 0; t < 4; ++t) {
              glds16(ksrc + (size_t)(4 * n + t) * 64 * AW, (unsigned)__builtin_amdgcn_readfirstlane((int)(lds0 + AT_RING + t * AT_STAGE + wid * 1024)));
              glds16(vsrc + (size_t)(4 * n + t) * 64 * AW, (unsigned)__builtin_amdgcn_readfirstlane((int)(lds0 + AT_RING + t * AT_STAGE + 8192 + wid * 1024))); }
          AT_WAIT_BAR(); }
        const float cfar = ((const LAS float*)(lds + AT_TB))[h * 128 + 127]; const float NINF = -INFINITY;
        bf16x8 qn[4];
#pragma unroll
        for (int d0 = 0; d0 < 4; ++d0) qn[d0] = *(const bf16x8*)(Q + ((size_t)b * SEQ + (e_c & 0xfffu)) * AW + h * 64 + 16 * d0 + 8 * hi);
        for (int g = wid; g < ngr; g += NWAVES) {
            const int p = 32 * g + r32; const bool valid = p < cnt;
            const unsigned e = e_c;
            const int row = (int)(e & 0xfffu); const unsigned slot = e >> 12;
            const size_t tq = (size_t)b * SEQ + row;
            bf16x8 qr[4];
#pragma unroll
            for (int d0 = 0; d0 < 4; ++d0) qr[d0] = qn[d0];
            { const int p2 = 32 * (g + 2 * NWAVES) + r32; e_c = e_n; e_n = lst[(p2 < cnt) ? p2 : 0];
#pragma unroll
              for (int d0 = 0; d0 < 4; ++d0) qn[d0] = *(const bf16x8*)(Q + ((size_t)b * SEQ + (e_c & 0xfffu)) * AW + h * 64 + 16 * d0 + 8 * hi); }
            const bool adj = (row >> 8) == n + 1;
            f32x16 o0, o1;
#pragma unroll
            for (int r = 0; r < 16; ++r) { o0[r] = 0.f; o1[r] = 0.f; }
            float lsum = 0.f;
#pragma unroll
            for (int t = 0; t < 4; ++t) {
                const float iv = (t >= 2 && adj) ? NINF : cfar;
                f32x16 c0, c1;
#pragma unroll
                for (int r = 0; r < 16; ++r) { c0[r] = iv; c1[r] = iv; }
                { const LAS unsigned char* Kt_ = lds + AT_RING + t * AT_STAGE + r32 * 128;
#pragma unroll
                  for (int d0 = 0; d0 < 4; ++d0) {
                      c0 = __builtin_amdgcn_mfma_f32_32x32x16_bf16(FR_KF(Kt_, d0, 0), qr[d0], c0, 0, 0, 0);
                      c1 = __builtin_amdgcn_mfma_f32_32x32x16_bf16(FR_KF(Kt_, d0, 1), qr[d0], c1, 0, 0, 0); } }
                float sacc = 0.f;
#pragma unroll
                for (int r = 0; r < 16; ++r) { c0[r] = __builtin_amdgcn_exp2f(c0[r]); c1[r] = __builtin_amdgcn_exp2f(c1[r]); sacc += c0[r] + c1[r]; }
                lsum += sacc;
                u32x4v pw[4];
#pragma unroll
                for (int s_ = 0; s_ < 2; ++s_) {
                    pw[s_] = (u32x4v){cvtpk(c0[8 * s_], c0[8 * s_ + 1]), cvtpk(c0[8 * s_ + 2], c0[8 * s_ + 3]), cvtpk(c0[8 * s_ + 4], c0[8 * s_ + 5]), cvtpk(c0[8 * s_ + 6], c0[8 * s_ + 7])};
                    pw[2 + s_] = (u32x4v){cvtpk(c1[8 * s_], c1[8 * s_ + 1]), cvtpk(c1[8 * s_ + 2], c1[8 * s_ + 3]), cvtpk(c1[8 * s_ + 4], c1[8 * s_ + 5]), cvtpk(c1[8 * s_ + 6], c1[8 * s_ + 7])}; }
                const LAS unsigned char* Vt_ = lds + AT_RING + t * AT_STAGE + 8192;
#pragma unroll
                for (int ks = 0; ks < 4; ++ks) { const bf16x8 pa_ = __builtin_bit_cast(bf16x8, pw[ks]);
#pragma unroll
                    for (int d0 = 0; d0 < 2; ++d0) { const LAS unsigned char* vp_ = Vt_ + (2 * ks) * 1024 + d0 * 512 + vbl;
                        const s16x4 lo_ = __builtin_bit_cast(s16x4, __builtin_amdgcn_ds_read_tr16_b64_v4i16((LAS v4i16_t*)vp_)), hh_ = __builtin_bit_cast(s16x4, __builtin_amdgcn_ds_read_tr16_b64_v4i16((LAS v4i16_t*)(vp_ + 1024)));
                        const bf16x8 vf_ = (bf16x8){lo_[0], lo_[1], lo_[2], lo_[3], hh_[0], hh_[1], hh_[2], hh_[3]};
                        if (d0 == 0) o0 = __builtin_amdgcn_mfma_f32_32x32x16_bf16(pa_, vf_, o0, 0, 0, 0); else o1 = __builtin_amdgcn_mfma_f32_32x32x16_bf16(pa_, vf_, o1, 0, 0, 0); } }
            }
            lsum += __shfl_xor(lsum, 32);
#pragma unroll
            for (int r = 0; r < 16; ++r) { const int orow = crow(r, hi); ost16[orow * 64 + r32] = (unsigned short)f2bf(o0[r]); ost16[orow * 64 + 32 + r32] = (unsigned short)f2bf(o1[r]); }
            LDS_WAIT(); asm volatile("" ::: "memory");
#pragma unroll
            for (int i = 0; i < 4; ++i) { const int rw = i * 8 + (lane >> 3), ch = lane & 7;
                const v4u w = *(const LAS v4u*)(ost16 + rw * 64 + ch * 8);
                const unsigned ei = (unsigned)__shfl((int)e, rw);
                const size_t trow = (size_t)b * SEQ + (ei & 0xfffu); const unsigned sl = ei >> 12;
                unsigned char* sp = (sl == 0) ? F.ws + WS_SL0 + trow * 1024 : (sl == 1) ? ((trow < 4 * SEQ) ? F.ws + WS_SL1A + trow * 1024 : F.ws + WS_QI + (trow - 4 * SEQ) * 1024) : F.ws + WS_XB + trow * 1024;
                if (32 * g + rw < cnt) *(v4u*)(sp + (h * 64 + ch * 8) * 2) = w; }
            if (hi == 0 && valid) LS[(tq * 8 + h) * 4 + slot] = lsum;
            LDS_WAIT(); asm volatile("" ::: "memory");
        }
        __syncthreads();
    }
#undef FR_KF
}
__device__ __forceinline__ void moba_own_phase(Frame& F, int layer) {
    int tid_o = threadIdx.x; asm volatile("" : "+v"(tid_o));
    const int lane = tid_o & 63, r32 = lane & 31, hi = lane >> 5, wid = __builtin_amdgcn_readfirstlane(tid_o >> 6);
    LAS unsigned char* lds = F.lds;
    __syncthreads();
    { LAS float* tb = (LAS float*)(lds + AT_TB); build_bias_table(F, tb, layer, 0); }
    __syncthreads();
    const bf16* Q = (const bf16*)(F.ws + WS_QA); const bf16* SG = (const bf16*)(F.ws + WS_SGA);
    bf16* Y = (bf16*)(F.ws + WS_XB);
    LAS unsigned short* ost16 = (LAS unsigned short*)(lds + AT_BM) + wid * 2048;
    const unsigned lds0 = (unsigned)(uintptr_t)lds;
    const int kswz = (r32 ^ (r32 >> 3)) & 7;
    const int vbl = ((lane >> 4) & 1) * 32 + (lane & 3) * 8 + (4 * hi + ((lane & 15) >> 2)) * 64;
    const float NINF = -INFINITY;
    const int wrow = wid < 4 ? wid : 11 - wid;
    const int npr = (512 - F.vcu + F.G - 1) / F.G, nu = 2 * npr;
#define OW_UNIT(k, bb, hh, kk) do { const int pr_ = F.vcu + F.G * ((k) >> 1), bh_ = pr_ >> 3, s_ = pr_ & 7; bb = bh_ >> 3; hh = bh_ & 7; kk = ((k) & 1) ? s_ : 15 - s_; } while (0)
#define OW_KF(Kt_, d0, p) (*(const LAS bf16x8*)((Kt_) + (p) * 4096 + (((2 * (d0) + hi) ^ kswz ^ (4 * (p))) << 4)))
    bf16x8 qn[4]; unsigned adjn = 0u; v4u sgn[4], swn[3][4]; float sln[3][4];
#define OW_FETCH(k) do { int b_, h_, blk_; OW_UNIT(k, b_, h_, blk_); \
        const int TB_ = blk_ > 0 ? 4 * blk_ - 2 : 0, NT_ = blk_ > 0 ? 6 : 4, q0_ = 256 * blk_ + 32 * wrow; \
        const bf16* Kg_ = (const bf16*)(F.ws + WS_KA) + (size_t)b_ * SEQ * AW + h_ * 64; const bf16* Vg_ = (const bf16*)(F.ws + WS_VA) + (size_t)b_ * SEQ * AW + h_ * 64; \
        const int krow_ = 8 * wid + (lane >> 3); \
        const bf16* ksrc_ = Kg_ + (size_t)krow_ * AW + 8 * ((lane & 7) ^ ((krow_ ^ (krow_ >> 3)) & 7)); \
        const bf16* vsrc_ = Vg_ + (size_t)(8 * wid + ((lane & 31) >> 2)) * AW + 32 * (lane >> 5) + 8 * (lane & 3); \
        _Pragma("unroll") for (int t = 0; t < 6; ++t) if (t < NT_) { \
            glds16(ksrc_ + (size_t)(TB_ + t) * 64 * AW, (unsigned)__builtin_amdgcn_readfirstlane((int)(lds0 + AT_RING + t * AT_STAGE + wid * 1024))); \
            glds16(vsrc_ + (size_t)(TB_ + t) * 64 * AW, (unsigned)__builtin_amdgcn_readfirstlane((int)(lds0 + AT_RING + t * AT_STAGE + 8192 + wid * 1024))); } \
        const size_t tq_ = (size_t)b_ * SEQ + q0_ + r32; \
        _Pragma("unroll") for (int d0 = 0; d0 < 4; ++d0) qn[d0] = *(const bf16x8*)(Q + tq_ * AW + h_ * 64 + 16 * d0 + 8 * hi); \
        adjn = (blk_ > 0) ? ((const unsigned*)(F.ws + WS_LS))[(tq_ * 8 + h_) * 4 + 3] : 0u;     \
        _Pragma("unroll") for (int i = 0; i < 4; ++i) sgn[i] = *(const v4u*)(SG + ((size_t)b_ * SEQ + q0_ + i * 8 + (lane >> 3)) * AW + h_ * 64 + (lane & 7) * 8); \
        _Pragma("unroll") for (int sl = 0; sl < 3; ++sl) _Pragma("unroll") for (int i = 0; i < 4; ++i) { const size_t trow = (size_t)b_ * SEQ + q0_ + i * 8 + (lane >> 3); \
            const unsigned char* sp = (sl == 0) ? F.ws + WS_SL0 + trow * 1024 : (sl == 1) ? ((trow < 4 * SEQ) ? F.ws + WS_SL1A + trow * 1024 : F.ws + WS_QI + (trow - 4 * SEQ) * 1024) : F.ws + WS_XB + trow * 1024; \
            swn[sl][i] = *(const v4u*)(sp + (h_ * 64 + (lane & 7) * 8) * 2); sln[sl][i] = ((const float*)(F.ws + WS_LS))[(trow * 8 + h_) * 4 + sl]; } } while (0)
    if (nu > 0) OW_FETCH(0);
    for (int k = 0; k < nu; ++k) {
        int b, h, blk; OW_UNIT(k, b, h, blk);
        const int q0 = 256 * blk + 32 * wrow, q = q0 + r32;
        const int TB = blk > 0 ? 4 * blk - 2 : 0, NT = blk > 0 ? 6 : 4;
        const LAS float* tbh = (const LAS float*)(lds + AT_TB) + h * 128;
        const float cfar = tbh[127];
        AT_WAIT_BAR();
        bf16x8 qr[4]; v4u sgv[4], slw[3][4]; float sll[3][4];
#pragma unroll
        for (int d0 = 0; d0 < 4; ++d0) qr[d0] = qn[d0];
        const bool adjsel = adjn != 0u;
#pragma unroll
        for (int i = 0; i < 4; ++i) sgv[i] = sgn[i];
#pragma unroll
        for (int sl = 0; sl < 3; ++sl)
#pragma unroll
            for (int i = 0; i < 4; ++i) { slw[sl][i] = swn[sl][i]; sll[sl][i] = sln[sl][i]; }
        f32x16 o0, o1;
#pragma unroll
        for (int r = 0; r < 16; ++r) { o0[r] = 0.f; o1[r] = 0.f; }
        float lsum = 0.f;
#pragma unroll 1
        for (int t = 0; t < NT; ++t) {
            const int ta = TB + t, kv0 = 64 * ta; const bool own = (ta >> 2) == blk; const bool sel = own || adjsel;
            if (kv0 > q0 + 31) continue;
            f32x16 c0, c1;
            if ((q0 - (kv0 + 63)) < 113) {
#pragma unroll
                for (int r = 0; r < 16; ++r) { const int bp = (r & 3) + 8 * (r >> 2);
                    const int d0_ = q - (kv0 + bp + 4 * hi), d1_ = d0_ - 32;
                    const float b0_ = tbh[d0_ < 0 ? 0 : (d0_ > 127 ? 127 : d0_)], b1_ = tbh[d1_ < 0 ? 0 : (d1_ > 127 ? 127 : d1_)];
                    c0[r] = (sel && d0_ >= 0) ? b0_ : NINF; c1[r] = (sel && d1_ >= 0) ? b1_ : NINF; } }
            else { const float iv = sel ? cfar : NINF;
#pragma unroll
                for (int r = 0; r < 16; ++r) { c0[r] = iv; c1[r] = iv; } }
            { const LAS unsigned char* Kt_ = lds + AT_RING + t * AT_STAGE + r32 * 128;
#pragma unroll
              for (int d0 = 0; d0 < 4; ++d0) {
                  c0 = __builtin_amdgcn_mfma_f32_32x32x16_bf16(OW_KF(Kt_, d0, 0), qr[d0], c0, 0, 0, 0);
                  c1 = __builtin_amdgcn_mfma_f32_32x32x16_bf16(OW_KF(Kt_, d0, 1), qr[d0], c1, 0, 0, 0); } }
            float sacc = 0.f;
#pragma unroll
            for (int r = 0; r < 16; ++r) { c0[r] = __builtin_amdgcn_exp2f(c0[r]); c1[r] = __builtin_amdgcn_exp2f(c1[r]); sacc += c0[r] + c1[r]; }
            lsum += sacc;
            u32x4v pw[4];
#pragma unroll
            for (int s_ = 0; s_ < 2; ++s_) {
                pw[s_] = (u32x4v){cvtpk(c0[8 * s_], c0[8 * s_ + 1]), cvtpk(c0[8 * s_ + 2], c0[8 * s_ + 3]), cvtpk(c0[8 * s_ + 4], c0[8 * s_ + 5]), cvtpk(c0[8 * s_ + 6], c0[8 * s_ + 7])};
                pw[2 + s_] = (u32x4v){cvtpk(c1[8 * s_], c1[8 * s_ + 1]), cvtpk(c1[8 * s_ + 2], c1[8 * s_ + 3]), cvtpk(c1[8 * s_ + 4], c1[8 * s_ + 5]), cvtpk(c1[8 * s_ + 6], c1[8 * s_ + 7])}; }
            const LAS unsigned char* Vt_ = lds + AT_RING + t * AT_STAGE + 8192;
#pragma unroll
            for (int ks = 0; ks < 4; ++ks) { const bf16x8 pa_ = __builtin_bit_cast(bf16x8, pw[ks]);
#pragma unroll
                for (int d0 = 0; d0 < 2; ++d0) { const LAS unsigned char* vp_ = Vt_ + (2 * ks) * 1024 + d0 * 512 + vbl;
                    const s16x4 lo_ = __builtin_bit_cast(s16x4, __builtin_amdgcn_ds_read_tr16_b64_v4i16((LAS v4i16_t*)vp_)), hh_ = __builtin_bit_cast(s16x4, __builtin_amdgcn_ds_read_tr16_b64_v4i16((LAS v4i16_t*)(vp_ + 1024)));
                    const bf16x8 vf_ = (bf16x8){lo_[0], lo_[1], lo_[2], lo_[3], hh_[0], hh_[1], hh_[2], hh_[3]};
                    if (d0 == 0) o0 = __builtin_amdgcn_mfma_f32_32x32x16_bf16(pa_, vf_, o0, 0, 0, 0); else o1 = __builtin_amdgcn_mfma_f32_32x32x16_bf16(pa_, vf_, o1, 0, 0, 0); } }
        }
        asm volatile("s_waitcnt lgkmcnt(0)\n\ts_barrier" ::: "memory");
        if (k + 1 < nu) OW_FETCH(k + 1);
        lsum += __shfl_xor(lsum, 32);
#pragma unroll
        for (int r = 0; r < 16; ++r) { const int orow = crow(r, hi); ost16[orow * 64 + r32] = (unsigned short)f2bf(o0[r]); ost16[orow * 64 + 32 + r32] = (unsigned short)f2bf(o1[r]); }
        LDS_WAIT(); asm volatile("" ::: "memory");
        const int nsl = blk < 3 ? blk : 3;
#pragma unroll
        for (int i = 0; i < 4; ++i) { const int row = i * 8 + (lane >> 3), ch = lane & 7;
            const v4u w0 = *(const LAS v4u*)(ost16 + row * 64 + ch * 8);
            float a[8] = {bflo(w0.x), bfhi(w0.x), bflo(w0.y), bfhi(w0.y), bflo(w0.z), bfhi(w0.z), bflo(w0.w), bfhi(w0.w)};
            float lt = __shfl(lsum, row);
#pragma unroll
            for (int sl = 0; sl < 3; ++sl) if (sl < nsl) { const v4u w = slw[sl][i];
                a[0] += bflo(w.x); a[1] += bfhi(w.x); a[2] += bflo(w.y); a[3] += bfhi(w.y); a[4] += bflo(w.z); a[5] += bfhi(w.z); a[6] += bflo(w.w); a[7] += bfhi(w.w);
                lt += sll[sl][i]; }
            const float rl = __builtin_amdgcn_rcpf(lt);
            const size_t off = ((size_t)b * SEQ + q0 + row) * AW + h * 64 + ch * 8;
            const v4u g = sgv[i]; v4u o;
            o.x = pk2(a[0] * rl * bflo(g.x), a[1] * rl * bfhi(g.x)); o.y = pk2(a[2] * rl * bflo(g.y), a[3] * rl * bfhi(g.y)); o.z = pk2(a[4] * rl * bflo(g.z), a[5] * rl * bfhi(g.z)); o.w = pk2(a[6] * rl * bflo(g.w), a[7] * rl * bfhi(g.w));
            *(v4u*)(Y + off) = o; }
        LDS_WAIT(); asm volatile("" ::: "memory");
    }
    asm volatile("s_waitcnt vmcnt(0) lgkmcnt(0)\n\ts_barrier" ::: "memory");
#undef OW_UNIT
#undef OW_KF
#undef OW_FETCH
}
__device__ __forceinline__ void attn_phase_fast(Frame& F, int layer) {
    { LAS float* tb = (LAS float*)(F.lds + AT_TB);
      build_bias_table(F, tb, layer, 0);
      build_bias_table(F, tb + 1024, layer, 8); }
    __syncthreads();
#ifndef REP_ATT_A
#define REP_ATT_A 1
#endif
#ifndef REP_ATT_B
#define REP_ATT_B 1
#endif
    for (int rep = 0; rep < REP_ATT_A; ++rep)
    for (int pr = F.vcu; pr < 512; pr += F.G) {
        const int bh = pr >> 3, s = pr & 7;
        attn_unit<0>(F, bh >> 3, bh & 7, 15 - s); attn_unit<0>(F, bh >> 3, bh & 7, s); }
    for (int rep = 0; rep < REP_ATT_B; ++rep)
    for (int pr = F.vcu; pr < 512; pr += F.G) {
        const int b = pr >> 6, s = pr & 63;
        attn_unit<1>(F, b, 0, 127 - s); attn_unit<1>(F, b, 0, s); }
}

constexpr int IDX_S_OFF = 0, IDX_Q_OFF = RING_BYTES, IDX_W_OFF = RING_BYTES + 8192, IDX_H_OFF = RING_BYTES;
static_assert(IDX_H_OFF + 8 * 3328 <= LDSCTL_OFF, "idx LDS");

#define DPPI_(x, ctrl) __builtin_amdgcn_update_dpp(0, (x), (ctrl), 0xF, 0xF, true)
#define DPPF_(x, ctrl) __builtin_bit_cast(float, DPPI_(__builtin_bit_cast(int, (x)), (ctrl)))
__device__ __forceinline__ float rl_f(float x, int l) { return __builtin_bit_cast(float, __builtin_amdgcn_readlane(__builtin_bit_cast(int, x), l)); }
__device__ __forceinline__ float wave_minf(float x) {
    x = fminf(x, DPPF_(x, 0xB1)); x = fminf(x, DPPF_(x, 0x4E)); x = fminf(x, DPPF_(x, 0x141)); x = fminf(x, DPPF_(x, 0x140));
    return fminf(fminf(rl_f(x, 0), rl_f(x, 16)), fminf(rl_f(x, 32), rl_f(x, 48)));
}
__device__ __forceinline__ float wave_maxf(float x) {
    x = fmaxf(x, DPPF_(x, 0xB1)); x = fmaxf(x, DPPF_(x, 0x4E)); x = fmaxf(x, DPPF_(x, 0x141)); x = fmaxf(x, DPPF_(x, 0x140));
    return fmaxf(fmaxf(rl_f(x, 0), rl_f(x, 16)), fmaxf(rl_f(x, 32), rl_f(x, 48)));
}
#define SEL_OPAQUE() do { _Pragma("unroll") for (int j_ = 0; j_ < 64; ++j_) asm volatile("" : "+v"(v[j_])); } while (0)
__device__ __forceinline__ unsigned pkrtz_f16(float a, float b) { unsigned r; asm("v_cvt_pkrtz_f16_f32 %0, %1, %2" : "=v"(r) : "v"(a), "v"(b)); return r; }
typedef _Float16 sel_t;
typedef _Float16 sel8_t __attribute__((ext_vector_type(8)));
__device__ __forceinline__ unsigned bin_of(float x, float lo, float scale) {
    int r; const float t = (x - lo) * scale; asm("v_cvt_i32_f32 %0, %1" : "=v"(r) : "v"(t)); const unsigned u = (unsigned)r; return u < 256u ? u : 256u;
}
#define SEL_PAD(R_, n_, nch_, nch4_) do { _Pragma("unroll") for (int k_ = 0; k_ < 4; ++k_) { const int i_ = 64 * ((nch_) - 1 + k_) + lane; if ((nch_) - 1 + k_ < (nch4_) && i_ >= (n_)) (R_)[i_] = (sel_t)(-INFINITY); } } while (0)
#define SEL_LOAD4(xx_, Rl_, j0_) float xx_[4]; { const sel_t a0_ = (Rl_)[64 * (j0_)], a1_ = (Rl_)[64 * (j0_) + 64], a2_ = (Rl_)[64 * (j0_) + 128], a3_ = (Rl_)[64 * (j0_) + 192]; xx_[0] = (float)a0_; xx_[1] = (float)a1_; xx_[2] = (float)a2_; xx_[3] = (float)a3_; }
template <bool KNOWN>
__device__ __forceinline__ void select_core(LAS sel_t* R, int n, int lane, LAS unsigned* hist, float& T_out, int& needT_out, float lo_in = 0.f, float hi_in = 0.f) {
    const int nch = (n + 63) >> 6, nch4 = (nch + 3) & ~3;
    SEL_PAD(R, n, nch, nch4);
    LDS_WAIT(); asm volatile("" ::: "memory");
    const LAS sel_t* Rl = R + lane;
    float lo = lo_in, hi = hi_in;
    if (!KNOWN) { lo = INFINITY; hi = -INFINITY;
        for (int j0 = 0; j0 < nch4; j0 += 4) { SEL_LOAD4(xx, Rl, j0);
#pragma unroll
            for (int u = 0; u < 4; ++u) { const float x = xx[u]; lo = fminf(lo, x == -INFINITY ? INFINITY : x); hi = fmaxf(hi, x); } }
        lo = wave_minf(lo); hi = wave_maxf(hi); }
    int need = 256; float T = lo; int needT = 256;
    for (int iter = 0; iter < 48; ++iter) {
        T = lo; needT = need;
        if (!(hi > lo)) break;
        hist[lane] = 0u; hist[64 + lane] = 0u; hist[128 + lane] = 0u; hist[192 + lane] = 0u; hist[256 + (lane & 3)] = 0u;
        LDS_WAIT(); asm volatile("" ::: "memory");
        const float scale = 255.99f / (hi - lo);
        for (int j0 = 0; j0 < nch4; j0 += 4) { SEL_LOAD4(xx, Rl, j0);
#pragma unroll
            for (int u = 0; u < 4; ++u) __hip_atomic_fetch_add(hist + bin_of(xx[u], lo, scale), 1u, __ATOMIC_RELAXED, __HIP_MEMORY_SCOPE_WORKGROUP); }
        LDS_WAIT(); asm volatile("" ::: "memory");
        const unsigned h0 = hist[4 * lane], h1 = hist[4 * lane + 1], h2 = hist[4 * lane + 2], h3 = hist[4 * lane + 3];
        unsigned suf = h0 + h1 + h2 + h3;
        suf += (unsigned)__builtin_amdgcn_update_dpp(0, (int)suf, 0x101, 0xF, 0xF, true); suf += (unsigned)__builtin_amdgcn_update_dpp(0, (int)suf, 0x102, 0xF, 0xF, true);
        suf += (unsigned)__builtin_amdgcn_update_dpp(0, (int)suf, 0x104, 0xF, 0xF, true); suf += (unsigned)__builtin_amdgcn_update_dpp(0, (int)suf, 0x108, 0xF, 0xF, true);
        { const unsigned r1 = __builtin_amdgcn_readlane(suf, 16), r2 = __builtin_amdgcn_readlane(suf, 32), r3 = __builtin_amdgcn_readlane(suf, 48);
          const int rw = lane >> 4; suf += (rw == 0) ? (r1 + r2 + r3) : (rw == 1) ? (r2 + r3) : (rw == 2) ? r3 : 0u; }
        const u64 bal = __ballot(suf >= (unsigned)need);
        if (bal == 0ull) break;
        const int ls = 63 - __builtin_clzll(bal);
        const unsigned a3 = __builtin_amdgcn_readlane(h3, ls), a2 = __builtin_amdgcn_readlane(h2, ls), a1 = __builtin_amdgcn_readlane(h1, ls), a0 = __builtin_amdgcn_readlane(h0, ls);
        const unsigned above_lane = __builtin_amdgcn_readlane(suf, ls) - (a0 + a1 + a2 + a3);
        unsigned bstar, above, cstar;
        if (above_lane + a3 >= (unsigned)need) { bstar = 4 * ls + 3; above = above_lane; cstar = a3; }
        else if (above_lane + a3 + a2 >= (unsigned)need) { bstar = 4 * ls + 2; above = above_lane + a3; cstar = a2; }
        else if (above_lane + a3 + a2 + a1 >= (unsigned)need) { bstar = 4 * ls + 1; above = above_lane + a3 + a2; cstar = a1; }
        else { bstar = 4 * ls; above = above_lane + a3 + a2 + a1; cstar = a0; }
        need -= (int)above;
        float nlo = INFINITY, nhi = -INFINITY; int cnt = 0;
        LAS float* candx = (LAS float*)hist; LAS unsigned* candi = hist + 64;
        for (int j0 = 0; j0 < nch4; j0 += 4) { SEL_LOAD4(xx, Rl, j0);
#pragma unroll
            for (int u = 0; u < 4; ++u) { const float x = xx[u]; const int j = j0 + u;
                const bool c = bin_of(x, lo, scale) == bstar;
                const u64 cb = __ballot(c);
                if (cb != 0ull) { nlo = fminf(nlo, c ? x : INFINITY); nhi = fmaxf(nhi, c ? x : -INFINITY);
                    const int pos = cnt + (int)__builtin_amdgcn_mbcnt_hi((unsigned)(cb >> 32), __builtin_amdgcn_mbcnt_lo((unsigned)cb, 0u));
                    if (c && pos < 64) { candx[pos] = x; candi[pos] = (unsigned)(64 * j + lane); }
                    cnt += __builtin_popcountll(cb); } } }
        if (cstar <= 64u) {
            LDS_WAIT(); asm volatile("" ::: "memory");
            const bool mine = lane < (int)cstar;
            const float mx = mine ? candx[lane] : -INFINITY; const unsigned mi = candi[lane];
            int rank = 0;
            for (int i = 0; i < (int)cstar; ++i) { const float xi = rl_f(mx, i); const unsigned ii = (unsigned)__builtin_amdgcn_readlane((int)mi, i); rank += (xi > mx || (xi == mx && ii < mi)) ? 1 : 0; }
            const u64 tb_ = __ballot(mine && rank == need - 1);
            if (tb_ == 0ull) break;
            T = rl_f(mx, __builtin_ctzll(tb_));
            needT = need - __builtin_popcountll(__ballot(mine && mx > T));
            LDS_WAIT(); asm volatile("" ::: "memory");
            break;
        }
        nlo = wave_minf(nlo); nhi = wave_maxf(nhi);
        if ((int)cstar == need) { T = nlo; needT = 1 << 20; break; }
        lo = nlo; hi = nhi;
    }
    T_out = T; needT_out = needT;
}

__device__ __forceinline__ unsigned sel_key(float x) { unsigned hb = (unsigned)__builtin_bit_cast(unsigned short, (sel_t)x); hb = (hb == 0x8000u) ? 0u : hb; return (hb & 0x8000u) ? (~hb & 0xffffu) : (hb | 0x8000u); }
__device__ __forceinline__ void select_bisect(const LAS sel_t* R, int cnt, int lane, float& T_out, int& needT_out, unsigned klo = 0u, unsigned khi = 0xffffu) {
    const LAS unsigned short* Rb = (const LAS unsigned short*)R + lane;
    unsigned key[16];
#pragma unroll
    for (int j = 0; j < 16; ++j) { const int idx = 64 * j + lane; unsigned hb = (idx < cnt) ? (unsigned)Rb[64 * j] : 0xfc00u;
        hb = (hb == 0x8000u) ? 0u : hb;
        key[j] = (hb & 0x8000u) ? (~hb & 0xffffu) : (hb | 0x8000u); }
#define SEL_WSUM(c_) ({ int s_ = (c_); s_ += __builtin_amdgcn_update_dpp(0, s_, 0xB1, 0xF, 0xF, true); s_ += __builtin_amdgcn_update_dpp(0, s_, 0x4E, 0xF, 0xF, true); \
        s_ += __builtin_amdgcn_update_dpp(0, s_, 0x141, 0xF, 0xF, true); s_ += __builtin_amdgcn_update_dpp(0, s_, 0x140, 0xF, 0xF, true); \
        __builtin_amdgcn_readlane(s_, 0) + __builtin_amdgcn_readlane(s_, 16) + __builtin_amdgcn_readlane(s_, 32) + __builtin_amdgcn_readlane(s_, 48); })
    const unsigned dif = (klo ^ khi) & 0xffffu; const int hb0 = dif ? 31 - __builtin_clz(dif) : -1;
    unsigned P = (hb0 >= 15) ? 0u : (klo & ~((2u << (hb0 < 0 ? 0 : hb0)) - 1u) & 0xffffu); if (hb0 < 0) P = klo & 0xffffu;
#pragma unroll 1
    for (int bit = hb0; bit >= 0; --bit) { const unsigned Tc = P | (1u << bit); u64 bb[16];
#pragma unroll
        for (int j = 0; j < 16; ++j) bb[j] = __ballot(key[j] >= Tc);
        __builtin_amdgcn_sched_barrier(0);
        int c = 0;
#pragma unroll
        for (int j = 0; j < 16; ++j) c += __builtin_popcountll(bb[j]);
        if (c >= 256) P = Tc; }
    int gtl = 0;
#pragma unroll
    for (int j = 0; j < 16; ++j) gtl += (key[j] > P) ? 1 : 0;
    const int gt = SEL_WSUM(gtl);
#undef SEL_WSUM
    const unsigned hb = (P & 0x8000u) ? (P & 0x7fffu) : (~P & 0xffffu);
    T_out = (float)__builtin_bit_cast(sel_t, (unsigned short)hb); needT_out = 256 - gt;
}
#define SEL_MB(b_) ((int)__builtin_amdgcn_mbcnt_hi((unsigned)((b_) >> 32), __builtin_amdgcn_mbcnt_lo((unsigned)(b_), 0u)))
#define SEL_EMIT4(xx_, id0_, id1_, id2_, id3_) do { \
        const bool e0_ = xx_[0] == T, e1_ = xx_[1] == T, e2_ = xx_[2] == T, e3_ = xx_[3] == T; \
        const u64 tb0_ = __ballot(e0_), tb1_ = __ballot(e1_), tb2_ = __ballot(e2_), tb3_ = __ballot(e3_); \
        bool s0_ = xx_[0] > T, s1_ = xx_[1] > T, s2_ = xx_[2] > T, s3_ = xx_[3] > T; \
        if ((tb0_ | tb1_ | tb2_ | tb3_) != 0ull) { const int tn0_ = __builtin_popcountll(tb0_), tn1_ = __builtin_popcountll(tb1_), tn2_ = __builtin_popcountll(tb2_); \
            s0_ = s0_ || (e0_ && trun + SEL_MB(tb0_) < needT); s1_ = s1_ || (e1_ && trun + tn0_ + SEL_MB(tb1_) < needT); \
            s2_ = s2_ || (e2_ && trun + tn0_ + tn1_ + SEL_MB(tb2_) < needT); s3_ = s3_ || (e3_ && trun + tn0_ + tn1_ + tn2_ + SEL_MB(tb3_) < needT); \
            trun += tn0_ + tn1_ + tn2_ + __builtin_popcountll(tb3_); } \
        const u64 sb0_ = __ballot(s0_), sb1_ = __ballot(s1_), sb2_ = __ballot(s2_), sb3_ = __ballot(s3_); \
        const int sn0_ = __builtin_popcountll(sb0_), sn1_ = __builtin_popcountll(sb1_), sn2_ = __builtin_popcountll(sb2_); \
        const int q0_ = srun + SEL_MB(sb0_), q1_ = srun + sn0_ + SEL_MB(sb1_), q2_ = srun + sn0_ + sn1_ + SEL_MB(sb2_), q3_ = srun + sn0_ + sn1_ + sn2_ + SEL_MB(sb3_); \
        srun += sn0_ + sn1_ + sn2_ + __builtin_popcountll(sb3_); \
        if (s0_ && q0_ < 256) dst[q0_] = (unsigned short)(id0_); if (s1_ && q1_ < 256) dst[q1_] = (unsigned short)(id1_); \
        if (s2_ && q2_ < 256) dst[q2_] = (unsigned short)(id2_); if (s3_ && q3_ < 256) dst[q3_] = (unsigned short)(id3_); } while (0)
__device__ __forceinline__ void list_row(const LAS sel_t* R, int n, int lane, float T, int needT, unsigned short* dst) {
    const int nch = (n + 63) >> 6, nch4 = (nch + 3) & ~3; const LAS sel_t* Rl = R + lane;
    int trun = 0, srun = 0;
    for (int j0 = 0; j0 < nch4; j0 += 4) { SEL_LOAD4(xx, Rl, j0);
        SEL_EMIT4(xx, 64 * j0 + lane, 64 * j0 + 64 + lane, 64 * j0 + 128 + lane, 64 * j0 + 192 + lane); }
}
__device__ __forceinline__ void select_row(LAS sel_t* R, int n, int lane, LAS unsigned* hist, unsigned short* dst) {
    const int nch = (n + 63) >> 6, nch4 = (nch + 3) & ~3;
    SEL_PAD(R, n, nch, nch4);
    LDS_WAIT(); asm volatile("" ::: "memory");
    const LAS sel_t* Rl = R + lane;
    LAS unsigned short* idx16 = (LAS unsigned short*)(hist + 320);
    float T; int needT;
    if (n <= 1024) { select_bisect(R, n, lane, T, needT); list_row(R, n, lane, T, needT, dst); return; }
    bool fast = true;
    float L = 0.f; int cnt = 0;
    {
        const float x0 = Rl[0];
        int kth = (64 * 640) / n; kth = kth < 4 ? 4 : (kth > 60 ? 60 : kth);
        int above = 0;
#pragma unroll
        for (int i = 0; i < 8; ++i) { const sel8_t q = *(const LAS sel8_t*)(R + 8 * i);
#pragma unroll
            for (int k = 0; k < 8; ++k) above += ((float)q[k] > x0) ? 1 : 0; }
        fast = false;
        for (int attempt = 0; attempt < 3 && !fast; ++attempt) {
            L = wave_minf(above <= kth ? x0 : INFINITY);
            int cl = 0;
            { const sel_t Lh = (sel_t)L; const int nel = 64 * nch4;
              for (int e0 = 8 * lane; e0 < nel; e0 += 512) { const sel8_t q = *(const LAS sel8_t*)(R + e0);
#pragma unroll
                  for (int k = 0; k < 8; ++k) cl += (q[k] >= Lh) ? 1 : 0; } }
            cl += __builtin_amdgcn_update_dpp(0, cl, 0xB1, 0xF, 0xF, true); cl += __builtin_amdgcn_update_dpp(0, cl, 0x4E, 0xF, 0xF, true);
            cl += __builtin_amdgcn_update_dpp(0, cl, 0x141, 0xF, 0xF, true); cl += __builtin_amdgcn_update_dpp(0, cl, 0x140, 0xF, 0xF, true);
            cnt = __builtin_amdgcn_readlane(cl, 0) + __builtin_amdgcn_readlane(cl, 16) + __builtin_amdgcn_readlane(cl, 32) + __builtin_amdgcn_readlane(cl, 48);
            fast = cnt >= 256 && cnt <= 1024;
            if (cnt > 1024) kth = (kth > 1) ? (kth >> 1) : 0; else kth = (2 * kth + 2 > 63) ? 63 : 2 * kth + 2;
        }
    }
    if (!fast) { select_core<false>(R, n, lane, hist, T, needT); list_row(R, n, lane, T, needT, dst); return; }
    int pos = 0; float hmax = -INFINITY;
    for (int j0 = 0; j0 < nch4; j0 += 4) { SEL_LOAD4(xx, Rl, j0);
        asm volatile("" ::: "memory");
        hmax = fmaxf(fmaxf(hmax, xx[0]), fmaxf(xx[1], fmaxf(xx[2], xx[3])));
        const bool c0 = xx[0] >= L, c1 = xx[1] >= L, c2 = xx[2] >= L, c3 = xx[3] >= L;
        const u64 b0 = __ballot(c0), b1 = __ballot(c1), b2 = __ballot(c2), b3 = __ballot(c3);
        const int n0 = __builtin_popcountll(b0), n1 = __builtin_popcountll(b1), n2 = __builtin_popcountll(b2);
        const int p0 = pos + SEL_MB(b0), p1 = pos + n0 + SEL_MB(b1), p2 = pos + n0 + n1 + SEL_MB(b2), p3 = pos + n0 + n1 + n2 + SEL_MB(b3);
        pos += n0 + n1 + n2 + __builtin_popcountll(b3);
        if (c0) { R[p0] = (sel_t)xx[0]; idx16[p0] = (unsigned short)(64 * j0 + lane); }
        if (c1) { R[p1] = (sel_t)xx[1]; idx16[p1] = (unsigned short)(64 * j0 + 64 + lane); }
        if (c2) { R[p2] = (sel_t)xx[2]; idx16[p2] = (unsigned short)(64 * j0 + 128 + lane); }
        if (c3) { R[p3] = (sel_t)xx[3]; idx16[p3] = (unsigned short)(64 * j0 + 192 + lane); }
        asm volatile("" ::: "memory"); }
    LDS_WAIT(); asm volatile("" ::: "memory");
    select_bisect(R, cnt, lane, T, needT, (unsigned)__builtin_amdgcn_readfirstlane((int)sel_key(L)), (unsigned)__builtin_amdgcn_readfirstlane((int)sel_key(wave_maxf(hmax))));
    { const int ncl_ = (cnt + 63) >> 6, ncl4_ = (ncl_ + 3) & ~3; SEL_PAD(R, cnt, ncl_, ncl4_); }
    LDS_WAIT(); asm volatile("" ::: "memory");
    const int ncl4 = (((cnt + 63) >> 6) + 3) & ~3; int trun = 0, srun = 0;
    for (int j0 = 0; j0 < ncl4; j0 += 4) { SEL_LOAD4(xx, Rl, j0);
        const unsigned i0_ = idx16[64 * j0 + lane], i1_ = idx16[64 * j0 + 64 + lane], i2_ = idx16[64 * j0 + 128 + lane], i3_ = idx16[64 * j0 + 192 + lane];
        SEL_EMIT4(xx, i0_, i1_, i2_, i3_); }
}

#ifdef NAIVE_IDX
__device__ __forceinline__ void idx_phase_naive(Frame& F) {
    PHASE_TID();
    LAS float* S = (LAS float*)(F.lds + IDX_S_OFF); LAS float* qs = (LAS float*)(F.lds + IDX_Q_OFF); LAS float* wsm = (LAS float*)(F.lds + IDX_W_OFF);
    LAS unsigned* hist = (LAS unsigned*)(F.lds + IDX_H_OFF) + F.wave * 832;
    const bf16* QI = (const bf16*)(F.ws + WS_QI); const bf16* KI = (const bf16*)(F.ws + WS_KI); const float* WI = (const float*)(F.ws + WS_WI); u64* BM = (u64*)(F.ws + WS_BM);
    for (int un = blockIdx.x; un < TOK / 8; un += F.G) {
        const int b = un >> 9, q0 = (un & 511) * 8; const size_t t0 = (size_t)b * SEQ + q0;
        for (int e = ptid; e < 8 * 256; e += NWAVES * 64) qs[e] = bf2f(QI[t0 * 256 + e]);
        if (ptid < 32) wsm[ptid] = WI[t0 * 4 + ptid];
        __syncthreads();
        const int nk = q0 + 8;
        for (int k = ptid; k < nk; k += NWAVES * 64) {
            float kf[64];
            { const v4u* kp = (const v4u*)(KI + ((size_t)b * SEQ + k) * 64);
#pragma unroll
                for (int c = 0; c < 8; ++c) { const v4u w = kp[c]; kf[8 * c + 0] = bflo(w.x); kf[8 * c + 1] = bfhi(w.x); kf[8 * c + 2] = bflo(w.y); kf[8 * c + 3] = bfhi(w.y); kf[8 * c + 4] = bflo(w.z); kf[8 * c + 5] = bfhi(w.z); kf[8 * c + 6] = bflo(w.w); kf[8 * c + 7] = bfhi(w.w); } }
            for (int i = 0; i < 8; ++i) { float sc = 0.f;
#pragma unroll
                for (int h = 0; h < 4; ++h) { float dot = 0.f; const LAS f32x4* qp = (const LAS f32x4*)(qs + i * 256 + h * 64);
#pragma unroll
                    for (int c = 0; c < 16; ++c) { const f32x4 qq = qp[c]; dot += kf[4 * c] * qq[0]; dot += kf[4 * c + 1] * qq[1]; dot += kf[4 * c + 2] * qq[2]; dot += kf[4 * c + 3] * qq[3]; }
                    sc += wsm[i * 4 + h] * fmaxf(dot, 0.f); }
                S[i * 4096 + k] = sc; }
        }
        __syncthreads();
        { const int i = F.wave, n = q0 + i + 1; u64 word;
            if (n <= 256) { const int full = n >> 6, rem = n & 63; word = (plane < full) ? ~0ull : (plane == full ? ((1ull << rem) - 1ull) : 0ull); }
            else word = select_row(S + i * 4096, n, plane, hist);
            BM[(t0 + i) * 64 + plane] = word; }
        __syncthreads();
    }
}

#endif
__device__ __forceinline__ float dpp_quad_sum(float x) {
    x += __builtin_bit_cast(float, __builtin_amdgcn_mov_dpp(__builtin_bit_cast(int, x), 0xB1, 0xF, 0xF, true));
    x += __builtin_bit_cast(float, __builtin_amdgcn_mov_dpp(__builtin_bit_cast(int, x), 0x4E, 0xF, 0xF, true));
    return x;
}
__device__ __forceinline__ void relu_w_quadsum4(const pg8::f32x4 a, float w, float (&s)[4]) {
    float r0 = __int_as_float(max(__float_as_int(a[0]), 0)), r1 = __int_as_float(max(__float_as_int(a[1]), 0)), r2 = __int_as_float(max(__float_as_int(a[2]), 0)), r3 = __int_as_float(max(__float_as_int(a[3]), 0));
    asm("v_mul_f32 %0, %4, %0\n\tv_mul_f32 %1, %4, %1\n\tv_mul_f32 %2, %4, %2\n\tv_mul_f32 %3, %4, %3\n\t"
        "v_add_f32_dpp %0, %0, %0 quad_perm:[1,0,3,2] row_mask:0xf bank_mask:0xf\n\tv_add_f32_dpp %1, %1, %1 quad_perm:[1,0,3,2] row_mask:0xf bank_mask:0xf\n\t"
        "v_add_f32_dpp %2, %2, %2 quad_perm:[1,0,3,2] row_mask:0xf bank_mask:0xf\n\tv_add_f32_dpp %3, %3, %3 quad_perm:[1,0,3,2] row_mask:0xf bank_mask:0xf\n\t"
        "v_add_f32_dpp %0, %0, %0 quad_perm:[2,3,0,1] row_mask:0xf bank_mask:0xf\n\tv_add_f32_dpp %1, %1, %1 quad_perm:[2,3,0,1] row_mask:0xf bank_mask:0xf\n\t"
        "v_add_f32_dpp %2, %2, %2 quad_perm:[2,3,0,1] row_mask:0xf bank_mask:0xf\n\tv_add_f32_dpp %3, %3, %3 quad_perm:[2,3,0,1] row_mask:0xf bank_mask:0xf"
        : "+v"(r0), "+v"(r1), "+v"(r2), "+v"(r3) : "v"(w));
    s[0] = r0; s[1] = r1; s[2] = r2; s[3] = r3;
}
__device__ __forceinline__ void idx_phase(Frame& F) {
    PHASE_TID();
    LAS sel_t* S = (LAS sel_t*)(F.lds + IDX_S_OFF);
    LAS unsigned* hist = (LAS unsigned*)(F.lds + IDX_H_OFF) + F.wave * 832;
    const bf16* QI = (const bf16*)(F.ws + WS_QI); const bf16* KI = (const bf16*)(F.ws + WS_KI); const float* WI = (const float*)(F.ws + WS_WI); u64* BM = (u64*)(F.ws + WS_BM);
    const int c16 = plane & 15, kg = plane >> 4, qloc = c16 >> 2, hh = c16 & 3;
    {
        const float* KMP = (const float*)(F.ws + WS_KMP); bf16* KMH = (bf16*)(F.ws + WS_KMH); bf16* KML = (bf16*)(F.ws + WS_KML);
        for (int e = blockIdx.x * (NWAVES * 64) + ptid; e < BATCH * NH * 32 * 64; e += F.G * NWAVES * 64) {
            const int d = e & 63, n = (e >> 6) & 31, h = (e >> 11) & 7, b = e >> 14; unsigned vh = 0, vl = 0;
            if (n < 16) { const float* p = KMP + ((((size_t)b * 16 + n) * 8 + h) * 2) * 64 + d; const float v = (p[0] + p[64]) * (1.0f / 256.0f);
                vh = f2bf(v); vl = f2bf(v - __uint_as_float(vh << 16)); }
            KMH[e] = (bf16)vh; KML[e] = (bf16)vl; }
    }
    for (int un = blockIdx.x; un < TOK / 16; un += F.G) {
        const int b = un & 7, m_ = un >> 3, q0 = (m_ < 128 ? m_ : 383 - m_) * 16; const size_t t0 = (size_t)b * SEQ + q0;
        bf16x8 qf[4][2]; pg8::f32x4 wq[4];
#pragma unroll
        for (int g = 0; g < 4; ++g) { wq[g] = *(const pg8::f32x4*)(WI + (t0 + 4 * g + kg) * 4);
#pragma unroll
            for (int ks = 0; ks < 2; ++ks) qf[g][ks] = *(const bf16x8*)(QI + (t0 + 4 * g + qloc) * 256 + hh * 64 + 32 * ks + 8 * kg); }
        const int nchunk = (q0 + 16 + 15) >> 4;
        const bf16* kbase = KI + (size_t)b * SEQ * 64 + (size_t)(plane >> 2) * 64 + 8 * (plane & 3);
        const int kbp = 4 * (4 * c16 + kg);
#define IDX_LOAD(KA, c0_) do { _Pragma("unroll") for (int u = 0; u < 4; ++u) { const int c = (c0_) + u * NWAVES; const bf16* kp = kbase + (size_t)(c < nchunk ? c : F.wave) * 16 * 64; \
            KA[u][0] = *(const bf16x8*)kp; KA[u][1] = *(const bf16x8*)(kp + 32); } } while (0)
#define IDX_COMP(KA, c0_) do { _Pragma("unroll") for (int u = 0; u < 4; ++u) { const int c = (c0_) + u * NWAVES; \
            if (c < nchunk) { bf16x8 kx0_, kx1_; \
              { const u32x4v r0_ = __builtin_bit_cast(u32x4v, KA[u][0]), r1_ = __builtin_bit_cast(u32x4v, KA[u][1]); u32x4v t0_, t1_; \
                _Pragma("unroll") for (int w_ = 0; w_ < 4; ++w_) { t0_[w_] = (unsigned)__builtin_amdgcn_ds_bpermute(kbp, (int)r0_[w_]); t1_[w_] = (unsigned)__builtin_amdgcn_ds_bpermute(kbp, (int)r1_[w_]); } \
                kx0_ = __builtin_bit_cast(bf16x8, t0_); kx1_ = __builtin_bit_cast(bf16x8, t1_); } \
                \
              pg8::f32x4 ac_[4]; \
              _Pragma("unroll") for (int g = 0; g < 4; ++g) ac_[g] = __builtin_amdgcn_mfma_f32_16x16x32_bf16(qf[g][0], kx0_, (pg8::f32x4){0.f, 0.f, 0.f, 0.f}, 0, 0, 0); \
              _Pragma("unroll") for (int g = 0; g < 4; ++g) ac_[g] = __builtin_amdgcn_mfma_f32_16x16x32_bf16(qf[g][1], kx1_, ac_[g], 0, 0, 0); \
              _Pragma("unroll") for (int g = 0; g < 4; ++g) { \
                const float r0_ = __int_as_float(max(__float_as_int(ac_[g][0]), 0)), r1_ = __int_as_float(max(__float_as_int(ac_[g][1]), 0)), r2_ = __int_as_float(max(__float_as_int(ac_[g][2]), 0)), r3_ = __int_as_float(max(__float_as_int(ac_[g][3]), 0)); \
                float sc_ = wq[g][0] * r0_; sc_ = fmaf(wq[g][1], r1_, sc_); sc_ = fmaf(wq[g][2], r2_, sc_); sc_ = fmaf(wq[g][3], r3_, sc_); \
                *(LAS unsigned short*)(S + (4 * g + kg) * 4096 + 16 * c + c16) = (unsigned short)pkrtz_f16(sc_, 0.f); } } } } while (0)
        { bf16x8 kaA[4][2], kaB[4][2];
          IDX_LOAD(kaA, F.wave);
          for (int c0 = F.wave; c0 < nchunk; c0 += 8 * NWAVES) {
              IDX_LOAD(kaB, c0 + 4 * NWAVES);
              IDX_COMP(kaA, c0);
              IDX_LOAD(kaA, c0 + 8 * NWAVES);
              IDX_COMP(kaB, c0 + 4 * NWAVES);
          } }
#undef IDX_LOAD
#undef IDX_COMP
        __syncthreads();
#pragma unroll 1
        for (int r2 = 0; r2 < 2; ++r2) { const int i = F.wave + 8 * r2, n = q0 + i + 1; unsigned short* lrow = (unsigned short*)BM + (t0 + i) * 256;
            if (n <= 256) { u32x2v w_; w_.x = (unsigned)(4 * plane) | ((unsigned)(4 * plane + 1) << 16); w_.y = (unsigned)(4 * plane + 2) | ((unsigned)(4 * plane + 3) << 16); *(u32x2v*)(lrow + 4 * plane) = w_; }
            else select_row(S + i * 4096, n, plane, hist, lrow); }
        __syncthreads();
    }
}

struct Args { const float* in[11]; float* out; unsigned char* ws; int ph_lo, ph_hi, li, pad; };
__global__ void __launch_bounds__(NWAVES * 64, 2) hyb_fwd(Args args) {
    extern __shared__ __attribute__((aligned(16))) unsigned char lds[];
    Frame F;
    F.lds = (LAS unsigned char*)lds;
    F.MISC = (volatile LAS unsigned*)(F.lds + MISC_OFF);
    F.wave = __builtin_amdgcn_readfirstlane((int)threadIdx.x >> 6);
    F.G = gridDim.x; { const int bx = blockIdx.x; F.vcu = (F.G % 8 == 0) ? (bx % 8) * (F.G / 8) + bx / 8 : bx; }
    F.ws = args.ws; F.ctl = (gu32*)(args.ws + WS_CTL); F.out = args.out;
    for (int u = threadIdx.x; u < (LDS_BYTES - LDSCTL_OFF) / 4; u += NWAVES * 64) ((LAS unsigned*)(F.lds + LDSCTL_OFF))[u] = 0u;
    __syncthreads();
    const bool one_launch = (args.ph_hi - args.ph_lo) > 1;
    XcdBarrier bar; bar.bar = (unsigned*)(F.ctl + CW_BAR); bar.x = 0; bar.st = nullptr;
    if (one_launch) bar = xcd_barrier_post((unsigned*)(F.ctl + CW_BAR), F.MISC + 8);
    const int lo = args.ph_lo, hi = args.ph_hi;
    unsigned char* ws = args.ws;
#ifndef REP_K
#define REP_K -2
#endif
#pragma unroll 1
    for (int ph2 = 2 * lo; ph2 < 2 * hi; ++ph2) {
        const int ph = ph2 >> 1;
        const int l = (ph - 1) / 5, k = (ph == 0) ? -1 : (ph - 1) % 5;
        if ((ph2 & 1) && k != REP_K) continue;
        if (k < 0) {
#ifndef NO_P0
            p0_prologue(F);
            if (blockIdx.x == 0) bias_maxima(F);
#endif
        } else if (k == 0) {
#ifndef NO_P1
            pg8::Gemm g{(const pg8::bf16_t*)(ws + WS_XB), (const pg8::bf16_t*)(ws + WS_WIN) + (size_t)l * NIN * DM, TOK, NIN, DM};
            pg8::StaticOrder S; S.init(TOK, NIN, F.G, (int)blockIdx.x);
            pg8::EpiIn E; E.rss = (const float*)(ws + WS_RSS); E.qna = in_ptr(3) + l * 64; E.kna = in_ptr(4) + l * 64; E.qnb = in_ptr(5) + l * 64; E.knb = in_ptr(6) + l * 64;
            E.QA = (pg8::bf16_t*)(ws + WS_QA); E.KA = (pg8::bf16_t*)(ws + WS_KA); E.VA = (pg8::bf16_t*)(ws + WS_VA); E.SGA = (pg8::bf16_t*)(ws + WS_SGA); E.QB = (pg8::bf16_t*)(ws + WS_QB); E.SGB = (pg8::bf16_t*)(ws + WS_SGB);
            E.KB = (pg8::bf16_t*)(ws + WS_KB); E.VB = (pg8::bf16_t*)(ws + WS_VB); E.KI = (pg8::bf16_t*)(ws + WS_KI); E.QI = (pg8::bf16_t*)(ws + WS_QI); E.SMA = (pg8::bf16_t*)(ws + WS_SMA); E.SMB = (pg8::bf16_t*)(ws + WS_SMB);
            E.WI = (float*)(ws + WS_WI); E.KMP = (float*)(ws + WS_KMP);
            pg8::gemm_phase<pg8::EpiIn, pg8::StaticOrder, true, true>(F.lds, g, S, E);
#endif
        } else if (k == 1) {
#ifndef NO_IDX
#ifdef NAIVE_IDX
            idx_phase_naive(F);
#else
            idx_phase(F);
#endif
#endif
        } else if (k == 2) {
#ifndef NO_ATT
#ifdef NAIVE_ATT
            naive_attn<0>(F, l); __syncthreads(); naive_attn<1>(F, l);
#else
#ifdef CLOCK_PROBE
            if (blockIdx.x == 0 && threadIdx.x == 0 && l == 0) { F.MISC[16] = (unsigned)__builtin_amdgcn_s_memtime(); F.MISC[17] = (unsigned)__builtin_amdgcn_s_memrealtime(); }
#endif
            moba_mask_pass(F, l); xcd_barrier(bar);
            dsa_sparse_phase(F, l); moba_far_phase(F, l); xcd_barrier(bar);
            moba_own_phase(F, l);
#ifdef CLOCK_PROBE
            if (blockIdx.x == 0 && threadIdx.x == 0 && l == 0) { const unsigned dt = (unsigned)__builtin_amdgcn_s_memtime() - F.MISC[16], dr = (unsigned)__builtin_amdgcn_s_memrealtime() - F.MISC[17]; F.MISC[18] = (unsigned)((unsigned long long)dt * 100ull / (dr ? dr : 1u)); }
#endif
#endif
#endif
        } else if (k == 3) {
#ifndef NO_P4
            pg8::Gemm g{(const pg8::bf16_t*)(ws + WS_XB), (const pg8::bf16_t*)(ws + WS_WBR) + (size_t)l * 2048 * AW, 2 * TOK, 2048, AW};
            pg8::PairOrder S; S.init(F.G, (int)blockIdx.x);
            pg8::EpiMerge E{(const pg8::bf16_t*)(ws + WS_SMA), (pg8::bf16_t*)(ws + WS_SMB)};
            pg8::gemm_phase<pg8::EpiMerge, pg8::PairOrder, true, true>(F.lds, g, S, E);
#endif
        } else {
#ifndef NO_P5
            pg8::Gemm g{(const pg8::bf16_t*)(ws + WS_SMB), (const pg8::bf16_t*)(ws + WS_WOUT) + (size_t)l * DM * DM, TOK, DM, DM};
            pg8::StaticOrder S; S.init(TOK, DM, F.G, (int)blockIdx.x);
            if (l == 0) { pg8::EpiOut<true> E{in_ptr(0), F.out, (pg8::bf16_t*)(ws + WS_XB), (float*)(ws + WS_RSS)};
                pg8::gemm_phase<pg8::EpiOut<true>, pg8::StaticOrder, true, true>(F.lds, g, S, E); }
            else { pg8::EpiOut<false> E{F.out, F.out, nullptr, nullptr};
                pg8::gemm_phase<pg8::EpiOut<false>, pg8::StaticOrder, true, true>(F.lds, g, S, E); }
#endif
        }
        if (!((ph == hi - 1) && ((ph2 & 1) || k != REP_K))) xcd_barrier(bar);
    }
#ifdef CLOCK_PROBE
    if (blockIdx.x == 0 && threadIdx.x == 0) {
        const unsigned long long t0 = __builtin_amdgcn_s_memrealtime(); const unsigned long long want = (unsigned long long)F.MISC[18] * 100ull;
        while (__builtin_amdgcn_s_memrealtime() - t0 < want) __builtin_amdgcn_s_sleep(16);
    }
#endif
}

#ifndef N_LAUNCHES
#define N_LAUNCHES 1
#endif
extern "C" void kernel_launch(void* const* d_in, const int* in_sizes, int n_in, void* d_out, int out_size, void* d_ws, size_t ws_size, hipStream_t stream) {
    static int grid = 0;
    if (grid == 0) {
        if (n_in != 11 || in_sizes[0] != TOK * DM || out_size != TOK * DM || ws_size < WS_END) { fprintf(stderr, "kernel_launch: unexpected shapes (n_in %d in0 %d out %d ws %zu)\n", n_in, n_in > 0 ? in_sizes[0] : -1, out_size, ws_size); grid = -1; return; }
        int dev = 0, cus = 0;
        if (hipGetDevice(&dev) != hipSuccess || hipDeviceGetAttribute(&cus, hipDeviceAttributeMultiprocessorCount, dev) != hipSuccess) { grid = -1; return; }
        if (hipFuncSetAttribute((const void*)hyb_fwd, hipFuncAttributeMaxDynamicSharedMemorySize, LDS_BYTES) != hipSuccess) { fprintf(stderr, "kernel_launch: hipFuncSetAttribute failed\n"); grid = -1; return; }
        int per_cu = 0;
        if (hipOccupancyMaxActiveBlocksPerMultiprocessor(&per_cu, (const void*)hyb_fwd, NWAVES * 64, LDS_BYTES) != hipSuccess || per_cu < 1) fprintf(stderr, "kernel_launch: occupancy query says %d\n", per_cu);
        (void)hipGetLastError();
        grid = cus;
    }
    if (grid < 0) return;
    if (hipMemsetAsync((char*)d_ws + WS_CTL, 0, CTL_ZERO_BYTES, stream) != hipSuccess) return;
    Args a{};
    for (int i = 0; i < 11; ++i) a.in[i] = (const float*)d_in[i];
    a.out = (float*)d_out; a.ws = (unsigned char*)d_ws;
    if (N_LAUNCHES == 1) { a.ph_lo = 0; a.ph_hi = NPHASE; a.li = 0; hipLaunchKernelGGL(hyb_fwd, dim3(grid), dim3(NWAVES * 64), LDS_BYTES, stream, a); }
    else for (int li = 0; li < NPHASE; ++li) { a.ph_lo = li; a.ph_hi = li + 1; a.li = li; hipLaunchKernelGGL(hyb_fwd, dim3(grid), dim3(NWAVES * 64), LDS_BYTES, stream, a); }
}
```
